# Optimizing an MI355X kernel written in HIP

```python
import jax, jax.numpy as jnp
from jax import lax
import numpy as np

D_MODEL = 1024
BATCH = 8
SEQ = 8192
DEPTH = 2

CHUNK = 64
MEM_LEN = 256
FOX_HEADS = 8
FOX_HEAD_DIM = 64
FOX_WIDTH = FOX_HEADS * FOX_HEAD_DIM
POOL_WIDTH = D_MODEL - FOX_WIDTH
POOL_WINDOWS = (2, 4, 8, 16)
POOL_GROUPS = len(POOL_WINDOWS)
POOL_GROUP_DIM = POOL_WIDTH // POOL_GROUPS
IN_COLS = 3 * FOX_WIDTH + POOL_WIDTH + FOX_HEADS
MEM_HEADS = 4
MEM_HEAD_DIM = 128
MEM_WIDTH = MEM_HEADS * MEM_HEAD_DIM
D_FF = ((-(-8 * D_MODEL // 3) + 255) // 256) * 256
Q_BLOCK = 128
EPS = 1e-6

kernel_name = "fox_pool_hybrid_encoder"


def rmsnorm(x, g):
    xf = x.astype(jnp.float32)
    y = xf * lax.rsqrt(jnp.mean(xf * xf, axis=-1, keepdims=True) + EPS)
    return (y * g.astype(jnp.float32)).astype(x.dtype)


def forgetting_attention(q, k, v, f_logit):
    c = jnp.cumsum(jax.nn.log_sigmoid(f_logit.astype(jnp.float32)), axis=-1)
    scale = FOX_HEAD_DIM ** -0.5
    S = q.shape[2]
    outs = []
    for start in range(0, S, Q_BLOCK):
        end = start + Q_BLOCK
        qb = q[:, :, start:end]
        kb = k[:, :, :end]
        vb = v[:, :, :end]
        s = jnp.einsum('bhqd,bhkd->bhqk', qb, kb, preferred_element_type=jnp.float32) * scale
        s = s + c[:, :, start:end, None] - c[:, :, None, :end]
        qpos = start + jnp.arange(Q_BLOCK)
        kpos = jnp.arange(end)
        s = jnp.where(kpos[None, :] <= qpos[:, None], s, -jnp.inf)
        p = jax.nn.softmax(s, axis=-1)
        outs.append(jnp.einsum('bhqk,bhkd->bhqd', p.astype(vb.dtype), vb))
    return jnp.concatenate(outs, axis=2)


def multiscale_pool(p, w_pool, pool_scale):
    B, S, _ = p.shape
    pf = p.astype(jnp.float32).reshape(B, S, POOL_GROUPS, POOL_GROUP_DIM)
    cs = jnp.concatenate([jnp.zeros((B, 1, POOL_GROUPS, POOL_GROUP_DIM), jnp.float32),
                          jnp.cumsum(pf, axis=1)], axis=1)
    t = jnp.arange(S)
    outs = []
    for g, w in enumerate(POOL_WINDOWS):
        csg = cs[:, :, g]
        lower = jnp.pad(csg, ((0, 0), (w - 1, 0), (0, 0)))[:, :S]
        cnt = jnp.minimum(t + 1, w).astype(jnp.float32)[None, :, None]
        mixed = (csg[:, 1:] - lower) / cnt - pf[:, :, g]
        outs.append(jnp.einsum('bsc,cd->bsd', mixed, w_pool[g].astype(jnp.float32)))
    y = jnp.concatenate(outs, axis=-1) * pool_scale.astype(jnp.float32)
    return y.astype(p.dtype)


def head_split(t, n_heads, head_dim):
    B, S, _ = t.shape
    return t.reshape(B, S, n_heads, head_dim)


def setup_inputs(seed: int = 0) -> dict:
    key = jax.random.key(seed)
    ks = jax.random.split(key, 24)
    f32 = jnp.float32
    D = D_MODEL

    def nrm(k, shape, fan_in):
        return jax.random.normal(k, shape, f32) * (fan_in ** -0.5)

    def gain(k, shape):
        return 1.0 + 0.05 * jax.random.normal(k, shape, f32)

    return {
        "x": jax.random.normal(ks[0], (BATCH, SEQ, D), f32),
        "mem": jax.random.normal(ks[1], (BATCH, MEM_LEN, D), f32),
        "g_mix": gain(ks[2], (DEPTH, D)),
        "w_in": nrm(ks[3], (DEPTH, D, IN_COLS), D),
        "b_forget": 3.0 + 0.5 * jax.random.normal(ks[4], (DEPTH, FOX_HEADS), f32),
        "g_q_fox": gain(ks[5], (DEPTH, FOX_HEAD_DIM)),
        "g_k_fox": gain(ks[6], (DEPTH, FOX_HEAD_DIM)),
        "w_pool": nrm(ks[7], (DEPTH, POOL_GROUPS, POOL_GROUP_DIM, POOL_GROUP_DIM), POOL_GROUP_DIM),
        "pool_scale": gain(ks[8], (DEPTH, POOL_WIDTH)),
        "w_out": nrm(ks[9], (DEPTH, D, D), D),
        "g_mem_q": gain(ks[10], (DEPTH, D)),
        "g_mem_kv": gain(ks[11], (DEPTH, D)),
        "w_mem_q": nrm(ks[12], (DEPTH, D, MEM_WIDTH), D),
        "w_mem_kv": nrm(ks[13], (DEPTH, D, 2 * MEM_WIDTH), D),
        "g_q_mem": gain(ks[14], (DEPTH, MEM_HEAD_DIM)),
        "g_k_mem": gain(ks[15], (DEPTH, MEM_HEAD_DIM)),
        "w_mem_out": nrm(ks[16], (DEPTH, MEM_WIDTH, D), MEM_WIDTH),
        "g_ffn": gain(ks[17], (DEPTH, D)),
        "w_gate_up": nrm(ks[18], (DEPTH, D, 2 * D_FF), D),
        "w_down": nrm(ks[19], (DEPTH, D_FF, D), D_FF),
    }


def reference(x, mem, g_mix, w_in, b_forget, g_q_fox, g_k_fox, w_pool, pool_scale, w_out,
              g_mem_q, g_mem_kv, w_mem_q, w_mem_kv, g_q_mem, g_k_mem, w_mem_out,
              g_ffn, w_gate_up, w_down):
    B, S, _ = x.shape
    h = x
    for l in range(DEPTH):
        xn = rmsnorm(h, g_mix[l])
        z = jnp.einsum('bsd,dc->bsc', xn, w_in[l])
        q = z[..., :FOX_WIDTH]
        k = z[..., FOX_WIDTH:2 * FOX_WIDTH]
        v = z[..., 2 * FOX_WIDTH:3 * FOX_WIDTH]
        p_in = z[..., 3 * FOX_WIDTH:3 * FOX_WIDTH + POOL_WIDTH]
        f_logit = z[..., 3 * FOX_WIDTH + POOL_WIDTH:] + b_forget[l]
        q = rmsnorm(head_split(q, FOX_HEADS, FOX_HEAD_DIM), g_q_fox[l]).transpose(0, 2, 1, 3)
        k = rmsnorm(head_split(k, FOX_HEADS, FOX_HEAD_DIM), g_k_fox[l]).transpose(0, 2, 1, 3)
        v = head_split(v, FOX_HEADS, FOX_HEAD_DIM).transpose(0, 2, 1, 3)
        fox = forgetting_attention(q, k, v, f_logit.transpose(0, 2, 1))
        fox = fox.transpose(0, 2, 1, 3).reshape(B, S, FOX_WIDTH)
        pool = multiscale_pool(p_in, w_pool[l], pool_scale[l])
        h = h + jnp.einsum('bsc,cd->bsd', jnp.concatenate([fox, pool], axis=-1), w_out[l])

        hn = rmsnorm(h, g_mem_q[l])
        mn = rmsnorm(mem, g_mem_kv[l])
        mq = rmsnorm(head_split(jnp.einsum('bsd,dc->bsc', hn, w_mem_q[l]), MEM_HEADS, MEM_HEAD_DIM), g_q_mem[l])
        mkv = jnp.einsum('bmd,dc->bmc', mn, w_mem_kv[l])
        mk = rmsnorm(head_split(mkv[..., :MEM_WIDTH], MEM_HEADS, MEM_HEAD_DIM), g_k_mem[l])
        mv = head_split(mkv[..., MEM_WIDTH:], MEM_HEADS, MEM_HEAD_DIM)
        sc = jnp.einsum('bshd,bmhd->bhsm', mq, mk, preferred_element_type=jnp.float32) * (MEM_HEAD_DIM ** -0.5)
        pm = jax.nn.softmax(sc, axis=-1).astype(mv.dtype)
        mo = jnp.einsum('bhsm,bmhd->bshd', pm, mv).reshape(B, S, MEM_WIDTH)
        h = h + jnp.einsum('bsc,cd->bsd', mo, w_mem_out[l])

        hn = rmsnorm(h, g_ffn[l])
        gu = jnp.einsum('bsd,df->bsf', hn, w_gate_up[l])
        act = jax.nn.silu(gu[..., :D_FF]) * gu[..., D_FF:]
        h = h + jnp.einsum('bsf,fd->bsd', act, w_down[l])
    return h
```

```cpp
#include <hip/hip_runtime.h>
#include <hip/hip_cooperative_groups.h>
#include <cstdio>
#include <cstdint>
#include <cstddef>
namespace pg8 {
#define PG8_LAS __attribute__((address_space(3)))
typedef unsigned short bf16_t;
typedef short bf16x8 __attribute__((ext_vector_type(8)));
typedef float f32x4 __attribute__((ext_vector_type(4)));
typedef unsigned u32x4 __attribute__((ext_vector_type(4)));
constexpr int BM = 256, BK = 64, HALF = 128, HTB = HALF * BK * 2  , STAGE_BYTES = 8 * HTB, NXCD = 8, WGM = 8;

__host__ __device__ __forceinline__ int lds_byte(int r, int c) { const int st = (r >> 4) * 2 + (c >> 5), rr = r & 15, cc = c & 31, ob = rr * 64 + cc * 2; return st * 1024 + (ob ^ (((ob >> 9) & 1) << 5)); }
__host__ __device__ __forceinline__ void stage_rc(int b, int& R, int& C) { const int st = b / 1024, sb = b % 1024, swz = sb ^ (((sb >> 9) & 1) << 5); R = (st >> 1) * 16 + swz / 64; C = (st & 1) * 32 + (swz % 64) / 2; }
__host__ __device__ __forceinline__ int perm32(int rho) { const int n = rho >> 4, i = rho & 15; return 8 * (i >> 2) + 4 * n + (i & 3); }

struct Unit { int pm, pn; };
struct Gemm { const bf16_t* A; const bf16_t* Bt; int M, N, K; };

struct StaticOrder {
    int nM, nN, nwg, G, c;
    __host__ __device__ void init(int M, int N, int G_, int c_) { nM = M / BM; nN = N / BM; nwg = nM * nN; G = G_; c = c_; }
    __host__ __device__ bool next(int i, Unit& u) const {
        const long L = (long)i * G + c; if (L >= nwg) return false;
        int wgid = (int)L; { const int q = nwg / NXCD, r = nwg % NXCD, xcd = wgid % NXCD, off = wgid / NXCD; wgid = (xcd < r ? xcd * (q + 1) : r * (q + 1) + (xcd - r) * q) + off; }
        const int nig = WGM * nN, gid = wgid / nig, fm = gid * WGM, gsz = (nM - fm) < WGM ? (nM - fm) : WGM;
        u.pm = fm + ((wgid % nig) % gsz); u.pn = (wgid % nig) / gsz; return true;
    }
    __device__ __forceinline__ void a_ready(const Unit&) const {}
    __device__ __forceinline__ void done(const Unit&) const {}
};

__device__ __forceinline__ unsigned cvt_pk_bf16(float lo, float hi) { unsigned r; asm volatile("v_cvt_pk_bf16_f32 %0, %1, %2" : "=v"(r) : "v"(lo), "v"(hi)); return r; }
typedef unsigned u32x2 __attribute__((ext_vector_type(2)));
constexpr float RMS_EPS = 1e-6f;
constexpr float LOG2E = 1.4426950408889634f;
__device__ __forceinline__ void epi_bar() { asm volatile("s_waitcnt lgkmcnt(0)\n\ts_barrier" ::: "memory"); }
__device__ __forceinline__ float sum4(f32x4 a) { return (a[0] + a[1]) + (a[2] + a[3]); }
__device__ __forceinline__ float sumsq4(f32x4 v) { return (v[0] * v[0] + v[1] * v[1]) + (v[2] * v[2] + v[3] * v[3]); }
__device__ __forceinline__ float rstd_row(const float* ssq, int row) {
    const f32x4* p = (const f32x4*)(ssq + (size_t)row * 16);
    const f32x4 a = p[0], b = p[1], c = p[2], d = p[3];
    return __builtin_amdgcn_rsqf(((sum4(a) + sum4(b)) + (sum4(c) + sum4(d))) * (1.0f / 1024.0f) + RMS_EPS);
}
__device__ __forceinline__ void rstd_to_lds(const float* ssq, int row0, PG8_LAS float* RS) {
    const int t = threadIdx.x; if (t < 256) RS[t] = rstd_row(ssq, row0 + t);
}
__device__ __forceinline__ u32x4 pack8(f32x4 a, f32x4 b) { u32x4 w; w.x = cvt_pk_bf16(a[0], a[1]); w.y = cvt_pk_bf16(a[2], a[3]); w.z = cvt_pk_bf16(b[0], b[1]); w.w = cvt_pk_bf16(b[2], b[3]); return w; }
__device__ __forceinline__ float log2sigmoid(float x) { return LOG2E * (fminf(x, 0.f) - log1pf(expf(-fabsf(x)))); }

struct EpiResid {
    static constexpr bool PERM = false, AFTER_DRAIN = false;
    const float* base; float* out; bf16_t* hb; float* ssq;
    __device__ __forceinline__ void operator()(const f32x4 (&acc)[2][2][4][2], const Unit& u, int wr, int wc, int fr, int fq) const {
        const int col0 = u.pn * BM + wc * 32 + 4 * fq;
#pragma unroll
        for (int ai = 0; ai < 2; ++ai)
#pragma unroll
            for (int m = 0; m < 4; ++m) {
                const int row = u.pm * BM + ai * HALF + wr * 64 + m * 16 + fr; const size_t off = (size_t)row * 1024 + col0; float s = 0.f;
#pragma unroll
                for (int bj = 0; bj < 2; ++bj)
#pragma unroll
                    for (int n = 0; n < 2; ++n) {
                        const f32x4 bs = *(const f32x4*)(base + off + bj * HALF + n * 16); const f32x4 o = bs + acc[ai][bj][m][n];
                        *(f32x4*)(out + off + bj * HALF + n * 16) = o; s += sumsq4(o);
                        u32x2 w; w.x = cvt_pk_bf16(o[0], o[1]); w.y = cvt_pk_bf16(o[2], o[3]); *(u32x2*)(hb + off + bj * HALF + n * 16) = w; }
                s += __shfl_xor(s, 16); s += __shfl_xor(s, 32);
                if (fq == 0) ssq[(size_t)row * 16 + u.pn * 4 + wc] = s;
                if (m & 1) asm volatile("" ::: "memory");
            }
    }
};

struct EpiInProj {
    static constexpr bool PERM = true, AFTER_DRAIN = false;
    const float* ssq; bf16_t *Q, *K, *V, *P; float* LF; const float *gq, *gk, *bfg; PG8_LAS float* X; float qscale;
    __device__ __forceinline__ void operator()(const f32x4 (&acc)[2][2][4][2], const Unit& u, int wr, int wc, int fr, int fq) const {
        const int pn = u.pn, rl0 = wr * 64 + fr; PG8_LAS float* RS = X + 2048;
        rstd_to_lds(ssq, u.pm * BM, RS);
        if (pn < 4) {
#pragma unroll
            for (int ai = 0; ai < 2; ++ai)
#pragma unroll
                for (int m = 0; m < 4; ++m)
#pragma unroll
                    for (int bj = 0; bj < 2; ++bj) { float s = sumsq4(acc[ai][bj][m][0]) + sumsq4(acc[ai][bj][m][1]);
                        s += __shfl_xor(s, 16); s += __shfl_xor(s, 32);
                        if (fq == 0) X[(ai * HALF + rl0 + m * 16) * 8 + bj * 4 + wc] = s; }
        }
        epi_bar();
        if (pn < 4) {
            const float* g = (pn < 2) ? gq : gk; const float extra = (pn < 2) ? qscale : 1.0f; bf16_t* O = (pn < 2) ? Q : K;
            const int dcol = (wc & 1) * 32 + 8 * fq; const f32x4 g0 = *(const f32x4*)(g + dcol) * extra, g1 = *(const f32x4*)(g + dcol + 4) * extra;
            const int colb = (pn & 1) * 256 + wc * 32 + 8 * fq;
#pragma unroll
            for (int ai = 0; ai < 2; ++ai)
#pragma unroll
                for (int m = 0; m < 4; ++m) { const int rl = ai * HALF + rl0 + m * 16; bf16_t* rowp = O + (size_t)(u.pm * BM + rl) * 512 + colb; const float rsv = RS[rl];
#pragma unroll
                    for (int bj = 0; bj < 2; ++bj) { const float hs = X[rl * 8 + bj * 4 + (wc & 2)] + X[rl * 8 + bj * 4 + (wc & 2) + 1];
                        const float sc = rsv * __builtin_amdgcn_rsqf(hs * rsv * rsv * (1.0f / 64.0f) + RMS_EPS);
                        *(u32x4*)(rowp + bj * HALF) = pack8(acc[ai][bj][m][0] * sc * g0, acc[ai][bj][m][1] * sc * g1); }
                    asm volatile("" ::: "memory"); }
        } else if (pn < 8) {
            bf16_t* O = (pn < 6) ? V : P; const int colb = (pn & 1) * 256 + wc * 32 + 8 * fq;
#pragma unroll
            for (int ai = 0; ai < 2; ++ai)
#pragma unroll
                for (int m = 0; m < 4; ++m) { bf16_t* rowp = O + (size_t)(u.pm * BM + ai * HALF + rl0 + m * 16) * 512 + colb; const float rsv = RS[ai * HALF + rl0 + m * 16];
#pragma unroll
                    for (int bj = 0; bj < 2; ++bj) *(u32x4*)(rowp + bj * HALF) = pack8(acc[ai][bj][m][0] * rsv, acc[ai][bj][m][1] * rsv);
                    asm volatile("" ::: "memory"); }
        } else {
            if (wc == 0 && fq == 0) {
                const f32x4 b0 = *(const f32x4*)(bfg), b1 = *(const f32x4*)(bfg + 4);
#pragma unroll
                for (int ai = 0; ai < 2; ++ai)
#pragma unroll
                    for (int m = 0; m < 4; ++m) { float* lp = LF + (size_t)(u.pm * BM + ai * HALF + rl0 + m * 16) * 8; const float rsv = RS[ai * HALF + rl0 + m * 16];
                        const f32x4 z0 = acc[ai][0][m][0] * rsv + b0, z1 = acc[ai][0][m][1] * rsv + b1;
                        *(f32x4*)(lp) = (f32x4){log2sigmoid(z0[0]), log2sigmoid(z0[1]), log2sigmoid(z0[2]), log2sigmoid(z0[3])};
                        *(f32x4*)(lp + 4) = (f32x4){log2sigmoid(z1[0]), log2sigmoid(z1[1]), log2sigmoid(z1[2]), log2sigmoid(z1[3])}; }
            }
        }
    }
};

template <int MODE> struct EpiHead128 {
    static constexpr bool PERM = true, AFTER_DRAIN = false;
    const float* ssq; bf16_t* O; bf16_t* O2; const float* g; PG8_LAS float* X; float oscale;
    __device__ __forceinline__ void operator()(const f32x4 (&acc)[2][2][4][2], const Unit& u, int wr, int wc, int fr, int fq) const {
        const int pn = u.pn, rl0 = wr * 64 + fr; PG8_LAS float* RS = X + 2048;
        if (MODE == 0) rstd_to_lds(ssq, u.pm * BM, RS);
        if (MODE == 0 || pn < 2) {
#pragma unroll
            for (int ai = 0; ai < 2; ++ai)
#pragma unroll
                for (int m = 0; m < 4; ++m)
#pragma unroll
                    for (int bj = 0; bj < 2; ++bj) { float s = sumsq4(acc[ai][bj][m][0]) + sumsq4(acc[ai][bj][m][1]);
                        s += __shfl_xor(s, 16); s += __shfl_xor(s, 32);
                        if (fq == 0) X[(ai * HALF + rl0 + m * 16) * 8 + bj * 4 + wc] = s; }
            epi_bar();
            const int d0 = wc * 32 + 8 * fq; const f32x4 g0 = *(const f32x4*)(g + d0) * oscale, g1 = *(const f32x4*)(g + d0 + 4) * oscale;
#pragma unroll
            for (int ai = 0; ai < 2; ++ai)
#pragma unroll
                for (int m = 0; m < 4; ++m) { const int rl = ai * HALF + rl0 + m * 16; const float rsv = (MODE == 0) ? RS[rl] : 1.0f;
#pragma unroll
                    for (int bj = 0; bj < 2; ++bj) { const f32x4 xs = *(const PG8_LAS f32x4*)(X + rl * 8 + bj * 4);
                        const float sc = rsv * __builtin_amdgcn_rsqf(sum4(xs) * rsv * rsv * (1.0f / 128.0f) + RMS_EPS);
                        bf16_t* dst = (MODE == 0) ? O + (size_t)(u.pm * BM + rl) * 512 + pn * 256 + bj * HALF + d0
                                                  : O + ((size_t)(u.pm * 4 + 2 * pn + bj) * 256 + rl) * 128 + d0;
                        *(u32x4*)dst = pack8(acc[ai][bj][m][0] * sc * g0, acc[ai][bj][m][1] * sc * g1); }
                    asm volatile("" ::: "memory"); }
        } else {
            const int d0 = wc * 32 + 8 * fq;
#pragma unroll
            for (int ai = 0; ai < 2; ++ai)
#pragma unroll
                for (int m = 0; m < 4; ++m) { const int rl = ai * HALF + rl0 + m * 16;
#pragma unroll
                    for (int bj = 0; bj < 2; ++bj) { bf16_t* dst = O2 + ((size_t)(u.pm * 4 + 2 * (pn - 2) + bj) * 128 + d0) * 256 + rl;
                        const u32x4 w = pack8(acc[ai][bj][m][0], acc[ai][bj][m][1]);
                        dst[0 * 256] = (bf16_t)(w.x & 0xffffu); dst[1 * 256] = (bf16_t)(w.x >> 16); dst[2 * 256] = (bf16_t)(w.y & 0xffffu); dst[3 * 256] = (bf16_t)(w.y >> 16);
                        dst[4 * 256] = (bf16_t)(w.z & 0xffffu); dst[5 * 256] = (bf16_t)(w.z >> 16); dst[6 * 256] = (bf16_t)(w.w & 0xffffu); dst[7 * 256] = (bf16_t)(w.w >> 16); }
                    asm volatile("" ::: "memory"); }
        }
    }
};

struct EpiSwiglu {
    static constexpr bool PERM = true, AFTER_DRAIN = false;
    const float* ssq; bf16_t* ACT; PG8_LAS float* X;
    __device__ __forceinline__ static f32x4 swi(f32x4 gt, f32x4 up) { f32x4 r;
#pragma unroll
        for (int j = 0; j < 4; ++j) { const float e = __builtin_amdgcn_exp2f(-LOG2E * gt[j]); r[j] = gt[j] * __builtin_amdgcn_rcpf(1.0f + e) * up[j]; }
        return r; }
    __device__ __forceinline__ void operator()(const f32x4 (&acc)[2][2][4][2], const Unit& u, int wr, int wc, int fr, int fq) const {
        const int rl0 = wr * 64 + fr, colb = u.pn * 128 + wc * 32 + 8 * fq; PG8_LAS float* RS = X + 2048;
        rstd_to_lds(ssq, u.pm * BM, RS); epi_bar();
#pragma unroll
        for (int ai = 0; ai < 2; ++ai)
#pragma unroll
            for (int m = 0; m < 4; ++m) { const int row = u.pm * BM + ai * HALF + rl0 + m * 16; const float rs = RS[ai * HALF + rl0 + m * 16];
                const f32x4 a0 = swi(acc[ai][0][m][0] * rs, acc[ai][1][m][0] * rs), a1 = swi(acc[ai][0][m][1] * rs, acc[ai][1][m][1] * rs);
                *(u32x4*)(ACT + (size_t)row * 2816 + colb) = pack8(a0, a1); asm volatile("" ::: "memory"); }
    }
};

struct RangeOrder {
    int nN, c0, n, c;
    __host__ __device__ bool next(int i, Unit& u) const { const int k = c - c0; if (i != 0 || k < 0 || k >= n) return false; u.pm = k / nN; u.pn = k % nN; return true; }
    __device__ __forceinline__ void a_ready(const Unit&) const {}
    __device__ __forceinline__ void done(const Unit&) const {}
};
template <class Epi, class Sched, bool ALIGN_EPI = false, bool SP2 = false>
__device__ __forceinline__ void gemm_phase(PG8_LAS unsigned char* lds, const Gemm g, const Sched& S, const Epi& E) {
    int tid_l = threadIdx.x; asm volatile("" : "+v"(tid_l));
    const int tid = tid_l, wid = __builtin_amdgcn_readfirstlane(tid >> 6), lane = tid & 63, wr = wid >> 2, wc = wid & 3, fr = lane & 15, fq = lane >> 4;
    const int K = g.K, nt = K / BK;
    unsigned voffA[2], voffB[2];
#pragma unroll
    for (int i = 0; i < 2; ++i) { int R, C; stage_rc(tid * 16 + i * 8192, R, C); const int Rb = Epi::PERM ? ((R & ~31) + perm32(R & 31)) : R;
        voffA[i] = (unsigned)(R * K + C) * 2u; voffB[i] = (unsigned)(Rb * K + C) * 2u; }
    const size_t kstep = (size_t)(BK * 2);
    const size_t hstep = (size_t)HALF * K * 2;
    const size_t tstep = 2 * hstep;
    const unsigned ldsw = (unsigned)wid * 1024u;
    const int aoff = lds_byte(wr * 64 + fr, fq * 8), boff = lds_byte(wc * 32 + fr, fq * 8);
#define PG8_SA(b, h) (((b) * 2 + (h)) * HTB)
#define PG8_SB(b, h) ((4 + (b) * 2 + (h)) * HTB)
#define PG8_STAGE(bufoff, gbase, voff) do { _Pragma("unroll") for (int _i = 0; _i < 2; ++_i) \
        __builtin_amdgcn_global_load_lds((const unsigned*)((const char*)(gbase) + (voff)[_i]), (PG8_LAS unsigned*)(lds + (bufoff) + ldsw + _i * 8192), 16, 0, 0); } while (0)
#define PG8_LDA(dst, b, h) do { _Pragma("unroll") for (int m = 0; m < 4; ++m) _Pragma("unroll") for (int k = 0; k < 2; ++k) dst[m][k] = *(const PG8_LAS bf16x8*)(lds + PG8_SA(b, h) + aoff + m * 2048 + k * 1024); } while (0)
#define PG8_LDB(dst, b, h) do { _Pragma("unroll") for (int n = 0; n < 2; ++n) _Pragma("unroll") for (int k = 0; k < 2; ++k) dst[n][k] = *(const PG8_LAS bf16x8*)(lds + PG8_SB(b, h) + boff + n * 2048 + k * 1024); } while (0)
#define PG8_MMA(ai, bj, At, Bt) do { __builtin_amdgcn_s_setprio(1); _Pragma("unroll") for (int m = 0; m < 4; ++m) _Pragma("unroll") for (int n = 0; n < 2; ++n) _Pragma("unroll") for (int k = 0; k < 2; ++k) \
        acc[ai][bj][m][n] = __builtin_amdgcn_mfma_f32_16x16x32_bf16(Bt[n][k], At[m][k], acc[ai][bj][m][n], 0, 0, 0); __builtin_amdgcn_s_setprio(0); } while (0)
#define PG8_WAIT_V(n) asm volatile("s_waitcnt vmcnt(" #n ")" ::: "memory")
#define PG8_WAIT_L(n) asm volatile("s_waitcnt lgkmcnt(" #n ")" ::: "memory")
#define PG8_BAR __builtin_amdgcn_s_barrier()
#define PG8_SCHED __builtin_amdgcn_sched_barrier(0)
    Unit cur, nxt; int ui = 0;
    if (!S.next(0, cur)) return;
    f32x4 acc[2][2][4][2];
#pragma unroll
    for (int a = 0; a < 2; ++a)
#pragma unroll
        for (int b = 0; b < 2; ++b)
#pragma unroll
            for (int m = 0; m < 4; ++m)
#pragma unroll
                for (int n = 0; n < 2; ++n) acc[a][b][m][n] = (f32x4){0.f, 0.f, 0.f, 0.f};
    bf16x8 At[4][2], B0[2][2], B1[2][2];
    const char* cA = (const char*)g.A + (size_t)cur.pm * tstep; const char* cB = (const char*)g.Bt + (size_t)cur.pn * tstep;
    S.a_ready(cur);
    if constexpr (SP2) {
        PG8_STAGE(PG8_SB(0, 0), cB, voffB); PG8_STAGE(PG8_SB(0, 1), cB + hstep, voffB); PG8_STAGE(PG8_SA(0, 0), cA, voffA); PG8_STAGE(PG8_SA(0, 1), cA + hstep, voffA);
        if (wr == 1) PG8_BAR;
        PG8_WAIT_V(2); PG8_BAR;
        PG8_STAGE(PG8_SB(1, 0), cB + kstep, voffB); PG8_STAGE(PG8_SA(1, 0), cA + kstep, voffA); PG8_STAGE(PG8_SB(1, 1), cB + hstep + kstep, voffB);
        PG8_WAIT_V(6); PG8_BAR;
    } else {
        PG8_STAGE(PG8_SB(0, 0), cB, voffB); PG8_STAGE(PG8_SA(0, 0), cA, voffA); PG8_STAGE(PG8_SB(0, 1), cB + hstep, voffB); PG8_STAGE(PG8_SA(0, 1), cA + hstep, voffA);
        if (wr == 1) PG8_BAR;
        PG8_WAIT_V(4); PG8_BAR;
        PG8_STAGE(PG8_SB(1, 0), cB + kstep, voffB); PG8_STAGE(PG8_SA(1, 0), cA + kstep, voffA); PG8_STAGE(PG8_SB(1, 1), cB + hstep + kstep, voffB);
        PG8_WAIT_V(6); PG8_BAR;
    }
    for (;;) {
        const bool has_next = S.next(ui + 1, nxt);
        const char* nA = has_next ? (const char*)g.A + (size_t)nxt.pm * tstep : cA; const char* nB = has_next ? (const char*)g.Bt + (size_t)nxt.pn * tstep : cB;
        for (int t = 0; t < nt; t += 2) {
            const bool last = (t == nt - 2);
            const char* a1 = cA + (size_t)(t + 1) * kstep;
            const char* a2 = last ? nA : cA + (size_t)(t + 2) * kstep; const char* b2 = last ? nB : cB + (size_t)(t + 2) * kstep;
            const char* a3 = a2 + kstep; const char* b3 = b2 + kstep;
            if (last && has_next) S.a_ready(nxt);
            if constexpr (SP2) {
            PG8_LDB(B0, 0, 0); PG8_LDB(B1, 0, 1); PG8_SCHED; PG8_LDA(At, 0, 0); PG8_STAGE(PG8_SA(1, 1), a1 + hstep, voffA);
            PG8_WAIT_V(8); PG8_WAIT_L(0); PG8_BAR; PG8_MMA(0, 0, At, B0); PG8_MMA(0, 1, At, B1); PG8_BAR; PG8_SCHED;
            PG8_LDA(At, 0, 1); PG8_STAGE(PG8_SB(0, 0), b2, voffB); PG8_STAGE(PG8_SB(0, 1), b2 + hstep, voffB); PG8_STAGE(PG8_SA(0, 0), a2, voffA);
            PG8_WAIT_V(8); PG8_WAIT_L(0); PG8_BAR; PG8_MMA(1, 0, At, B0); PG8_MMA(1, 1, At, B1); PG8_BAR; PG8_SCHED;
            PG8_LDB(B0, 1, 0); PG8_LDB(B1, 1, 1); PG8_SCHED; PG8_LDA(At, 1, 0); PG8_STAGE(PG8_SA(0, 1), a2 + hstep, voffA);
            PG8_WAIT_V(8); PG8_WAIT_L(0); PG8_BAR; PG8_MMA(0, 0, At, B0); PG8_MMA(0, 1, At, B1); PG8_BAR; PG8_SCHED;
            PG8_LDA(At, 1, 1); PG8_STAGE(PG8_SB(1, 0), b3, voffB); PG8_STAGE(PG8_SB(1, 1), b3 + hstep, voffB); PG8_STAGE(PG8_SA(1, 0), a3, voffA);
            PG8_WAIT_V(8); PG8_WAIT_L(0); PG8_BAR; PG8_MMA(1, 0, At, B0); PG8_MMA(1, 1, At, B1); PG8_BAR; PG8_SCHED;
            } else {
            PG8_LDB(B0, 0, 0); PG8_SCHED; PG8_LDA(At, 0, 0); PG8_STAGE(PG8_SA(1, 1), a1 + hstep, voffA);
            PG8_WAIT_L(8); PG8_BAR; PG8_WAIT_L(0); PG8_MMA(0, 0, At, B0); PG8_BAR; PG8_SCHED;
            PG8_LDB(B1, 0, 1); PG8_STAGE(PG8_SB(0, 0), b2, voffB);
            PG8_BAR; PG8_WAIT_L(0); PG8_MMA(0, 1, At, B1); PG8_BAR;
            PG8_LDA(At, 0, 1); PG8_STAGE(PG8_SA(0, 0), a2, voffA);
            PG8_BAR; PG8_WAIT_L(0); PG8_MMA(1, 0, At, B0); PG8_BAR; PG8_SCHED;
            PG8_STAGE(PG8_SB(0, 1), b2 + hstep, voffB);
            PG8_WAIT_V(6); PG8_BAR; PG8_MMA(1, 1, At, B1); PG8_BAR;
            PG8_LDB(B0, 1, 0); PG8_SCHED; PG8_LDA(At, 1, 0); PG8_STAGE(PG8_SA(0, 1), a2 + hstep, voffA);
            PG8_WAIT_L(8); PG8_BAR; PG8_WAIT_L(0); PG8_MMA(0, 0, At, B0); PG8_BAR; PG8_SCHED;
            PG8_LDB(B1, 1, 1); PG8_STAGE(PG8_SB(1, 0), b3, voffB);
            PG8_BAR; PG8_WAIT_L(0); PG8_MMA(0, 1, At, B1); PG8_BAR;
            PG8_LDA(At, 1, 1); PG8_STAGE(PG8_SA(1, 0), a3, voffA);
            PG8_BAR; PG8_WAIT_L(0); PG8_MMA(1, 0, At, B0); PG8_BAR; PG8_SCHED;
            PG8_STAGE(PG8_SB(1, 1), b3 + hstep, voffB);
            PG8_WAIT_V(6); PG8_BAR; PG8_MMA(1, 1, At, B1); PG8_BAR;
            }
        }
        if constexpr (ALIGN_EPI) { if (wr == 0) PG8_BAR; }
        if constexpr (!Epi::AFTER_DRAIN) { E(acc, cur, wr, wc, fr, fq); S.done(cur); }
        if (!has_next) break;
#pragma unroll
        for (int a = 0; a < 2; ++a)
#pragma unroll
            for (int b = 0; b < 2; ++b)
#pragma unroll
                for (int m = 0; m < 4; ++m)
#pragma unroll
                    for (int n = 0; n < 2; ++n) acc[a][b][m][n] = (f32x4){0.f, 0.f, 0.f, 0.f};
        cur = nxt; cA = nA; cB = nB; ++ui;
        if constexpr (ALIGN_EPI) { if (wr == 1) PG8_BAR; }
    }
    PG8_WAIT_V(0);
    if constexpr (!ALIGN_EPI) { if (wr == 0) PG8_BAR; }
    PG8_BAR;
    if constexpr (Epi::AFTER_DRAIN) { E.fused(acc, cur, wr, wc, fr, fq, lds, wid, lane); S.done(cur); }
#undef PG8_SA
#undef PG8_SB
#undef PG8_STAGE
#undef PG8_LDA
#undef PG8_LDB
#undef PG8_MMA
#undef PG8_WAIT_V
#undef PG8_WAIT_L
#undef PG8_BAR
#undef PG8_SCHED
}
}
#include <hip/hip_bf16.h>
#include <cmath>
namespace attn_body {
using bf16=__hip_bfloat16;
using bf16x8=__attribute__((ext_vector_type(8)))short;
using s16x4=__attribute__((ext_vector_type(4)))short;
using f32x16=__attribute__((ext_vector_type(16)))float;
using u32x4=__attribute__((ext_vector_type(4)))unsigned;
using f32x4v=__attribute__((ext_vector_type(4)))float;
typedef const __attribute__((address_space(3))) f32x4v* lds_f4p;
constexpr int BATCH=8,NHEAD=8,SEQ=8192,D=64,DM=NHEAD*D,OPITCH=1024;
constexpr int NW=8,QBLK=32,QB=QBLK*NW,KVBLK=64,NQB=SEQ/QB;
constexpr int ATTN_PITCH=DM, ATTN_UNIT_ROWS=QB;
__device__ __forceinline__ int crow(int r,int hi){return (r&3)+8*(r>>2)+4*hi;}
#define SBAR() __builtin_amdgcn_sched_barrier(0)
__device__ __forceinline__ void cmask(f32x16&p0,f32x16&p1,int jb,int qrel,int hi){
  const float NEG=-INFINITY; int kb=64*jb+4*hi;
  #pragma unroll
  for(int r=0;r<16;++r){int kv=kb+(r&3)+8*(r>>2); if(kv>qrel)p0[r]=NEG; if(kv+32>qrel)p1[r]=NEG;}
}

constexpr int NSLOT=3, SLOTB=8192;
constexpr int LDS_K=0, LDS_V=NSLOT*SLOTB, LDS_WS=2*NSLOT*SLOTB, LDS_OST=LDS_WS+NW*64*4, LDS_C2=LDS_OST+NW*4096, LDS_BYTES=LDS_C2+SEQ*4;
constexpr float C2=0.125f*1.4426950408889634f;
__device__ __forceinline__ void glds16(const void*gsrc,unsigned lds_dst){unsigned keep;
  asm volatile("s_mov_b32 %0, m0\n\ts_mov_b32 m0, %2\n\ts_nop 0\n\tglobal_load_lds_dwordx4 %1, off\n\ts_mov_b32 m0, %0":"=&s"(keep):"v"(gsrc),"s"(lds_dst):"memory");}
__device__ __forceinline__ float max3f(float a,float b,float c){float r;asm("v_max3_f32 %0, %1, %2, %3":"=v"(r):"v"(a),"v"(b),"v"(c));return r;}
__device__ __forceinline__ float max2f(float a,float b){float r;asm("v_max_f32_e32 %0, %1, %2":"=v"(r):"v"(a),"v"(b));return r;}
__device__ __forceinline__ float fadd_s(float a,float b){float r;asm("v_add_f32_e32 %0, %1, %2":"=v"(r):"v"(a),"v"(b));return r;}
__device__ __forceinline__ float fsub_s(float a,float b){float r;asm("v_sub_f32_e32 %0, %1, %2":"=v"(r):"v"(a),"v"(b));return r;}
typedef float f32x2_t __attribute__((ext_vector_type(2))); typedef __bf16 bf16x2_t __attribute__((ext_vector_type(2)));
__device__ __forceinline__ unsigned cvtpk_s(float lo,float hi){f32x2_t v={lo,hi};bf16x2_t b=__builtin_convertvector(v,bf16x2_t);return __builtin_bit_cast(unsigned,b);}
#define WAIT_BAR(N) asm volatile("s_waitcnt vmcnt(" #N ") lgkmcnt(0)\n\ts_barrier":::"memory")

__device__ __forceinline__ void qkt(f32x16&p0,f32x16&p1,const char*Kslot,const bf16x8*qr,int r32,int hi){
  const char*kb=Kslot+hi*1024+r32*16;
  #pragma unroll
  for(int d0=0;d0<4;++d0){
    const bf16x8 b0=*reinterpret_cast<const bf16x8*>(kb+d0*2048);
    const bf16x8 b1=*reinterpret_cast<const bf16x8*>(kb+d0*2048+512);
    p0=__builtin_amdgcn_mfma_f32_32x32x16_bf16(b0,qr[d0],p0,0,0,0);p1=__builtin_amdgcn_mfma_f32_32x32x16_bf16(b1,qr[d0],p1,0,0,0);}
}
typedef __attribute__((address_space(3))) const char* lds_cptr;
typedef short v4i16_t __attribute__((ext_vector_type(4)));
__device__ __forceinline__ void kload8(bf16x8*kf,lds_cptr kp){
  kf[0]=*(const __attribute__((address_space(3))) bf16x8*)(kp);      kf[1]=*(const __attribute__((address_space(3))) bf16x8*)(kp+512);
  kf[2]=*(const __attribute__((address_space(3))) bf16x8*)(kp+2048); kf[3]=*(const __attribute__((address_space(3))) bf16x8*)(kp+2560);
  kf[4]=*(const __attribute__((address_space(3))) bf16x8*)(kp+4096); kf[5]=*(const __attribute__((address_space(3))) bf16x8*)(kp+4608);
  kf[6]=*(const __attribute__((address_space(3))) bf16x8*)(kp+6144); kf[7]=*(const __attribute__((address_space(3))) bf16x8*)(kp+6656);
}
__device__ __forceinline__ void kload2(bf16x8*kf,lds_cptr kp,int j){ kf[2*j]=*(const __attribute__((address_space(3))) bf16x8*)(kp+j*2048); kf[2*j+1]=*(const __attribute__((address_space(3))) bf16x8*)(kp+j*2048+512); }
__device__ __forceinline__ s16x4 vtr(lds_cptr p){ return __builtin_bit_cast(s16x4,__builtin_amdgcn_ds_read_tr16_b64_v4i16((__attribute__((address_space(3))) v4i16_t*)p)); }
__device__ __forceinline__ float rowmax(const f32x16&p0,const f32x16&p1){
  float a=max3f(p0[0],p0[1],p1[0]),b=max3f(p0[2],p0[3],p1[1]);a=max3f(a,p1[2],p1[3]);
  #pragma unroll
  for(int r=4;r<16;r+=4){a=max3f(a,p0[r],p0[r+1]);b=max3f(b,p0[r+2],p0[r+3]);a=max3f(a,p1[r],p1[r+1]);b=max3f(b,p1[r+2],p1[r+3]);}
  const float m=max2f(a,b);
  auto rr=__builtin_amdgcn_permlane32_swap(__float_as_uint(m),__float_as_uint(m),false,false);
  return max2f(__uint_as_float(rr[0]),__uint_as_float(rr[1]));
}
__device__ __forceinline__ void pv(f32x16*o,int vb,bf16x8 pa0,bf16x8 pa1,bf16x8 pa2,bf16x8 pa3){
  #pragma unroll
  for(int d0=0;d0<2;++d0){s16x4 lo[4],hi[4];
    #pragma unroll
    for(int ks=0;ks<4;++ks){
      asm volatile("ds_read_b64_tr_b16 %0,%1 offset:%c2":"=&v"(lo[ks]):"v"(vb),"i"(d0*4096+ks*1024):"memory");
      asm volatile("ds_read_b64_tr_b16 %0,%1 offset:%c2":"=&v"(hi[ks]):"v"(vb),"i"(d0*4096+ks*1024+512):"memory");}
    asm volatile("s_waitcnt lgkmcnt(0)":::"memory");SBAR();
    #define PK(k) (bf16x8){lo[k][0],lo[k][1],lo[k][2],lo[k][3],hi[k][0],hi[k][1],hi[k][2],hi[k][3]}
    o[d0]=__builtin_amdgcn_mfma_f32_32x32x16_bf16(pa0,PK(0),o[d0],0,0,0);
    o[d0]=__builtin_amdgcn_mfma_f32_32x32x16_bf16(pa1,PK(1),o[d0],0,0,0);
    o[d0]=__builtin_amdgcn_mfma_f32_32x32x16_bf16(pa2,PK(2),o[d0],0,0,0);
    o[d0]=__builtin_amdgcn_mfma_f32_32x32x16_bf16(pa3,PK(3),o[d0],0,0,0);
    #undef PK
  }
}

#ifndef ATTN_STORE16
#define ATTN_STORE16(p,v) (*(u32x4*)(p)=(v))
#endif
template<int THRL> __device__ __forceinline__ void attn_unit(int b,int h,int qb,const bf16*Q,const bf16*__restrict__ K,const bf16*__restrict__ V,bf16*O,const float*__restrict__ NC2,char*shm){
  int tid_l=threadIdx.x; asm volatile("":"+v"(tid_l)); const int tid=tid_l,lane=tid&63,r32=lane&31,hi=lane>>5; const int wid=__builtin_amdgcn_readfirstlane(tid>>6);
  const long rowbase=(long)b*SEQ; const int q0=qb*QB;
  { const float*cg_=NC2+(long)(b*NHEAD+h)*SEQ; float*cl_=(float*)(shm+LDS_C2); const int nq_=q0+QB;
    for(int i_=tid*4;i_<nq_;i_+=NW*64*4)*(f32x4v*)(cl_+i_)=*(const f32x4v*)(cg_+i_); }
  const bf16*Qw=Q+(rowbase+q0+wid*QBLK)*DM+h*D;
  const bf16*Kh=K+rowbase*DM+h*D,*Vh=V+rowbase*DM+h*D;
  const unsigned lds0=(unsigned)(uintptr_t)shm;
  float*wsf=(float*)(shm+LDS_WS)+wid*64;
  const bf16*ksrc=Kh+(long)lane*DM+wid*8;
  const bf16*vsrc=Vh+(long)(16*(wid&3)+(lane>>2))*DM+(wid>>2)*32+(lane&3)*8;
  const unsigned kdst=lds0+LDS_K+wid*1024, vdst=lds0+LDS_V+wid*1024;
  #define DMA_K(t,slot) glds16(ksrc+(long)(t)*KVBLK*DM,(unsigned)__builtin_amdgcn_readfirstlane(kdst+(slot)))
  #define DMA_V(t,slot) glds16(vsrc+(long)(t)*KVBLK*DM,(unsigned)__builtin_amdgcn_readfirstlane(vdst+(slot)))
  const int vb0=(int)(lds0+LDS_V)+((lane>>4)&1)*32+(lane&3)*8+(4*hi+((lane&15)>>2))*64;
  const char*Kbase=shm+LDS_K; bf16x8 kf[8];
  const lds_cptr shm3=(lds_cptr)shm; const lds_cptr c2l=shm3+LDS_C2+16*hi; const lds_cptr kp0=shm3+LDS_K+hi*1024+r32*16; const lds_cptr vp0=shm3+LDS_V+((lane>>4)&1)*32+(lane&3)*8+(4*hi+((lane&15)>>2))*64;
  const int NT=(q0+QB)/KVBLK;
  DMA_K(0,0);DMA_V(0,0);DMA_K(1,SLOTB);
  bf16x8 qr[4];
  #pragma unroll
  for(int d0=0;d0<4;++d0)qr[d0]=*reinterpret_cast<const bf16x8*>(&Qw[(long)r32*DM+d0*16+hi*8]);
  float mhat=0.f,l_reg=0.f;f32x16 o[2];o[0]=f32x16{};o[1]=f32x16{};
  const int qrel=wid*QBLK+r32;
  #define CMASK(P0,P1,t) do{int jb_=(t)-(NT-4); if(jb_>=0)cmask(P0,P1,jb_,qrel,hi);}while(0)
  bool resc=false;
  #define START(P0,P1) do{ const float rm=rowmax(P0,P1); resc=false; \
    { const float dl=rm; mhat=fadd_s(mhat,dl); \
      _Pragma("unroll") for(int r=0;r<16;++r){P0[r]=fsub_s(P0[r],dl);P1[r]=fsub_s(P1[r],dl);} \
      } \
    _Pragma("unroll") for(int r=0;r<16;++r)P0[r]=__builtin_amdgcn_exp2f(P0[r]); }while(0)
  #define RESC() do{ if(resc){ asm volatile("s_waitcnt lgkmcnt(0)":::"memory"); \
      _Pragma("unroll") for(int d_=0;d_<2;++d_) _Pragma("unroll") for(int r=0;r<16;++r)o[d_][r]*=wsf[crow(r,hi)]; } }while(0)
  f32x16 pA0,pA1,pB0,pB1;
  #define KBLD(X0,X1,tt) do{ const lds_f4p cb_=(lds_f4p)(c2l+(tt)*256); \
    _Pragma("unroll") for(int g_=0;g_<4;++g_){ const f32x4v a_=cb_[2*g_], b_=cb_[2*g_+8]; \
      X0[4*g_+0]=a_[0]-mhat; X0[4*g_+1]=a_[1]-mhat; X0[4*g_+2]=a_[2]-mhat; X0[4*g_+3]=a_[3]-mhat; \
      X1[4*g_+0]=b_[0]-mhat; X1[4*g_+1]=b_[1]-mhat; X1[4*g_+2]=b_[2]-mhat; X1[4*g_+3]=b_[3]-mhat; } }while(0)
  int sl_prev=0,sl_cur=0,sl_next=SLOTB;
  #define ROT() do{sl_prev=sl_cur;sl_cur=sl_next;sl_next=(sl_next==(NSLOT-1)*SLOTB)?0:sl_next+SLOTB;}while(0)
  DMA_K(2,2*SLOTB);
  WAIT_BAR(3);
  KBLD(pA0,pA1,0);
  qkt(pA0,pA1,Kbase,qr,r32,hi);asm volatile("s_nop 15\n\ts_nop 7":"+v"(pA0),"+v"(pA1));CMASK(pA0,pA1,0);
  START(pA0,pA1);
  KBLD(pB0,pB1,1);
  _Pragma("unroll") for(int r=0;r<16;++r)pA1[r]=__builtin_amdgcn_exp2f(pA1[r]);
  WAIT_BAR(0);
  DMA_K(3,0);DMA_V(1,SLOTB);
  ROT();
  kload8(kf,kp0+sl_cur);
  WAIT_BAR(2);
  s16x4 vlo[8],vhi[8]; u32x4 pw0,pw1,pw2,pw3;
  #define PKW(P,B) cvtpk_s(P[B],P[B+1])
  #define PAF(k) __builtin_bit_cast(bf16x8,pw##k)
  #define VFR(i) (bf16x8){vlo[i][0],vlo[i][1],vlo[i][2],vlo[i][3],vhi[i][0],vhi[i][1],vhi[i][2],vhi[i][3]}
  #define PIN(x) asm volatile("":"+v"(x))
  #define MX3(a,b,c) __builtin_fmaxf(__builtin_fmaxf((a),(b)),(c))
  #define GAPA(MF,A0,A1,A2,A3,W0,W1,PW) do{ MF; sacc+=A0; sacc+=A1; sacc+=A2; sacc+=A3; PIN(sacc); W0; W1; PIN(PW); SBAR(); }while(0)
  #define EX(v) __builtin_amdgcn_exp2f(v)
  #define GAPB(MF,X,B) do{ MF; X[B]=EX(X[B]); X[B+1]=EX(X[B+1]); X[B+2]=EX(X[B+2]); X[B+3]=EX(X[B+3]); PIN(X); SBAR(); }while(0)
  #define VRD(i) do{ vlo[i]=vtr(vp_+(((i)>>2)*4096+((i)&3)*1024)); vhi[i]=vtr(vp_+(((i)>>2)*4096+((i)&3)*1024+512)); }while(0)
  #define KRD(G,j) do{ if(G){ kload2(kf,kp0+sl_next,j); SBAR(); } }while(0)
  #define STEP(C0,C1,P0,P1,t,GK,GV,GL) do{ SBAR(); \
    const lds_cptr vp_=vp0+sl_prev; \
    VRD(0); SBAR(); float sacc=(P0[0]+P0[1]); \
    GAPA(C0=__builtin_amdgcn_mfma_f32_32x32x16_bf16(kf[0],qr[0],C0,0,0,0), P0[2],P0[3],P0[4],P0[5],     pw0[0]=PKW(P0,0), pw0[1]=PKW(P0,2), pw0); \
    VRD(4); SBAR(); GAPA(C1=__builtin_amdgcn_mfma_f32_32x32x16_bf16(kf[1],qr[0],C1,0,0,0), P0[6],P0[7],P0[8],P0[9],     pw0[2]=PKW(P0,4), pw0[3]=PKW(P0,6), pw0); \
    VRD(1); SBAR(); GAPA(C0=__builtin_amdgcn_mfma_f32_32x32x16_bf16(kf[2],qr[1],C0,0,0,0),   P0[10],P0[11],P0[12],P0[13], pw1[0]=PKW(P0,8), pw1[1]=PKW(P0,10), pw1); \
    VRD(5); SBAR(); GAPA(C1=__builtin_amdgcn_mfma_f32_32x32x16_bf16(kf[3],qr[1],C1,0,0,0),   P0[14],P0[15],P1[0],P1[1],   pw1[2]=PKW(P0,12),pw1[3]=PKW(P0,14), pw1); \
    VRD(2); SBAR(); GAPA(C0=__builtin_amdgcn_mfma_f32_32x32x16_bf16(kf[4],qr[2],C0,0,0,0),   P1[2],P1[3],P1[4],P1[5],     pw2[0]=PKW(P1,0), pw2[1]=PKW(P1,2), pw2); \
    VRD(6); SBAR(); GAPA(C1=__builtin_amdgcn_mfma_f32_32x32x16_bf16(kf[5],qr[2],C1,0,0,0),   P1[6],P1[7],P1[8],P1[9],     pw2[2]=PKW(P1,4), pw2[3]=PKW(P1,6), pw2); \
    VRD(3); SBAR(); GAPA(C0=__builtin_amdgcn_mfma_f32_32x32x16_bf16(kf[6],qr[3],C0,0,0,0),   P1[10],P1[11],P1[12],P1[13], pw3[0]=PKW(P1,8), pw3[1]=PKW(P1,10), pw3); \
    VRD(7); SBAR(); GAPA(C1=__builtin_amdgcn_mfma_f32_32x32x16_bf16(kf[7],qr[3],C1,0,0,0),   P1[14],P1[15],0.f,0.f,       pw3[2]=PKW(P1,12),pw3[3]=PKW(P1,14), pw3); \
    l_reg+=sacc; \
    if(GK){DMA_K((t)+3,sl_cur);} if(GV){DMA_V((t)+1,sl_next);} \
    CMASK(C0,C1,t); \
    { float a=MX3(C0[0],C0[1],C1[0]),b=MX3(C0[2],C0[3],C1[1]); a=MX3(a,C1[2],C1[3]); \
      _Pragma("unroll") for(int r=4;r<16;r+=4){a=MX3(a,C0[r],C0[r+1]);b=MX3(b,C0[r+2],C0[r+3]);a=MX3(a,C1[r],C1[r+1]);b=MX3(b,C1[r+2],C1[r+3]);} \
      float rm=__builtin_fmaxf(a,b); { auto rr=__builtin_amdgcn_permlane32_swap(__float_as_uint(rm),__float_as_uint(rm),false,false); rm=__builtin_fmaxf(__uint_as_float(rr[0]),__uint_as_float(rr[1])); } \
      resc=false; \
      if(__builtin_expect(__any(rm>(float)THRL),0)){ const float dl=__builtin_fmaxf(rm,0.f); mhat+=dl; \
        _Pragma("unroll") for(int r=0;r<16;++r){C0[r]-=dl;C1[r]-=dl;} \
        const float f=__builtin_amdgcn_exp2f(-dl); l_reg*=f; if(hi==0)wsf[r32]=f; resc=true; } } \
    SBAR(); \
    GAPB(o[0]=__builtin_amdgcn_mfma_f32_32x32x16_bf16(PAF(0),VFR(0),o[0],0,0,0), C0,0); \
    GAPB(o[1]=__builtin_amdgcn_mfma_f32_32x32x16_bf16(PAF(0),VFR(4),o[1],0,0,0), C0,4); \
    KRD(GL,0); GAPB(o[0]=__builtin_amdgcn_mfma_f32_32x32x16_bf16(PAF(1),VFR(1),o[0],0,0,0), C0,8); \
    KRD(GL,1); GAPB(o[1]=__builtin_amdgcn_mfma_f32_32x32x16_bf16(PAF(1),VFR(5),o[1],0,0,0), C0,12); \
    KRD(GL,2); GAPB(o[0]=__builtin_amdgcn_mfma_f32_32x32x16_bf16(PAF(2),VFR(2),o[0],0,0,0), C1,0); \
    KRD(GL,3); GAPB(o[1]=__builtin_amdgcn_mfma_f32_32x32x16_bf16(PAF(2),VFR(6),o[1],0,0,0), C1,4); \
    GAPB(o[0]=__builtin_amdgcn_mfma_f32_32x32x16_bf16(PAF(3),VFR(3),o[0],0,0,0), C1,8); \
    GAPB(o[1]=__builtin_amdgcn_mfma_f32_32x32x16_bf16(PAF(3),VFR(7),o[1],0,0,0), C1,12); \
    if(GL){ KBLD(P0,P1,(t)+1); } \
    }while(0)
  int t=1;
  #undef CMASK
  #define CMASK(P0,P1,t) do{}while(0)
  for(;t+5<NT;t+=2){
    STEP(pB0,pB1,pA0,pA1,t,true,true,true);     WAIT_BAR(2); RESC(); ROT();
    STEP(pA0,pA1,pB0,pB1,t+1,true,true,true);   WAIT_BAR(2); RESC(); ROT();
  }
  #undef CMASK
  #define CMASK(P0,P1,t) do{int jb_=(t)-(NT-4); if(jb_>=0)cmask(P0,P1,jb_,qrel,hi);}while(0)
  #define ENDW(tt) do{ if((tt)+3<NT){WAIT_BAR(2);} else if((tt)+2<NT){WAIT_BAR(1);} else {WAIT_BAR(0);} }while(0)
  for(;t+1<NT;t+=2){
    STEP(pB0,pB1,pA0,pA1,t,(t+3<NT),(t+1<NT),(t+1<NT));       ENDW(t);   RESC(); ROT();
    STEP(pA0,pA1,pB0,pB1,t+1,(t+4<NT),(t+2<NT),(t+2<NT));     ENDW(t+1); RESC(); ROT();
  }
  STEP(pB0,pB1,pA0,pA1,NT-1,false,false,false); RESC();
  { float sacc=pB0[0]+pB0[1]; _Pragma("unroll") for(int r=2;r<16;++r)sacc+=pB0[r]; _Pragma("unroll") for(int r=0;r<16;++r)sacc+=pB1[r]; l_reg+=sacc;
    pw0=(u32x4){PKW(pB0,0),PKW(pB0,2),PKW(pB0,4),PKW(pB0,6)};pw1=(u32x4){PKW(pB0,8),PKW(pB0,10),PKW(pB0,12),PKW(pB0,14)};pw2=(u32x4){PKW(pB1,0),PKW(pB1,2),PKW(pB1,4),PKW(pB1,6)};pw3=(u32x4){PKW(pB1,8),PKW(pB1,10),PKW(pB1,12),PKW(pB1,14)};
    SBAR(); pv(o,vb0+sl_cur,PAF(0),PAF(1),PAF(2),PAF(3)); }
  #undef PKW
  #undef PAF
  #undef VFR
  #undef PIN
  #undef MX3
  #undef GAPA
  #undef GAPB
  #undef EX
  #undef VRD
  #undef KRD
  #undef STEP
  #undef ENDW
  {auto rr=__builtin_amdgcn_permlane32_swap(__float_as_uint(l_reg),__float_as_uint(l_reg),false,false);l_reg=__uint_as_float(rr[0])+__uint_as_float(rr[1]);}
  if(hi==0)wsf[32+r32]=l_reg;asm volatile("s_waitcnt lgkmcnt(0)":::"memory");
  float rli[16];
  #pragma unroll
  for(int r=0;r<16;++r)rli[r]=__builtin_amdgcn_rcpf(wsf[32+crow(r,hi)]);
  bf16*Ow=O+(rowbase+q0+wid*QBLK)*OPITCH+h*D;
  { bf16*stg=(bf16*)(shm+LDS_OST)+wid*2048;
    #pragma unroll
    for(int r=0;r<16;++r){const int orow=crow(r,hi);
      #pragma unroll
      for(int d0=0;d0<2;++d0)stg[orow*64+d0*32+r32]=__float2bfloat16(o[d0][r]*rli[r]);}
    asm volatile("s_waitcnt lgkmcnt(0)":::"memory");
    #pragma unroll
    for(int i=0;i<4;++i){const int row=i*8+(lane>>3),ch=lane&7; const u32x4 v=*(const u32x4*)(stg+row*64+ch*8); ATTN_STORE16(Ow+(long)row*OPITCH+ch*8,v);} }
  asm volatile("s_waitcnt lgkmcnt(0)\n\ts_barrier":::"memory");
  #undef DMA_K
  #undef DMA_V
  #undef CMASK
  #undef START
  #undef RESC
  #undef ROT
  #undef KBLD
}
constexpr int ATTN_LDS_BYTES=LDS_BYTES;
struct AttnTensors { const bf16* Q; const bf16* K; const bf16* V; bf16* O; const float* NC2; };
struct AttnUnit { int bh; int qb; };
struct StaticOrder {
  int vcu;
  __device__ __forceinline__ explicit StaticOrder(int grid,int block):vcu((block%8)*(grid/8)+block/8){}
  __device__ __forceinline__ bool next(int i,AttnUnit&u)const{ if(i>=8)return false; const int s=vcu&3; u.bh=vcu>>2; u.qb=8*(i>>1)+((i&1)?7-s:s); return true; }
  __device__ __forceinline__ void a_ready(const AttnUnit&)const{}
  __device__ __forceinline__ void done(const AttnUnit&)const{}
};
template<class Sched,int THRL=8> __device__ __forceinline__ void attn_phase(char*lds,const AttnTensors&T,const Sched&S){
  AttnUnit u;
  for(int i=0;S.next(i,u);++i){ S.a_ready(u); attn_unit<THRL>(u.bh/NHEAD,u.bh%NHEAD,u.qb,T.Q,T.K,T.V,T.O,T.NC2,lds); S.done(u); }
}
#undef SBAR
#undef WAIT_BAR
}
namespace xat {
#define XLAS __attribute__((address_space(3)))
typedef unsigned short bf16_t;
typedef short bf16x8 __attribute__((ext_vector_type(8)));
typedef float f32x16 __attribute__((ext_vector_type(16)));
typedef unsigned u32x4 __attribute__((ext_vector_type(4)));
typedef unsigned u32x2 __attribute__((ext_vector_type(2)));
constexpr int KROW = 272, VROW = 520, LDS_K = 0, LDS_V = 256 * KROW, LDS_END = LDS_V + 128 * VROW;
__device__ __forceinline__ unsigned cvtpk(float lo, float hi) { unsigned r; asm volatile("v_cvt_pk_bf16_f32 %0, %1, %2" : "=v"(r) : "v"(lo), "v"(hi)); return r; }
__device__ __forceinline__ void load_kv(const bf16_t* MKbh, const bf16_t* MVtbh, XLAS unsigned char* lds, int tid) {
    for (int i = tid; i < 4096; i += 512) { const int row = i >> 4, ch = i & 15; const u32x4 v = *(const u32x4*)(MKbh + row * 128 + ch * 8); *(XLAS u32x4*)(lds + LDS_K + row * KROW + ch * 16) = v; }
    for (int i = tid; i < 4096; i += 512) { const int row = i >> 5, ch = i & 31; const u32x4 v = *(const u32x4*)(MVtbh + row * 256 + ch * 8);
        XLAS u32x2* p = (XLAS u32x2*)(lds + LDS_V + row * VROW + ch * 16); p[0] = (u32x2){v.x, v.y}; p[1] = (u32x2){v.z, v.w}; }
}
__device__ __forceinline__ void unit(const bf16_t* MQ, bf16_t* MO, int b, int h, int qblk, XLAS unsigned char* lds) {
    int tid = threadIdx.x; asm volatile("" : "+v"(tid)); const int lane = tid & 63, r32 = lane & 31, hi = lane >> 5, wid = tid >> 6;
    const size_t row = (size_t)b * 8192 + qblk * 256 + wid * 32 + r32;
    const bf16_t* qp = MQ + row * 512 + h * 128 + hi * 8;
    bf16x8 qr[8];
#pragma unroll
    for (int d0 = 0; d0 < 8; ++d0) qr[d0] = *(const bf16x8*)(qp + d0 * 16);
    f32x16 S[8];
#pragma unroll
    for (int kb = 0; kb < 8; ++kb) { S[kb] = f32x16{};
#pragma unroll
        for (int d0 = 0; d0 < 8; ++d0) { const bf16x8 kf = *(const XLAS bf16x8*)(lds + LDS_K + (32 * kb + r32) * KROW + d0 * 32 + hi * 16);
            S[kb] = __builtin_amdgcn_mfma_f32_32x32x16_bf16(kf, qr[d0], S[kb], 0, 0, 0); }
        __builtin_amdgcn_sched_barrier(0); }
    float m = S[0][0];
#pragma unroll
    for (int kb = 0; kb < 8; ++kb)
#pragma unroll
        for (int r = 0; r < 16; ++r) m = fmaxf(m, S[kb][r]);
    m = fmaxf(m, __shfl_xor(m, 32));
    float l = 0.f;
#pragma unroll
    for (int kb = 0; kb < 8; ++kb)
#pragma unroll
        for (int r = 0; r < 16; ++r) { const float p = __builtin_amdgcn_exp2f(S[kb][r] - m); S[kb][r] = p; l += p; }
    l += __shfl_xor(l, 32);
    u32x4 pw[8][2];
#pragma unroll
    for (int kb = 0; kb < 8; ++kb)
#pragma unroll
        for (int sp = 0; sp < 2; ++sp) { pw[kb][sp].x = cvtpk(S[kb][8 * sp + 0], S[kb][8 * sp + 1]); pw[kb][sp].y = cvtpk(S[kb][8 * sp + 2], S[kb][8 * sp + 3]); pw[kb][sp].z = cvtpk(S[kb][8 * sp + 4], S[kb][8 * sp + 5]); pw[kb][sp].w = cvtpk(S[kb][8 * sp + 6], S[kb][8 * sp + 7]); }
    __builtin_amdgcn_sched_barrier(0);
    f32x16 o[4];
#pragma unroll
    for (int db = 0; db < 4; ++db) o[db] = f32x16{};
#pragma unroll
    for (int kb = 0; kb < 8; ++kb)
#pragma unroll
        for (int sp = 0; sp < 2; ++sp) {
            const bf16x8 pk = __builtin_bit_cast(bf16x8, pw[kb][sp]);
#pragma unroll
            for (int db = 0; db < 4; ++db) { const XLAS unsigned char* vb = lds + LDS_V + (32 * db + r32) * VROW + (32 * kb + 16 * sp + 4 * hi) * 2;
                const u32x2 lo = *(const XLAS u32x2*)vb, hh = *(const XLAS u32x2*)(vb + 16);
                const u32x4 vw = (u32x4){lo.x, lo.y, hh.x, hh.y};
                o[db] = __builtin_amdgcn_mfma_f32_32x32x16_bf16(__builtin_bit_cast(bf16x8, vw), pk, o[db], 0, 0, 0); }
            __builtin_amdgcn_sched_barrier(0); }
    const float inv = 1.0f / l;
    bf16_t* op = MO + row * 512 + h * 128 + 4 * hi;
#pragma unroll
    for (int db = 0; db < 4; ++db)
#pragma unroll
        for (int g = 0; g < 4; ++g) { u32x2 w; w.x = cvtpk(o[db][4 * g + 0] * inv, o[db][4 * g + 1] * inv); w.y = cvtpk(o[db][4 * g + 2] * inv, o[db][4 * g + 3] * inv);
            *(u32x2*)(op + 32 * db + 8 * g) = w; }
}
}

namespace cg = cooperative_groups;
#define LAS __attribute__((address_space(3)))
typedef unsigned short bf16;
typedef unsigned v4u __attribute__((ext_vector_type(4)));
typedef unsigned v2u __attribute__((ext_vector_type(2)));
typedef float f32x4 __attribute__((ext_vector_type(4)));
constexpr int NWAVES = 8;
constexpr int DM = 1024, BATCH = 8, SEQ = 8192, MTOK = BATCH * SEQ, DEPTH = 2, NIN = 2056, NINP = 2304, DFF = 2816, MEMLEN = 256;
constexpr float EPS = 1e-6f;
constexpr size_t MiB = 1u << 20;
constexpr size_t WS_W = 1 * MiB, WS_WSTRIDE = 28 * MiB;
constexpr size_t WO_IN = 0, WO_OUT = 5 * MiB, WO_MQ = 7 * MiB, WO_MKV = 8 * MiB, WO_MO = 10 * MiB, WO_GU = 11 * MiB, WO_D = 22 * MiB;
constexpr size_t WS_LF = 58 * MiB, WS_NC2 = 60 * MiB, WS_SSQ = 62 * MiB, WS_MN = 66 * MiB, WS_MK = 74 * MiB, WS_MVT = 78 * MiB;
constexpr size_t WS_HB = 96 * MiB, WS_Q = 224 * MiB, WS_K = 288 * MiB, WS_V = 352 * MiB, WS_P = 416 * MiB, WS_CAT = 480 * MiB, WS_MQ = 608 * MiB, WS_MO = 672 * MiB, WS_END = 736 * MiB;
constexpr size_t WS_ACT = 224 * MiB;
static_assert(WS_ACT + (size_t)MTOK * DFF * 2 <= WS_MQ, "ACT overlay");
constexpr int RING_BYTES = 131072, EPIX_OFF = 132096, LDS_BYTES = 147456;

__device__ __forceinline__ unsigned f2bf(float f) { unsigned u = __builtin_bit_cast(unsigned, f); return (u + 0x7fffu + ((u >> 16) & 1u)) >> 16; }
__device__ __forceinline__ unsigned pk2(float lo, float hi) { return f2bf(lo) | (f2bf(hi) << 16); }
__device__ __forceinline__ float wave_sum(float v) {
#pragma unroll
    for (int o = 1; o < 64; o <<= 1) v += __shfl_xor(v, o);
    return v;
}
__device__ __forceinline__ void tr_item(const float* W, int N, int k0, int n0, const float* g, bf16* WT, int Kdst, int drow0, LAS float* scr, int lane) {
    const int nn = lane & 31; const bool ok = (n0 + nn) < N;
#pragma unroll 8
    for (int i = 0; i < 32; ++i) { const int kk = 2 * i + (lane >> 5); float v = ok ? W[(size_t)(k0 + kk) * N + n0 + nn] : 0.f; if (g) v *= g[k0 + kk]; scr[kk * 33 + nn] = v; }
    asm volatile("s_waitcnt lgkmcnt(0)" ::: "memory");
    const int c = lane & 7;
#pragma unroll
    for (int j = 0; j < 4; ++j) { const int n = (lane >> 3) + 8 * j; const LAS float* s = scr + (8 * c) * 33 + n;
        v4u o; o.x = pk2(s[0 * 33], s[1 * 33]); o.y = pk2(s[2 * 33], s[3 * 33]); o.z = pk2(s[4 * 33], s[5 * 33]); o.w = pk2(s[6 * 33], s[7 * 33]);
        *(v4u*)(WT + (size_t)(drow0 + n) * Kdst + k0 + 8 * c) = o; }
    asm volatile("s_waitcnt lgkmcnt(0)" ::: "memory");
}

#ifndef PHMASK
#define PHMASK 0x3ff
#endif
__device__ __forceinline__ unsigned long long karg(int k) {
    const __attribute__((address_space(4))) unsigned long long* ka = (const __attribute__((address_space(4))) unsigned long long*)__builtin_amdgcn_kernarg_segment_ptr();
    asm volatile("" : "+s"(ka)); return ka[k];
}
struct Args { const float* in[20]; float* out; unsigned char* ws; };

__global__ void __launch_bounds__(NWAVES * 64, 2) fwd_megakernel(Args args) {
    extern __shared__ __attribute__((aligned(16))) unsigned char lds[];
    cg::grid_group grid = cg::this_grid();
    LAS unsigned char* const L = (LAS unsigned char*)lds;
    const int wave = __builtin_amdgcn_readfirstlane((int)threadIdx.x >> 6);
    const int G = gridDim.x, bx = blockIdx.x;
    const int vcu = (G % 8 == 0) ? (bx % 8) * (G / 8) + bx / 8 : bx;
    LAS float* const EX = (LAS float*)(L + EPIX_OFF);
#define DEFPTRS \
    int tid = threadIdx.x; asm volatile("" : "+v"(tid)); const int lane = tid & 63; (void)lane; \
    unsigned char* const ws = (unsigned char*)karg(21); float* const out = (float*)karg(20); (void)out; \
    bf16* const HB = (bf16*)(ws + WS_HB); bf16* const Qb = (bf16*)(ws + WS_Q); bf16* const Kb = (bf16*)(ws + WS_K); bf16* const Vb = (bf16*)(ws + WS_V); bf16* const Pb = (bf16*)(ws + WS_P); \
    bf16* const CAT = (bf16*)(ws + WS_CAT); bf16* const MQ = (bf16*)(ws + WS_MQ); bf16* const MO = (bf16*)(ws + WS_MO); bf16* const ACT = (bf16*)(ws + WS_ACT); \
    float* const LF = (float*)(ws + WS_LF); float* const NC2 = (float*)(ws + WS_NC2); float* const SSQ = (float*)(ws + WS_SSQ); \
    bf16* const MN = (bf16*)(ws + WS_MN); bf16* const MK = (bf16*)(ws + WS_MK); bf16* const MVT = (bf16*)(ws + WS_MVT); \
    (void)HB; (void)Qb; (void)Kb; (void)Vb; (void)Pb; (void)CAT; (void)MQ; (void)MO; (void)ACT; (void)LF; (void)NC2; (void)SSQ; (void)MN; (void)MK; (void)MVT;
#define IN(k) ((const float*)karg(k))

    if constexpr ((PHMASK >> 0) & 1) { DEFPTRS
        LAS float* scr = (LAS float*)(L + wave * 16384);
        const int gw = vcu * NWAVES + wave, NGW = G * NWAVES;
        constexpr int I_IN = 16 * 72, I_OUT = 8 * 32, I_MQ = 16 * 16, I_MKV = 16 * 32, I_MO = 8 * 32, I_GU = 16 * 176, I_D = 44 * 32, I_L = I_IN + I_OUT + I_MQ + I_MKV + I_MO + I_GU + I_D;
        for (int it = gw; it < DEPTH * I_L; it += NGW) {
            const int l = it / I_L; int r = it % I_L; unsigned char* wl = ws + WS_W + (size_t)l * WS_WSTRIDE;
            if (r < I_IN) { const int kb = r / 72, nb = r % 72; tr_item(IN(3) + (size_t)l * DM * NIN, NIN, 64 * kb, 32 * nb, IN(2) + l * DM, (bf16*)(wl + WO_IN), DM, 32 * nb, scr, lane); continue; } r -= I_IN;
            if (r < I_OUT) { const int kb = r / 32, nb = r % 32; tr_item(IN(9) + (size_t)l * DM * DM, DM, 64 * kb, 32 * nb, nullptr, (bf16*)(wl + WO_OUT), DM, 32 * nb, scr, lane); continue; } r -= I_OUT;
            if (r < I_MQ) { const int kb = r / 16, nb = r % 16; tr_item(IN(12) + (size_t)l * DM * 512, 512, 64 * kb, 32 * nb, IN(10) + l * DM, (bf16*)(wl + WO_MQ), DM, 32 * nb, scr, lane); continue; } r -= I_MQ;
            if (r < I_MKV) { const int kb = r / 32, nb = r % 32; tr_item(IN(13) + (size_t)l * DM * 1024, 1024, 64 * kb, 32 * nb, nullptr, (bf16*)(wl + WO_MKV), DM, 32 * nb, scr, lane); continue; } r -= I_MKV;
            if (r < I_MO) { const int kb = r / 32, nb = r % 32; tr_item(IN(16) + (size_t)l * 512 * DM, DM, 64 * kb, 32 * nb, nullptr, (bf16*)(wl + WO_MO), 512, 32 * nb, scr, lane); continue; } r -= I_MO;
            if (r < I_GU) { const int kb = r / 176, nb = r % 176; const int n0 = 32 * nb; const int drow = (n0 < DFF) ? (n0 / 128) * 256 + (n0 % 128) : ((n0 - DFF) / 128) * 256 + 128 + ((n0 - DFF) % 128);
                tr_item(IN(18) + (size_t)l * DM * 2 * DFF, 2 * DFF, 64 * kb, n0, IN(17) + l * DM, (bf16*)(wl + WO_GU), DM, drow, scr, lane); continue; } r -= I_GU;
            { const int kb = r / 32, nb = r % 32; tr_item(IN(19) + (size_t)l * DFF * DM, DM, 64 * kb, 32 * nb, nullptr, (bf16*)(wl + WO_D), DFF, 32 * nb, scr, lane); }
        }
        for (int idx = bx * 512 + tid; idx < DEPTH * 512 * 1024; idx += G * 512) {
            const int l = idx / (512 * 1024), rem = idx % (512 * 1024), kc = rem / 1024, n = rem % 1024, g = kc >> 7, c = kc & 127;
            const float* wp = IN(7) + ((size_t)(l * 4 + g) * 128 + c) * 128; const float* ps = IN(8) + l * 512 + g * 128; const float* wo = IN(9) + (size_t)l * DM * DM + (size_t)(512 + g * 128) * DM + n;
            float a = 0.f;
            for (int d = 0; d < 128; ++d) a += wp[d] * ps[d] * wo[(size_t)d * DM];
            ((bf16*)(ws + WS_W + (size_t)l * WS_WSTRIDE + WO_OUT))[(size_t)n * DM + 512 + kc] = (bf16)f2bf(a);
        }
        for (int m = gw; m < MTOK; m += NGW) {
            const f32x4* xr = (const f32x4*)(IN(0) + (size_t)m * DM) + lane; f32x4 v[4]; float s = 0.f;
#pragma unroll
            for (int j = 0; j < 4; ++j) { v[j] = xr[64 * j]; s += (v[j].x * v[j].x + v[j].y * v[j].y) + (v[j].z * v[j].z + v[j].w * v[j].w); }
            s = wave_sum(s);
            v2u* o8 = (v2u*)(HB + (size_t)m * DM) + lane;
#pragma unroll
            for (int j = 0; j < 4; ++j) o8[64 * j] = (v2u){pk2(v[j].x, v[j].y), pk2(v[j].z, v[j].w)};
            if (lane < 16) SSQ[(size_t)m * 16 + lane] = (lane == 0) ? s : 0.f;
        }
        for (int m = gw; m < DEPTH * BATCH * MEMLEN; m += NGW) {
            const int l = m / (BATCH * MEMLEN), rr = m % (BATCH * MEMLEN);
            const f32x4* xr = (const f32x4*)(IN(1) + (size_t)rr * DM) + lane; const f32x4* gr = (const f32x4*)(IN(11) + l * DM) + lane; f32x4 v[4]; float s = 0.f;
#pragma unroll
            for (int j = 0; j < 4; ++j) { v[j] = xr[64 * j]; s += (v[j].x * v[j].x + v[j].y * v[j].y) + (v[j].z * v[j].z + v[j].w * v[j].w); }
            const float rstd = 1.0f / sqrtf(wave_sum(s) * (1.0f / DM) + EPS);
            v2u* o8 = (v2u*)(MN + (size_t)m * DM) + lane;
#pragma unroll
            for (int j = 0; j < 4; ++j) { const f32x4 gg = gr[64 * j]; o8[64 * j] = (v2u){pk2(v[j].x * rstd * gg.x, v[j].y * rstd * gg.y), pk2(v[j].z * rstd * gg.z, v[j].w * rstd * gg.w)}; }
        }
    }
    grid.sync();

    for (int l = 0; l < DEPTH; ++l) {
        if constexpr ((PHMASK >> 1) & 1) { DEFPTRS
            pg8::Gemm g{HB, (const bf16*)(ws + WS_W + (size_t)l * WS_WSTRIDE + WO_IN), MTOK, NINP, DM}; pg8::StaticOrder S; S.init(MTOK, NINP, G, bx);
            pg8::EpiInProj E{SSQ, Qb, Kb, Vb, Pb, LF, IN(5) + l * 64, IN(6) + l * 64, IN(4) + l * 8, EX, 0.125f * pg8::LOG2E};
            pg8::gemm_phase<pg8::EpiInProj, pg8::StaticOrder, true, true>(L, g, S, E);
        }
        grid.sync();
        if constexpr ((PHMASK >> 2) & 1) { DEFPTRS
            if (bx < 64) {
                const int b = bx >> 3, h = bx & 7; const float* src = LF + ((size_t)b * SEQ + tid * 16) * 8 + h; float v[16]; float s = 0.f;
#pragma unroll
                for (int j = 0; j < 16; ++j) { s += src[j * 8]; v[j] = s; }
                LAS float* sc = (LAS float*)L; sc[tid] = s; __syncthreads();
                for (int off = 1; off < 512; off <<= 1) { const float t = (tid >= off) ? sc[tid - off] : 0.f; __syncthreads(); sc[tid] += t; __syncthreads(); }
                const float excl = sc[tid] - s; float* dst = NC2 + (size_t)bx * SEQ + tid * 16;
#pragma unroll
                for (int j = 0; j < 16; j += 4) *(f32x4*)(dst + j) = (f32x4){-(excl + v[j]), -(excl + v[j + 1]), -(excl + v[j + 2]), -(excl + v[j + 3])};
                __syncthreads();
            } else if (l == 0 && bx < 128) {
                const int l2 = (bx - 64) >> 5;
                pg8::Gemm g{MN + (size_t)l2 * BATCH * MEMLEN * DM, (const bf16*)(ws + WS_W + (size_t)l2 * WS_WSTRIDE + WO_MKV), BATCH * MEMLEN, 1024, DM};
                pg8::RangeOrder S{4, 64 + 32 * l2, 32, bx};
                pg8::EpiHead128<1> E{nullptr, MK + (size_t)l2 * BATCH * 4 * MEMLEN * 128, MVT + (size_t)l2 * BATCH * 4 * MEMLEN * 128, IN(15) + l2 * 128, EX, 1.0f};
                pg8::gemm_phase<pg8::EpiHead128<1>, pg8::RangeOrder, true, true>(L, g, S, E);
            }
            for (int task = bx * 512 + tid; task < (MTOK / 32) * 64; task += G * 512) {
                const int cgp = task & 63, r0 = (task >> 6) * 32, t0 = r0 & (SEQ - 1), w = 2 << (cgp >> 4);
                const bf16* pp = Pb + (size_t)r0 * 512 + cgp * 8; bf16* op = CAT + (size_t)r0 * DM + 512 + cgp * 8;
                float sum[8];
#pragma unroll
                for (int j = 0; j < 8; ++j) sum[j] = 0.f;
                for (int j = 1; j < w; ++j) if (t0 - j >= 0) { const v4u u = *(const v4u*)(pp - (ptrdiff_t)j * 512);
                    sum[0] += __uint_as_float(u.x << 16); sum[1] += __uint_as_float(u.x & 0xffff0000u); sum[2] += __uint_as_float(u.y << 16); sum[3] += __uint_as_float(u.y & 0xffff0000u);
                    sum[4] += __uint_as_float(u.z << 16); sum[5] += __uint_as_float(u.z & 0xffff0000u); sum[6] += __uint_as_float(u.w << 16); sum[7] += __uint_as_float(u.w & 0xffff0000u); }
                for (int i = 0; i < 32; ++i) {
                    const v4u u = *(const v4u*)(pp + (size_t)i * 512); float cur[8];
                    cur[0] = __uint_as_float(u.x << 16); cur[1] = __uint_as_float(u.x & 0xffff0000u); cur[2] = __uint_as_float(u.y << 16); cur[3] = __uint_as_float(u.y & 0xffff0000u);
                    cur[4] = __uint_as_float(u.z << 16); cur[5] = __uint_as_float(u.z & 0xffff0000u); cur[6] = __uint_as_float(u.w << 16); cur[7] = __uint_as_float(u.w & 0xffff0000u);
                    const int t = t0 + i; const float rc = 1.0f / (float)((t + 1 < w) ? t + 1 : w); float o[8];
#pragma unroll
                    for (int j = 0; j < 8; ++j) { sum[j] += cur[j]; o[j] = sum[j] * rc - cur[j]; }
                    *(v4u*)(op + (size_t)i * DM) = (v4u){pk2(o[0], o[1]), pk2(o[2], o[3]), pk2(o[4], o[5]), pk2(o[6], o[7])};
                    if (t + 1 - w >= 0) { const v4u q = *(const v4u*)(pp + (ptrdiff_t)(i + 1 - w) * 512);
                        sum[0] -= __uint_as_float(q.x << 16); sum[1] -= __uint_as_float(q.x & 0xffff0000u); sum[2] -= __uint_as_float(q.y << 16); sum[3] -= __uint_as_float(q.y & 0xffff0000u);
                        sum[4] -= __uint_as_float(q.z << 16); sum[5] -= __uint_as_float(q.z & 0xffff0000u); sum[6] -= __uint_as_float(q.w << 16); sum[7] -= __uint_as_float(q.w & 0xffff0000u); }
                }
            }
        }
        grid.sync();
        if constexpr ((PHMASK >> 3) & 1) { DEFPTRS
            const attn_body::AttnTensors AT{(const attn_body::bf16*)Qb, (const attn_body::bf16*)Kb, (const attn_body::bf16*)Vb, (attn_body::bf16*)CAT, NC2};
            const attn_body::StaticOrder S(G, bx);
            attn_body::attn_phase<attn_body::StaticOrder, 20>((char*)lds, AT, S);
        }
        grid.sync();
        if constexpr ((PHMASK >> 4) & 1) { DEFPTRS
            pg8::Gemm g{CAT, (const bf16*)(ws + WS_W + (size_t)l * WS_WSTRIDE + WO_OUT), MTOK, DM, DM}; pg8::StaticOrder S; S.init(MTOK, DM, G, bx);
            pg8::EpiResid E{(l == 0) ? IN(0) : out, out, HB, SSQ};
            pg8::gemm_phase<pg8::EpiResid, pg8::StaticOrder, true, true>(L, g, S, E);
        }
        grid.sync();
        if constexpr ((PHMASK >> 5) & 1) { DEFPTRS
            pg8::Gemm g{HB, (const bf16*)(ws + WS_W + (size_t)l * WS_WSTRIDE + WO_MQ), MTOK, 512, DM}; pg8::StaticOrder S; S.init(MTOK, 512, G, bx);
            pg8::EpiHead128<0> E{SSQ, MQ, nullptr, IN(14) + l * 128, EX, 0.08838834764831845f * pg8::LOG2E};
            pg8::gemm_phase<pg8::EpiHead128<0>, pg8::StaticOrder, true, true>(L, g, S, E);
        }
        grid.sync();
        if constexpr ((PHMASK >> 6) & 1) { DEFPTRS
            const int bh = vcu >> 3, b = bh >> 2, h = bh & 3;
            if (bh < BATCH * 4) {
                xat::load_kv(MK + ((size_t)l * BATCH * 4 + bh) * MEMLEN * 128, MVT + ((size_t)l * BATCH * 4 + bh) * MEMLEN * 128, L, tid);
                __syncthreads();
                for (int i = 0; i < 4; ++i) xat::unit(MQ, MO, b, h, (vcu & 7) * 4 + i, L);
                __syncthreads();
            }
        }
        grid.sync();
        if constexpr ((PHMASK >> 7) & 1) { DEFPTRS
            pg8::Gemm g{MO, (const bf16*)(ws + WS_W + (size_t)l * WS_WSTRIDE + WO_MO), MTOK, DM, 512}; pg8::StaticOrder S; S.init(MTOK, DM, G, bx);
            pg8::EpiResid E{out, out, HB, SSQ};
            pg8::gemm_phase<pg8::EpiResid, pg8::StaticOrder, true, true>(L, g, S, E);
        }
        grid.sync();
        if constexpr ((PHMASK >> 8) & 1) { DEFPTRS
            pg8::Gemm g{HB, (const bf16*)(ws + WS_W + (size_t)l * WS_WSTRIDE + WO_GU), MTOK, 2 * DFF, DM}; pg8::StaticOrder S; S.init(MTOK, 2 * DFF, G, bx);
            pg8::EpiSwiglu E{SSQ, ACT, EX};
            pg8::gemm_phase<pg8::EpiSwiglu, pg8::StaticOrder, true, true>(L, g, S, E);
        }
        grid.sync();
        if constexpr ((PHMASK >> 9) & 1) { DEFPTRS
            pg8::Gemm g{ACT, (const bf16*)(ws + WS_W + (size_t)l * WS_WSTRIDE + WO_D), MTOK, DM, DFF}; pg8::StaticOrder S; S.init(MTOK, DM, G, bx);
            pg8::EpiResid E{out, out, HB, SSQ};
            pg8::gemm_phase<pg8::EpiResid, pg8::StaticOrder, true, true>(L, g, S, E);
        }
        if (l + 1 < DEPTH) grid.sync();
    }
}

extern "C" void kernel_launch(void* const* d_in, const int* in_sizes, int n_in, void* d_out, int out_size, void* d_ws, size_t ws_size, hipStream_t stream) {
    static int grid = 0;
    if (grid == 0) {
        if (n_in != 20 || out_size != MTOK * DM || ws_size < WS_END) { fprintf(stderr, "kernel_launch: unexpected shapes (n_in %d, out %d, ws %zu)\n", n_in, out_size, ws_size); grid = -1; return; }
        int dev = 0, cus = 0, per_cu = 0;
        if (hipGetDevice(&dev) != hipSuccess || hipDeviceGetAttribute(&cus, hipDeviceAttributeMultiprocessorCount, dev) != hipSuccess) { grid = -1; return; }
        if (hipFuncSetAttribute((const void*)fwd_megakernel, hipFuncAttributeMaxDynamicSharedMemorySize, LDS_BYTES) != hipSuccess) { fprintf(stderr, "kernel_launch: hipFuncSetAttribute failed\n"); grid = -1; return; }
        if (hipOccupancyMaxActiveBlocksPerMultiprocessor(&per_cu, (const void*)fwd_megakernel, NWAVES * 64, LDS_BYTES) != hipSuccess || per_cu < 1) { fprintf(stderr, "kernel_launch: occupancy query says %d\n", per_cu); per_cu = 1; }
        (void)hipGetLastError();
        grid = cus * 1;
        if (grid != 256) fprintf(stderr, "kernel_launch: %d CUs; the unit orders assume 256\n", grid);
    }
    if (grid < 0) return;
    Args a{};
    for (int i = 0; i < 20; ++i) a.in[i] = (const float*)d_in[i];
    a.out = (float*)d_out; a.ws = (unsigned char*)d_ws;
    void* kargs[] = {&a};
    hipError_t e = hipLaunchCooperativeKernel((const void*)fwd_megakernel, dim3(grid), dim3(NWAVES * 64), kargs, LDS_BYTES, stream);
    if (e != hipSuccess) fprintf(stderr, "kernel_launch: cooperative launch failed: %s (grid %d)\n", hipGetErrorString(e), grid);
}
```

```cpp
#include <hip/hip_runtime.h>
#include <hip/hip_cooperative_groups.h>
#include <cstdio>
#include <cstdint>
#include <cstddef>
namespace pg8 {
#define PG8_LAS __attribute__((address_space(3)))
typedef unsigned short bf16_t;
typedef short bf16x8 __attribute__((ext_vector_type(8)));
typedef float f32x4 __attribute__((ext_vector_type(4)));
typedef unsigned u32x4 __attribute__((ext_vector_type(4)));
constexpr int BM = 256, BK = 64, HALF = 128, HTB = HALF * BK * 2  , STAGE_BYTES = 8 * HTB, NXCD = 8, WGM = 8;

__host__ __device__ __forceinline__ int lds_byte(int r, int c) { const int st = (r >> 4) * 2 + (c >> 5), rr = r & 15, cc = c & 31, ob = rr * 64 + cc * 2; return st * 1024 + (ob ^ (((ob >> 9) & 1) << 5)); }
__host__ __device__ __forceinline__ void stage_rc(int b, int& R, int& C) { const int st = b / 1024, sb = b % 1024, swz = sb ^ (((sb >> 9) & 1) << 5); R = (st >> 1) * 16 + swz / 64; C = (st & 1) * 32 + (swz % 64) / 2; }
__host__ __device__ __forceinline__ int perm32(int rho) { const int n = rho >> 4, i = rho & 15; return 8 * (i >> 2) + 4 * n + (i & 3); }

struct Unit { int pm, pn; };
struct Gemm { const bf16_t* A; const bf16_t* Bt; int M, N, K; };

struct StaticOrder {
    int nM, nN, nwg, G, c;
    __host__ __device__ void init(int M, int N, int G_, int c_) { nM = M / BM; nN = N / BM; nwg = nM * nN; G = G_; c = c_; }
    __host__ __device__ bool next(int i, Unit& u) const {
        const long L = (long)i * G + c; if (L >= nwg) return false;
        int wgid = (int)L; { const int q = nwg / NXCD, r = nwg % NXCD, xcd = wgid % NXCD, off = wgid / NXCD; wgid = (xcd < r ? xcd * (q + 1) : r * (q + 1) + (xcd - r) * q) + off; }
        const int nig = WGM * nN, gid = wgid / nig, fm = gid * WGM, gsz = (nM - fm) < WGM ? (nM - fm) : WGM;
        u.pm = fm + ((wgid % nig) % gsz); u.pn = (wgid % nig) / gsz; return true;
    }
    __device__ __forceinline__ void a_ready(const Unit&) const {}
    __device__ __forceinline__ void done(const Unit&) const {}
};

__device__ __forceinline__ unsigned cvt_pk_bf16(float lo, float hi) { unsigned r; asm volatile("v_cvt_pk_bf16_f32 %0, %1, %2" : "=v"(r) : "v"(lo), "v"(hi)); return r; }
typedef unsigned u32x2 __attribute__((ext_vector_type(2)));
constexpr float RMS_EPS = 1e-6f;
constexpr float LOG2E = 1.4426950408889634f;
__device__ __forceinline__ void epi_bar() { asm volatile("s_waitcnt lgkmcnt(0)\n\ts_barrier" ::: "memory"); }
__device__ __forceinline__ float sum4(f32x4 a) { return (a[0] + a[1]) + (a[2] + a[3]); }
__device__ __forceinline__ float sumsq4(f32x4 v) { return (v[0] * v[0] + v[1] * v[1]) + (v[2] * v[2] + v[3] * v[3]); }
__device__ __forceinline__ float rstd_row(const float* ssq, int row) {
    const f32x4* p = (const f32x4*)(ssq + (size_t)row * 16);
    const f32x4 a = p[0], b = p[1], c = p[2], d = p[3];
    return __builtin_amdgcn_rsqf(((sum4(a) + sum4(b)) + (sum4(c) + sum4(d))) * (1.0f / 1024.0f) + RMS_EPS);
}
__device__ __forceinline__ void rstd_to_lds(const float* ssq, int row0, PG8_LAS float* RS) {
    const int t = threadIdx.x; if (t < 256) RS[t] = rstd_row(ssq, row0 + t);
}
__device__ __forceinline__ u32x4 pack8(f32x4 a, f32x4 b) { u32x4 w; w.x = cvt_pk_bf16(a[0], a[1]); w.y = cvt_pk_bf16(a[2], a[3]); w.z = cvt_pk_bf16(b[0], b[1]); w.w = cvt_pk_bf16(b[2], b[3]); return w; }
__device__ __forceinline__ float log2sigmoid(float x) { return LOG2E * (fminf(x, 0.f) - log1pf(expf(-fabsf(x)))); }

struct EpiResid {
    static constexpr bool PERM = false, AFTER_DRAIN = false;
    const float* base; float* out; bf16_t* hb; float* ssq;
    __device__ __forceinline__ void operator()(const f32x4 (&acc)[2][2][4][2], const Unit& u, int wr, int wc, int fr, int fq) const {
        const int col0 = u.pn * BM + wc * 32 + 4 * fq;
#pragma unroll
        for (int ai = 0; ai < 2; ++ai)
#pragma unroll
            for (int m = 0; m < 4; ++m) {
                const int row = u.pm * BM + ai * HALF + wr * 64 + m * 16 + fr; const size_t off = (size_t)row * 1024 + col0; float s = 0.f;
#pragma unroll
                for (int bj = 0; bj < 2; ++bj)
#pragma unroll
                    for (int n = 0; n < 2; ++n) {
                        const f32x4 bs = *(const f32x4*)(base + off + bj * HALF + n * 16); const f32x4 o = bs + acc[ai][bj][m][n];
                        *(f32x4*)(out + off + bj * HALF + n * 16) = o; s += sumsq4(o);
                        u32x2 w; w.x = cvt_pk_bf16(o[0], o[1]); w.y = cvt_pk_bf16(o[2], o[3]); *(u32x2*)(hb + off + bj * HALF + n * 16) = w; }
                s += __shfl_xor(s, 16); s += __shfl_xor(s, 32);
                if (fq == 0) ssq[(size_t)row * 16 + u.pn * 4 + wc] = s;
                if (m & 1) asm volatile("" ::: "memory");
            }
    }
};

struct EpiInProj {
    static constexpr bool PERM = true, AFTER_DRAIN = false;
    const float* ssq; bf16_t *Q, *K, *V, *P; float* LF; const float *gq, *gk, *bfg; PG8_LAS float* X; float qscale;
    __device__ __forceinline__ void operator()(const f32x4 (&acc)[2][2][4][2], const Unit& u, int wr, int wc, int fr, int fq) const {
        const int pn = u.pn, rl0 = wr * 64 + fr; PG8_LAS float* RS = X + 2048;
        rstd_to_lds(ssq, u.pm * BM, RS);
        if (pn < 4) {
#pragma unroll
            for (int ai = 0; ai < 2; ++ai)
#pragma unroll
                for (int m = 0; m < 4; ++m)
#pragma unroll
                    for (int bj = 0; bj < 2; ++bj) { float s = sumsq4(acc[ai][bj][m][0]) + sumsq4(acc[ai][bj][m][1]);
                        s += __shfl_xor(s, 16); s += __shfl_xor(s, 32);
                        if (fq == 0) X[(ai * HALF + rl0 + m * 16) * 8 + bj * 4 + wc] = s; }
        }
        epi_bar();
        if (pn < 4) {
            const float* g = (pn < 2) ? gq : gk; const float extra = (pn < 2) ? qscale : 1.0f; bf16_t* O = (pn < 2) ? Q : K;
            const int dcol = (wc & 1) * 32 + 8 * fq; const f32x4 g0 = *(const f32x4*)(g + dcol) * extra, g1 = *(const f32x4*)(g + dcol + 4) * extra;
            const int colb = (pn & 1) * 256 + wc * 32 + 8 * fq;
#pragma unroll
            for (int ai = 0; ai < 2; ++ai)
#pragma unroll
                for (int m = 0; m < 4; ++m) { const int rl = ai * HALF + rl0 + m * 16; bf16_t* rowp = O + (size_t)(u.pm * BM + rl) * 512 + colb; const float rsv = RS[rl];
#pragma unroll
                    for (int bj = 0; bj < 2; ++bj) { const float hs = X[rl * 8 + bj * 4 + (wc & 2)] + X[rl * 8 + bj * 4 + (wc & 2) + 1];
                        const float sc = rsv * __builtin_amdgcn_rsqf(hs * rsv * rsv * (1.0f / 64.0f) + RMS_EPS);
                        *(u32x4*)(rowp + bj * HALF) = pack8(acc[ai][bj][m][0] * sc * g0, acc[ai][bj][m][1] * sc * g1); }
                    asm volatile("" ::: "memory"); }
        } else if (pn < 8) {
            bf16_t* O = (pn < 6) ? V : P; const int colb = (pn & 1) * 256 + wc * 32 + 8 * fq;
#pragma unroll
            for (int ai = 0; ai < 2; ++ai)
#pragma unroll
                for (int m = 0; m < 4; ++m) { bf16_t* rowp = O + (size_t)(u.pm * BM + ai * HALF + rl0 + m * 16) * 512 + colb; const float rsv = RS[ai * HALF + rl0 + m * 16];
#pragma unroll
                    for (int bj = 0; bj < 2; ++bj) *(u32x4*)(rowp + bj * HALF) = pack8(acc[ai][bj][m][0] * rsv, acc[ai][bj][m][1] * rsv);
                    asm volatile("" ::: "memory"); }
        } else {
            if (wc == 0 && fq == 0) {
                const f32x4 b0 = *(const f32x4*)(bfg), b1 = *(const f32x4*)(bfg + 4);
#pragma unroll
                for (int ai = 0; ai < 2; ++ai)
#pragma unroll
                    for (int m = 0; m < 4; ++m) { float* lp = LF + (size_t)(u.pm * BM + ai * HALF + rl0 + m * 16) * 8; const float rsv = RS[ai * HALF + rl0 + m * 16];
                        const f32x4 z0 = acc[ai][0][m][0] * rsv + b0, z1 = acc[ai][0][m][1] * rsv + b1;
                        *(f32x4*)(lp) = (f32x4){log2sigmoid(z0[0]), log2sigmoid(z0[1]), log2sigmoid(z0[2]), log2sigmoid(z0[3])};
                        *(f32x4*)(lp + 4) = (f32x4){log2sigmoid(z1[0]), log2sigmoid(z1[1]), log2sigmoid(z1[2]), log2sigmoid(z1[3])}; }
            }
        }
    }
};

template <int MODE> struct EpiHead128 {
    static constexpr bool PERM = true, AFTER_DRAIN = false;
    const float* ssq; bf16_t* O; bf16_t* O2; const float* g; PG8_LAS float* X; float oscale;
    __device__ __forceinline__ void operator()(const f32x4 (&acc)[2][2][4][2], const Unit& u, int wr, int wc, int fr, int fq) const {
        const int pn = u.pn, rl0 = wr * 64 + fr; PG8_LAS float* RS = X + 2048;
        if (MODE == 0) rstd_to_lds(ssq, u.pm * BM, RS);
        if (MODE == 0 || pn < 2) {
#pragma unroll
            for (int ai = 0; ai < 2; ++ai)
#pragma unroll
                for (int m = 0; m < 4; ++m)
#pragma unroll
                    for (int bj = 0; bj < 2; ++bj) { float s = sumsq4(acc[ai][bj][m][0]) + sumsq4(acc[ai][bj][m][1]);
                        s += __shfl_xor(s, 16); s += __shfl_xor(s, 32);
                        if (fq == 0) X[(ai * HALF + rl0 + m * 16) * 8 + bj * 4 + wc] = s; }
            epi_bar();
            const int d0 = wc * 32 + 8 * fq; const f32x4 g0 = *(const f32x4*)(g + d0) * oscale, g1 = *(const f32x4*)(g + d0 + 4) * oscale;
#pragma unroll
            for (int ai = 0; ai < 2; ++ai)
#pragma unroll
                for (int m = 0; m < 4; ++m) { const int rl = ai * HALF + rl0 + m * 16; const float rsv = (MODE == 0) ? RS[rl] : 1.0f;
#pragma unroll
                    for (int bj = 0; bj < 2; ++bj) { const f32x4 xs = *(const PG8_LAS f32x4*)(X + rl * 8 + bj * 4);
                        const float sc = rsv * __builtin_amdgcn_rsqf(sum4(xs) * rsv * rsv * (1.0f / 128.0f) + RMS_EPS);
                        bf16_t* dst = (MODE == 0) ? O + (size_t)(u.pm * BM + rl) * 512 + pn * 256 + bj * HALF + d0
                                                  : O + ((size_t)(u.pm * 4 + 2 * pn + bj) * 256 + rl) * 128 + d0;
                        *(u32x4*)dst = pack8(acc[ai][bj][m][0] * sc * g0, acc[ai][bj][m][1] * sc * g1); }
                    asm volatile("" ::: "memory"); }
        } else {
            const int d0 = wc * 32 + 8 * fq;
#pragma unroll
            for (int ai = 0; ai < 2; ++ai)
#pragma unroll
                for (int m = 0; m < 4; ++m) { const int rl = ai * HALF + rl0 + m * 16;
#pragma unroll
                    for (int bj = 0; bj < 2; ++bj) { bf16_t* dst = O2 + ((size_t)(u.pm * 4 + 2 * (pn - 2) + bj) * 128 + d0) * 256 + rl;
                        const u32x4 w = pack8(acc[ai][bj][m][0], acc[ai][bj][m][1]);
                        dst[0 * 256] = (bf16_t)(w.x & 0xffffu); dst[1 * 256] = (bf16_t)(w.x >> 16); dst[2 * 256] = (bf16_t)(w.y & 0xffffu); dst[3 * 256] = (bf16_t)(w.y >> 16);
                        dst[4 * 256] = (bf16_t)(w.z & 0xffffu); dst[5 * 256] = (bf16_t)(w.z >> 16); dst[6 * 256] = (bf16_t)(w.w & 0xffffu); dst[7 * 256] = (bf16_t)(w.w >> 16); }
                    asm volatile("" ::: "memory"); }
        }
    }
};

struct EpiSwiglu {
    static constexpr bool PERM = true, AFTER_DRAIN = false;
    const float* ssq; bf16_t* ACT; PG8_LAS float* X;
    __device__ __forceinline__ static f32x4 swi(f32x4 gt, f32x4 up) { f32x4 r;
#pragma unroll
        for (int j = 0; j < 4; ++j) { const float e = __builtin_amdgcn_exp2f(-LOG2E * gt[j]); r[j] = gt[j] * __builtin_amdgcn_rcpf(1.0f + e) * up[j]; }
        return r; }
    __device__ __forceinline__ void operator()(const f32x4 (&acc)[2][2][4][2], const Unit& u, int wr, int wc, int fr, int fq) const {
        const int rl0 = wr * 64 + fr, colb = u.pn * 128 + wc * 32 + 8 * fq; PG8_LAS float* RS = X + 2048;
        rstd_to_lds(ssq, u.pm * BM, RS); epi_bar();
#pragma unroll
        for (int ai = 0; ai < 2; ++ai)
#pragma unroll
            for (int m = 0; m < 4; ++m) { const int row = u.pm * BM + ai * HALF + rl0 + m * 16; const float rs = RS[ai * HALF + rl0 + m * 16];
                const f32x4 a0 = swi(acc[ai][0][m][0] * rs, acc[ai][1][m][0] * rs), a1 = swi(acc[ai][0][m][1] * rs, acc[ai][1][m][1] * rs);
                *(u32x4*)(ACT + (size_t)row * 2816 + colb) = pack8(a0, a1); asm volatile("" ::: "memory"); }
    }
};

struct RangeOrder {
    int nN, c0, n, c;
    __host__ __device__ bool next(int i, Unit& u) const { const int k = c - c0; if (i != 0 || k < 0 || k >= n) return false; u.pm = k / nN; u.pn = k % nN; return true; }
    __device__ __forceinline__ void a_ready(const Unit&) const {}
    __device__ __forceinline__ void done(const Unit&) const {}
};
template <class Epi, class Sched, bool ALIGN_EPI = false, bool SP2 = false>
__device__ __forceinline__ void gemm_phase(PG8_LAS unsigned char* lds, const Gemm g, const Sched& S, const Epi& E) {
    int tid_l = threadIdx.x; asm volatile("" : "+v"(tid_l));
    const int tid = tid_l, wid = __builtin_amdgcn_readfirstlane(tid >> 6), lane = tid & 63, wr = wid >> 2, wc = wid & 3, fr = lane & 15, fq = lane >> 4;
    const int K = g.K, nt = K / BK;
    unsigned voffA[2], voffB[2];
#pragma unroll
    for (int i = 0; i < 2; ++i) { int R, C; stage_rc(tid * 16 + i * 8192, R, C); const int Rb = Epi::PERM ? ((R & ~31) + perm32(R & 31)) : R;
        voffA[i] = (unsigned)(R * K + C) * 2u; voffB[i] = (unsigned)(Rb * K + C) * 2u; }
    const size_t kstep = (size_t)(BK * 2);
    const size_t hstep = (size_t)HALF * K * 2;
    const size_t tstep = 2 * hstep;
    const unsigned ldsw = (unsigned)wid * 1024u;
    const int aoff = lds_byte(wr * 64 + fr, fq * 8), boff = lds_byte(wc * 32 + fr, fq * 8);
#define PG8_SA(b, h) (((b) * 2 + (h)) * HTB)
#define PG8_SB(b, h) ((4 + (b) * 2 + (h)) * HTB)
#define PG8_STAGE(bufoff, gbase, voff) do { _Pragma("unroll") for (int _i = 0; _i < 2; ++_i) \
        __builtin_amdgcn_global_load_lds((const unsigned*)((const char*)(gbase) + (voff)[_i]), (PG8_LAS unsigned*)(lds + (bufoff) + ldsw + _i * 8192), 16, 0, 0); } while (0)
#define PG8_LDA(dst, b, h) do { _Pragma("unroll") for (int m = 0; m < 4; ++m) _Pragma("unroll") for (int k = 0; k < 2; ++k) dst[m][k] = *(const PG8_LAS bf16x8*)(lds + PG8_SA(b, h) + aoff + m * 2048 + k * 1024); } while (0)
#define PG8_LDB(dst, b, h) do { _Pragma("unroll") for (int n = 0; n < 2; ++n) _Pragma("unroll") for (int k = 0; k < 2; ++k) dst[n][k] = *(const PG8_LAS bf16x8*)(lds + PG8_SB(b, h) + boff + n * 2048 + k * 1024); } while (0)
#define PG8_MMA(ai, bj, At, Bt) do { __builtin_amdgcn_s_setprio(1); _Pragma("unroll") for (int m = 0; m < 4; ++m) _Pragma("unroll") for (int n = 0; n < 2; ++n) _Pragma("unroll") for (int k = 0; k < 2; ++k) \
        acc[ai][bj][m][n] = __builtin_amdgcn_mfma_f32_16x16x32_bf16(Bt[n][k], At[m][k], acc[ai][bj][m][n], 0, 0, 0); __builtin_amdgcn_s_setprio(0); } while (0)
#define PG8_WAIT_V(n) asm volatile("s_waitcnt vmcnt(" #n ")" ::: "memory")
#define PG8_WAIT_L(n) asm volatile("s_waitcnt lgkmcnt(" #n ")" ::: "memory")
#define PG8_BAR __builtin_amdgcn_s_barrier()
#define PG8_SCHED __builtin_amdgcn_sched_barrier(0)
    Unit cur, nxt; int ui = 0;
    if (!S.next(0, cur)) return;
    f32x4 acc[2][2][4][2];
#pragma unroll
    for (int a = 0; a < 2; ++a)
#pragma unroll
        for (int b = 0; b < 2; ++b)
#pragma unroll
            for (int m = 0; m < 4; ++m)
#pragma unroll
                for (int n = 0; n < 2; ++n) acc[a][b][m][n] = (f32x4){0.f, 0.f, 0.f, 0.f};
    bf16x8 At[4][2], B0[2][2], B1[2][2];
    const char* cA = (const char*)g.A + (size_t)cur.pm * tstep; const char* cB = (const char*)g.Bt + (size_t)cur.pn * tstep;
    S.a_ready(cur);
    if constexpr (SP2) {
        PG8_STAGE(PG8_SB(0, 0), cB, voffB); PG8_STAGE(PG8_SB(0, 1), cB + hstep, voffB); PG8_STAGE(PG8_SA(0, 0), cA, voffA); PG8_STAGE(PG8_SA(0, 1), cA + hstep, voffA);
        if (wr == 1) PG8_BAR;
        PG8_WAIT_V(2); PG8_BAR;
        PG8_STAGE(PG8_SB(1, 0), cB + kstep, voffB); PG8_STAGE(PG8_SA(1, 0), cA + kstep, voffA); PG8_STAGE(PG8_SB(1, 1), cB + hstep + kstep, voffB);
        PG8_WAIT_V(6); PG8_BAR;
    } else {
        PG8_STAGE(PG8_SB(0, 0), cB, voffB); PG8_STAGE(PG8_SA(0, 0), cA, voffA); PG8_STAGE(PG8_SB(0, 1), cB + hstep, voffB); PG8_STAGE(PG8_SA(0, 1), cA + hstep, voffA);
        if (wr == 1) PG8_BAR;
        PG8_WAIT_V(4); PG8_BAR;
        PG8_STAGE(PG8_SB(1, 0), cB + kstep, voffB); PG8_STAGE(PG8_SA(1, 0), cA + kstep, voffA); PG8_STAGE(PG8_SB(1, 1), cB + hstep + kstep, voffB);
        PG8_WAIT_V(6); PG8_BAR;
    }
    for (;;) {
        const bool has_next = S.next(ui + 1, nxt);
        const char* nA = has_next ? (const char*)g.A + (size_t)nxt.pm * tstep : cA; const char* nB = has_next ? (const char*)g.Bt + (size_t)nxt.pn * tstep : cB;
        for (int t = 0; t < nt; t += 2) {
            const bool last = (t == nt - 2);
            const char* a1 = cA + (size_t)(t + 1) * kstep;
            const char* a2 = last ? nA : cA + (size_t)(t + 2) * kstep; const char* b2 = last ? nB : cB + (size_t)(t + 2) * kstep;
            const char* a3 = a2 + kstep; const char* b3 = b2 + kstep;
            if (last && has_next) S.a_ready(nxt);
            if constexpr (SP2) {
            PG8_LDB(B0, 0, 0); PG8_LDB(B1, 0, 1); PG8_SCHED; PG8_LDA(At, 0, 0); PG8_STAGE(PG8_SA(1, 1), a1 + hstep, voffA);
            PG8_WAIT_V(8); PG8_WAIT_L(0); PG8_BAR; PG8_MMA(0, 0, At, B0); PG8_MMA(0, 1, At, B1); PG8_BAR; PG8_SCHED;
            PG8_LDA(At, 0, 1); PG8_STAGE(PG8_SB(0, 0), b2, voffB); PG8_STAGE(PG8_SB(0, 1), b2 + hstep, voffB); PG8_STAGE(PG8_SA(0, 0), a2, voffA);
            PG8_WAIT_V(8); PG8_WAIT_L(0); PG8_BAR; PG8_MMA(1, 0, At, B0); PG8_MMA(1, 1, At, B1); PG8_BAR; PG8_SCHED;
            PG8_LDB(B0, 1, 0); PG8_LDB(B1, 1, 1); PG8_SCHED; PG8_LDA(At, 1, 0); PG8_STAGE(PG8_SA(0, 1), a2 + hstep, voffA);
            PG8_WAIT_V(8); PG8_WAIT_L(0); PG8_BAR; PG8_MMA(0, 0, At, B0); PG8_MMA(0, 1, At, B1); PG8_BAR; PG8_SCHED;
            PG8_LDA(At, 1, 1); PG8_STAGE(PG8_SB(1, 0), b3, voffB); PG8_STAGE(PG8_SB(1, 1), b3 + hstep, voffB); PG8_STAGE(PG8_SA(1, 0), a3, voffA);
            PG8_WAIT_V(8); PG8_WAIT_L(0); PG8_BAR; PG8_MMA(1, 0, At, B0); PG8_MMA(1, 1, At, B1); PG8_BAR; PG8_SCHED;
            } else {
            PG8_LDB(B0, 0, 0); PG8_SCHED; PG8_LDA(At, 0, 0); PG8_STAGE(PG8_SA(1, 1), a1 + hstep, voffA);
            PG8_WAIT_L(8); PG8_BAR; PG8_WAIT_L(0); PG8_MMA(0, 0, At, B0); PG8_BAR; PG8_SCHED;
            PG8_LDB(B1, 0, 1); PG8_STAGE(PG8_SB(0, 0), b2, voffB);
            PG8_BAR; PG8_WAIT_L(0); PG8_MMA(0, 1, At, B1); PG8_BAR;
            PG8_LDA(At, 0, 1); PG8_STAGE(PG8_SA(0, 0), a2, voffA);
            PG8_BAR; PG8_WAIT_L(0); PG8_MMA(1, 0, At, B0); PG8_BAR; PG8_SCHED;
            PG8_STAGE(PG8_SB(0, 1), b2 + hstep, voffB);
            PG8_WAIT_V(6); PG8_BAR; PG8_MMA(1, 1, At, B1); PG8_BAR;
            PG8_LDB(B0, 1, 0); PG8_SCHED; PG8_LDA(At, 1, 0); PG8_STAGE(PG8_SA(0, 1), a2 + hstep, voffA);
            PG8_WAIT_L(8); PG8_BAR; PG8_WAIT_L(0); PG8_MMA(0, 0, At, B0); PG8_BAR; PG8_SCHED;
            PG8_LDB(B1, 1, 1); PG8_STAGE(PG8_SB(1, 0), b3, voffB);
            PG8_BAR; PG8_WAIT_L(0); PG8_MMA(0, 1, At, B1); PG8_BAR;
            PG8_LDA(At, 1, 1); PG8_STAGE(PG8_SA(1, 0), a3, voffA);
            PG8_BAR; PG8_WAIT_L(0); PG8_MMA(1, 0, At, B0); PG8_BAR; PG8_SCHED;
            PG8_STAGE(PG8_SB(1, 1), b3 + hstep, voffB);
            PG8_WAIT_V(6); PG8_BAR; PG8_MMA(1, 1, At, B1); PG8_BAR;
            }
        }
        if constexpr (ALIGN_EPI) { if (wr == 0) PG8_BAR; }
        if constexpr (!Epi::AFTER_DRAIN) { E(acc, cur, wr, wc, fr, fq); S.done(cur); }
        if (!has_next) break;
#pragma unroll
        for (int a = 0; a < 2; ++a)
#pragma unroll
            for (int b = 0; b < 2; ++b)
#pragma unroll
                for (int m = 0; m < 4; ++m)
#pragma unroll
                    for (int n = 0; n < 2; ++n) acc[a][b][m][n] = (f32x4){0.f, 0.f, 0.f, 0.f};
        cur = nxt; cA = nA; cB = nB; ++ui;
        if constexpr (ALIGN_EPI) { if (wr == 1) PG8_BAR; }
    }
    PG8_WAIT_V(0);
    if constexpr (!ALIGN_EPI) { if (wr == 0) PG8_BAR; }
    PG8_BAR;
    if constexpr (Epi::AFTER_DRAIN) { E.fused(acc, cur, wr, wc, fr, fq, lds, wid, lane); S.done(cur); }
#undef PG8_SA
#undef PG8_SB
#undef PG8_STAGE
#undef PG8_LDA
#undef PG8_LDB
#undef PG8_MMA
#undef PG8_WAIT_V
#undef PG8_WAIT_L
#undef PG8_BAR
#undef PG8_SCHED
}
}
#include <hip/hip_bf16.h>
#include <cmath>
namespace attn_body {
using bf16=__hip_bfloat16;
using bf16x8=__attribute__((ext_vector_type(8)))short;
using s16x4=__attribute__((ext_vector_type(4)))short;
using f32x16=__attribute__((ext_vector_type(16)))float;
using u32x4=__attribute__((ext_vector_type(4)))unsigned;
using f32x4v=__attribute__((ext_vector_type(4)))float;
typedef const __attribute__((address_space(3))) f32x4v* lds_f4p;
constexpr int BATCH=8,NHEAD=8,SEQ=8192,D=64,DM=NHEAD*D,OPITCH=1024;
constexpr int NW=8,QBLK=32,QB=QBLK*NW,KVBLK=64,NQB=SEQ/QB;
constexpr int ATTN_PITCH=DM, ATTN_UNIT_ROWS=QB;
__device__ __forceinline__ int crow(int r,int hi){return (r&3)+8*(r>>2)+4*hi;}
#define SBAR() __builtin_amdgcn_sched_barrier(0)
__device__ __forceinline__ void cmask(f32x16&p0,f32x16&p1,int jb,int qrel,int hi){
  const float NEG=-INFINITY; int kb=64*jb+4*hi;
  #pragma unroll
  for(int r=0;r<16;++r){int kv=kb+(r&3)+8*(r>>2); if(kv>qrel)p0[r]=NEG; if(kv+32>qrel)p1[r]=NEG;}
}

constexpr int NSLOT=3, SLOTB=8192;
constexpr int LDS_K=0, LDS_V=NSLOT*SLOTB, LDS_WS=2*NSLOT*SLOTB, LDS_OST=LDS_WS+NW*64*4, LDS_C2=LDS_OST+NW*4096, LDS_BYTES=LDS_C2+SEQ*4;
constexpr float C2=0.125f*1.4426950408889634f;
__device__ __forceinline__ void glds16(const void*gsrc,unsigned lds_dst){unsigned keep;
  asm volatile("s_mov_b32 %0, m0\n\ts_mov_b32 m0, %2\n\ts_nop 0\n\tglobal_load_lds_dwordx4 %1, off\n\ts_mov_b32 m0, %0":"=&s"(keep):"v"(gsrc),"s"(lds_dst):"memory");}
__device__ __forceinline__ float max3f(float a,float b,float c){float r;asm("v_max3_f32 %0, %1, %2, %3":"=v"(r):"v"(a),"v"(b),"v"(c));return r;}
__device__ __forceinline__ float max2f(float a,float b){float r;asm("v_max_f32_e32 %0, %1, %2":"=v"(r):"v"(a),"v"(b));return r;}
__device__ __forceinline__ float fadd_s(float a,float b){float r;asm("v_add_f32_e32 %0, %1, %2":"=v"(r):"v"(a),"v"(b));return r;}
__device__ __forceinline__ float fsub_s(float a,float b){float r;asm("v_sub_f32_e32 %0, %1, %2":"=v"(r):"v"(a),"v"(b));return r;}
typedef float f32x2_t __attribute__((ext_vector_type(2))); typedef __bf16 bf16x2_t __attribute__((ext_vector_type(2)));
__device__ __forceinline__ unsigned cvtpk_s(float lo,float hi){f32x2_t v={lo,hi};bf16x2_t b=__builtin_convertvector(v,bf16x2_t);return __builtin_bit_cast(unsigned,b);}
#define WAIT_BAR(N) asm volatile("s_waitcnt vmcnt(" #N ") lgkmcnt(0)\n\ts_barrier":::"memory")

__device__ __forceinline__ void qkt(f32x16&p0,f32x16&p1,const char*Kslot,const bf16x8*qr,int r32,int hi){
  const char*kb=Kslot+hi*1024+r32*16;
  #pragma unroll
  for(int d0=0;d0<4;++d0){
    const bf16x8 b0=*reinterpret_cast<const bf16x8*>(kb+d0*2048);
    const bf16x8 b1=*reinterpret_cast<const bf16x8*>(kb+d0*2048+512);
    p0=__builtin_amdgcn_mfma_f32_32x32x16_bf16(b0,qr[d0],p0,0,0,0);p1=__builtin_amdgcn_mfma_f32_32x32x16_bf16(b1,qr[d0],p1,0,0,0);}
}
typedef __attribute__((address_space(3))) const char* lds_cptr;
typedef short v4i16_t __attribute__((ext_vector_type(4)));
__device__ __forceinline__ void kload8(bf16x8*kf,lds_cptr kp){
  kf[0]=*(const __attribute__((address_space(3))) bf16x8*)(kp);      kf[1]=*(const __attribute__((address_space(3))) bf16x8*)(kp+512);
  kf[2]=*(const __attribute__((address_space(3))) bf16x8*)(kp+2048); kf[3]=*(const __attribute__((address_space(3))) bf16x8*)(kp+2560);
  kf[4]=*(const __attribute__((address_space(3))) bf16x8*)(kp+4096); kf[5]=*(const __attribute__((address_space(3))) bf16x8*)(kp+4608);
  kf[6]=*(const __attribute__((address_space(3))) bf16x8*)(kp+6144); kf[7]=*(const __attribute__((address_space(3))) bf16x8*)(kp+6656);
}
__device__ __forceinline__ void kload2(bf16x8*kf,lds_cptr kp,int j){ kf[2*j]=*(const __attribute__((address_space(3))) bf16x8*)(kp+j*2048); kf[2*j+1]=*(const __attribute__((address_space(3))) bf16x8*)(kp+j*2048+512); }
__device__ __forceinline__ s16x4 vtr(lds_cptr p){ return __builtin_bit_cast(s16x4,__builtin_amdgcn_ds_read_tr16_b64_v4i16((__attribute__((address_space(3))) v4i16_t*)p)); }
__device__ __forceinline__ float rowmax(const f32x16&p0,const f32x16&p1){
  float a=max3f(p0[0],p0[1],p1[0]),b=max3f(p0[2],p0[3],p1[1]);a=max3f(a,p1[2],p1[3]);
  #pragma unroll
  for(int r=4;r<16;r+=4){a=max3f(a,p0[r],p0[r+1]);b=max3f(b,p0[r+2],p0[r+3]);a=max3f(a,p1[r],p1[r+1]);b=max3f(b,p1[r+2],p1[r+3]);}
  const float m=max2f(a,b);
  auto rr=__builtin_amdgcn_permlane32_swap(__float_as_uint(m),__float_as_uint(m),false,false);
  return max2f(__uint_as_float(rr[0]),__uint_as_float(rr[1]));
}
__device__ __forceinline__ void pv(f32x16*o,int vb,bf16x8 pa0,bf16x8 pa1,bf16x8 pa2,bf16x8 pa3){
  #pragma unroll
  for(int d0=0;d0<2;++d0){s16x4 lo[4],hi[4];
    #pragma unroll
    for(int ks=0;ks<4;++ks){
      asm volatile("ds_read_b64_tr_b16 %0,%1 offset:%c2":"=&v"(lo[ks]):"v"(vb),"i"(d0*4096+ks*1024):"memory");
      asm volatile("ds_read_b64_tr_b16 %0,%1 offset:%c2":"=&v"(hi[ks]):"v"(vb),"i"(d0*4096+ks*1024+512):"memory");}
    asm volatile("s_waitcnt lgkmcnt(0)":::"memory");SBAR();
    #define PK(k) (bf16x8){lo[k][0],lo[k][1],lo[k][2],lo[k][3],hi[k][0],hi[k][1],hi[k][2],hi[k][3]}
    o[d0]=__builtin_amdgcn_mfma_f32_32x32x16_bf16(pa0,PK(0),o[d0],0,0,0);
    o[d0]=__builtin_amdgcn_mfma_f32_32x32x16_bf16(pa1,PK(1),o[d0],0,0,0);
    o[d0]=__builtin_amdgcn_mfma_f32_32x32x16_bf16(pa2,PK(2),o[d0],0,0,0);
    o[d0]=__builtin_amdgcn_mfma_f32_32x32x16_bf16(pa3,PK(3),o[d0],0,0,0);
    #undef PK
  }
}

#ifndef ATTN_STORE16
#define ATTN_STORE16(p,v) (*(u32x4*)(p)=(v))
#endif
template<int THRL> __device__ __forceinline__ void attn_unit(int b,int h,int qb,const bf16*Q,const bf16*__restrict__ K,const bf16*__restrict__ V,bf16*O,const float*__restrict__ NC2,int ts,char*shm){
  int tid_l=threadIdx.x; asm volatile("":"+v"(tid_l)); const int tid=tid_l,lane=tid&63,r32=lane&31,hi=lane>>5; const int wid=__builtin_amdgcn_readfirstlane(tid>>6);
  const long rowbase=(long)b*SEQ; const int q0=qb*QB;
  { const float*cg_=NC2+(long)(b*NHEAD+h)*SEQ+ts*KVBLK; float*cl_=(float*)(shm+LDS_C2); const int nq_=q0+QB-ts*KVBLK;
    for(int i_=tid*4;i_<nq_;i_+=NW*64*4)*(f32x4v*)(cl_+i_)=*(const f32x4v*)(cg_+i_); }
  const bf16*Qw=Q+(rowbase+q0+wid*QBLK)*DM+h*D;
  const bf16*Kh=K+(rowbase+(long)ts*KVBLK)*DM+h*D,*Vh=V+(rowbase+(long)ts*KVBLK)*DM+h*D;
  const unsigned lds0=(unsigned)(uintptr_t)shm;
  float*wsf=(float*)(shm+LDS_WS)+wid*64;
  const bf16*ksrc=Kh+(long)lane*DM+wid*8;
  const bf16*vsrc=Vh+(long)(16*(wid&3)+(lane>>2))*DM+(wid>>2)*32+(lane&3)*8;
  const unsigned kdst=lds0+LDS_K+wid*1024, vdst=lds0+LDS_V+wid*1024;
  #define DMA_K(t,slot) glds16(ksrc+(long)(t)*KVBLK*DM,(unsigned)__builtin_amdgcn_readfirstlane(kdst+(slot)))
  #define DMA_V(t,slot) glds16(vsrc+(long)(t)*KVBLK*DM,(unsigned)__builtin_amdgcn_readfirstlane(vdst+(slot)))
  const int vb0=(int)(lds0+LDS_V)+((lane>>4)&1)*32+(lane&3)*8+(4*hi+((lane&15)>>2))*64;
  const char*Kbase=shm+LDS_K; bf16x8 kf[8];
  const lds_cptr shm3=(lds_cptr)shm; const lds_cptr c2l=shm3+LDS_C2+16*hi; const lds_cptr kp0=shm3+LDS_K+hi*1024+r32*16; const lds_cptr vp0=shm3+LDS_V+((lane>>4)&1)*32+(lane&3)*8+(4*hi+((lane&15)>>2))*64;
  const int NT=(q0+QB)/KVBLK-ts;
  DMA_K(0,0);DMA_V(0,0);DMA_K(1,SLOTB);
  bf16x8 qr[4];
  #pragma unroll
  for(int d0=0;d0<4;++d0)qr[d0]=*reinterpret_cast<const bf16x8*>(&Qw[(long)r32*DM+d0*16+hi*8]);
  float mhat=0.f,l_reg=0.f;f32x16 o[2];o[0]=f32x16{};o[1]=f32x16{};
  const int qrel=wid*QBLK+r32;
  #define CMASK(P0,P1,t) do{int jb_=(t)-(NT-4); if(jb_>=0)cmask(P0,P1,jb_,qrel,hi);}while(0)
  bool resc=false;
  #define START(P0,P1) do{ const float rm=rowmax(P0,P1); resc=false; \
    { const float dl=rm; mhat=fadd_s(mhat,dl); \
      _Pragma("unroll") for(int r=0;r<16;++r){P0[r]=fsub_s(P0[r],dl);P1[r]=fsub_s(P1[r],dl);} \
      } \
    _Pragma("unroll") for(int r=0;r<16;++r)P0[r]=__builtin_amdgcn_exp2f(P0[r]); }while(0)
  #define RESC() do{ if(resc){ asm volatile("s_waitcnt lgkmcnt(0)":::"memory"); \
      _Pragma("unroll") for(int d_=0;d_<2;++d_) _Pragma("unroll") for(int r=0;r<16;++r)o[d_][r]*=wsf[crow(r,hi)]; } }while(0)
  f32x16 pA0,pA1,pB0,pB1;
  #define KBLD(X0,X1,tt) do{ const lds_f4p cb_=(lds_f4p)(c2l+(tt)*256); \
    _Pragma("unroll") for(int g_=0;g_<4;++g_){ const f32x4v a_=cb_[2*g_], b_=cb_[2*g_+8]; \
      X0[4*g_+0]=a_[0]-mhat; X0[4*g_+1]=a_[1]-mhat; X0[4*g_+2]=a_[2]-mhat; X0[4*g_+3]=a_[3]-mhat; \
      X1[4*g_+0]=b_[0]-mhat; X1[4*g_+1]=b_[1]-mhat; X1[4*g_+2]=b_[2]-mhat; X1[4*g_+3]=b_[3]-mhat; } }while(0)
  int sl_prev=0,sl_cur=0,sl_next=SLOTB;
  #define ROT() do{sl_prev=sl_cur;sl_cur=sl_next;sl_next=(sl_next==(NSLOT-1)*SLOTB)?0:sl_next+SLOTB;}while(0)
  DMA_K(2,2*SLOTB);
  WAIT_BAR(3);
  KBLD(pA0,pA1,0);
  qkt(pA0,pA1,Kbase,qr,r32,hi);asm volatile("s_nop 15\n\ts_nop 7":"+v"(pA0),"+v"(pA1));CMASK(pA0,pA1,0);
  START(pA0,pA1);
  KBLD(pB0,pB1,1);
  _Pragma("unroll") for(int r=0;r<16;++r)pA1[r]=__builtin_amdgcn_exp2f(pA1[r]);
  WAIT_BAR(0);
  DMA_K(3,0);DMA_V(1,SLOTB);
  ROT();
  kload8(kf,kp0+sl_cur);
  WAIT_BAR(2);
  s16x4 vlo[8],vhi[8]; u32x4 pw0,pw1,pw2,pw3;
  #define PKW(P,B) cvtpk_s(P[B],P[B+1])
  #define PAF(k) __builtin_bit_cast(bf16x8,pw##k)
  #define VFR(i) (bf16x8){vlo[i][0],vlo[i][1],vlo[i][2],vlo[i][3],vhi[i][0],vhi[i][1],vhi[i][2],vhi[i][3]}
  #define PIN(x) asm volatile("":"+v"(x))
  #define MX3(a,b,c) __builtin_fmaxf(__builtin_fmaxf((a),(b)),(c))
  #define GAPA(MF,A0,A1,A2,A3,W0,W1,PW) do{ MF; sacc+=A0; sacc+=A1; sacc+=A2; sacc+=A3; PIN(sacc); W0; W1; PIN(PW); SBAR(); }while(0)
  #define EX(v) __builtin_amdgcn_exp2f(v)
  #define GAPB(MF,X,B) do{ MF; X[B]=EX(X[B]); X[B+1]=EX(X[B+1]); X[B+2]=EX(X[B+2]); X[B+3]=EX(X[B+3]); PIN(X); SBAR(); }while(0)
  #define VRD(i) do{ vlo[i]=vtr(vp_+(((i)>>2)*4096+((i)&3)*1024)); vhi[i]=vtr(vp_+(((i)>>2)*4096+((i)&3)*1024+512)); }while(0)
  #define KRD(G,j) do{ if(G){ kload2(kf,kp0+sl_next,j); SBAR(); } }while(0)
  #define STEP(C0,C1,P0,P1,t,GK,GV,GL) do{ SBAR(); \
    const lds_cptr vp_=vp0+sl_prev; \
    VRD(0); SBAR(); float sacc=(P0[0]+P0[1]); \
    GAPA(C0=__builtin_amdgcn_mfma_f32_32x32x16_bf16(kf[0],qr[0],C0,0,0,0), P0[2],P0[3],P0[4],P0[5],     pw0[0]=PKW(P0,0), pw0[1]=PKW(P0,2), pw0); \
    VRD(4); SBAR(); GAPA(C1=__builtin_amdgcn_mfma_f32_32x32x16_bf16(kf[1],qr[0],C1,0,0,0), P0[6],P0[7],P0[8],P0[9],     pw0[2]=PKW(P0,4), pw0[3]=PKW(P0,6), pw0); \
    VRD(1); SBAR(); GAPA(C0=__builtin_amdgcn_mfma_f32_32x32x16_bf16(kf[2],qr[1],C0,0,0,0),   P0[10],P0[11],P0[12],P0[13], pw1[0]=PKW(P0,8), pw1[1]=PKW(P0,10), pw1); \
    VRD(5); SBAR(); GAPA(C1=__builtin_amdgcn_mfma_f32_32x32x16_bf16(kf[3],qr[1],C1,0,0,0),   P0[14],P0[15],P1[0],P1[1],   pw1[2]=PKW(P0,12),pw1[3]=PKW(P0,14), pw1); \
    VRD(2); SBAR(); GAPA(C0=__builtin_amdgcn_mfma_f32_32x32x16_bf16(kf[4],qr[2],C0,0,0,0),   P1[2],P1[3],P1[4],P1[5],     pw2[0]=PKW(P1,0), pw2[1]=PKW(P1,2), pw2); \
    VRD(6); SBAR(); GAPA(C1=__builtin_amdgcn_mfma_f32_32x32x16_bf16(kf[5],qr[2],C1,0,0,0),   P1[6],P1[7],P1[8],P1[9],     pw2[2]=PKW(P1,4), pw2[3]=PKW(P1,6), pw2); \
    VRD(3); SBAR(); GAPA(C0=__builtin_amdgcn_mfma_f32_32x32x16_bf16(kf[6],qr[3],C0,0,0,0),   P1[10],P1[11],P1[12],P1[13], pw3[0]=PKW(P1,8), pw3[1]=PKW(P1,10), pw3); \
    VRD(7); SBAR(); GAPA(C1=__builtin_amdgcn_mfma_f32_32x32x16_bf16(kf[7],qr[3],C1,0,0,0),   P1[14],P1[15],0.f,0.f,       pw3[2]=PKW(P1,12),pw3[3]=PKW(P1,14), pw3); \
    l_reg+=sacc; \
    if(GK){DMA_K((t)+3,sl_cur);} if(GV){DMA_V((t)+1,sl_next);} \
    CMASK(C0,C1,t); \
    { float a=MX3(C0[0],C0[1],C1[0]),b=MX3(C0[2],C0[3],C1[1]); a=MX3(a,C1[2],C1[3]); \
      _Pragma("unroll") for(int r=4;r<16;r+=4){a=MX3(a,C0[r],C0[r+1]);b=MX3(b,C0[r+2],C0[r+3]);a=MX3(a,C1[r],C1[r+1]);b=MX3(b,C1[r+2],C1[r+3]);} \
      float rm=__builtin_fmaxf(a,b); { auto rr=__builtin_amdgcn_permlane32_swap(__float_as_uint(rm),__float_as_uint(rm),false,false); rm=__builtin_fmaxf(__uint_as_float(rr[0]),__uint_as_float(rr[1])); } \
      resc=false; \
      if(__builtin_expect(__any(rm>(float)THRL),0)){ const float dl=__builtin_fmaxf(rm,0.f); mhat+=dl; \
        _Pragma("unroll") for(int r=0;r<16;++r){C0[r]-=dl;C1[r]-=dl;} \
        const float f=__builtin_amdgcn_exp2f(-dl); l_reg*=f; if(hi==0)wsf[r32]=f; resc=true; } } \
    SBAR(); \
    GAPB(o[0]=__builtin_amdgcn_mfma_f32_32x32x16_bf16(PAF(0),VFR(0),o[0],0,0,0), C0,0); \
    GAPB(o[1]=__builtin_amdgcn_mfma_f32_32x32x16_bf16(PAF(0),VFR(4),o[1],0,0,0), C0,4); \
    KRD(GL,0); GAPB(o[0]=__builtin_amdgcn_mfma_f32_32x32x16_bf16(PAF(1),VFR(1),o[0],0,0,0), C0,8); \
    KRD(GL,1); GAPB(o[1]=__builtin_amdgcn_mfma_f32_32x32x16_bf16(PAF(1),VFR(5),o[1],0,0,0), C0,12); \
    KRD(GL,2); GAPB(o[0]=__builtin_amdgcn_mfma_f32_32x32x16_bf16(PAF(2),VFR(2),o[0],0,0,0), C1,0); \
    KRD(GL,3); GAPB(o[1]=__builtin_amdgcn_mfma_f32_32x32x16_bf16(PAF(2),VFR(6),o[1],0,0,0), C1,4); \
    GAPB(o[0]=__builtin_amdgcn_mfma_f32_32x32x16_bf16(PAF(3),VFR(3),o[0],0,0,0), C1,8); \
    GAPB(o[1]=__builtin_amdgcn_mfma_f32_32x32x16_bf16(PAF(3),VFR(7),o[1],0,0,0), C1,12); \
    if(GL){ KBLD(P0,P1,(t)+1); } \
    }while(0)
  int t=1;
  #undef CMASK
  #define CMASK(P0,P1,t) do{}while(0)
  for(;t+5<NT;t+=2){
    STEP(pB0,pB1,pA0,pA1,t,true,true,true);     WAIT_BAR(2); RESC(); ROT();
    STEP(pA0,pA1,pB0,pB1,t+1,true,true,true);   WAIT_BAR(2); RESC(); ROT();
  }
  #undef CMASK
  #define CMASK(P0,P1,t) do{int jb_=(t)-(NT-4); if(jb_>=0)cmask(P0,P1,jb_,qrel,hi);}while(0)
  #define ENDW(tt) do{ if((tt)+3<NT){WAIT_BAR(2);} else if((tt)+2<NT){WAIT_BAR(1);} else {WAIT_BAR(0);} }while(0)
  for(;t+1<NT;t+=2){
    STEP(pB0,pB1,pA0,pA1,t,(t+3<NT),(t+1<NT),(t+1<NT));       ENDW(t);   RESC(); ROT();
    STEP(pA0,pA1,pB0,pB1,t+1,(t+4<NT),(t+2<NT),(t+2<NT));     ENDW(t+1); RESC(); ROT();
  }
  STEP(pB0,pB1,pA0,pA1,NT-1,false,false,false); RESC();
  { float sacc=pB0[0]+pB0[1]; _Pragma("unroll") for(int r=2;r<16;++r)sacc+=pB0[r]; _Pragma("unroll") for(int r=0;r<16;++r)sacc+=pB1[r]; l_reg+=sacc;
    pw0=(u32x4){PKW(pB0,0),PKW(pB0,2),PKW(pB0,4),PKW(pB0,6)};pw1=(u32x4){PKW(pB0,8),PKW(pB0,10),PKW(pB0,12),PKW(pB0,14)};pw2=(u32x4){PKW(pB1,0),PKW(pB1,2),PKW(pB1,4),PKW(pB1,6)};pw3=(u32x4){PKW(pB1,8),PKW(pB1,10),PKW(pB1,12),PKW(pB1,14)};
    SBAR(); pv(o,vb0+sl_cur,PAF(0),PAF(1),PAF(2),PAF(3)); }
  #undef PKW
  #undef PAF
  #undef VFR
  #undef PIN
  #undef MX3
  #undef GAPA
  #undef GAPB
  #undef EX
  #undef VRD
  #undef KRD
  #undef STEP
  #undef ENDW
  {auto rr=__builtin_amdgcn_permlane32_swap(__float_as_uint(l_reg),__float_as_uint(l_reg),false,false);l_reg=__uint_as_float(rr[0])+__uint_as_float(rr[1]);}
  if(hi==0)wsf[32+r32]=l_reg;asm volatile("s_waitcnt lgkmcnt(0)":::"memory");
  float rli[16];
  #pragma unroll
  for(int r=0;r<16;++r)rli[r]=__builtin_amdgcn_rcpf(wsf[32+crow(r,hi)]);
  bf16*Ow=O+(rowbase+q0+wid*QBLK)*OPITCH+h*D;
  { bf16*stg=(bf16*)(shm+LDS_OST)+wid*2048;
    #pragma unroll
    for(int r=0;r<16;++r){const int orow=crow(r,hi);
      #pragma unroll
      for(int d0=0;d0<2;++d0)stg[orow*64+d0*32+r32]=__float2bfloat16(o[d0][r]*rli[r]);}
    asm volatile("s_waitcnt lgkmcnt(0)":::"memory");
    #pragma unroll
    for(int i=0;i<4;++i){const int row=i*8+(lane>>3),ch=lane&7; const u32x4 v=*(const u32x4*)(stg+row*64+ch*8); ATTN_STORE16(Ow+(long)row*OPITCH+ch*8,v);} }
  asm volatile("s_waitcnt lgkmcnt(0)\n\ts_barrier":::"memory");
  #undef DMA_K
  #undef DMA_V
  #undef CMASK
  #undef START
  #undef RESC
  #undef ROT
  #undef KBLD
}
constexpr int ATTN_LDS_BYTES=LDS_BYTES;
struct AttnTensors { const bf16* Q; const bf16* K; const bf16* V; bf16* O; const float* NC2; const int* TS; };
struct AttnUnit { int bh; int qb; };
struct QueueOrder {
  unsigned* cnt; volatile __attribute__((address_space(3))) unsigned* slot;
  __device__ __forceinline__ bool next(int,AttnUnit&u)const{
    if(threadIdx.x==0)*slot=__hip_atomic_fetch_add(cnt,1u,__ATOMIC_RELAXED,__HIP_MEMORY_SCOPE_AGENT);
    __syncthreads(); const unsigned n=*slot; if(n>=(unsigned)(BATCH*NHEAD*NQB))return false; u.qb=NQB-1-(int)(n>>6); u.bh=(int)(n&63u); return true; }
  __device__ __forceinline__ void a_ready(const AttnUnit&)const{}
  __device__ __forceinline__ void done(const AttnUnit&)const{}
};
struct StaticOrder {
  int vcu;
  __device__ __forceinline__ explicit StaticOrder(int grid,int block):vcu((block%8)*(grid/8)+block/8){}
  __device__ __forceinline__ bool next(int i,AttnUnit&u)const{ if(i>=8)return false; const int s=vcu&3; u.bh=vcu>>2; u.qb=8*(i>>1)+((i&1)?7-s:s); return true; }
  __device__ __forceinline__ void a_ready(const AttnUnit&)const{}
  __device__ __forceinline__ void done(const AttnUnit&)const{}
};
template<class Sched,int THRL=8> __device__ __forceinline__ void attn_phase(char*lds,const AttnTensors&T,const Sched&S){
  AttnUnit u;
  for(int i=0;S.next(i,u);++i){ S.a_ready(u); attn_unit<THRL>(u.bh/NHEAD,u.bh%NHEAD,u.qb,T.Q,T.K,T.V,T.O,T.NC2,__builtin_amdgcn_readfirstlane(T.TS[u.bh*NQB+u.qb]),lds); S.done(u); }
}
#undef SBAR
#undef WAIT_BAR
}
namespace xat {
#define XLAS __attribute__((address_space(3)))
typedef unsigned short bf16_t;
typedef short bf16x8 __attribute__((ext_vector_type(8)));
typedef float f32x16 __attribute__((ext_vector_type(16)));
typedef unsigned u32x4 __attribute__((ext_vector_type(4)));
typedef unsigned u32x2 __attribute__((ext_vector_type(2)));
constexpr int KROW = 272, VROW = 520, LDS_K = 0, LDS_V = 256 * KROW, LDS_END = LDS_V + 128 * VROW;
__device__ __forceinline__ unsigned cvtpk(float lo, float hi) { unsigned r; asm volatile("v_cvt_pk_bf16_f32 %0, %1, %2" : "=v"(r) : "v"(lo), "v"(hi)); return r; }
__device__ __forceinline__ void load_kv(const bf16_t* MKbh, const bf16_t* MVtbh, XLAS unsigned char* lds, int tid) {
    for (int i = tid; i < 4096; i += 512) { const int row = i >> 4, ch = i & 15; const u32x4 v = *(const u32x4*)(MKbh + row * 128 + ch * 8); *(XLAS u32x4*)(lds + LDS_K + row * KROW + ch * 16) = v; }
    for (int i = tid; i < 4096; i += 512) { const int row = i >> 5, ch = i & 31; const u32x4 v = *(const u32x4*)(MVtbh + row * 256 + ch * 8);
        XLAS u32x2* p = (XLAS u32x2*)(lds + LDS_V + row * VROW + ch * 16); p[0] = (u32x2){v.x, v.y}; p[1] = (u32x2){v.z, v.w}; }
}
__device__ __forceinline__ void unit(const bf16_t* MQ, bf16_t* MO, int b, int h, int qblk, XLAS unsigned char* lds) {
    int tid = threadIdx.x; asm volatile("" : "+v"(tid)); const int lane = tid & 63, r32 = lane & 31, hi = lane >> 5, wid = tid >> 6;
    const size_t row = (size_t)b * 8192 + qblk * 256 + wid * 32 + r32;
    const bf16_t* qp = MQ + row * 512 + h * 128 + hi * 8;
    bf16x8 qr[8];
#pragma unroll
    for (int d0 = 0; d0 < 8; ++d0) qr[d0] = *(const bf16x8*)(qp + d0 * 16);
    f32x16 S[8];
#pragma unroll
    for (int kb = 0; kb < 8; ++kb) { S[kb] = f32x16{};
#pragma unroll
        for (int d0 = 0; d0 < 8; ++d0) { const bf16x8 kf = *(const XLAS bf16x8*)(lds + LDS_K + (32 * kb + r32) * KROW + d0 * 32 + hi * 16);
            S[kb] = __builtin_amdgcn_mfma_f32_32x32x16_bf16(kf, qr[d0], S[kb], 0, 0, 0); }
        __builtin_amdgcn_sched_barrier(0); }
    float m = S[0][0];
#pragma unroll
    for (int kb = 0; kb < 8; ++kb)
#pragma unroll
        for (int r = 0; r < 16; ++r) m = fmaxf(m, S[kb][r]);
    m = fmaxf(m, __shfl_xor(m, 32));
    float l = 0.f;
#pragma unroll
    for (int kb = 0; kb < 8; ++kb)
#pragma unroll
        for (int r = 0; r < 16; ++r) { const float p = __builtin_amdgcn_exp2f(S[kb][r] - m); S[kb][r] = p; l += p; }
    l += __shfl_xor(l, 32);
    u32x4 pw[8][2];
#pragma unroll
    for (int kb = 0; kb < 8; ++kb)
#pragma unroll
        for (int sp = 0; sp < 2; ++sp) { pw[kb][sp].x = cvtpk(S[kb][8 * sp + 0], S[kb][8 * sp + 1]); pw[kb][sp].y = cvtpk(S[kb][8 * sp + 2], S[kb][8 * sp + 3]); pw[kb][sp].z = cvtpk(S[kb][8 * sp + 4], S[kb][8 * sp + 5]); pw[kb][sp].w = cvtpk(S[kb][8 * sp + 6], S[kb][8 * sp + 7]); }
    __builtin_amdgcn_sched_barrier(0);
    f32x16 o[4];
#pragma unroll
    for (int db = 0; db < 4; ++db) o[db] = f32x16{};
#pragma unroll
    for (int kb = 0; kb < 8; ++kb)
#pragma unroll
        for (int sp = 0; sp < 2; ++sp) {
            const bf16x8 pk = __builtin_bit_cast(bf16x8, pw[kb][sp]);
#pragma unroll
            for (int db = 0; db < 4; ++db) { const XLAS unsigned char* vb = lds + LDS_V + (32 * db + r32) * VROW + (32 * kb + 16 * sp + 4 * hi) * 2;
                const u32x2 lo = *(const XLAS u32x2*)vb, hh = *(const XLAS u32x2*)(vb + 16);
                const u32x4 vw = (u32x4){lo.x, lo.y, hh.x, hh.y};
                o[db] = __builtin_amdgcn_mfma_f32_32x32x16_bf16(__builtin_bit_cast(bf16x8, vw), pk, o[db], 0, 0, 0); }
            __builtin_amdgcn_sched_barrier(0); }
    const float inv = 1.0f / l;
    bf16_t* op = MO + row * 512 + h * 128 + 4 * hi;
#pragma unroll
    for (int db = 0; db < 4; ++db)
#pragma unroll
        for (int g = 0; g < 4; ++g) { u32x2 w; w.x = cvtpk(o[db][4 * g + 0] * inv, o[db][4 * g + 1] * inv); w.y = cvtpk(o[db][4 * g + 2] * inv, o[db][4 * g + 3] * inv);
            *(u32x2*)(op + 32 * db + 8 * g) = w; }
}
}

namespace cg = cooperative_groups;
#define LAS __attribute__((address_space(3)))
typedef unsigned short bf16;
typedef unsigned v4u __attribute__((ext_vector_type(4)));
typedef unsigned v2u __attribute__((ext_vector_type(2)));
typedef float f32x4 __attribute__((ext_vector_type(4)));
constexpr int NWAVES = 8;
constexpr int DM = 1024, BATCH = 8, SEQ = 8192, MTOK = BATCH * SEQ, DEPTH = 2, NIN = 2056, NINP = 2304, DFF = 2816, MEMLEN = 256;
constexpr float EPS = 1e-6f;
constexpr size_t MiB = 1u << 20;
constexpr size_t WS_W = 1 * MiB, WS_WSTRIDE = 28 * MiB;
constexpr size_t WO_IN = 0, WO_OUT = 5 * MiB, WO_MQ = 7 * MiB, WO_MKV = 8 * MiB, WO_MO = 10 * MiB, WO_GU = 11 * MiB, WO_D = 22 * MiB;
constexpr size_t WS_QCNT = 0, WS_TS = 4096;
constexpr size_t WS_LF = 58 * MiB, WS_NC2 = 60 * MiB, WS_SSQ = 62 * MiB, WS_MN = 66 * MiB, WS_MK = 74 * MiB, WS_MVT = 78 * MiB;
constexpr size_t WS_HB = 96 * MiB, WS_Q = 224 * MiB, WS_K = 288 * MiB, WS_V = 352 * MiB, WS_P = 416 * MiB, WS_CAT = 480 * MiB, WS_MQ = 608 * MiB, WS_MO = 672 * MiB, WS_END = 736 * MiB;
constexpr size_t WS_ACT = 224 * MiB;
static_assert(WS_ACT + (size_t)MTOK * DFF * 2 <= WS_MQ, "ACT overlay");
constexpr int RING_BYTES = 131072, EPIX_OFF = 132096, LDS_BYTES = 147456;

__device__ __forceinline__ unsigned f2bf(float f) { unsigned u = __builtin_bit_cast(unsigned, f); return (u + 0x7fffu + ((u >> 16) & 1u)) >> 16; }
__device__ __forceinline__ unsigned pk2(float lo, float hi) { return f2bf(lo) | (f2bf(hi) << 16); }
__device__ __forceinline__ float wave_sum(float v) {
#pragma unroll
    for (int o = 1; o < 64; o <<= 1) v += __shfl_xor(v, o);
    return v;
}
__device__ __forceinline__ void tr_item(const float* W, int N, int k0, int n0, const float* g, bf16* WT, int Kdst, int drow0, LAS float* scr, int lane) {
    const int nn = lane & 31; const bool ok = (n0 + nn) < N;
#pragma unroll 8
    for (int i = 0; i < 32; ++i) { const int kk = 2 * i + (lane >> 5); float v = ok ? W[(size_t)(k0 + kk) * N + n0 + nn] : 0.f; if (g) v *= g[k0 + kk]; scr[kk * 33 + nn] = v; }
    asm volatile("s_waitcnt lgkmcnt(0)" ::: "memory");
    const int c = lane & 7;
#pragma unroll
    for (int j = 0; j < 4; ++j) { const int n = (lane >> 3) + 8 * j; const LAS float* s = scr + (8 * c) * 33 + n;
        v4u o; o.x = pk2(s[0 * 33], s[1 * 33]); o.y = pk2(s[2 * 33], s[3 * 33]); o.z = pk2(s[4 * 33], s[5 * 33]); o.w = pk2(s[6 * 33], s[7 * 33]);
        *(v4u*)(WT + (size_t)(drow0 + n) * Kdst + k0 + 8 * c) = o; }
    asm volatile("s_waitcnt lgkmcnt(0)" ::: "memory");
}

#ifndef PHMASK
#define PHMASK 0x3ff
#endif
__device__ __forceinline__ unsigned long long karg(int k) {
    const __attribute__((address_space(4))) unsigned long long* ka = (const __attribute__((address_space(4))) unsigned long long*)__builtin_amdgcn_kernarg_segment_ptr();
    asm volatile("" : "+s"(ka)); return ka[k];
}
#define GSYNC() grid.sync()
struct Args { const float* in[20]; float* out; unsigned char* ws; };

__global__ void __launch_bounds__(NWAVES * 64, 2) fwd_megakernel(Args args) {
    extern __shared__ __attribute__((aligned(16))) unsigned char lds[];
    cg::grid_group grid = cg::this_grid();
    LAS unsigned char* const L = (LAS unsigned char*)lds;
    const int wave = __builtin_amdgcn_readfirstlane((int)threadIdx.x >> 6);
    const int G = gridDim.x, bx = blockIdx.x;
    const int vcu = (G % 8 == 0) ? (bx % 8) * (G / 8) + bx / 8 : bx;
    LAS float* const EX = (LAS float*)(L + EPIX_OFF);
#define DEFPTRS \
    int tid = threadIdx.x; asm volatile("" : "+v"(tid)); const int lane = tid & 63; (void)lane; \
    unsigned char* const ws = (unsigned char*)karg(21); float* const out = (float*)karg(20); (void)out; \
    bf16* const HB = (bf16*)(ws + WS_HB); bf16* const Qb = (bf16*)(ws + WS_Q); bf16* const Kb = (bf16*)(ws + WS_K); bf16* const Vb = (bf16*)(ws + WS_V); bf16* const Pb = (bf16*)(ws + WS_P); \
    bf16* const CAT = (bf16*)(ws + WS_CAT); bf16* const MQ = (bf16*)(ws + WS_MQ); bf16* const MO = (bf16*)(ws + WS_MO); bf16* const ACT = (bf16*)(ws + WS_ACT); \
    float* const LF = (float*)(ws + WS_LF); float* const NC2 = (float*)(ws + WS_NC2); float* const SSQ = (float*)(ws + WS_SSQ); \
    bf16* const MN = (bf16*)(ws + WS_MN); bf16* const MK = (bf16*)(ws + WS_MK); bf16* const MVT = (bf16*)(ws + WS_MVT); \
    (void)HB; (void)Qb; (void)Kb; (void)Vb; (void)Pb; (void)CAT; (void)MQ; (void)MO; (void)ACT; (void)LF; (void)NC2; (void)SSQ; (void)MN; (void)MK; (void)MVT;
#define IN(k) ((const float*)karg(k))

    if constexpr ((PHMASK >> 0) & 1) { DEFPTRS
        LAS float* scr = (LAS float*)(L + wave * 16384);
        const int gw = vcu * NWAVES + wave, NGW = G * NWAVES;
        constexpr int I_IN = 16 * 72, I_OUT = 8 * 32, I_MQ = 16 * 16, I_MKV = 16 * 32, I_MO = 8 * 32, I_GU = 16 * 176, I_D = 44 * 32, I_L = I_IN + I_OUT + I_MQ + I_MKV + I_MO + I_GU + I_D;
        for (int it = gw; it < DEPTH * I_L; it += NGW) {
            const int l = it / I_L; int r = it % I_L; unsigned char* wl = ws + WS_W + (size_t)l * WS_WSTRIDE;
            if (r < I_IN) { const int kb = r / 72, nb = r % 72; tr_item(IN(3) + (size_t)l * DM * NIN, NIN, 64 * kb, 32 * nb, IN(2) + l * DM, (bf16*)(wl + WO_IN), DM, 32 * nb, scr, lane); continue; } r -= I_IN;
            if (r < I_OUT) { const int kb = r / 32, nb = r % 32; tr_item(IN(9) + (size_t)l * DM * DM, DM, 64 * kb, 32 * nb, nullptr, (bf16*)(wl + WO_OUT), DM, 32 * nb, scr, lane); continue; } r -= I_OUT;
            if (r < I_MQ) { const int kb = r / 16, nb = r % 16; tr_item(IN(12) + (size_t)l * DM * 512, 512, 64 * kb, 32 * nb, IN(10) + l * DM, (bf16*)(wl + WO_MQ), DM, 32 * nb, scr, lane); continue; } r -= I_MQ;
            if (r < I_MKV) { const int kb = r / 32, nb = r % 32; tr_item(IN(13) + (size_t)l * DM * 1024, 1024, 64 * kb, 32 * nb, nullptr, (bf16*)(wl + WO_MKV), DM, 32 * nb, scr, lane); continue; } r -= I_MKV;
            if (r < I_MO) { const int kb = r / 32, nb = r % 32; tr_item(IN(16) + (size_t)l * 512 * DM, DM, 64 * kb, 32 * nb, nullptr, (bf16*)(wl + WO_MO), 512, 32 * nb, scr, lane); continue; } r -= I_MO;
            if (r < I_GU) { const int kb = r / 176, nb = r % 176; const int n0 = 32 * nb; const int drow = (n0 < DFF) ? (n0 / 128) * 256 + (n0 % 128) : ((n0 - DFF) / 128) * 256 + 128 + ((n0 - DFF) % 128);
                tr_item(IN(18) + (size_t)l * DM * 2 * DFF, 2 * DFF, 64 * kb, n0, IN(17) + l * DM, (bf16*)(wl + WO_GU), DM, drow, scr, lane); continue; } r -= I_GU;
            { const int kb = r / 32, nb = r % 32; tr_item(IN(19) + (size_t)l * DFF * DM, DM, 64 * kb, 32 * nb, nullptr, (bf16*)(wl + WO_D), DFF, 32 * nb, scr, lane); }
        }
        if (bx == 0 && tid < DEPTH) ((unsigned*)(ws + WS_QCNT))[tid * 64] = 0u;
        for (int idx = bx * 512 + tid; idx < DEPTH * 512 * 1024; idx += G * 512) {
            const int l = idx / (512 * 1024), rem = idx % (512 * 1024), kc = rem / 1024, n = rem % 1024, g = kc >> 7, c = kc & 127;
            const float* wp = IN(7) + ((size_t)(l * 4 + g) * 128 + c) * 128; const float* ps = IN(8) + l * 512 + g * 128; const float* wo = IN(9) + (size_t)l * DM * DM + (size_t)(512 + g * 128) * DM + n;
            float a = 0.f;
            for (int d = 0; d < 128; ++d) a += wp[d] * ps[d] * wo[(size_t)d * DM];
            ((bf16*)(ws + WS_W + (size_t)l * WS_WSTRIDE + WO_OUT))[(size_t)n * DM + 512 + kc] = (bf16)f2bf(a);
        }
        for (int m = gw; m < MTOK; m += NGW) {
            const f32x4* xr = (const f32x4*)(IN(0) + (size_t)m * DM) + lane; f32x4 v[4]; float s = 0.f;
#pragma unroll
            for (int j = 0; j < 4; ++j) { v[j] = xr[64 * j]; s += (v[j].x * v[j].x + v[j].y * v[j].y) + (v[j].z * v[j].z + v[j].w * v[j].w); }
            s = wave_sum(s);
            v2u* o8 = (v2u*)(HB + (size_t)m * DM) + lane;
#pragma unroll
            for (int j = 0; j < 4; ++j) o8[64 * j] = (v2u){pk2(v[j].x, v[j].y), pk2(v[j].z, v[j].w)};
            if (lane < 16) SSQ[(size_t)m * 16 + lane] = (lane == 0) ? s : 0.f;
        }
        for (int m = gw; m < DEPTH * BATCH * MEMLEN; m += NGW) {
            const int l = m / (BATCH * MEMLEN), rr = m % (BATCH * MEMLEN);
            const f32x4* xr = (const f32x4*)(IN(1) + (size_t)rr * DM) + lane; const f32x4* gr = (const f32x4*)(IN(11) + l * DM) + lane; f32x4 v[4]; float s = 0.f;
#pragma unroll
            for (int j = 0; j < 4; ++j) { v[j] = xr[64 * j]; s += (v[j].x * v[j].x + v[j].y * v[j].y) + (v[j].z * v[j].z + v[j].w * v[j].w); }
            const float rstd = 1.0f / sqrtf(wave_sum(s) * (1.0f / DM) + EPS);
            v2u* o8 = (v2u*)(MN + (size_t)m * DM) + lane;
#pragma unroll
            for (int j = 0; j < 4; ++j) { const f32x4 gg = gr[64 * j]; o8[64 * j] = (v2u){pk2(v[j].x * rstd * gg.x, v[j].y * rstd * gg.y), pk2(v[j].z * rstd * gg.z, v[j].w * rstd * gg.w)}; }
        }
    }
    GSYNC();

    for (int l = 0; l < DEPTH; ++l) {
        if constexpr ((PHMASK >> 1) & 1) { DEFPTRS
            pg8::Gemm g{HB, (const bf16*)(ws + WS_W + (size_t)l * WS_WSTRIDE + WO_IN), MTOK, NINP, DM}; pg8::StaticOrder S; S.init(MTOK, NINP, G, bx);
            pg8::EpiInProj E{SSQ, Qb, Kb, Vb, Pb, LF, IN(5) + l * 64, IN(6) + l * 64, IN(4) + l * 8, EX, 0.125f * pg8::LOG2E};
            pg8::gemm_phase<pg8::EpiInProj, pg8::StaticOrder, true, true>(L, g, S, E);
        }
        GSYNC();
        if constexpr ((PHMASK >> 2) & 1) { DEFPTRS
            if (bx < 64) {
                const int b = bx >> 3, h = bx & 7; const float* src = LF + ((size_t)b * SEQ + tid * 16) * 8 + h; float v[16]; float s = 0.f;
#pragma unroll
                for (int j = 0; j < 16; ++j) { s += src[j * 8]; v[j] = s; }
                LAS float* sc = (LAS float*)L; sc[tid] = s; __syncthreads();
                for (int off = 1; off < 512; off <<= 1) { const float t = (tid >= off) ? sc[tid - off] : 0.f; __syncthreads(); sc[tid] += t; __syncthreads(); }
                const float excl = sc[tid] - s; float* dst = NC2 + (size_t)bx * SEQ + tid * 16; LAS float* ncl = (LAS float*)(L + 4096) + tid * 16;
#pragma unroll
                for (int j = 0; j < 16; j += 4) { const f32x4 nv = (f32x4){-(excl + v[j]), -(excl + v[j + 1]), -(excl + v[j + 2]), -(excl + v[j + 3])}; *(f32x4*)(dst + j) = nv; *(LAS f32x4*)(ncl + j) = nv; }
                __syncthreads();
                if (tid < 32) {
                    float gq = 0.f, gk = 0.f; const float* gqp = IN(5) + l * 64; const float* gkp = IN(6) + l * 64;
                    for (int d = 0; d < 64; ++d) { gq = fmaxf(gq, fabsf(gqp[d])); gk = fmaxf(gk, fabsf(gkp[d])); }
                    const float thresh = 2.0f * (64.0f * gq * gk * 0.125f * pg8::LOG2E) + 30.0f;
                    const LAS float* nc = (const LAS float*)(L + 4096); const float ref = nc[256 * tid]; int t = 0;
                    while (t < 4 * tid && ref - nc[64 * t + 63] > thresh) ++t;
                    ((int*)(ws + WS_TS))[bx * 32 + tid] = t & ~1;
                }
                __syncthreads();
            } else if (l == 0 && bx < 128) {
                const int l2 = (bx - 64) >> 5;
                pg8::Gemm g{MN + (size_t)l2 * BATCH * MEMLEN * DM, (const bf16*)(ws + WS_W + (size_t)l2 * WS_WSTRIDE + WO_MKV), BATCH * MEMLEN, 1024, DM};
                pg8::RangeOrder S{4, 64 + 32 * l2, 32, bx};
                pg8::EpiHead128<1> E{nullptr, MK + (size_t)l2 * BATCH * 4 * MEMLEN * 128, MVT + (size_t)l2 * BATCH * 4 * MEMLEN * 128, IN(15) + l2 * 128, EX, 1.0f};
                pg8::gemm_phase<pg8::EpiHead128<1>, pg8::RangeOrder, true, true>(L, g, S, E);
            }
            for (int task = bx * 512 + tid; task < (MTOK / 32) * 64; task += G * 512) {
                const int cgp = task & 63, r0 = (task >> 6) * 32, t0 = r0 & (SEQ - 1), w = 2 << (cgp >> 4);
                const bf16* pp = Pb + (size_t)r0 * 512 + cgp * 8; bf16* op = CAT + (size_t)r0 * DM + 512 + cgp * 8;
                float sum[8];
#pragma unroll
                for (int j = 0; j < 8; ++j) sum[j] = 0.f;
                for (int j = 1; j < w; ++j) if (t0 - j >= 0) { const v4u u = *(const v4u*)(pp - (ptrdiff_t)j * 512);
                    sum[0] += __uint_as_float(u.x << 16); sum[1] += __uint_as_float(u.x & 0xffff0000u); sum[2] += __uint_as_float(u.y << 16); sum[3] += __uint_as_float(u.y & 0xffff0000u);
                    sum[4] += __uint_as_float(u.z << 16); sum[5] += __uint_as_float(u.z & 0xffff0000u); sum[6] += __uint_as_float(u.w << 16); sum[7] += __uint_as_float(u.w & 0xffff0000u); }
                for (int i = 0; i < 32; ++i) {
                    const v4u u = *(const v4u*)(pp + (size_t)i * 512); float cur[8];
                    cur[0] = __uint_as_float(u.x << 16); cur[1] = __uint_as_float(u.x & 0xffff0000u); cur[2] = __uint_as_float(u.y << 16); cur[3] = __uint_as_float(u.y & 0xffff0000u);
                    cur[4] = __uint_as_float(u.z << 16); cur[5] = __uint_as_float(u.z & 0xffff0000u); cur[6] = __uint_as_float(u.w << 16); cur[7] = __uint_as_float(u.w & 0xffff0000u);
                    const int t = t0 + i; const float rc = 1.0f / (float)((t + 1 < w) ? t + 1 : w); float o[8];
#pragma unroll
                    for (int j = 0; j < 8; ++j) { sum[j] += cur[j]; o[j] = sum[j] * rc - cur[j]; }
                    *(v4u*)(op + (size_t)i * DM) = (v4u){pk2(o[0], o[1]), pk2(o[2], o[3]), pk2(o[4], o[5]), pk2(o[6], o[7])};
                    if (t + 1 - w >= 0) { const v4u q = *(const v4u*)(pp + (ptrdiff_t)(i + 1 - w) * 512);
                        sum[0] -= __uint_as_float(q.x << 16); sum[1] -= __uint_as_float(q.x & 0xffff0000u); sum[2] -= __uint_as_float(q.y << 16); sum[3] -= __uint_as_float(q.y & 0xffff0000u);
                        sum[4] -= __uint_as_float(q.z << 16); sum[5] -= __uint_as_float(q.z & 0xffff0000u); sum[6] -= __uint_as_float(q.w << 16); sum[7] -= __uint_as_float(q.w & 0xffff0000u); }
                }
            }
        }
        GSYNC();
        if constexpr ((PHMASK >> 3) & 1) { DEFPTRS
            const attn_body::AttnTensors AT{(const attn_body::bf16*)Qb, (const attn_body::bf16*)Kb, (const attn_body::bf16*)Vb, (attn_body::bf16*)CAT, NC2, (const int*)(ws + WS_TS)};
            const attn_body::QueueOrder S{(unsigned*)(ws + WS_QCNT) + l * 64, (volatile LAS unsigned*)(L + attn_body::ATTN_LDS_BYTES)};
            attn_body::attn_phase<attn_body::QueueOrder, 20>((char*)lds, AT, S);
        }
        GSYNC();
        if constexpr ((PHMASK >> 4) & 1) { DEFPTRS
            pg8::Gemm g{CAT, (const bf16*)(ws + WS_W + (size_t)l * WS_WSTRIDE + WO_OUT), MTOK, DM, DM}; pg8::StaticOrder S; S.init(MTOK, DM, G, bx);
            pg8::EpiResid E{(l == 0) ? IN(0) : out, out, HB, SSQ};
            pg8::gemm_phase<pg8::EpiResid, pg8::StaticOrder, true, true>(L, g, S, E);
        }
        GSYNC();
        if constexpr ((PHMASK >> 5) & 1) { DEFPTRS
            pg8::Gemm g{HB, (const bf16*)(ws + WS_W + (size_t)l * WS_WSTRIDE + WO_MQ), MTOK, 512, DM}; pg8::StaticOrder S; S.init(MTOK, 512, G, bx);
            pg8::EpiHead128<0> E{SSQ, MQ, nullptr, IN(14) + l * 128, EX, 0.08838834764831845f * pg8::LOG2E};
            pg8::gemm_phase<pg8::EpiHead128<0>, pg8::StaticOrder, true, true>(L, g, S, E);
        }
        GSYNC();
        if constexpr ((PHMASK >> 6) & 1) { DEFPTRS
            const int bh = vcu >> 3, b = bh >> 2, h = bh & 3;
            if (bh < BATCH * 4) {
                xat::load_kv(MK + ((size_t)l * BATCH * 4 + bh) * MEMLEN * 128, MVT + ((size_t)l * BATCH * 4 + bh) * MEMLEN * 128, L, tid);
                __syncthreads();
                for (int i = 0; i < 4; ++i) xat::unit(MQ, MO, b, h, (vcu & 7) * 4 + i, L);
                __syncthreads();
            }
        }
        GSYNC();
        if constexpr ((PHMASK >> 7) & 1) { DEFPTRS
            pg8::Gemm g{MO, (const bf16*)(ws + WS_W + (size_t)l * WS_WSTRIDE + WO_MO), MTOK, DM, 512}; pg8::StaticOrder S; S.init(MTOK, DM, G, bx);
            pg8::EpiResid E{out, out, HB, SSQ};
            pg8::gemm_phase<pg8::EpiResid, pg8::StaticOrder, true, true>(L, g, S, E);
        }
        GSYNC();
        if constexpr ((PHMASK >> 8) & 1) { DEFPTRS
            pg8::Gemm g{HB, (const bf16*)(ws + WS_W + (size_t)l * WS_WSTRIDE + WO_GU), MTOK, 2 * DFF, DM}; pg8::StaticOrder S; S.init(MTOK, 2 * DFF, G, bx);
            pg8::EpiSwiglu E{SSQ, ACT, EX};
            pg8::gemm_phase<pg8::EpiSwiglu, pg8::StaticOrder, true, true>(L, g, S, E);
        }
        GSYNC();
        if constexpr ((PHMASK >> 9) & 1) { DEFPTRS
            pg8::Gemm g{ACT, (const bf16*)(ws + WS_W + (size_t)l * WS_WSTRIDE + WO_D), MTOK, DM, DFF}; pg8::StaticOrder S; S.init(MTOK, DM, G, bx);
            pg8::EpiResid E{out, out, HB, SSQ};
            pg8::gemm_phase<pg8::EpiResid, pg8::StaticOrder, true, true>(L, g, S, E);
        }
        if (l + 1 < DEPTH) GSYNC();
    }
}

extern "C" void kernel_launch(void* const* d_in, const int* in_sizes, int n_in, void* d_out, int out_size, void* d_ws, size_t ws_size, hipStream_t stream) {
    static int grid = 0;
    if (grid == 0) {
        if (n_in != 20 || out_size != MTOK * DM || ws_size < WS_END) { fprintf(stderr, "kernel_launch: unexpected shapes (n_in %d, out %d, ws %zu)\n", n_in, out_size, ws_size); grid = -1; return; }
        int dev = 0, cus = 0, per_cu = 0;
        if (hipGetDevice(&dev) != hipSuccess || hipDeviceGetAttribute(&cus, hipDeviceAttributeMultiprocessorCount, dev) != hipSuccess) { grid = -1; return; }
        if (hipFuncSetAttribute((const void*)fwd_megakernel, hipFuncAttributeMaxDynamicSharedMemorySize, LDS_BYTES) != hipSuccess) { fprintf(stderr, "kernel_launch: hipFuncSetAttribute failed\n"); grid = -1; return; }
        if (hipOccupancyMaxActiveBlocksPerMultiprocessor(&per_cu, (const void*)fwd_megakernel, NWAVES * 64, LDS_BYTES) != hipSuccess || per_cu < 1) { fprintf(stderr, "kernel_launch: occupancy query says %d\n", per_cu); per_cu = 1; }
        (void)hipGetLastError();
        grid = cus * 1;
        if (grid != 256) fprintf(stderr, "kernel_launch: %d CUs; the unit orders assume 256\n", grid);
    }
    if (grid < 0) return;
    Args a{};
    for (int i = 0; i < 20; ++i) a.in[i] = (const float*)d_in[i];
    a.out = (float*)d_out; a.ws = (unsigned char*)d_ws;
    void* kargs[] = {&a};
    hipError_t e = hipLaunchCooperativeKernel((const void*)fwd_megakernel, dim3(grid), dim3(NWAVES * 64), kargs, LDS_BYTES, stream);
    if (e != hipSuccess) fprintf(stderr, "kernel_launch: cooperative launch failed: %s (grid %d)\n", hipGetErrorString(e), grid);
}
```

```cpp
#include <hip/hip_runtime.h>
#include <hip/hip_cooperative_groups.h>
#include <cstdio>
#include <cstdint>
#include <cstddef>
namespace pg8 {
#define PG8_LAS __attribute__((address_space(3)))
typedef unsigned short bf16_t;
typedef short bf16x8 __attribute__((ext_vector_type(8)));
typedef float f32x4 __attribute__((ext_vector_type(4)));
typedef unsigned u32x4 __attribute__((ext_vector_type(4)));
constexpr int BM = 256, BK = 64, HALF = 128, HTB = HALF * BK * 2  , STAGE_BYTES = 8 * HTB, NXCD = 8, WGM = 8;

__host__ __device__ __forceinline__ int lds_byte(int r, int c) { const int st = (r >> 4) * 2 + (c >> 5), rr = r & 15, cc = c & 31, ob = rr * 64 + cc * 2; return st * 1024 + (ob ^ (((ob >> 9) & 1) << 5)); }
__host__ __device__ __forceinline__ void stage_rc(int b, int& R, int& C) { const int st = b / 1024, sb = b % 1024, swz = sb ^ (((sb >> 9) & 1) << 5); R = (st >> 1) * 16 + swz / 64; C = (st & 1) * 32 + (swz % 64) / 2; }
__host__ __device__ __forceinline__ int perm32(int rho) { const int n = rho >> 4, i = rho & 15; return 8 * (i >> 2) + 4 * n + (i & 3); }

struct Unit { int pm, pn; };
struct Gemm { const bf16_t* A; const bf16_t* Bt; int M, N, K; };

struct StaticOrder {
    int nM, nN, nwg, G, c;
    __host__ __device__ void init(int M, int N, int G_, int c_) { nM = M / BM; nN = N / BM; nwg = nM * nN; G = G_; c = c_; }
    __host__ __device__ bool next(int i, Unit& u) const {
        const long L = (long)i * G + c; if (L >= nwg) return false;
        int wgid = (int)L; { const int q = nwg / NXCD, r = nwg % NXCD, xcd = wgid % NXCD, off = wgid / NXCD; wgid = (xcd < r ? xcd * (q + 1) : r * (q + 1) + (xcd - r) * q) + off; }
        const int nig = WGM * nN, gid = wgid / nig, fm = gid * WGM, gsz = (nM - fm) < WGM ? (nM - fm) : WGM;
        u.pm = fm + ((wgid % nig) % gsz); u.pn = (wgid % nig) / gsz; return true;
    }
    __device__ __forceinline__ void a_ready(const Unit&) const {}
    __device__ __forceinline__ void done(const Unit&) const {}
};

__device__ __forceinline__ unsigned cvt_pk_bf16(float lo, float hi) { unsigned r; asm volatile("v_cvt_pk_bf16_f32 %0, %1, %2" : "=v"(r) : "v"(lo), "v"(hi)); return r; }
typedef unsigned u32x2 __attribute__((ext_vector_type(2)));
constexpr float RMS_EPS = 1e-6f;
constexpr float LOG2E = 1.4426950408889634f;
__device__ __forceinline__ void epi_bar() { asm volatile("s_waitcnt lgkmcnt(0)\n\ts_barrier" ::: "memory"); }
__device__ __forceinline__ float sum4(f32x4 a) { return (a[0] + a[1]) + (a[2] + a[3]); }
__device__ __forceinline__ float sumsq4(f32x4 v) { return (v[0] * v[0] + v[1] * v[1]) + (v[2] * v[2] + v[3] * v[3]); }
__device__ __forceinline__ float rstd_row(const float* ssq, int row) {
    const f32x4* p = (const f32x4*)(ssq + (size_t)row * 16);
    const f32x4 a = p[0], b = p[1], c = p[2], d = p[3];
    return __builtin_amdgcn_rsqf(((sum4(a) + sum4(b)) + (sum4(c) + sum4(d))) * (1.0f / 1024.0f) + RMS_EPS);
}
__device__ __forceinline__ void rstd_to_lds(const float* ssq, int row0, PG8_LAS float* RS) {
    const int t = threadIdx.x; if (t < 256) RS[t] = rstd_row(ssq, row0 + t);
}
__device__ __forceinline__ u32x4 pack8(f32x4 a, f32x4 b) { u32x4 w; w.x = cvt_pk_bf16(a[0], a[1]); w.y = cvt_pk_bf16(a[2], a[3]); w.z = cvt_pk_bf16(b[0], b[1]); w.w = cvt_pk_bf16(b[2], b[3]); return w; }
__device__ __forceinline__ float log2sigmoid(float x) { return LOG2E * (fminf(x, 0.f) - log1pf(expf(-fabsf(x)))); }

struct EpiResid {
    static constexpr bool PERM = true, AFTER_DRAIN = false;
    const float* basef; float* outf; bf16_t* hb; float* ssq;
    __device__ __forceinline__ void operator()(const f32x4 (&acc)[2][2][4][2], const Unit& u, int wr, int wc, int fr, int fq) const {
        const int col0 = u.pn * BM + wc * 32 + 8 * fq;
#pragma unroll
        for (int ai = 0; ai < 2; ++ai)
#pragma unroll
            for (int m = 0; m < 4; ++m) {
                const int row = u.pm * BM + ai * HALF + wr * 64 + m * 16 + fr; const size_t off = (size_t)row * 1024 + col0; float s = 0.f;
#pragma unroll
                for (int bj = 0; bj < 2; ++bj) {
                    f32x4 b0, b1;
                    if (basef) { b0 = *(const f32x4*)(basef + off + bj * HALF); b1 = *(const f32x4*)(basef + off + bj * HALF + 4); }
                    else { const u32x4 w = *(const u32x4*)(hb + off + bj * HALF);
                        b0 = (f32x4){__uint_as_float(w.x << 16), __uint_as_float(w.x & 0xffff0000u), __uint_as_float(w.y << 16), __uint_as_float(w.y & 0xffff0000u)};
                        b1 = (f32x4){__uint_as_float(w.z << 16), __uint_as_float(w.z & 0xffff0000u), __uint_as_float(w.w << 16), __uint_as_float(w.w & 0xffff0000u)}; }
                    const f32x4 o0 = b0 + acc[ai][bj][m][0], o1 = b1 + acc[ai][bj][m][1];
                    if (outf) { *(f32x4*)(outf + off + bj * HALF) = o0; *(f32x4*)(outf + off + bj * HALF + 4) = o1; }
                    else { *(u32x4*)(hb + off + bj * HALF) = pack8(o0, o1); s += sumsq4(o0) + sumsq4(o1); } }
                if (!outf) { s += __shfl_xor(s, 16); s += __shfl_xor(s, 32); if (fq == 0) ssq[(size_t)row * 16 + u.pn * 4 + wc] = s; }
                asm volatile("" ::: "memory");
            }
    }
};

struct EpiInProj {
    static constexpr bool PERM = true, AFTER_DRAIN = false;
    const float* ssq; bf16_t *Q, *K, *V, *P; float* LF; const float *gq, *gk, *bfg; PG8_LAS float* X; float qscale;
    __device__ __forceinline__ void operator()(const f32x4 (&acc)[2][2][4][2], const Unit& u, int wr, int wc, int fr, int fq) const {
        const int pn = u.pn, rl0 = wr * 64 + fr; PG8_LAS float* RS = X + 2048;
        rstd_to_lds(ssq, u.pm * BM, RS);
        if (pn < 4) {
#pragma unroll
            for (int ai = 0; ai < 2; ++ai)
#pragma unroll
                for (int m = 0; m < 4; ++m)
#pragma unroll
                    for (int bj = 0; bj < 2; ++bj) { float s = sumsq4(acc[ai][bj][m][0]) + sumsq4(acc[ai][bj][m][1]);
                        s += __shfl_xor(s, 16); s += __shfl_xor(s, 32);
                        if (fq == 0) X[(ai * HALF + rl0 + m * 16) * 8 + bj * 4 + wc] = s; }
        }
        epi_bar();
        if (pn < 4) {
            const float* g = (pn < 2) ? gq : gk; const float extra = (pn < 2) ? qscale : 1.0f; bf16_t* O = (pn < 2) ? Q : K;
            const int dcol = (wc & 1) * 32 + 8 * fq; const f32x4 g0 = *(const f32x4*)(g + dcol) * extra, g1 = *(const f32x4*)(g + dcol + 4) * extra;
            const int colb = (pn & 1) * 256 + wc * 32 + 8 * fq;
#pragma unroll
            for (int ai = 0; ai < 2; ++ai)
#pragma unroll
                for (int m = 0; m < 4; ++m) { const int rl = ai * HALF + rl0 + m * 16; bf16_t* rowp = O + (size_t)(u.pm * BM + rl) * 512 + colb; const float rsv = RS[rl];
#pragma unroll
                    for (int bj = 0; bj < 2; ++bj) { const float hs = X[rl * 8 + bj * 4 + (wc & 2)] + X[rl * 8 + bj * 4 + (wc & 2) + 1];
                        const float sc = rsv * __builtin_amdgcn_rsqf(hs * rsv * rsv * (1.0f / 64.0f) + RMS_EPS);
                        *(u32x4*)(rowp + bj * HALF) = pack8(acc[ai][bj][m][0] * sc * g0, acc[ai][bj][m][1] * sc * g1); }
                    asm volatile("" ::: "memory"); }
        } else if (pn < 8) {
            bf16_t* O = (pn < 6) ? V : P; const int colb = (pn & 1) * 256 + wc * 32 + 8 * fq;
#pragma unroll
            for (int ai = 0; ai < 2; ++ai)
#pragma unroll
                for (int m = 0; m < 4; ++m) { bf16_t* rowp = O + (size_t)(u.pm * BM + ai * HALF + rl0 + m * 16) * 512 + colb; const float rsv = RS[ai * HALF + rl0 + m * 16];
#pragma unroll
                    for (int bj = 0; bj < 2; ++bj) *(u32x4*)(rowp + bj * HALF) = pack8(acc[ai][bj][m][0] * rsv, acc[ai][bj][m][1] * rsv);
                    asm volatile("" ::: "memory"); }
        } else {
            if (wc == 0 && fq == 0) {
                const f32x4 b0 = *(const f32x4*)(bfg), b1 = *(const f32x4*)(bfg + 4);
#pragma unroll
                for (int ai = 0; ai < 2; ++ai)
#pragma unroll
                    for (int m = 0; m < 4; ++m) { float* lp = LF + (size_t)(u.pm * BM + ai * HALF + rl0 + m * 16) * 8; const float rsv = RS[ai * HALF + rl0 + m * 16];
                        const f32x4 z0 = acc[ai][0][m][0] * rsv + b0, z1 = acc[ai][0][m][1] * rsv + b1;
                        *(f32x4*)(lp) = (f32x4){log2sigmoid(z0[0]), log2sigmoid(z0[1]), log2sigmoid(z0[2]), log2sigmoid(z0[3])};
                        *(f32x4*)(lp + 4) = (f32x4){log2sigmoid(z1[0]), log2sigmoid(z1[1]), log2sigmoid(z1[2]), log2sigmoid(z1[3])}; }
            }
        }
    }
};

template <int MODE> struct EpiHead128 {
    static constexpr bool PERM = true, AFTER_DRAIN = false;
    const float* ssq; bf16_t* O; bf16_t* O2; const float* g; PG8_LAS float* X; float oscale;
    __device__ __forceinline__ void operator()(const f32x4 (&acc)[2][2][4][2], const Unit& u, int wr, int wc, int fr, int fq) const {
        const int pn = u.pn, rl0 = wr * 64 + fr; PG8_LAS float* RS = X + 2048;
        if (MODE == 0) rstd_to_lds(ssq, u.pm * BM, RS);
        if (MODE == 0 || pn < 2) {
#pragma unroll
            for (int ai = 0; ai < 2; ++ai)
#pragma unroll
                for (int m = 0; m < 4; ++m)
#pragma unroll
                    for (int bj = 0; bj < 2; ++bj) { float s = sumsq4(acc[ai][bj][m][0]) + sumsq4(acc[ai][bj][m][1]);
                        s += __shfl_xor(s, 16); s += __shfl_xor(s, 32);
                        if (fq == 0) X[(ai * HALF + rl0 + m * 16) * 8 + bj * 4 + wc] = s; }
            epi_bar();
            const int d0 = wc * 32 + 8 * fq; const f32x4 g0 = *(const f32x4*)(g + d0) * oscale, g1 = *(const f32x4*)(g + d0 + 4) * oscale;
#pragma unroll
            for (int ai = 0; ai < 2; ++ai)
#pragma unroll
                for (int m = 0; m < 4; ++m) { const int rl = ai * HALF + rl0 + m * 16; const float rsv = (MODE == 0) ? RS[rl] : 1.0f;
#pragma unroll
                    for (int bj = 0; bj < 2; ++bj) { const f32x4 xs = *(const PG8_LAS f32x4*)(X + rl * 8 + bj * 4);
                        const float sc = rsv * __builtin_amdgcn_rsqf(sum4(xs) * rsv * rsv * (1.0f / 128.0f) + RMS_EPS);
                        bf16_t* dst = (MODE == 0) ? O + (size_t)(u.pm * BM + rl) * 512 + pn * 256 + bj * HALF + d0
                                                  : O + ((size_t)(u.pm * 4 + 2 * pn + bj) * 256 + rl) * 128 + d0;
                        *(u32x4*)dst = pack8(acc[ai][bj][m][0] * sc * g0, acc[ai][bj][m][1] * sc * g1); }
                    asm volatile("" ::: "memory"); }
        } else {
            const int d0 = wc * 32 + 8 * fq;
#pragma unroll
            for (int ai = 0; ai < 2; ++ai)
#pragma unroll
                for (int m = 0; m < 4; ++m) { const int rl = ai * HALF + rl0 + m * 16;
#pragma unroll
                    for (int bj = 0; bj < 2; ++bj) { bf16_t* dst = O2 + ((size_t)(u.pm * 4 + 2 * (pn - 2) + bj) * 128 + d0) * 256 + rl;
                        const u32x4 w = pack8(acc[ai][bj][m][0], acc[ai][bj][m][1]);
                        dst[0 * 256] = (bf16_t)(w.x & 0xffffu); dst[1 * 256] = (bf16_t)(w.x >> 16); dst[2 * 256] = (bf16_t)(w.y & 0xffffu); dst[3 * 256] = (bf16_t)(w.y >> 16);
                        dst[4 * 256] = (bf16_t)(w.z & 0xffffu); dst[5 * 256] = (bf16_t)(w.z >> 16); dst[6 * 256] = (bf16_t)(w.w & 0xffffu); dst[7 * 256] = (bf16_t)(w.w >> 16); }
                    asm volatile("" ::: "memory"); }
        }
    }
};

struct EpiSwiglu {
    static constexpr bool PERM = true, AFTER_DRAIN = false;
    const float* ssq; bf16_t* ACT; PG8_LAS float* X;
    __device__ __forceinline__ static f32x4 swi(f32x4 gt, f32x4 up) { f32x4 r;
#pragma unroll
        for (int j = 0; j < 4; ++j) { const float e = __builtin_amdgcn_exp2f(-LOG2E * gt[j]); r[j] = gt[j] * __builtin_amdgcn_rcpf(1.0f + e) * up[j]; }
        return r; }
    __device__ __forceinline__ void operator()(const f32x4 (&acc)[2][2][4][2], const Unit& u, int wr, int wc, int fr, int fq) const {
        const int rl0 = wr * 64 + fr, colb = u.pn * 128 + wc * 32 + 8 * fq; PG8_LAS float* RS = X + 2048;
        rstd_to_lds(ssq, u.pm * BM, RS); epi_bar();
#pragma unroll
        for (int ai = 0; ai < 2; ++ai)
#pragma unroll
            for (int m = 0; m < 4; ++m) { const int row = u.pm * BM + ai * HALF + rl0 + m * 16; const float rs = RS[ai * HALF + rl0 + m * 16];
                const f32x4 a0 = swi(acc[ai][0][m][0] * rs, acc[ai][1][m][0] * rs), a1 = swi(acc[ai][0][m][1] * rs, acc[ai][1][m][1] * rs);
                *(u32x4*)(ACT + (size_t)row * 2816 + colb) = pack8(a0, a1); asm volatile("" ::: "memory"); }
    }
};

struct RangeOrder {
    int nN, c0, n, c;
    __host__ __device__ bool next(int i, Unit& u) const { const int k = c - c0; if (i != 0 || k < 0 || k >= n) return false; u.pm = k / nN; u.pn = k % nN; return true; }
    __device__ __forceinline__ void a_ready(const Unit&) const {}
    __device__ __forceinline__ void done(const Unit&) const {}
};
template <class Epi, class Sched, bool ALIGN_EPI = false, bool SP2 = false>
__device__ __forceinline__ void gemm_phase(PG8_LAS unsigned char* lds, const Gemm g, const Sched& S, const Epi& E) {
    int tid_l = threadIdx.x; asm volatile("" : "+v"(tid_l));
    const int tid = tid_l, wid = __builtin_amdgcn_readfirstlane(tid >> 6), lane = tid & 63, wr = wid >> 2, wc = wid & 3, fr = lane & 15, fq = lane >> 4;
    const int K = g.K, nt = K / BK;
    unsigned voffA[2], voffB[2];
#pragma unroll
    for (int i = 0; i < 2; ++i) { int R, C; stage_rc(tid * 16 + i * 8192, R, C); const int Rb = Epi::PERM ? ((R & ~31) + perm32(R & 31)) : R;
        voffA[i] = (unsigned)(R * K + C) * 2u; voffB[i] = (unsigned)(Rb * K + C) * 2u; }
    const size_t kstep = (size_t)(BK * 2);
    const size_t hstep = (size_t)HALF * K * 2;
    const size_t tstep = 2 * hstep;
    const unsigned ldsw = (unsigned)wid * 1024u;
    const int aoff = lds_byte(wr * 64 + fr, fq * 8), boff = lds_byte(wc * 32 + fr, fq * 8);
#define PG8_SA(b, h) (((b) * 2 + (h)) * HTB)
#define PG8_SB(b, h) ((4 + (b) * 2 + (h)) * HTB)
#define PG8_STAGE(bufoff, gbase, voff) do { _Pragma("unroll") for (int _i = 0; _i < 2; ++_i) \
        __builtin_amdgcn_global_load_lds((const unsigned*)((const char*)(gbase) + (voff)[_i]), (PG8_LAS unsigned*)(lds + (bufoff) + ldsw + _i * 8192), 16, 0, 0); } while (0)
#define PG8_LDA(dst, b, h) do { _Pragma("unroll") for (int m = 0; m < 4; ++m) _Pragma("unroll") for (int k = 0; k < 2; ++k) dst[m][k] = *(const PG8_LAS bf16x8*)(lds + PG8_SA(b, h) + aoff + m * 2048 + k * 1024); } while (0)
#define PG8_LDB(dst, b, h) do { _Pragma("unroll") for (int n = 0; n < 2; ++n) _Pragma("unroll") for (int k = 0; k < 2; ++k) dst[n][k] = *(const PG8_LAS bf16x8*)(lds + PG8_SB(b, h) + boff + n * 2048 + k * 1024); } while (0)
#define PG8_MMA(ai, bj, At, Bt) do { __builtin_amdgcn_s_setprio(1); _Pragma("unroll") for (int m = 0; m < 4; ++m) _Pragma("unroll") for (int n = 0; n < 2; ++n) _Pragma("unroll") for (int k = 0; k < 2; ++k) \
        acc[ai][bj][m][n] = __builtin_amdgcn_mfma_f32_16x16x32_bf16(Bt[n][k], At[m][k], acc[ai][bj][m][n], 0, 0, 0); __builtin_amdgcn_s_setprio(0); } while (0)
#define PG8_WAIT_V(n) asm volatile("s_waitcnt vmcnt(" #n ")" ::: "memory")
#define PG8_WAIT_L(n) asm volatile("s_waitcnt lgkmcnt(" #n ")" ::: "memory")
#define PG8_BAR __builtin_amdgcn_s_barrier()
#define PG8_SCHED __builtin_amdgcn_sched_barrier(0)
    Unit cur, nxt; int ui = 0;
    if (!S.next(0, cur)) return;
    f32x4 acc[2][2][4][2];
#pragma unroll
    for (int a = 0; a < 2; ++a)
#pragma unroll
        for (int b = 0; b < 2; ++b)
#pragma unroll
            for (int m = 0; m < 4; ++m)
#pragma unroll
                for (int n = 0; n < 2; ++n) acc[a][b][m][n] = (f32x4){0.f, 0.f, 0.f, 0.f};
    bf16x8 At[4][2], B0[2][2], B1[2][2];
    const char* cA = (const char*)g.A + (size_t)cur.pm * tstep; const char* cB = (const char*)g.Bt + (size_t)cur.pn * tstep;
    S.a_ready(cur);
    if constexpr (SP2) {
        PG8_STAGE(PG8_SB(0, 0), cB, voffB); PG8_STAGE(PG8_SB(0, 1), cB + hstep, voffB); PG8_STAGE(PG8_SA(0, 0), cA, voffA); PG8_STAGE(PG8_SA(0, 1), cA + hstep, voffA);
        if (wr == 1) PG8_BAR;
        PG8_WAIT_V(2); PG8_BAR;
        PG8_STAGE(PG8_SB(1, 0), cB + kstep, voffB); PG8_STAGE(PG8_SA(1, 0), cA + kstep, voffA); PG8_STAGE(PG8_SB(1, 1), cB + hstep + kstep, voffB);
        PG8_WAIT_V(6); PG8_BAR;
    } else {
        PG8_STAGE(PG8_SB(0, 0), cB, voffB); PG8_STAGE(PG8_SA(0, 0), cA, voffA); PG8_STAGE(PG8_SB(0, 1), cB + hstep, voffB); PG8_STAGE(PG8_SA(0, 1), cA + hstep, voffA);
        if (wr == 1) PG8_BAR;
        PG8_WAIT_V(4); PG8_BAR;
        PG8_STAGE(PG8_SB(1, 0), cB + kstep, voffB); PG8_STAGE(PG8_SA(1, 0), cA + kstep, voffA); PG8_STAGE(PG8_SB(1, 1), cB + hstep + kstep, voffB);
        PG8_WAIT_V(6); PG8_BAR;
    }
    for (;;) {
        const bool has_next = S.next(ui + 1, nxt);
        const char* nA = has_next ? (const char*)g.A + (size_t)nxt.pm * tstep : cA; const char* nB = has_next ? (const char*)g.Bt + (size_t)nxt.pn * tstep : cB;
        for (int t = 0; t < nt; t += 2) {
            const bool last = (t == nt - 2);
            const char* a1 = cA + (size_t)(t + 1) * kstep;
            const char* a2 = last ? nA : cA + (size_t)(t + 2) * kstep; const char* b2 = last ? nB : cB + (size_t)(t + 2) * kstep;
            const char* a3 = a2 + kstep; const char* b3 = b2 + kstep;
            if (last && has_next) S.a_ready(nxt);
            if constexpr (SP2) {
            PG8_LDB(B0, 0, 0); PG8_LDB(B1, 0, 1); PG8_SCHED; PG8_LDA(At, 0, 0); PG8_STAGE(PG8_SA(1, 1), a1 + hstep, voffA);
            PG8_WAIT_V(8); PG8_WAIT_L(0); PG8_BAR; PG8_MMA(0, 0, At, B0); PG8_MMA(0, 1, At, B1); PG8_BAR; PG8_SCHED;
            PG8_LDA(At, 0, 1); PG8_STAGE(PG8_SB(0, 0), b2, voffB); PG8_STAGE(PG8_SB(0, 1), b2 + hstep, voffB); PG8_STAGE(PG8_SA(0, 0), a2, voffA);
            PG8_WAIT_V(8); PG8_WAIT_L(0); PG8_BAR; PG8_MMA(1, 0, At, B0); PG8_MMA(1, 1, At, B1); PG8_BAR; PG8_SCHED;
            PG8_LDB(B0, 1, 0); PG8_LDB(B1, 1, 1); PG8_SCHED; PG8_LDA(At, 1, 0); PG8_STAGE(PG8_SA(0, 1), a2 + hstep, voffA);
            PG8_WAIT_V(8); PG8_WAIT_L(0); PG8_BAR; PG8_MMA(0, 0, At, B0); PG8_MMA(0, 1, At, B1); PG8_BAR; PG8_SCHED;
            PG8_LDA(At, 1, 1); PG8_STAGE(PG8_SB(1, 0), b3, voffB); PG8_STAGE(PG8_SB(1, 1), b3 + hstep, voffB); PG8_STAGE(PG8_SA(1, 0), a3, voffA);
            PG8_WAIT_V(8); PG8_WAIT_L(0); PG8_BAR; PG8_MMA(1, 0, At, B0); PG8_MMA(1, 1, At, B1); PG8_BAR; PG8_SCHED;
            } else {
            PG8_LDB(B0, 0, 0); PG8_SCHED; PG8_LDA(At, 0, 0); PG8_STAGE(PG8_SA(1, 1), a1 + hstep, voffA);
            PG8_WAIT_L(8); PG8_BAR; PG8_WAIT_L(0); PG8_MMA(0, 0, At, B0); PG8_BAR; PG8_SCHED;
            PG8_LDB(B1, 0, 1); PG8_STAGE(PG8_SB(0, 0), b2, voffB);
            PG8_BAR; PG8_WAIT_L(0); PG8_MMA(0, 1, At, B1); PG8_BAR;
            PG8_LDA(At, 0, 1); PG8_STAGE(PG8_SA(0, 0), a2, voffA);
            PG8_BAR; PG8_WAIT_L(0); PG8_MMA(1, 0, At, B0); PG8_BAR; PG8_SCHED;
            PG8_STAGE(PG8_SB(0, 1), b2 + hstep, voffB);
            PG8_WAIT_V(6); PG8_BAR; PG8_MMA(1, 1, At, B1); PG8_BAR;
            PG8_LDB(B0, 1, 0); PG8_SCHED; PG8_LDA(At, 1, 0); PG8_STAGE(PG8_SA(0, 1), a2 + hstep, voffA);
            PG8_WAIT_L(8); PG8_BAR; PG8_WAIT_L(0); PG8_MMA(0, 0, At, B0); PG8_BAR; PG8_SCHED;
            PG8_LDB(B1, 1, 1); PG8_STAGE(PG8_SB(1, 0), b3, voffB);
            PG8_BAR; PG8_WAIT_L(0); PG8_MMA(0, 1, At, B1); PG8_BAR;
            PG8_LDA(At, 1, 1); PG8_STAGE(PG8_SA(1, 0), a3, voffA);
            PG8_BAR; PG8_WAIT_L(0); PG8_MMA(1, 0, At, B0); PG8_BAR; PG8_SCHED;
            PG8_STAGE(PG8_SB(1, 1), b3 + hstep, voffB);
            PG8_WAIT_V(6); PG8_BAR; PG8_MMA(1, 1, At, B1); PG8_BAR;
            }
        }
        if constexpr (ALIGN_EPI) { if (wr == 0) PG8_BAR; }
        if constexpr (!Epi::AFTER_DRAIN) { E(acc, cur, wr, wc, fr, fq); S.done(cur); }
        if (!has_next) break;
#pragma unroll
        for (int a = 0; a < 2; ++a)
#pragma unroll
            for (int b = 0; b < 2; ++b)
#pragma unroll
                for (int m = 0; m < 4; ++m)
#pragma unroll
                    for (int n = 0; n < 2; ++n) acc[a][b][m][n] = (f32x4){0.f, 0.f, 0.f, 0.f};
        cur = nxt; cA = nA; cB = nB; ++ui;
        if constexpr (ALIGN_EPI) { if (wr == 1) PG8_BAR; }
    }
    PG8_WAIT_V(0);
    if constexpr (!ALIGN_EPI) { if (wr == 0) PG8_BAR; }
    PG8_BAR;
    if constexpr (Epi::AFTER_DRAIN) { E.fused(acc, cur, wr, wc, fr, fq, lds, wid, lane); S.done(cur); }
#undef PG8_SA
#undef PG8_SB
#undef PG8_STAGE
#undef PG8_LDA
#undef PG8_LDB
#undef PG8_MMA
#undef PG8_WAIT_V
#undef PG8_WAIT_L
#undef PG8_BAR
#undef PG8_SCHED
}
}
#include <hip/hip_bf16.h>
#include <cmath>
namespace attn_body {
using bf16=__hip_bfloat16;
using bf16x8=__attribute__((ext_vector_type(8)))short;
using s16x4=__attribute__((ext_vector_type(4)))short;
using f32x16=__attribute__((ext_vector_type(16)))float;
using u32x4=__attribute__((ext_vector_type(4)))unsigned;
using f32x4v=__attribute__((ext_vector_type(4)))float;
typedef const __attribute__((address_space(3))) f32x4v* lds_f4p;
constexpr int BATCH=8,NHEAD=8,SEQ=8192,D=64,DM=NHEAD*D,OPITCH=1024;
constexpr int NW=8,QBLK=32,QB=QBLK*NW,KVBLK=64,NQB=SEQ/QB;
constexpr int ATTN_PITCH=DM, ATTN_UNIT_ROWS=QB;
__device__ __forceinline__ int crow(int r,int hi){return (r&3)+8*(r>>2)+4*hi;}
#define SBAR() __builtin_amdgcn_sched_barrier(0)
__device__ __forceinline__ void cmask(f32x16&p0,f32x16&p1,int jb,int qrel,int hi){
  const float NEG=-INFINITY; int kb=64*jb+4*hi;
  #pragma unroll
  for(int r=0;r<16;++r){int kv=kb+(r&3)+8*(r>>2); if(kv>qrel)p0[r]=NEG; if(kv+32>qrel)p1[r]=NEG;}
}

constexpr int NSLOT=3, SLOTB=8192;
constexpr int LDS_K=0, LDS_V=NSLOT*SLOTB, LDS_WS=2*NSLOT*SLOTB, LDS_OST=LDS_WS+NW*64*4, LDS_C2=LDS_OST+NW*4096, LDS_BYTES=LDS_C2+SEQ*4;
constexpr float C2=0.125f*1.4426950408889634f;
__device__ __forceinline__ void glds16(const void*gsrc,unsigned lds_dst){unsigned keep;
  asm volatile("s_mov_b32 %0, m0\n\ts_mov_b32 m0, %2\n\ts_nop 0\n\tglobal_load_lds_dwordx4 %1, off\n\ts_mov_b32 m0, %0":"=&s"(keep):"v"(gsrc),"s"(lds_dst):"memory");}
__device__ __forceinline__ float max3f(float a,float b,float c){float r;asm("v_max3_f32 %0, %1, %2, %3":"=v"(r):"v"(a),"v"(b),"v"(c));return r;}
__device__ __forceinline__ float max2f(float a,float b){float r;asm("v_max_f32_e32 %0, %1, %2":"=v"(r):"v"(a),"v"(b));return r;}
__device__ __forceinline__ float fadd_s(float a,float b){float r;asm("v_add_f32_e32 %0, %1, %2":"=v"(r):"v"(a),"v"(b));return r;}
__device__ __forceinline__ float fsub_s(float a,float b){float r;asm("v_sub_f32_e32 %0, %1, %2":"=v"(r):"v"(a),"v"(b));return r;}
typedef float f32x2_t __attribute__((ext_vector_type(2))); typedef __bf16 bf16x2_t __attribute__((ext_vector_type(2)));
__device__ __forceinline__ unsigned cvtpk_s(float lo,float hi){f32x2_t v={lo,hi};bf16x2_t b=__builtin_convertvector(v,bf16x2_t);return __builtin_bit_cast(unsigned,b);}
#define WAIT_BAR(N) asm volatile("s_waitcnt vmcnt(" #N ") lgkmcnt(0)\n\ts_barrier":::"memory")

__device__ __forceinline__ void qkt(f32x16&p0,f32x16&p1,const char*Kslot,const bf16x8*qr,int r32,int hi){
  const char*kb=Kslot+hi*1024+r32*16;
  #pragma unroll
  for(int d0=0;d0<4;++d0){
    const bf16x8 b0=*reinterpret_cast<const bf16x8*>(kb+d0*2048);
    const bf16x8 b1=*reinterpret_cast<const bf16x8*>(kb+d0*2048+512);
    p0=__builtin_amdgcn_mfma_f32_32x32x16_bf16(b0,qr[d0],p0,0,0,0);p1=__builtin_amdgcn_mfma_f32_32x32x16_bf16(b1,qr[d0],p1,0,0,0);}
}
typedef __attribute__((address_space(3))) const char* lds_cptr;
typedef short v4i16_t __attribute__((ext_vector_type(4)));
__device__ __forceinline__ void kload8(bf16x8*kf,lds_cptr kp){
  kf[0]=*(const __attribute__((address_space(3))) bf16x8*)(kp);      kf[1]=*(const __attribute__((address_space(3))) bf16x8*)(kp+512);
  kf[2]=*(const __attribute__((address_space(3))) bf16x8*)(kp+2048); kf[3]=*(const __attribute__((address_space(3))) bf16x8*)(kp+2560);
  kf[4]=*(const __attribute__((address_space(3))) bf16x8*)(kp+4096); kf[5]=*(const __attribute__((address_space(3))) bf16x8*)(kp+4608);
  kf[6]=*(const __attribute__((address_space(3))) bf16x8*)(kp+6144); kf[7]=*(const __attribute__((address_space(3))) bf16x8*)(kp+6656);
}
__device__ __forceinline__ void kload2(bf16x8*kf,lds_cptr kp,int j){ kf[2*j]=*(const __attribute__((address_space(3))) bf16x8*)(kp+j*2048); kf[2*j+1]=*(const __attribute__((address_space(3))) bf16x8*)(kp+j*2048+512); }
__device__ __forceinline__ s16x4 vtr(lds_cptr p){ return __builtin_bit_cast(s16x4,__builtin_amdgcn_ds_read_tr16_b64_v4i16((__attribute__((address_space(3))) v4i16_t*)p)); }
__device__ __forceinline__ float rowmax(const f32x16&p0,const f32x16&p1){
  float a=max3f(p0[0],p0[1],p1[0]),b=max3f(p0[2],p0[3],p1[1]);a=max3f(a,p1[2],p1[3]);
  #pragma unroll
  for(int r=4;r<16;r+=4){a=max3f(a,p0[r],p0[r+1]);b=max3f(b,p0[r+2],p0[r+3]);a=max3f(a,p1[r],p1[r+1]);b=max3f(b,p1[r+2],p1[r+3]);}
  const float m=max2f(a,b);
  auto rr=__builtin_amdgcn_permlane32_swap(__float_as_uint(m),__float_as_uint(m),false,false);
  return max2f(__uint_as_float(rr[0]),__uint_as_float(rr[1]));
}
__device__ __forceinline__ void pv(f32x16*o,int vb,bf16x8 pa0,bf16x8 pa1,bf16x8 pa2,bf16x8 pa3){
  #pragma unroll
  for(int d0=0;d0<2;++d0){s16x4 lo[4],hi[4];
    #pragma unroll
    for(int ks=0;ks<4;++ks){
      asm volatile("ds_read_b64_tr_b16 %0,%1 offset:%c2":"=&v"(lo[ks]):"v"(vb),"i"(d0*4096+ks*1024):"memory");
      asm volatile("ds_read_b64_tr_b16 %0,%1 offset:%c2":"=&v"(hi[ks]):"v"(vb),"i"(d0*4096+ks*1024+512):"memory");}
    asm volatile("s_waitcnt lgkmcnt(0)":::"memory");SBAR();
    #define PK(k) (bf16x8){lo[k][0],lo[k][1],lo[k][2],lo[k][3],hi[k][0],hi[k][1],hi[k][2],hi[k][3]}
    o[d0]=__builtin_amdgcn_mfma_f32_32x32x16_bf16(pa0,PK(0),o[d0],0,0,0);
    o[d0]=__builtin_amdgcn_mfma_f32_32x32x16_bf16(pa1,PK(1),o[d0],0,0,0);
    o[d0]=__builtin_amdgcn_mfma_f32_32x32x16_bf16(pa2,PK(2),o[d0],0,0,0);
    o[d0]=__builtin_amdgcn_mfma_f32_32x32x16_bf16(pa3,PK(3),o[d0],0,0,0);
    #undef PK
  }
}

#ifndef ATTN_STORE16
#define ATTN_STORE16(p,v) (*(u32x4*)(p)=(v))
#endif
template<int THRL> __device__ __forceinline__ void attn_unit(int b,int h,int qb,const bf16*Q,const bf16*__restrict__ K,const bf16*__restrict__ V,bf16*O,const float*__restrict__ NC2,int ts,char*shm){
  int tid_l=threadIdx.x; asm volatile("":"+v"(tid_l)); const int tid=tid_l,lane=tid&63,r32=lane&31,hi=lane>>5; const int wid=__builtin_amdgcn_readfirstlane(tid>>6);
  const long rowbase=(long)b*SEQ; const int q0=qb*QB;
  { const float*cg_=NC2+(long)(b*NHEAD+h)*SEQ+ts*KVBLK; float*cl_=(float*)(shm+LDS_C2); const int nq_=q0+QB-ts*KVBLK;
    for(int i_=tid*4;i_<nq_;i_+=NW*64*4)*(f32x4v*)(cl_+i_)=*(const f32x4v*)(cg_+i_); }
  const bf16*Qw=Q+(rowbase+q0+wid*QBLK)*DM+h*D;
  const bf16*Kh=K+(rowbase+(long)ts*KVBLK)*DM+h*D,*Vh=V+(rowbase+(long)ts*KVBLK)*DM+h*D;
  const unsigned lds0=(unsigned)(uintptr_t)shm;
  float*wsf=(float*)(shm+LDS_WS)+wid*64;
  const bf16*ksrc=Kh+(long)lane*DM+wid*8;
  const bf16*vsrc=Vh+(long)(16*(wid&3)+(lane>>2))*DM+(wid>>2)*32+(lane&3)*8;
  const unsigned kdst=lds0+LDS_K+wid*1024, vdst=lds0+LDS_V+wid*1024;
  #define DMA_K(t,slot) glds16(ksrc+(long)(t)*KVBLK*DM,(unsigned)__builtin_amdgcn_readfirstlane(kdst+(slot)))
  #define DMA_V(t,slot) glds16(vsrc+(long)(t)*KVBLK*DM,(unsigned)__builtin_amdgcn_readfirstlane(vdst+(slot)))
  const int vb0=(int)(lds0+LDS_V)+((lane>>4)&1)*32+(lane&3)*8+(4*hi+((lane&15)>>2))*64;
  const char*Kbase=shm+LDS_K; bf16x8 kf[8];
  const lds_cptr shm3=(lds_cptr)shm; const lds_cptr c2l=shm3+LDS_C2+16*hi; const lds_cptr kp0=shm3+LDS_K+hi*1024+r32*16; const lds_cptr vp0=shm3+LDS_V+((lane>>4)&1)*32+(lane&3)*8+(4*hi+((lane&15)>>2))*64;
  const int NT=(q0+QB)/KVBLK-ts;
  DMA_K(0,0);DMA_V(0,0);DMA_K(1,SLOTB);
  bf16x8 qr[4];
  #pragma unroll
  for(int d0=0;d0<4;++d0)qr[d0]=*reinterpret_cast<const bf16x8*>(&Qw[(long)r32*DM+d0*16+hi*8]);
  float mhat=0.f,l_reg=0.f;f32x16 o[2];o[0]=f32x16{};o[1]=f32x16{};
  const int qrel=wid*QBLK+r32;
  #define CMASK(P0,P1,t) do{int jb_=(t)-(NT-4); if(jb_>=0)cmask(P0,P1,jb_,qrel,hi);}while(0)
  bool resc=false;
  #define START(P0,P1) do{ const float rm=rowmax(P0,P1); resc=false; \
    { const float dl=rm; mhat=fadd_s(mhat,dl); \
      _Pragma("unroll") for(int r=0;r<16;++r){P0[r]=fsub_s(P0[r],dl);P1[r]=fsub_s(P1[r],dl);} \
      } \
    _Pragma("unroll") for(int r=0;r<16;++r)P0[r]=__builtin_amdgcn_exp2f(P0[r]); }while(0)
  #define RESC() do{ if(resc){ asm volatile("s_waitcnt lgkmcnt(0)":::"memory"); \
      _Pragma("unroll") for(int d_=0;d_<2;++d_) _Pragma("unroll") for(int r=0;r<16;++r)o[d_][r]*=wsf[crow(r,hi)]; } }while(0)
  f32x16 pA0,pA1,pB0,pB1;
  #define KBLD(X0,X1,tt) do{ const lds_f4p cb_=(lds_f4p)(c2l+(tt)*256); \
    _Pragma("unroll") for(int g_=0;g_<4;++g_){ const f32x4v a_=cb_[2*g_], b_=cb_[2*g_+8]; \
      X0[4*g_+0]=a_[0]-mhat; X0[4*g_+1]=a_[1]-mhat; X0[4*g_+2]=a_[2]-mhat; X0[4*g_+3]=a_[3]-mhat; \
      X1[4*g_+0]=b_[0]-mhat; X1[4*g_+1]=b_[1]-mhat; X1[4*g_+2]=b_[2]-mhat; X1[4*g_+3]=b_[3]-mhat; } }while(0)
  int sl_prev=0,sl_cur=0,sl_next=SLOTB;
  #define ROT() do{sl_prev=sl_cur;sl_cur=sl_next;sl_next=(sl_next==(NSLOT-1)*SLOTB)?0:sl_next+SLOTB;}while(0)
  DMA_K(2,2*SLOTB);
  WAIT_BAR(3);
  KBLD(pA0,pA1,0);
  qkt(pA0,pA1,Kbase,qr,r32,hi);asm volatile("s_nop 15\n\ts_nop 7":"+v"(pA0),"+v"(pA1));CMASK(pA0,pA1,0);
  START(pA0,pA1);
  KBLD(pB0,pB1,1);
  _Pragma("unroll") for(int r=0;r<16;++r)pA1[r]=__builtin_amdgcn_exp2f(pA1[r]);
  WAIT_BAR(0);
  DMA_K(3,0);DMA_V(1,SLOTB);
  ROT();
  kload8(kf,kp0+sl_cur);
  WAIT_BAR(2);
  s16x4 vlo[8],vhi[8]; u32x4 pw0,pw1,pw2,pw3;
  #define PKW(P,B) cvtpk_s(P[B],P[B+1])
  #define PAF(k) __builtin_bit_cast(bf16x8,pw##k)
  #define VFR(i) (bf16x8){vlo[i][0],vlo[i][1],vlo[i][2],vlo[i][3],vhi[i][0],vhi[i][1],vhi[i][2],vhi[i][3]}
  #define PIN(x) asm volatile("":"+v"(x))
  #define MX3(a,b,c) __builtin_fmaxf(__builtin_fmaxf((a),(b)),(c))
  #define GAPA(MF,A0,A1,A2,A3,W0,W1,PW) do{ MF; sacc+=A0; sacc+=A1; sacc+=A2; sacc+=A3; PIN(sacc); W0; W1; PIN(PW); SBAR(); }while(0)
  #define EX(v) __builtin_amdgcn_exp2f(v)
  #define GAPB(MF,X,B) do{ MF; X[B]=EX(X[B]); X[B+1]=EX(X[B+1]); X[B+2]=EX(X[B+2]); X[B+3]=EX(X[B+3]); PIN(X); SBAR(); }while(0)
  #define VRD(i) do{ vlo[i]=vtr(vp_+(((i)>>2)*4096+((i)&3)*1024)); vhi[i]=vtr(vp_+(((i)>>2)*4096+((i)&3)*1024+512)); }while(0)
  #define KRD(G,j) do{ if(G){ kload2(kf,kp0+sl_next,j); SBAR(); } }while(0)
  #define STEP(C0,C1,P0,P1,t,GK,GV,GL) do{ SBAR(); \
    const lds_cptr vp_=vp0+sl_prev; \
    VRD(0); SBAR(); float sacc=(P0[0]+P0[1]); \
    GAPA(C0=__builtin_amdgcn_mfma_f32_32x32x16_bf16(kf[0],qr[0],C0,0,0,0), P0[2],P0[3],P0[4],P0[5],     pw0[0]=PKW(P0,0), pw0[1]=PKW(P0,2), pw0); \
    VRD(4); SBAR(); GAPA(C1=__builtin_amdgcn_mfma_f32_32x32x16_bf16(kf[1],qr[0],C1,0,0,0), P0[6],P0[7],P0[8],P0[9],     pw0[2]=PKW(P0,4), pw0[3]=PKW(P0,6), pw0); \
    VRD(1); SBAR(); GAPA(C0=__builtin_amdgcn_mfma_f32_32x32x16_bf16(kf[2],qr[1],C0,0,0,0),   P0[10],P0[11],P0[12],P0[13], pw1[0]=PKW(P0,8), pw1[1]=PKW(P0,10), pw1); \
    VRD(5); SBAR(); GAPA(C1=__builtin_amdgcn_mfma_f32_32x32x16_bf16(kf[3],qr[1],C1,0,0,0),   P0[14],P0[15],P1[0],P1[1],   pw1[2]=PKW(P0,12),pw1[3]=PKW(P0,14), pw1); \
    VRD(2); SBAR(); GAPA(C0=__builtin_amdgcn_mfma_f32_32x32x16_bf16(kf[4],qr[2],C0,0,0,0),   P1[2],P1[3],P1[4],P1[5],     pw2[0]=PKW(P1,0), pw2[1]=PKW(P1,2), pw2); \
    VRD(6); SBAR(); GAPA(C1=__builtin_amdgcn_mfma_f32_32x32x16_bf16(kf[5],qr[2],C1,0,0,0),   P1[6],P1[7],P1[8],P1[9],     pw2[2]=PKW(P1,4), pw2[3]=PKW(P1,6), pw2); \
    VRD(3); SBAR(); GAPA(C0=__builtin_amdgcn_mfma_f32_32x32x16_bf16(kf[6],qr[3],C0,0,0,0),   P1[10],P1[11],P1[12],P1[13], pw3[0]=PKW(P1,8), pw3[1]=PKW(P1,10), pw3); \
    VRD(7); SBAR(); GAPA(C1=__builtin_amdgcn_mfma_f32_32x32x16_bf16(kf[7],qr[3],C1,0,0,0),   P1[14],P1[15],0.f,0.f,       pw3[2]=PKW(P1,12),pw3[3]=PKW(P1,14), pw3); \
    l_reg+=sacc; \
    if(GK){DMA_K((t)+3,sl_cur);} if(GV){DMA_V((t)+1,sl_next);} \
    CMASK(C0,C1,t); \
    { float a=MX3(C0[0],C0[1],C1[0]),b=MX3(C0[2],C0[3],C1[1]); a=MX3(a,C1[2],C1[3]); \
      _Pragma("unroll") for(int r=4;r<16;r+=4){a=MX3(a,C0[r],C0[r+1]);b=MX3(b,C0[r+2],C0[r+3]);a=MX3(a,C1[r],C1[r+1]);b=MX3(b,C1[r+2],C1[r+3]);} \
      float rm=__builtin_fmaxf(a,b); { auto rr=__builtin_amdgcn_permlane32_swap(__float_as_uint(rm),__float_as_uint(rm),false,false); rm=__builtin_fmaxf(__uint_as_float(rr[0]),__uint_as_float(rr[1])); } \
      resc=false; \
      if(__builtin_expect(__any(rm>(float)THRL),0)){ const float dl=__builtin_fmaxf(rm,0.f); mhat+=dl; \
        _Pragma("unroll") for(int r=0;r<16;++r){C0[r]-=dl;C1[r]-=dl;} \
        const float f=__builtin_amdgcn_exp2f(-dl); l_reg*=f; if(hi==0)wsf[r32]=f; resc=true; } } \
    SBAR(); \
    GAPB(o[0]=__builtin_amdgcn_mfma_f32_32x32x16_bf16(PAF(0),VFR(0),o[0],0,0,0), C0,0); \
    GAPB(o[1]=__builtin_amdgcn_mfma_f32_32x32x16_bf16(PAF(0),VFR(4),o[1],0,0,0), C0,4); \
    KRD(GL,0); GAPB(o[0]=__builtin_amdgcn_mfma_f32_32x32x16_bf16(PAF(1),VFR(1),o[0],0,0,0), C0,8); \
    KRD(GL,1); GAPB(o[1]=__builtin_amdgcn_mfma_f32_32x32x16_bf16(PAF(1),VFR(5),o[1],0,0,0), C0,12); \
    KRD(GL,2); GAPB(o[0]=__builtin_amdgcn_mfma_f32_32x32x16_bf16(PAF(2),VFR(2),o[0],0,0,0), C1,0); \
    KRD(GL,3); GAPB(o[1]=__builtin_amdgcn_mfma_f32_32x32x16_bf16(PAF(2),VFR(6),o[1],0,0,0), C1,4); \
    GAPB(o[0]=__builtin_amdgcn_mfma_f32_32x32x16_bf16(PAF(3),VFR(3),o[0],0,0,0), C1,8); \
    GAPB(o[1]=__builtin_amdgcn_mfma_f32_32x32x16_bf16(PAF(3),VFR(7),o[1],0,0,0), C1,12); \
    if(GL){ KBLD(P0,P1,(t)+1); } \
    }while(0)
  int t=1;
  #undef CMASK
  #define CMASK(P0,P1,t) do{}while(0)
  for(;t+5<NT;t+=2){
    STEP(pB0,pB1,pA0,pA1,t,true,true,true);     WAIT_BAR(2); RESC(); ROT();
    STEP(pA0,pA1,pB0,pB1,t+1,true,true,true);   WAIT_BAR(2); RESC(); ROT();
  }
  #undef CMASK
  #define CMASK(P0,P1,t) do{int jb_=(t)-(NT-4); if(jb_>=0)cmask(P0,P1,jb_,qrel,hi);}while(0)
  #define ENDW(tt) do{ if((tt)+3<NT){WAIT_BAR(2);} else if((tt)+2<NT){WAIT_BAR(1);} else {WAIT_BAR(0);} }while(0)
  for(;t+1<NT;t+=2){
    STEP(pB0,pB1,pA0,pA1,t,(t+3<NT),(t+1<NT),(t+1<NT));       ENDW(t);   RESC(); ROT();
    STEP(pA0,pA1,pB0,pB1,t+1,(t+4<NT),(t+2<NT),(t+2<NT));     ENDW(t+1); RESC(); ROT();
  }
  STEP(pB0,pB1,pA0,pA1,NT-1,false,false,false); RESC();
  { float sacc=pB0[0]+pB0[1]; _Pragma("unroll") for(int r=2;r<16;++r)sacc+=pB0[r]; _Pragma("unroll") for(int r=0;r<16;++r)sacc+=pB1[r]; l_reg+=sacc;
    pw0=(u32x4){PKW(pB0,0),PKW(pB0,2),PKW(pB0,4),PKW(pB0,6)};pw1=(u32x4){PKW(pB0,8),PKW(pB0,10),PKW(pB0,12),PKW(pB0,14)};pw2=(u32x4){PKW(pB1,0),PKW(pB1,2),PKW(pB1,4),PKW(pB1,6)};pw3=(u32x4){PKW(pB1,8),PKW(pB1,10),PKW(pB1,12),PKW(pB1,14)};
    SBAR(); pv(o,vb0+sl_cur,PAF(0),PAF(1),PAF(2),PAF(3)); }
  #undef PKW
  #undef PAF
  #undef VFR
  #undef PIN
  #undef MX3
  #undef GAPA
  #undef GAPB
  #undef EX
  #undef VRD
  #undef KRD
  #undef STEP
  #undef ENDW
  {auto rr=__builtin_amdgcn_permlane32_swap(__float_as_uint(l_reg),__float_as_uint(l_reg),false,false);l_reg=__uint_as_float(rr[0])+__uint_as_float(rr[1]);}
  if(hi==0)wsf[32+r32]=l_reg;asm volatile("s_waitcnt lgkmcnt(0)":::"memory");
  float rli[16];
  #pragma unroll
  for(int r=0;r<16;++r)rli[r]=__builtin_amdgcn_rcpf(wsf[32+crow(r,hi)]);
  bf16*Ow=O+(rowbase+q0+wid*QBLK)*OPITCH+h*D;
  { bf16*stg=(bf16*)(shm+LDS_OST)+wid*2048;
    #pragma unroll
    for(int r=0;r<16;++r){const int orow=crow(r,hi);
      #pragma unroll
      for(int d0=0;d0<2;++d0)stg[orow*64+d0*32+r32]=__float2bfloat16(o[d0][r]*rli[r]);}
    asm volatile("s_waitcnt lgkmcnt(0)":::"memory");
    #pragma unroll
    for(int i=0;i<4;++i){const int row=i*8+(lane>>3),ch=lane&7; const u32x4 v=*(const u32x4*)(stg+row*64+ch*8); ATTN_STORE16(Ow+(long)row*OPITCH+ch*8,v);} }
  asm volatile("s_waitcnt lgkmcnt(0)\n\ts_barrier":::"memory");
  #undef DMA_K
  #undef DMA_V
  #undef CMASK
  #undef START
  #undef RESC
  #undef ROT
  #undef KBLD
}
constexpr int ATTN_LDS_BYTES=LDS_BYTES;
struct AttnTensors { const bf16* Q; const bf16* K; const bf16* V; bf16* O; const float* NC2; const int* TS; };
struct AttnUnit { int bh; int qb; };
struct QueueOrder {
  unsigned* cnt; volatile __attribute__((address_space(3))) unsigned* slot;
  __device__ __forceinline__ bool next(int,AttnUnit&u)const{
    if(threadIdx.x==0)*slot=__hip_atomic_fetch_add(cnt,1u,__ATOMIC_RELAXED,__HIP_MEMORY_SCOPE_AGENT);
    __syncthreads(); const unsigned n=*slot; if(n>=(unsigned)(BATCH*NHEAD*NQB))return false; u.qb=NQB-1-(int)(n>>6); u.bh=(int)(n&63u); return true; }
  __device__ __forceinline__ void a_ready(const AttnUnit&)const{}
  __device__ __forceinline__ void done(const AttnUnit&)const{}
};
struct StaticOrder {
  int vcu;
  __device__ __forceinline__ explicit StaticOrder(int grid,int block):vcu((block%8)*(grid/8)+block/8){}
  __device__ __forceinline__ bool next(int i,AttnUnit&u)const{ if(i>=8)return false; const int s=vcu&3; u.bh=vcu>>2; u.qb=8*(i>>1)+((i&1)?7-s:s); return true; }
  __device__ __forceinline__ void a_ready(const AttnUnit&)const{}
  __device__ __forceinline__ void done(const AttnUnit&)const{}
};
template<class Sched,int THRL=8> __device__ __forceinline__ void attn_phase(char*lds,const AttnTensors&T,const Sched&S){
  AttnUnit u;
  for(int i=0;S.next(i,u);++i){ S.a_ready(u); attn_unit<THRL>(u.bh/NHEAD,u.bh%NHEAD,u.qb,T.Q,T.K,T.V,T.O,T.NC2,__builtin_amdgcn_readfirstlane(T.TS[u.bh*NQB+u.qb]),lds); S.done(u); }
}
#undef SBAR
#undef WAIT_BAR
}
namespace xat {
#define XLAS __attribute__((address_space(3)))
typedef unsigned short bf16_t;
typedef short bf16x8 __attribute__((ext_vector_type(8)));
typedef float f32x16 __attribute__((ext_vector_type(16)));
typedef unsigned u32x4 __attribute__((ext_vector_type(4)));
typedef unsigned u32x2 __attribute__((ext_vector_type(2)));
constexpr int KROW = 272, VROW = 520, LDS_K = 0, LDS_V = 256 * KROW, LDS_END = LDS_V + 128 * VROW;
__device__ __forceinline__ unsigned cvtpk(float lo, float hi) { unsigned r; asm volatile("v_cvt_pk_bf16_f32 %0, %1, %2" : "=v"(r) : "v"(lo), "v"(hi)); return r; }
__device__ __forceinline__ void load_kv(const bf16_t* MKbh, const bf16_t* MVtbh, XLAS unsigned char* lds, int tid) {
    for (int i = tid; i < 4096; i += 512) { const int row = i >> 4, ch = i & 15; const u32x4 v = *(const u32x4*)(MKbh + row * 128 + ch * 8); *(XLAS u32x4*)(lds + LDS_K + row * KROW + ch * 16) = v; }
    for (int i = tid; i < 4096; i += 512) { const int row = i >> 5, ch = i & 31; const u32x4 v = *(const u32x4*)(MVtbh + row * 256 + ch * 8);
        XLAS u32x2* p = (XLAS u32x2*)(lds + LDS_V + row * VROW + ch * 16); p[0] = (u32x2){v.x, v.y}; p[1] = (u32x2){v.z, v.w}; }
}
__device__ __forceinline__ void unit(const bf16_t* MQ, bf16_t* MO, int b, int h, int qblk, XLAS unsigned char* lds) {
    int tid = threadIdx.x; asm volatile("" : "+v"(tid)); const int lane = tid & 63, r32 = lane & 31, hi = lane >> 5, wid = tid >> 6;
    const size_t row = (size_t)b * 8192 + qblk * 256 + wid * 32 + r32;
    const bf16_t* qp = MQ + row * 512 + h * 128 + hi * 8;
    bf16x8 qr[8];
#pragma unroll
    for (int d0 = 0; d0 < 8; ++d0) qr[d0] = *(const bf16x8*)(qp + d0 * 16);
    f32x16 S[8];
#pragma unroll
    for (int kb = 0; kb < 8; ++kb) { S[kb] = f32x16{};
#pragma unroll
        for (int d0 = 0; d0 < 8; ++d0) { const bf16x8 kf = *(const XLAS bf16x8*)(lds + LDS_K + (32 * kb + r32) * KROW + d0 * 32 + hi * 16);
            S[kb] = __builtin_amdgcn_mfma_f32_32x32x16_bf16(kf, qr[d0], S[kb], 0, 0, 0); }
        __builtin_amdgcn_sched_barrier(0); }
    float m = S[0][0];
#pragma unroll
    for (int kb = 0; kb < 8; ++kb)
#pragma unroll
        for (int r = 0; r < 16; ++r) m = fmaxf(m, S[kb][r]);
    m = fmaxf(m, __shfl_xor(m, 32));
    float l = 0.f;
#pragma unroll
    for (int kb = 0; kb < 8; ++kb)
#pragma unroll
        for (int r = 0; r < 16; ++r) { const float p = __builtin_amdgcn_exp2f(S[kb][r] - m); S[kb][r] = p; l += p; }
    l += __shfl_xor(l, 32);
    u32x4 pw[8][2];
#pragma unroll
    for (int kb = 0; kb < 8; ++kb)
#pragma unroll
        for (int sp = 0; sp < 2; ++sp) { pw[kb][sp].x = cvtpk(S[kb][8 * sp + 0], S[kb][8 * sp + 1]); pw[kb][sp].y = cvtpk(S[kb][8 * sp + 2], S[kb][8 * sp + 3]); pw[kb][sp].z = cvtpk(S[kb][8 * sp + 4], S[kb][8 * sp + 5]); pw[kb][sp].w = cvtpk(S[kb][8 * sp + 6], S[kb][8 * sp + 7]); }
    __builtin_amdgcn_sched_barrier(0);
    f32x16 o[4];
#pragma unroll
    for (int db = 0; db < 4; ++db) o[db] = f32x16{};
#pragma unroll
    for (int kb = 0; kb < 8; ++kb)
#pragma unroll
        for (int sp = 0; sp < 2; ++sp) {
            const bf16x8 pk = __builtin_bit_cast(bf16x8, pw[kb][sp]);
#pragma unroll
            for (int db = 0; db < 4; ++db) { const XLAS unsigned char* vb = lds + LDS_V + (32 * db + r32) * VROW + (32 * kb + 16 * sp + 4 * hi) * 2;
                const u32x2 lo = *(const XLAS u32x2*)vb, hh = *(const XLAS u32x2*)(vb + 16);
                const u32x4 vw = (u32x4){lo.x, lo.y, hh.x, hh.y};
                o[db] = __builtin_amdgcn_mfma_f32_32x32x16_bf16(__builtin_bit_cast(bf16x8, vw), pk, o[db], 0, 0, 0); }
            __builtin_amdgcn_sched_barrier(0); }
    const float inv = 1.0f / l;
    bf16_t* op = MO + row * 512 + h * 128 + 4 * hi;
#pragma unroll
    for (int db = 0; db < 4; ++db)
#pragma unroll
        for (int g = 0; g < 4; ++g) { u32x2 w; w.x = cvtpk(o[db][4 * g + 0] * inv, o[db][4 * g + 1] * inv); w.y = cvtpk(o[db][4 * g + 2] * inv, o[db][4 * g + 3] * inv);
            *(u32x2*)(op + 32 * db + 8 * g) = w; }
}
}

namespace cg = cooperative_groups;
#define LAS __attribute__((address_space(3)))
typedef unsigned short bf16;
typedef unsigned v4u __attribute__((ext_vector_type(4)));
typedef unsigned v2u __attribute__((ext_vector_type(2)));
typedef float f32x4 __attribute__((ext_vector_type(4)));
constexpr int NWAVES = 8;
constexpr int DM = 1024, BATCH = 8, SEQ = 8192, MTOK = BATCH * SEQ, DEPTH = 2, NIN = 2056, NINP = 2304, DFF = 2816, MEMLEN = 256;
constexpr float EPS = 1e-6f;
constexpr size_t MiB = 1u << 20;
constexpr size_t WS_W = 1 * MiB, WS_WSTRIDE = 28 * MiB;
constexpr size_t WO_IN = 0, WO_OUT = 5 * MiB, WO_MQ = 7 * MiB, WO_MKV = 8 * MiB, WO_MO = 10 * MiB, WO_GU = 11 * MiB, WO_D = 22 * MiB;
constexpr size_t WS_QCNT = 0, WS_TS = 4096;
constexpr size_t WS_LF = 58 * MiB, WS_NC2 = 60 * MiB, WS_SSQ = 62 * MiB, WS_MN = 66 * MiB, WS_MK = 74 * MiB, WS_MVT = 78 * MiB;
constexpr size_t WS_HB = 96 * MiB, WS_Q = 224 * MiB, WS_K = 288 * MiB, WS_V = 352 * MiB, WS_P = 416 * MiB, WS_CAT = 480 * MiB, WS_MQ = 608 * MiB, WS_MO = 672 * MiB, WS_END = 736 * MiB;
constexpr size_t WS_ACT = 224 * MiB;
static_assert(WS_ACT + (size_t)MTOK * DFF * 2 <= WS_MQ, "ACT overlay");
constexpr int RING_BYTES = 131072, EPIX_OFF = 132096, LDS_BYTES = 147456;

__device__ __forceinline__ unsigned f2bf(float f) { unsigned u = __builtin_bit_cast(unsigned, f); return (u + 0x7fffu + ((u >> 16) & 1u)) >> 16; }
__device__ __forceinline__ unsigned pk2(float lo, float hi) { return f2bf(lo) | (f2bf(hi) << 16); }
__device__ __forceinline__ float wave_sum(float v) {
#pragma unroll
    for (int o = 1; o < 64; o <<= 1) v += __shfl_xor(v, o);
    return v;
}
__device__ __forceinline__ void tr_item(const float* W, int N, int k0, int n0, const float* g, bf16* WT, int Kdst, int drow0, LAS float* scr, int lane) {
    const int nn = lane & 31; const bool ok = (n0 + nn) < N;
#pragma unroll 8
    for (int i = 0; i < 32; ++i) { const int kk = 2 * i + (lane >> 5); float v = ok ? W[(size_t)(k0 + kk) * N + n0 + nn] : 0.f; if (g) v *= g[k0 + kk]; scr[kk * 33 + nn] = v; }
    asm volatile("s_waitcnt lgkmcnt(0)" ::: "memory");
    const int c = lane & 7;
#pragma unroll
    for (int j = 0; j < 4; ++j) { const int n = (lane >> 3) + 8 * j; const LAS float* s = scr + (8 * c) * 33 + n;
        v4u o; o.x = pk2(s[0 * 33], s[1 * 33]); o.y = pk2(s[2 * 33], s[3 * 33]); o.z = pk2(s[4 * 33], s[5 * 33]); o.w = pk2(s[6 * 33], s[7 * 33]);
        *(v4u*)(WT + (size_t)(drow0 + n) * Kdst + k0 + 8 * c) = o; }
    asm volatile("s_waitcnt lgkmcnt(0)" ::: "memory");
}

#ifndef PHMASK
#define PHMASK 0x3ff
#endif
__device__ __forceinline__ unsigned long long karg(int k) {
    const __attribute__((address_space(4))) unsigned long long* ka = (const __attribute__((address_space(4))) unsigned long long*)__builtin_amdgcn_kernarg_segment_ptr();
    asm volatile("" : "+s"(ka)); return ka[k];
}
#define GSYNC() grid.sync()
struct Args { const float* in[20]; float* out; unsigned char* ws; };

__global__ void __launch_bounds__(NWAVES * 64, 2) fwd_megakernel(Args args) {
    extern __shared__ __attribute__((aligned(16))) unsigned char lds[];
    cg::grid_group grid = cg::this_grid();
    LAS unsigned char* const L = (LAS unsigned char*)lds;
    const int wave = __builtin_amdgcn_readfirstlane((int)threadIdx.x >> 6);
    const int G = gridDim.x, bx = blockIdx.x;
    const int vcu = (G % 8 == 0) ? (bx % 8) * (G / 8) + bx / 8 : bx;
    LAS float* const EX = (LAS float*)(L + EPIX_OFF);
#define DEFPTRS \
    int tid = threadIdx.x; asm volatile("" : "+v"(tid)); const int lane = tid & 63; (void)lane; \
    unsigned char* const ws = (unsigned char*)karg(21); float* const out = (float*)karg(20); (void)out; \
    bf16* const HB = (bf16*)(ws + WS_HB); bf16* const Qb = (bf16*)(ws + WS_Q); bf16* const Kb = (bf16*)(ws + WS_K); bf16* const Vb = (bf16*)(ws + WS_V); bf16* const Pb = (bf16*)(ws + WS_P); \
    bf16* const CAT = (bf16*)(ws + WS_CAT); bf16* const MQ = (bf16*)(ws + WS_MQ); bf16* const MO = (bf16*)(ws + WS_MO); bf16* const ACT = (bf16*)(ws + WS_ACT); \
    float* const LF = (float*)(ws + WS_LF); float* const NC2 = (float*)(ws + WS_NC2); float* const SSQ = (float*)(ws + WS_SSQ); \
    bf16* const MN = (bf16*)(ws + WS_MN); bf16* const MK = (bf16*)(ws + WS_MK); bf16* const MVT = (bf16*)(ws + WS_MVT); \
    (void)HB; (void)Qb; (void)Kb; (void)Vb; (void)Pb; (void)CAT; (void)MQ; (void)MO; (void)ACT; (void)LF; (void)NC2; (void)SSQ; (void)MN; (void)MK; (void)MVT;
#define IN(k) ((const float*)karg(k))

    if constexpr ((PHMASK >> 0) & 1) { DEFPTRS
        LAS float* scr = (LAS float*)(L + wave * 16384);
        const int gw = vcu * NWAVES + wave, NGW = G * NWAVES;
        constexpr int I_IN = 16 * 72, I_OUT = 8 * 32, I_MQ = 16 * 16, I_MKV = 16 * 32, I_MO = 8 * 32, I_GU = 16 * 176, I_D = 44 * 32, I_L = I_IN + I_OUT + I_MQ + I_MKV + I_MO + I_GU + I_D;
        for (int it = gw; it < DEPTH * I_L; it += NGW) {
            const int l = it / I_L; int r = it % I_L; unsigned char* wl = ws + WS_W + (size_t)l * WS_WSTRIDE;
            if (r < I_IN) { const int kb = r / 72, nb = r % 72; tr_item(IN(3) + (size_t)l * DM * NIN, NIN, 64 * kb, 32 * nb, IN(2) + l * DM, (bf16*)(wl + WO_IN), DM, 32 * nb, scr, lane); continue; } r -= I_IN;
            if (r < I_OUT) { const int kb = r / 32, nb = r % 32; tr_item(IN(9) + (size_t)l * DM * DM, DM, 64 * kb, 32 * nb, nullptr, (bf16*)(wl + WO_OUT), DM, 32 * nb, scr, lane); continue; } r -= I_OUT;
            if (r < I_MQ) { const int kb = r / 16, nb = r % 16; tr_item(IN(12) + (size_t)l * DM * 512, 512, 64 * kb, 32 * nb, IN(10) + l * DM, (bf16*)(wl + WO_MQ), DM, 32 * nb, scr, lane); continue; } r -= I_MQ;
            if (r < I_MKV) { const int kb = r / 32, nb = r % 32; tr_item(IN(13) + (size_t)l * DM * 1024, 1024, 64 * kb, 32 * nb, nullptr, (bf16*)(wl + WO_MKV), DM, 32 * nb, scr, lane); continue; } r -= I_MKV;
            if (r < I_MO) { const int kb = r / 32, nb = r % 32; tr_item(IN(16) + (size_t)l * 512 * DM, DM, 64 * kb, 32 * nb, nullptr, (bf16*)(wl + WO_MO), 512, 32 * nb, scr, lane); continue; } r -= I_MO;
            if (r < I_GU) { const int kb = r / 176, nb = r % 176; const int n0 = 32 * nb; const int drow = (n0 < DFF) ? (n0 / 128) * 256 + (n0 % 128) : ((n0 - DFF) / 128) * 256 + 128 + ((n0 - DFF) % 128);
                tr_item(IN(18) + (size_t)l * DM * 2 * DFF, 2 * DFF, 64 * kb, n0, IN(17) + l * DM, (bf16*)(wl + WO_GU), DM, drow, scr, lane); continue; } r -= I_GU;
            { const int kb = r / 32, nb = r % 32; tr_item(IN(19) + (size_t)l * DFF * DM, DM, 64 * kb, 32 * nb, nullptr, (bf16*)(wl + WO_D), DFF, 32 * nb, scr, lane); }
        }
        if (bx == 0 && tid < DEPTH) ((unsigned*)(ws + WS_QCNT))[tid * 64] = 0u;
        for (int idx = bx * 512 + tid; idx < DEPTH * 512 * 1024; idx += G * 512) {
            const int l = idx / (512 * 1024), rem = idx % (512 * 1024), kc = rem / 1024, n = rem % 1024, g = kc >> 7, c = kc & 127;
            const float* wp = IN(7) + ((size_t)(l * 4 + g) * 128 + c) * 128; const float* ps = IN(8) + l * 512 + g * 128; const float* wo = IN(9) + (size_t)l * DM * DM + (size_t)(512 + g * 128) * DM + n;
            float a = 0.f;
            for (int d = 0; d < 128; ++d) a += wp[d] * ps[d] * wo[(size_t)d * DM];
            ((bf16*)(ws + WS_W + (size_t)l * WS_WSTRIDE + WO_OUT))[(size_t)n * DM + 512 + kc] = (bf16)f2bf(a);
        }
        for (int m = gw; m < MTOK; m += NGW) {
            const f32x4* xr = (const f32x4*)(IN(0) + (size_t)m * DM) + lane; f32x4 v[4]; float s = 0.f;
#pragma unroll
            for (int j = 0; j < 4; ++j) { v[j] = xr[64 * j]; s += (v[j].x * v[j].x + v[j].y * v[j].y) + (v[j].z * v[j].z + v[j].w * v[j].w); }
            s = wave_sum(s);
            v2u* o8 = (v2u*)(HB + (size_t)m * DM) + lane;
#pragma unroll
            for (int j = 0; j < 4; ++j) o8[64 * j] = (v2u){pk2(v[j].x, v[j].y), pk2(v[j].z, v[j].w)};
            if (lane < 16) SSQ[(size_t)m * 16 + lane] = (lane == 0) ? s : 0.f;
        }
        for (int m = gw; m < DEPTH * BATCH * MEMLEN; m += NGW) {
            const int l = m / (BATCH * MEMLEN), rr = m % (BATCH * MEMLEN);
            const f32x4* xr = (const f32x4*)(IN(1) + (size_t)rr * DM) + lane; const f32x4* gr = (const f32x4*)(IN(11) + l * DM) + lane; f32x4 v[4]; float s = 0.f;
#pragma unroll
            for (int j = 0; j < 4; ++j) { v[j] = xr[64 * j]; s += (v[j].x * v[j].x + v[j].y * v[j].y) + (v[j].z * v[j].z + v[j].w * v[j].w); }
            const float rstd = 1.0f / sqrtf(wave_sum(s) * (1.0f / DM) + EPS);
            v2u* o8 = (v2u*)(MN + (size_t)m * DM) + lane;
#pragma unroll
            for (int j = 0; j < 4; ++j) { const f32x4 gg = gr[64 * j]; o8[64 * j] = (v2u){pk2(v[j].x * rstd * gg.x, v[j].y * rstd * gg.y), pk2(v[j].z * rstd * gg.z, v[j].w * rstd * gg.w)}; }
        }
    }
    GSYNC();

    for (int l = 0; l < DEPTH; ++l) {
        if constexpr ((PHMASK >> 1) & 1) { DEFPTRS
            pg8::Gemm g{HB, (const bf16*)(ws + WS_W + (size_t)l * WS_WSTRIDE + WO_IN), MTOK, NINP, DM}; pg8::StaticOrder S; S.init(MTOK, NINP, G, bx);
            pg8::EpiInProj E{SSQ, Qb, Kb, Vb, Pb, LF, IN(5) + l * 64, IN(6) + l * 64, IN(4) + l * 8, EX, 0.125f * pg8::LOG2E};
            pg8::gemm_phase<pg8::EpiInProj, pg8::StaticOrder, true, true>(L, g, S, E);
        }
        GSYNC();
        if constexpr ((PHMASK >> 2) & 1) { DEFPTRS
            if (bx < 64) {
                const int b = bx >> 3, h = bx & 7; const float* src = LF + ((size_t)b * SEQ + tid * 16) * 8 + h; float v[16]; float s = 0.f;
#pragma unroll
                for (int j = 0; j < 16; ++j) { s += src[j * 8]; v[j] = s; }
                LAS float* sc = (LAS float*)L; sc[tid] = s; __syncthreads();
                for (int off = 1; off < 512; off <<= 1) { const float t = (tid >= off) ? sc[tid - off] : 0.f; __syncthreads(); sc[tid] += t; __syncthreads(); }
                const float excl = sc[tid] - s; float* dst = NC2 + (size_t)bx * SEQ + tid * 16; LAS float* ncl = (LAS float*)(L + 4096) + tid * 16;
#pragma unroll
                for (int j = 0; j < 16; j += 4) { const f32x4 nv = (f32x4){-(excl + v[j]), -(excl + v[j + 1]), -(excl + v[j + 2]), -(excl + v[j + 3])}; *(f32x4*)(dst + j) = nv; *(LAS f32x4*)(ncl + j) = nv; }
                __syncthreads();
                if (tid < 32) {
                    float gq = 0.f, gk = 0.f; const float* gqp = IN(5) + l * 64; const float* gkp = IN(6) + l * 64;
                    for (int d = 0; d < 64; ++d) { gq = fmaxf(gq, fabsf(gqp[d])); gk = fmaxf(gk, fabsf(gkp[d])); }
                    const float thresh = 2.0f * (64.0f * gq * gk * 0.125f * pg8::LOG2E) + 30.0f;
                    const LAS float* nc = (const LAS float*)(L + 4096); const float ref = nc[256 * tid]; int t = 0;
                    while (t < 4 * tid && ref - nc[64 * t + 63] > thresh) ++t;
                    ((int*)(ws + WS_TS))[bx * 32 + tid] = t & ~1;
                }
                __syncthreads();
            } else if (l == 0 && bx < 128) {
                const int l2 = (bx - 64) >> 5;
                pg8::Gemm g{MN + (size_t)l2 * BATCH * MEMLEN * DM, (const bf16*)(ws + WS_W + (size_t)l2 * WS_WSTRIDE + WO_MKV), BATCH * MEMLEN, 1024, DM};
                pg8::RangeOrder S{4, 64 + 32 * l2, 32, bx};
                pg8::EpiHead128<1> E{nullptr, MK + (size_t)l2 * BATCH * 4 * MEMLEN * 128, MVT + (size_t)l2 * BATCH * 4 * MEMLEN * 128, IN(15) + l2 * 128, EX, 1.0f};
                pg8::gemm_phase<pg8::EpiHead128<1>, pg8::RangeOrder, true, true>(L, g, S, E);
            }
            for (int task = bx * 512 + tid; task < (MTOK / 32) * 64; task += G * 512) {
                const int cgp = task & 63, r0 = (task >> 6) * 32, t0 = r0 & (SEQ - 1), w = 2 << (cgp >> 4);
                const bf16* pp = Pb + (size_t)r0 * 512 + cgp * 8; bf16* op = CAT + (size_t)r0 * DM + 512 + cgp * 8;
                float sum[8];
#pragma unroll
                for (int j = 0; j < 8; ++j) sum[j] = 0.f;
                for (int j = 1; j < w; ++j) if (t0 - j >= 0) { const v4u u = *(const v4u*)(pp - (ptrdiff_t)j * 512);
                    sum[0] += __uint_as_float(u.x << 16); sum[1] += __uint_as_float(u.x & 0xffff0000u); sum[2] += __uint_as_float(u.y << 16); sum[3] += __uint_as_float(u.y & 0xffff0000u);
                    sum[4] += __uint_as_float(u.z << 16); sum[5] += __uint_as_float(u.z & 0xffff0000u); sum[6] += __uint_as_float(u.w << 16); sum[7] += __uint_as_float(u.w & 0xffff0000u); }
                for (int i = 0; i < 32; ++i) {
                    const v4u u = *(const v4u*)(pp + (size_t)i * 512); float cur[8];
                    cur[0] = __uint_as_float(u.x << 16); cur[1] = __uint_as_float(u.x & 0xffff0000u); cur[2] = __uint_as_float(u.y << 16); cur[3] = __uint_as_float(u.y & 0xffff0000u);
                    cur[4] = __uint_as_float(u.z << 16); cur[5] = __uint_as_float(u.z & 0xffff0000u); cur[6] = __uint_as_float(u.w << 16); cur[7] = __uint_as_float(u.w & 0xffff0000u);
                    const int t = t0 + i; const float rc = 1.0f / (float)((t + 1 < w) ? t + 1 : w); float o[8];
#pragma unroll
                    for (int j = 0; j < 8; ++j) { sum[j] += cur[j]; o[j] = sum[j] * rc - cur[j]; }
                    *(v4u*)(op + (size_t)i * DM) = (v4u){pk2(o[0], o[1]), pk2(o[2], o[3]), pk2(o[4], o[5]), pk2(o[6], o[7])};
                    if (t + 1 - w >= 0) { const v4u q = *(const v4u*)(pp + (ptrdiff_t)(i + 1 - w) * 512);
                        sum[0] -= __uint_as_float(q.x << 16); sum[1] -= __uint_as_float(q.x & 0xffff0000u); sum[2] -= __uint_as_float(q.y << 16); sum[3] -= __uint_as_float(q.y & 0xffff0000u);
                        sum[4] -= __uint_as_float(q.z << 16); sum[5] -= __uint_as_float(q.z & 0xffff0000u); sum[6] -= __uint_as_float(q.w << 16); sum[7] -= __uint_as_float(q.w & 0xffff0000u); }
                }
            }
        }
        GSYNC();
        if constexpr ((PHMASK >> 3) & 1) { DEFPTRS
            const attn_body::AttnTensors AT{(const attn_body::bf16*)Qb, (const attn_body::bf16*)Kb, (const attn_body::bf16*)Vb, (attn_body::bf16*)CAT, NC2, (const int*)(ws + WS_TS)};
            const attn_body::QueueOrder S{(unsigned*)(ws + WS_QCNT) + l * 64, (volatile LAS unsigned*)(L + attn_body::ATTN_LDS_BYTES)};
            attn_body::attn_phase<attn_body::QueueOrder, 20>((char*)lds, AT, S);
        }
        GSYNC();
        if constexpr ((PHMASK >> 4) & 1) { DEFPTRS
            pg8::Gemm g{CAT, (const bf16*)(ws + WS_W + (size_t)l * WS_WSTRIDE + WO_OUT), MTOK, DM, DM}; pg8::StaticOrder S; S.init(MTOK, DM, G, bx);
            pg8::EpiResid E{(l == 0) ? IN(0) : nullptr, nullptr, HB, SSQ};
            pg8::gemm_phase<pg8::EpiResid, pg8::StaticOrder, true, true>(L, g, S, E);
        }
        GSYNC();
        if constexpr ((PHMASK >> 5) & 1) { DEFPTRS
            pg8::Gemm g{HB, (const bf16*)(ws + WS_W + (size_t)l * WS_WSTRIDE + WO_MQ), MTOK, 512, DM}; pg8::StaticOrder S; S.init(MTOK, 512, G, bx);
            pg8::EpiHead128<0> E{SSQ, MQ, nullptr, IN(14) + l * 128, EX, 0.08838834764831845f * pg8::LOG2E};
            pg8::gemm_phase<pg8::EpiHead128<0>, pg8::StaticOrder, true, true>(L, g, S, E);
        }
        GSYNC();
        if constexpr ((PHMASK >> 6) & 1) { DEFPTRS
            const int bh = vcu >> 3, b = bh >> 2, h = bh & 3;
            if (bh < BATCH * 4) {
                xat::load_kv(MK + ((size_t)l * BATCH * 4 + bh) * MEMLEN * 128, MVT + ((size_t)l * BATCH * 4 + bh) * MEMLEN * 128, L, tid);
                __syncthreads();
                for (int i = 0; i < 4; ++i) xat::unit(MQ, MO, b, h, (vcu & 7) * 4 + i, L);
                __syncthreads();
            }
        }
        GSYNC();
        if constexpr ((PHMASK >> 7) & 1) { DEFPTRS
            pg8::Gemm g{MO, (const bf16*)(ws + WS_W + (size_t)l * WS_WSTRIDE + WO_MO), MTOK, DM, 512}; pg8::StaticOrder S; S.init(MTOK, DM, G, bx);
            pg8::EpiResid E{nullptr, nullptr, HB, SSQ};
            pg8::gemm_phase<pg8::EpiResid, pg8::StaticOrder, true, true>(L, g, S, E);
        }
        GSYNC();
        if constexpr ((PHMASK >> 8) & 1) { DEFPTRS
            pg8::Gemm g{HB, (const bf16*)(ws + WS_W + (size_t)l * WS_WSTRIDE + WO_GU), MTOK, 2 * DFF, DM}; pg8::StaticOrder S; S.init(MTOK, 2 * DFF, G, bx);
            pg8::EpiSwiglu E{SSQ, ACT, EX};
            pg8::gemm_phase<pg8::EpiSwiglu, pg8::StaticOrder, true, true>(L, g, S, E);
        }
        GSYNC();
        if constexpr ((PHMASK >> 9) & 1) { DEFPTRS
            pg8::Gemm g{ACT, (const bf16*)(ws + WS_W + (size_t)l * WS_WSTRIDE + WO_D), MTOK, DM, DFF}; pg8::StaticOrder S; S.init(MTOK, DM, G, bx);
            pg8::EpiResid E{nullptr, (l == DEPTH - 1) ? out : nullptr, HB, SSQ};
            pg8::gemm_phase<pg8::EpiResid, pg8::StaticOrder, true, true>(L, g, S, E);
        }
        if (l + 1 < DEPTH) GSYNC();
    }
}

extern "C" void kernel_launch(void* const* d_in, const int* in_sizes, int n_in, void* d_out, int out_size, void* d_ws, size_t ws_size, hipStream_t stream) {
    static int grid = 0;
    if (grid == 0) {
        if (n_in != 20 || out_size != MTOK * DM || ws_size < WS_END) { fprintf(stderr, "kernel_launch: unexpected shapes (n_in %d, out %d, ws %zu)\n", n_in, out_size, ws_size); grid = -1; return; }
        int dev = 0, cus = 0, per_cu = 0;
        if (hipGetDevice(&dev) != hipSuccess || hipDeviceGetAttribute(&cus, hipDeviceAttributeMultiprocessorCount, dev) != hipSuccess) { grid = -1; return; }
        if (hipFuncSetAttribute((const void*)fwd_megakernel, hipFuncAttributeMaxDynamicSharedMemorySize, LDS_BYTES) != hipSuccess) { fprintf(stderr, "kernel_launch: hipFuncSetAttribute failed\n"); grid = -1; return; }
        if (hipOccupancyMaxActiveBlocksPerMultiprocessor(&per_cu, (const void*)fwd_megakernel, NWAVES * 64, LDS_BYTES) != hipSuccess || per_cu < 1) { fprintf(stderr, "kernel_launch: occupancy query says %d\n", per_cu); per_cu = 1; }
        (void)hipGetLastError();
        grid = cus * 1;
        if (grid != 256) fprintf(stderr, "kernel_launch: %d CUs; the unit orders assume 256\n", grid);
    }
    if (grid < 0) return;
    Args a{};
    for (int i = 0; i < 20; ++i) a.in[i] = (const float*)d_in[i];
    a.out = (float*)d_out; a.ws = (unsigned char*)d_ws;
    void* kargs[] = {&a};
    hipError_t e = hipLaunchCooperativeKernel((const void*)fwd_megakernel, dim3(grid), dim3(NWAVES * 64), kargs, LDS_BYTES, stream);
    if (e != hipSuccess) fprintf(stderr, "kernel_launch: cooperative launch failed: %s (grid %d)\n", hipGetErrorString(e), grid);
}
```

```cpp
#include <hip/hip_runtime.h>
#include <hip/hip_cooperative_groups.h>
#include <cstdio>
#include <cstdint>
#include <cstddef>
namespace pg8 {
#define PG8_LAS __attribute__((address_space(3)))
typedef unsigned short bf16_t;
typedef short bf16x8 __attribute__((ext_vector_type(8)));
typedef float f32x4 __attribute__((ext_vector_type(4)));
typedef unsigned u32x4 __attribute__((ext_vector_type(4)));
constexpr int BM = 256, BK = 64, HALF = 128, HTB = HALF * BK * 2  , STAGE_BYTES = 8 * HTB, NXCD = 8, WGM = 8;

__host__ __device__ __forceinline__ int lds_byte(int r, int c) { const int st = (r >> 4) * 2 + (c >> 5), rr = r & 15, cc = c & 31, ob = rr * 64 + cc * 2; return st * 1024 + (ob ^ (((ob >> 9) & 1) << 5)); }
__host__ __device__ __forceinline__ void stage_rc(int b, int& R, int& C) { const int st = b / 1024, sb = b % 1024, swz = sb ^ (((sb >> 9) & 1) << 5); R = (st >> 1) * 16 + swz / 64; C = (st & 1) * 32 + (swz % 64) / 2; }
__host__ __device__ __forceinline__ int perm32(int rho) { const int n = rho >> 4, i = rho & 15; return 8 * (i >> 2) + 4 * n + (i & 3); }

struct Unit { int pm, pn; };
struct Gemm { const bf16_t* A; const bf16_t* Bt; int M, N, K; };

struct StaticOrder {
    int nM, nN, nwg, G, c;
    __host__ __device__ void init(int M, int N, int G_, int c_) { nM = M / BM; nN = N / BM; nwg = nM * nN; G = G_; c = c_; }
    __host__ __device__ bool next(int i, Unit& u) const {
        const long L = (long)i * G + c; if (L >= nwg) return false;
        int wgid = (int)L; { const int q = nwg / NXCD, r = nwg % NXCD, xcd = wgid % NXCD, off = wgid / NXCD; wgid = (xcd < r ? xcd * (q + 1) : r * (q + 1) + (xcd - r) * q) + off; }
        const int nig = WGM * nN, gid = wgid / nig, fm = gid * WGM, gsz = (nM - fm) < WGM ? (nM - fm) : WGM;
        u.pm = fm + ((wgid % nig) % gsz); u.pn = (wgid % nig) / gsz; return true;
    }
    __device__ __forceinline__ void a_ready(const Unit&) const {}
    __device__ __forceinline__ void done(const Unit&) const {}
};

__device__ __forceinline__ unsigned cvt_pk_bf16(float lo, float hi) { unsigned r; asm volatile("v_cvt_pk_bf16_f32 %0, %1, %2" : "=v"(r) : "v"(lo), "v"(hi)); return r; }
typedef unsigned u32x2 __attribute__((ext_vector_type(2)));
constexpr float RMS_EPS = 1e-6f;
constexpr float LOG2E = 1.4426950408889634f;
__device__ __forceinline__ void epi_bar() { asm volatile("s_waitcnt lgkmcnt(0)\n\ts_barrier" ::: "memory"); }
__device__ __forceinline__ float sum4(f32x4 a) { return (a[0] + a[1]) + (a[2] + a[3]); }
__device__ __forceinline__ float sumsq4(f32x4 v) { return (v[0] * v[0] + v[1] * v[1]) + (v[2] * v[2] + v[3] * v[3]); }
__device__ __forceinline__ float rstd_row(const float* ssq, int row) {
    const f32x4* p = (const f32x4*)(ssq + (size_t)row * 16);
    const f32x4 a = p[0], b = p[1], c = p[2], d = p[3];
    return __builtin_amdgcn_rsqf(((sum4(a) + sum4(b)) + (sum4(c) + sum4(d))) * (1.0f / 1024.0f) + RMS_EPS);
}
__device__ __forceinline__ void rstd_to_lds(const float* ssq, int row0, PG8_LAS float* RS) {
    const int t = threadIdx.x; if (t < 256) RS[t] = rstd_row(ssq, row0 + t);
}
__device__ __forceinline__ u32x4 pack8(f32x4 a, f32x4 b) { u32x4 w; w.x = cvt_pk_bf16(a[0], a[1]); w.y = cvt_pk_bf16(a[2], a[3]); w.z = cvt_pk_bf16(b[0], b[1]); w.w = cvt_pk_bf16(b[2], b[3]); return w; }
__device__ __forceinline__ float log2sigmoid(float x) { return LOG2E * (fminf(x, 0.f) - log1pf(expf(-fabsf(x)))); }

struct EpiResid {
    static constexpr bool PERM = true, AFTER_DRAIN = false;
    const float* basef; float* outf; bf16_t* hb; float* ssq;
    __device__ __forceinline__ void operator()(const f32x4 (&acc)[2][2][4][2], const Unit& u, int wr, int wc, int fr, int fq) const {
        const int col0 = u.pn * BM + wc * 32 + 8 * fq;
#pragma unroll
        for (int ai = 0; ai < 2; ++ai)
#pragma unroll
            for (int m = 0; m < 4; ++m) {
                const int row = u.pm * BM + ai * HALF + wr * 64 + m * 16 + fr; const size_t off = (size_t)row * 1024 + col0; float s = 0.f;
#pragma unroll
                for (int bj = 0; bj < 2; ++bj) {
                    f32x4 b0, b1;
                    if (basef) { b0 = *(const f32x4*)(basef + off + bj * HALF); b1 = *(const f32x4*)(basef + off + bj * HALF + 4); }
                    else { const u32x4 w = *(const u32x4*)(hb + off + bj * HALF);
                        b0 = (f32x4){__uint_as_float(w.x << 16), __uint_as_float(w.x & 0xffff0000u), __uint_as_float(w.y << 16), __uint_as_float(w.y & 0xffff0000u)};
                        b1 = (f32x4){__uint_as_float(w.z << 16), __uint_as_float(w.z & 0xffff0000u), __uint_as_float(w.w << 16), __uint_as_float(w.w & 0xffff0000u)}; }
                    const f32x4 o0 = b0 + acc[ai][bj][m][0], o1 = b1 + acc[ai][bj][m][1];
                    if (outf) { *(f32x4*)(outf + off + bj * HALF) = o0; *(f32x4*)(outf + off + bj * HALF + 4) = o1; }
                    else { *(u32x4*)(hb + off + bj * HALF) = pack8(o0, o1); s += sumsq4(o0) + sumsq4(o1); } }
                if (!outf) { s += __shfl_xor(s, 16); s += __shfl_xor(s, 32); if (fq == 0) ssq[(size_t)row * 16 + u.pn * 4 + wc] = s; }
                asm volatile("" ::: "memory");
            }
    }
};

struct EpiInProj {
    static constexpr bool PERM = true, AFTER_DRAIN = false;
    const float* ssq; bf16_t *Q, *K, *V, *P; float* LF; const float *gq, *gk, *bfg; PG8_LAS float* X; float qscale;
    __device__ __forceinline__ void operator()(const f32x4 (&acc)[2][2][4][2], const Unit& u, int wr, int wc, int fr, int fq) const {
        const int pn = u.pn, rl0 = wr * 64 + fr; PG8_LAS float* RS = X + 2048;
        rstd_to_lds(ssq, u.pm * BM, RS);
        if (pn < 4) {
#pragma unroll
            for (int ai = 0; ai < 2; ++ai)
#pragma unroll
                for (int m = 0; m < 4; ++m)
#pragma unroll
                    for (int bj = 0; bj < 2; ++bj) { float s = sumsq4(acc[ai][bj][m][0]) + sumsq4(acc[ai][bj][m][1]);
                        s += __shfl_xor(s, 16); s += __shfl_xor(s, 32);
                        if (fq == 0) X[(ai * HALF + rl0 + m * 16) * 8 + bj * 4 + wc] = s; }
        }
        epi_bar();
        if (pn < 4) {
            const float* g = (pn < 2) ? gq : gk; const float extra = (pn < 2) ? qscale : 1.0f; bf16_t* O = (pn < 2) ? Q : K;
            const int dcol = (wc & 1) * 32 + 8 * fq; const f32x4 g0 = *(const f32x4*)(g + dcol) * extra, g1 = *(const f32x4*)(g + dcol + 4) * extra;
            const int colb = (pn & 1) * 256 + wc * 32 + 8 * fq;
#pragma unroll
            for (int ai = 0; ai < 2; ++ai)
#pragma unroll
                for (int m = 0; m < 4; ++m) { const int rl = ai * HALF + rl0 + m * 16; bf16_t* rowp = O + (size_t)(u.pm * BM + rl) * 512 + colb; const float rsv = RS[rl];
#pragma unroll
                    for (int bj = 0; bj < 2; ++bj) { const float hs = X[rl * 8 + bj * 4 + (wc & 2)] + X[rl * 8 + bj * 4 + (wc & 2) + 1];
                        const float sc = rsv * __builtin_amdgcn_rsqf(hs * rsv * rsv * (1.0f / 64.0f) + RMS_EPS);
                        *(u32x4*)(rowp + bj * HALF) = pack8(acc[ai][bj][m][0] * sc * g0, acc[ai][bj][m][1] * sc * g1); }
                    asm volatile("" ::: "memory"); }
        } else if (pn < 8) {
            bf16_t* O = (pn < 6) ? V : P; const int colb = (pn & 1) * 256 + wc * 32 + 8 * fq;
#pragma unroll
            for (int ai = 0; ai < 2; ++ai)
#pragma unroll
                for (int m = 0; m < 4; ++m) { bf16_t* rowp = O + (size_t)(u.pm * BM + ai * HALF + rl0 + m * 16) * 512 + colb; const float rsv = RS[ai * HALF + rl0 + m * 16];
#pragma unroll
                    for (int bj = 0; bj < 2; ++bj) *(u32x4*)(rowp + bj * HALF) = pack8(acc[ai][bj][m][0] * rsv, acc[ai][bj][m][1] * rsv);
                    asm volatile("" ::: "memory"); }
        } else {
            if (wc == 0 && fq == 0) {
                const f32x4 b0 = *(const f32x4*)(bfg), b1 = *(const f32x4*)(bfg + 4);
#pragma unroll
                for (int ai = 0; ai < 2; ++ai)
#pragma unroll
                    for (int m = 0; m < 4; ++m) { float* lp = LF + (size_t)(u.pm * BM + ai * HALF + rl0 + m * 16) * 8; const float rsv = RS[ai * HALF + rl0 + m * 16];
                        const f32x4 z0 = acc[ai][0][m][0] * rsv + b0, z1 = acc[ai][0][m][1] * rsv + b1;
                        *(f32x4*)(lp) = (f32x4){log2sigmoid(z0[0]), log2sigmoid(z0[1]), log2sigmoid(z0[2]), log2sigmoid(z0[3])};
                        *(f32x4*)(lp + 4) = (f32x4){log2sigmoid(z1[0]), log2sigmoid(z1[1]), log2sigmoid(z1[2]), log2sigmoid(z1[3])}; }
            }
        }
    }
};

template <int MODE> struct EpiHead128 {
    static constexpr bool PERM = true, AFTER_DRAIN = false;
    const float* ssq; bf16_t* O; bf16_t* O2; const float* g; PG8_LAS float* X; float oscale;
    __device__ __forceinline__ void operator()(const f32x4 (&acc)[2][2][4][2], const Unit& u, int wr, int wc, int fr, int fq) const {
        const int pn = u.pn, rl0 = wr * 64 + fr; PG8_LAS float* RS = X + 2048;
        if (MODE == 0) rstd_to_lds(ssq, u.pm * BM, RS);
        if (MODE == 0 || pn < 2) {
#pragma unroll
            for (int ai = 0; ai < 2; ++ai)
#pragma unroll
                for (int m = 0; m < 4; ++m)
#pragma unroll
                    for (int bj = 0; bj < 2; ++bj) { float s = sumsq4(acc[ai][bj][m][0]) + sumsq4(acc[ai][bj][m][1]);
                        s += __shfl_xor(s, 16); s += __shfl_xor(s, 32);
                        if (fq == 0) X[(ai * HALF + rl0 + m * 16) * 8 + bj * 4 + wc] = s; }
            epi_bar();
            const int d0 = wc * 32 + 8 * fq; const f32x4 g0 = *(const f32x4*)(g + d0) * oscale, g1 = *(const f32x4*)(g + d0 + 4) * oscale;
#pragma unroll
            for (int ai = 0; ai < 2; ++ai)
#pragma unroll
                for (int m = 0; m < 4; ++m) { const int rl = ai * HALF + rl0 + m * 16; const float rsv = (MODE == 0) ? RS[rl] : 1.0f;
#pragma unroll
                    for (int bj = 0; bj < 2; ++bj) { const f32x4 xs = *(const PG8_LAS f32x4*)(X + rl * 8 + bj * 4);
                        const float sc = rsv * __builtin_amdgcn_rsqf(sum4(xs) * rsv * rsv * (1.0f / 128.0f) + RMS_EPS);
                        bf16_t* dst = (MODE == 0) ? O + (size_t)(u.pm * BM + rl) * 512 + pn * 256 + bj * HALF + d0
                                                  : O + ((size_t)(u.pm * 4 + 2 * pn + bj) * 256 + rl) * 128 + d0;
                        *(u32x4*)dst = pack8(acc[ai][bj][m][0] * sc * g0, acc[ai][bj][m][1] * sc * g1); }
                    asm volatile("" ::: "memory"); }
        } else {
            const int d0 = wc * 32 + 8 * fq;
#pragma unroll
            for (int ai = 0; ai < 2; ++ai)
#pragma unroll
                for (int m = 0; m < 4; ++m) { const int rl = ai * HALF + rl0 + m * 16;
#pragma unroll
                    for (int bj = 0; bj < 2; ++bj) { bf16_t* dst = O2 + ((size_t)(u.pm * 4 + 2 * (pn - 2) + bj) * 128 + d0) * 256 + rl;
                        const u32x4 w = pack8(acc[ai][bj][m][0], acc[ai][bj][m][1]);
                        dst[0 * 256] = (bf16_t)(w.x & 0xffffu); dst[1 * 256] = (bf16_t)(w.x >> 16); dst[2 * 256] = (bf16_t)(w.y & 0xffffu); dst[3 * 256] = (bf16_t)(w.y >> 16);
                        dst[4 * 256] = (bf16_t)(w.z & 0xffffu); dst[5 * 256] = (bf16_t)(w.z >> 16); dst[6 * 256] = (bf16_t)(w.w & 0xffffu); dst[7 * 256] = (bf16_t)(w.w >> 16); }
                    asm volatile("" ::: "memory"); }
        }
    }
};

struct EpiSwiglu {
    static constexpr bool PERM = true, AFTER_DRAIN = false;
    const float* ssq; bf16_t* ACT; PG8_LAS float* X;
    __device__ __forceinline__ static f32x4 swi(f32x4 gt, f32x4 up) { f32x4 r;
#pragma unroll
        for (int j = 0; j < 4; ++j) { const float e = __builtin_amdgcn_exp2f(-LOG2E * gt[j]); r[j] = gt[j] * __builtin_amdgcn_rcpf(1.0f + e) * up[j]; }
        return r; }
    __device__ __forceinline__ void operator()(const f32x4 (&acc)[2][2][4][2], const Unit& u, int wr, int wc, int fr, int fq) const {
        const int rl0 = wr * 64 + fr, colb = u.pn * 128 + wc * 32 + 8 * fq; PG8_LAS float* RS = X + 2048;
        rstd_to_lds(ssq, u.pm * BM, RS); epi_bar();
#pragma unroll
        for (int ai = 0; ai < 2; ++ai)
#pragma unroll
            for (int m = 0; m < 4; ++m) { const int row = u.pm * BM + ai * HALF + rl0 + m * 16; const float rs = RS[ai * HALF + rl0 + m * 16];
                const f32x4 a0 = swi(acc[ai][0][m][0] * rs, acc[ai][1][m][0] * rs), a1 = swi(acc[ai][0][m][1] * rs, acc[ai][1][m][1] * rs);
                *(u32x4*)(ACT + (size_t)row * 2816 + colb) = pack8(a0, a1); asm volatile("" ::: "memory"); }
    }
};

struct RangeOrder {
    int nN, c0, n, c;
    __host__ __device__ bool next(int i, Unit& u) const { const int k = c - c0; if (i != 0 || k < 0 || k >= n) return false; u.pm = k / nN; u.pn = k % nN; return true; }
    __device__ __forceinline__ void a_ready(const Unit&) const {}
    __device__ __forceinline__ void done(const Unit&) const {}
};
template <class Epi, class Sched, bool ALIGN_EPI = false, bool SP2 = false>
__device__ __forceinline__ void gemm_phase(PG8_LAS unsigned char* lds, const Gemm g, const Sched& S, const Epi& E) {
    int tid_l = threadIdx.x; asm volatile("" : "+v"(tid_l));
    const int tid = tid_l, wid = __builtin_amdgcn_readfirstlane(tid >> 6), lane = tid & 63, wr = wid >> 2, wc = wid & 3, fr = lane & 15, fq = lane >> 4;
    const int K = g.K, nt = K / BK;
    unsigned voffA[2], voffB[2];
#pragma unroll
    for (int i = 0; i < 2; ++i) { int R, C; stage_rc(tid * 16 + i * 8192, R, C); const int Rb = Epi::PERM ? ((R & ~31) + perm32(R & 31)) : R;
        voffA[i] = (unsigned)(R * K + C) * 2u; voffB[i] = (unsigned)(Rb * K + C) * 2u; }
    const size_t kstep = (size_t)(BK * 2);
    const size_t hstep = (size_t)HALF * K * 2;
    const size_t tstep = 2 * hstep;
    const unsigned ldsw = (unsigned)wid * 1024u;
    const int aoff = lds_byte(wr * 64 + fr, fq * 8), boff = lds_byte(wc * 32 + fr, fq * 8);
#define PG8_SA(b, h) (((b) * 2 + (h)) * HTB)
#define PG8_SB(b, h) ((4 + (b) * 2 + (h)) * HTB)
#define PG8_STAGE(bufoff, gbase, voff) do { _Pragma("unroll") for (int _i = 0; _i < 2; ++_i) \
        __builtin_amdgcn_global_load_lds((const unsigned*)((const char*)(gbase) + (voff)[_i]), (PG8_LAS unsigned*)(lds + (bufoff) + ldsw + _i * 8192), 16, 0, 0); } while (0)
#define PG8_LDA(dst, b, h) do { _Pragma("unroll") for (int m = 0; m < 4; ++m) _Pragma("unroll") for (int k = 0; k < 2; ++k) dst[m][k] = *(const PG8_LAS bf16x8*)(lds + PG8_SA(b, h) + aoff + m * 2048 + k * 1024); } while (0)
#define PG8_LDB(dst, b, h) do { _Pragma("unroll") for (int n = 0; n < 2; ++n) _Pragma("unroll") for (int k = 0; k < 2; ++k) dst[n][k] = *(const PG8_LAS bf16x8*)(lds + PG8_SB(b, h) + boff + n * 2048 + k * 1024); } while (0)
#define PG8_MMA(ai, bj, At, Bt) do { __builtin_amdgcn_s_setprio(1); _Pragma("unroll") for (int m = 0; m < 4; ++m) _Pragma("unroll") for (int n = 0; n < 2; ++n) _Pragma("unroll") for (int k = 0; k < 2; ++k) \
        acc[ai][bj][m][n] = __builtin_amdgcn_mfma_f32_16x16x32_bf16(Bt[n][k], At[m][k], acc[ai][bj][m][n], 0, 0, 0); __builtin_amdgcn_s_setprio(0); } while (0)
#define PG8_WAIT_V(n) asm volatile("s_waitcnt vmcnt(" #n ")" ::: "memory")
#define PG8_WAIT_L(n) asm volatile("s_waitcnt lgkmcnt(" #n ")" ::: "memory")
#define PG8_BAR __builtin_amdgcn_s_barrier()
#define PG8_SCHED __builtin_amdgcn_sched_barrier(0)
    Unit cur, nxt; int ui = 0;
    if (!S.next(0, cur)) return;
    f32x4 acc[2][2][4][2];
#pragma unroll
    for (int a = 0; a < 2; ++a)
#pragma unroll
        for (int b = 0; b < 2; ++b)
#pragma unroll
            for (int m = 0; m < 4; ++m)
#pragma unroll
                for (int n = 0; n < 2; ++n) acc[a][b][m][n] = (f32x4){0.f, 0.f, 0.f, 0.f};
    bf16x8 At[4][2], B0[2][2], B1[2][2];
    const char* cA = (const char*)g.A + (size_t)cur.pm * tstep; const char* cB = (const char*)g.Bt + (size_t)cur.pn * tstep;
    S.a_ready(cur);
    if constexpr (SP2) {
        PG8_STAGE(PG8_SB(0, 0), cB, voffB); PG8_STAGE(PG8_SB(0, 1), cB + hstep, voffB); PG8_STAGE(PG8_SA(0, 0), cA, voffA); PG8_STAGE(PG8_SA(0, 1), cA + hstep, voffA);
        if (wr == 1) PG8_BAR;
        PG8_WAIT_V(2); PG8_BAR;
        PG8_STAGE(PG8_SB(1, 0), cB + kstep, voffB); PG8_STAGE(PG8_SA(1, 0), cA + kstep, voffA); PG8_STAGE(PG8_SB(1, 1), cB + hstep + kstep, voffB);
        PG8_WAIT_V(6); PG8_BAR;
    } else {
        PG8_STAGE(PG8_SB(0, 0), cB, voffB); PG8_STAGE(PG8_SA(0, 0), cA, voffA); PG8_STAGE(PG8_SB(0, 1), cB + hstep, voffB); PG8_STAGE(PG8_SA(0, 1), cA + hstep, voffA);
        if (wr == 1) PG8_BAR;
        PG8_WAIT_V(4); PG8_BAR;
        PG8_STAGE(PG8_SB(1, 0), cB + kstep, voffB); PG8_STAGE(PG8_SA(1, 0), cA + kstep, voffA); PG8_STAGE(PG8_SB(1, 1), cB + hstep + kstep, voffB);
        PG8_WAIT_V(6); PG8_BAR;
    }
    for (;;) {
        const bool has_next = S.next(ui + 1, nxt);
        const char* nA = has_next ? (const char*)g.A + (size_t)nxt.pm * tstep : cA; const char* nB = has_next ? (const char*)g.Bt + (size_t)nxt.pn * tstep : cB;
        for (int t = 0; t < nt; t += 2) {
            const bool last = (t == nt - 2);
            const char* a1 = cA + (size_t)(t + 1) * kstep;
            const char* a2 = last ? nA : cA + (size_t)(t + 2) * kstep; const char* b2 = last ? nB : cB + (size_t)(t + 2) * kstep;
            const char* a3 = a2 + kstep; const char* b3 = b2 + kstep;
            if (last && has_next) S.a_ready(nxt);
            if constexpr (SP2) {
            PG8_LDB(B0, 0, 0); PG8_LDB(B1, 0, 1); PG8_SCHED; PG8_LDA(At, 0, 0); PG8_STAGE(PG8_SA(1, 1), a1 + hstep, voffA);
            PG8_WAIT_V(8); PG8_WAIT_L(0); PG8_BAR; PG8_MMA(0, 0, At, B0); PG8_MMA(0, 1, At, B1); PG8_BAR; PG8_SCHED;
            PG8_LDA(At, 0, 1); PG8_STAGE(PG8_SB(0, 0), b2, voffB); PG8_STAGE(PG8_SB(0, 1), b2 + hstep, voffB); PG8_STAGE(PG8_SA(0, 0), a2, voffA);
            PG8_WAIT_V(8); PG8_WAIT_L(0); PG8_BAR; PG8_MMA(1, 0, At, B0); PG8_MMA(1, 1, At, B1); PG8_BAR; PG8_SCHED;
            PG8_LDB(B0, 1, 0); PG8_LDB(B1, 1, 1); PG8_SCHED; PG8_LDA(At, 1, 0); PG8_STAGE(PG8_SA(0, 1), a2 + hstep, voffA);
            PG8_WAIT_V(8); PG8_WAIT_L(0); PG8_BAR; PG8_MMA(0, 0, At, B0); PG8_MMA(0, 1, At, B1); PG8_BAR; PG8_SCHED;
            PG8_LDA(At, 1, 1); PG8_STAGE(PG8_SB(1, 0), b3, voffB); PG8_STAGE(PG8_SB(1, 1), b3 + hstep, voffB); PG8_STAGE(PG8_SA(1, 0), a3, voffA);
            PG8_WAIT_V(8); PG8_WAIT_L(0); PG8_BAR; PG8_MMA(1, 0, At, B0); PG8_MMA(1, 1, At, B1); PG8_BAR; PG8_SCHED;
            } else {
            PG8_LDB(B0, 0, 0); PG8_SCHED; PG8_LDA(At, 0, 0); PG8_STAGE(PG8_SA(1, 1), a1 + hstep, voffA);
            PG8_WAIT_L(8); PG8_BAR; PG8_WAIT_L(0); PG8_MMA(0, 0, At, B0); PG8_BAR; PG8_SCHED;
            PG8_LDB(B1, 0, 1); PG8_STAGE(PG8_SB(0, 0), b2, voffB);
            PG8_BAR; PG8_WAIT_L(0); PG8_MMA(0, 1, At, B1); PG8_BAR;
            PG8_LDA(At, 0, 1); PG8_STAGE(PG8_SA(0, 0), a2, voffA);
            PG8_BAR; PG8_WAIT_L(0); PG8_MMA(1, 0, At, B0); PG8_BAR; PG8_SCHED;
            PG8_STAGE(PG8_SB(0, 1), b2 + hstep, voffB);
            PG8_WAIT_V(6); PG8_BAR; PG8_MMA(1, 1, At, B1); PG8_BAR;
            PG8_LDB(B0, 1, 0); PG8_SCHED; PG8_LDA(At, 1, 0); PG8_STAGE(PG8_SA(0, 1), a2 + hstep, voffA);
            PG8_WAIT_L(8); PG8_BAR; PG8_WAIT_L(0); PG8_MMA(0, 0, At, B0); PG8_BAR; PG8_SCHED;
            PG8_LDB(B1, 1, 1); PG8_STAGE(PG8_SB(1, 0), b3, voffB);
            PG8_BAR; PG8_WAIT_L(0); PG8_MMA(0, 1, At, B1); PG8_BAR;
            PG8_LDA(At, 1, 1); PG8_STAGE(PG8_SA(1, 0), a3, voffA);
            PG8_BAR; PG8_WAIT_L(0); PG8_MMA(1, 0, At, B0); PG8_BAR; PG8_SCHED;
            PG8_STAGE(PG8_SB(1, 1), b3 + hstep, voffB);
            PG8_WAIT_V(6); PG8_BAR; PG8_MMA(1, 1, At, B1); PG8_BAR;
            }
        }
        if constexpr (ALIGN_EPI) { if (wr == 0) PG8_BAR; }
        if constexpr (!Epi::AFTER_DRAIN) { E(acc, cur, wr, wc, fr, fq); S.done(cur); }
        if (!has_next) break;
#pragma unroll
        for (int a = 0; a < 2; ++a)
#pragma unroll
            for (int b = 0; b < 2; ++b)
#pragma unroll
                for (int m = 0; m < 4; ++m)
#pragma unroll
                    for (int n = 0; n < 2; ++n) acc[a][b][m][n] = (f32x4){0.f, 0.f, 0.f, 0.f};
        cur = nxt; cA = nA; cB = nB; ++ui;
        if constexpr (ALIGN_EPI) { if (wr == 1) PG8_BAR; }
    }
    PG8_WAIT_V(0);
    if constexpr (!ALIGN_EPI) { if (wr == 0) PG8_BAR; }
    PG8_BAR;
    if constexpr (Epi::AFTER_DRAIN) { E.fused(acc, cur, wr, wc, fr, fq, lds, wid, lane); S.done(cur); }
#undef PG8_SA
#undef PG8_SB
#undef PG8_STAGE
#undef PG8_LDA
#undef PG8_LDB
#undef PG8_MMA
#undef PG8_WAIT_V
#undef PG8_WAIT_L
#undef PG8_BAR
#undef PG8_SCHED
}
}
#include <hip/hip_bf16.h>
#include <cmath>
namespace attn_body {
using bf16=__hip_bfloat16;
using bf16x8=__attribute__((ext_vector_type(8)))short;
using s16x4=__attribute__((ext_vector_type(4)))short;
using f32x16=__attribute__((ext_vector_type(16)))float;
using u32x4=__attribute__((ext_vector_type(4)))unsigned;
using f32x4v=__attribute__((ext_vector_type(4)))float;
typedef const __attribute__((address_space(3))) f32x4v* lds_f4p;
constexpr int BATCH=8,NHEAD=8,SEQ=8192,D=64,DM=NHEAD*D,OPITCH=1024;
constexpr int NW=8,QBLK=32,QB=QBLK*NW,KVBLK=64,NQB=SEQ/QB;
constexpr int ATTN_PITCH=DM, ATTN_UNIT_ROWS=QB;
__device__ __forceinline__ int crow(int r,int hi){return (r&3)+8*(r>>2)+4*hi;}
#define SBAR() __builtin_amdgcn_sched_barrier(0)
__device__ __forceinline__ void cmask(f32x16&p0,f32x16&p1,int jb,int qrel,int hi){
  const float NEG=-INFINITY; int kb=64*jb+4*hi;
  #pragma unroll
  for(int r=0;r<16;++r){int kv=kb+(r&3)+8*(r>>2); if(kv>qrel)p0[r]=NEG; if(kv+32>qrel)p1[r]=NEG;}
}

constexpr int NSLOT=3, SLOTB=8192;
constexpr int LDS_K=0, LDS_V=NSLOT*SLOTB, LDS_WS=2*NSLOT*SLOTB, LDS_OST=LDS_WS+NW*64*4, LDS_C2=LDS_OST+NW*4096, LDS_BYTES=LDS_C2+SEQ*4;
constexpr float C2=0.125f*1.4426950408889634f;
__device__ __forceinline__ void glds16(const void*gsrc,unsigned lds_dst){unsigned keep;
  asm volatile("s_mov_b32 %0, m0\n\ts_mov_b32 m0, %2\n\ts_nop 0\n\tglobal_load_lds_dwordx4 %1, off\n\ts_mov_b32 m0, %0":"=&s"(keep):"v"(gsrc),"s"(lds_dst):"memory");}
__device__ __forceinline__ float max3f(float a,float b,float c){float r;asm("v_max3_f32 %0, %1, %2, %3":"=v"(r):"v"(a),"v"(b),"v"(c));return r;}
__device__ __forceinline__ float max2f(float a,float b){float r;asm("v_max_f32_e32 %0, %1, %2":"=v"(r):"v"(a),"v"(b));return r;}
__device__ __forceinline__ float fadd_s(float a,float b){float r;asm("v_add_f32_e32 %0, %1, %2":"=v"(r):"v"(a),"v"(b));return r;}
__device__ __forceinline__ float fsub_s(float a,float b){float r;asm("v_sub_f32_e32 %0, %1, %2":"=v"(r):"v"(a),"v"(b));return r;}
typedef float f32x2_t __attribute__((ext_vector_type(2))); typedef __bf16 bf16x2_t __attribute__((ext_vector_type(2)));
__device__ __forceinline__ unsigned cvtpk_s(float lo,float hi){f32x2_t v={lo,hi};bf16x2_t b=__builtin_convertvector(v,bf16x2_t);return __builtin_bit_cast(unsigned,b);}
#define WAIT_BAR(N) asm volatile("s_waitcnt vmcnt(" #N ") lgkmcnt(0)\n\ts_barrier":::"memory")

__device__ __forceinline__ void qkt(f32x16&p0,f32x16&p1,const char*Kslot,const bf16x8*qr,int r32,int hi){
  const char*kb=Kslot+hi*1024+r32*16;
  #pragma unroll
  for(int d0=0;d0<4;++d0){
    const bf16x8 b0=*reinterpret_cast<const bf16x8*>(kb+d0*2048);
    const bf16x8 b1=*reinterpret_cast<const bf16x8*>(kb+d0*2048+512);
    p0=__builtin_amdgcn_mfma_f32_32x32x16_bf16(b0,qr[d0],p0,0,0,0);p1=__builtin_amdgcn_mfma_f32_32x32x16_bf16(b1,qr[d0],p1,0,0,0);}
}
typedef __attribute__((address_space(3))) const char* lds_cptr;
typedef short v4i16_t __attribute__((ext_vector_type(4)));
__device__ __forceinline__ void kload8(bf16x8*kf,lds_cptr kp){
  kf[0]=*(const __attribute__((address_space(3))) bf16x8*)(kp);      kf[1]=*(const __attribute__((address_space(3))) bf16x8*)(kp+512);
  kf[2]=*(const __attribute__((address_space(3))) bf16x8*)(kp+2048); kf[3]=*(const __attribute__((address_space(3))) bf16x8*)(kp+2560);
  kf[4]=*(const __attribute__((address_space(3))) bf16x8*)(kp+4096); kf[5]=*(const __attribute__((address_space(3))) bf16x8*)(kp+4608);
  kf[6]=*(const __attribute__((address_space(3))) bf16x8*)(kp+6144); kf[7]=*(const __attribute__((address_space(3))) bf16x8*)(kp+6656);
}
__device__ __forceinline__ void kload2(bf16x8*kf,lds_cptr kp,int j){ kf[2*j]=*(const __attribute__((address_space(3))) bf16x8*)(kp+j*2048); kf[2*j+1]=*(const __attribute__((address_space(3))) bf16x8*)(kp+j*2048+512); }
__device__ __forceinline__ s16x4 vtr(lds_cptr p){ return __builtin_bit_cast(s16x4,__builtin_amdgcn_ds_read_tr16_b64_v4i16((__attribute__((address_space(3))) v4i16_t*)p)); }
__device__ __forceinline__ float rowmax(const f32x16&p0,const f32x16&p1){
  float a=max3f(p0[0],p0[1],p1[0]),b=max3f(p0[2],p0[3],p1[1]);a=max3f(a,p1[2],p1[3]);
  #pragma unroll
  for(int r=4;r<16;r+=4){a=max3f(a,p0[r],p0[r+1]);b=max3f(b,p0[r+2],p0[r+3]);a=max3f(a,p1[r],p1[r+1]);b=max3f(b,p1[r+2],p1[r+3]);}
  const float m=max2f(a,b);
  auto rr=__builtin_amdgcn_permlane32_swap(__float_as_uint(m),__float_as_uint(m),false,false);
  return max2f(__uint_as_float(rr[0]),__uint_as_float(rr[1]));
}
__device__ __forceinline__ void pv(f32x16*o,int vb,bf16x8 pa0,bf16x8 pa1,bf16x8 pa2,bf16x8 pa3){
  #pragma unroll
  for(int d0=0;d0<2;++d0){s16x4 lo[4],hi[4];
    #pragma unroll
    for(int ks=0;ks<4;++ks){
      asm volatile("ds_read_b64_tr_b16 %0,%1 offset:%c2":"=&v"(lo[ks]):"v"(vb),"i"(d0*4096+ks*1024):"memory");
      asm volatile("ds_read_b64_tr_b16 %0,%1 offset:%c2":"=&v"(hi[ks]):"v"(vb),"i"(d0*4096+ks*1024+512):"memory");}
    asm volatile("s_waitcnt lgkmcnt(0)":::"memory");SBAR();
    #define PK(k) (bf16x8){lo[k][0],lo[k][1],lo[k][2],lo[k][3],hi[k][0],hi[k][1],hi[k][2],hi[k][3]}
    o[d0]=__builtin_amdgcn_mfma_f32_32x32x16_bf16(pa0,PK(0),o[d0],0,0,0);
    o[d0]=__builtin_amdgcn_mfma_f32_32x32x16_bf16(pa1,PK(1),o[d0],0,0,0);
    o[d0]=__builtin_amdgcn_mfma_f32_32x32x16_bf16(pa2,PK(2),o[d0],0,0,0);
    o[d0]=__builtin_amdgcn_mfma_f32_32x32x16_bf16(pa3,PK(3),o[d0],0,0,0);
    #undef PK
  }
}

#ifndef ATTN_STORE16
#define ATTN_STORE16(p,v) (*(u32x4*)(p)=(v))
#endif
template<int THRL> __device__ __forceinline__ void attn_unit(int b,int h,int qb,const bf16*Q,const bf16*__restrict__ K,const bf16*__restrict__ V,bf16*O,const float*__restrict__ NC2,int ts,char*shm){
  int tid_l=threadIdx.x; asm volatile("":"+v"(tid_l)); const int tid=tid_l,lane=tid&63,r32=lane&31,hi=lane>>5; const int wid=__builtin_amdgcn_readfirstlane(tid>>6);
  const long rowbase=(long)b*SEQ; const int q0=qb*QB;
  { const float*cg_=NC2+(long)(b*NHEAD+h)*SEQ+ts*KVBLK; float*cl_=(float*)(shm+LDS_C2); const int nq_=q0+QB-ts*KVBLK;
    for(int i_=tid*4;i_<nq_;i_+=NW*64*4)*(f32x4v*)(cl_+i_)=*(const f32x4v*)(cg_+i_); }
  const bf16*Qw=Q+(rowbase+q0+wid*QBLK)*DM+h*D;
  const bf16*Kh=K+(rowbase+(long)ts*KVBLK)*DM+h*D,*Vh=V+(rowbase+(long)ts*KVBLK)*DM+h*D;
  const unsigned lds0=(unsigned)(uintptr_t)shm;
  float*wsf=(float*)(shm+LDS_WS)+wid*64;
  const bf16*ksrc=Kh+(long)lane*DM+wid*8;
  const bf16*vsrc=Vh+(long)(16*(wid&3)+(lane>>2))*DM+(wid>>2)*32+(lane&3)*8;
  const unsigned kdst=lds0+LDS_K+wid*1024, vdst=lds0+LDS_V+wid*1024;
  #define DMA_K(t,slot) glds16(ksrc+(long)(t)*KVBLK*DM,(unsigned)__builtin_amdgcn_readfirstlane(kdst+(slot)))
  #define DMA_V(t,slot) glds16(vsrc+(long)(t)*KVBLK*DM,(unsigned)__builtin_amdgcn_readfirstlane(vdst+(slot)))
  const int vb0=(int)(lds0+LDS_V)+((lane>>4)&1)*32+(lane&3)*8+(4*hi+((lane&15)>>2))*64;
  const char*Kbase=shm+LDS_K; bf16x8 kf[8];
  const lds_cptr shm3=(lds_cptr)shm; const lds_cptr c2l=shm3+LDS_C2+16*hi; const lds_cptr kp0=shm3+LDS_K+hi*1024+r32*16; const lds_cptr vp0=shm3+LDS_V+((lane>>4)&1)*32+(lane&3)*8+(4*hi+((lane&15)>>2))*64;
  const int NT=(q0+QB)/KVBLK-ts;
  DMA_K(0,0);DMA_V(0,0);DMA_K(1,SLOTB);
  bf16x8 qr[4];
  #pragma unroll
  for(int d0=0;d0<4;++d0)qr[d0]=*reinterpret_cast<const bf16x8*>(&Qw[(long)r32*DM+d0*16+hi*8]);
  float mhat=0.f,l_reg=0.f;f32x16 o[2];o[0]=f32x16{};o[1]=f32x16{};
  const int qrel=wid*QBLK+r32;
  #define CMASK(P0,P1,t) do{int jb_=(t)-(NT-4); if(jb_>=0)cmask(P0,P1,jb_,qrel,hi);}while(0)
  bool resc=false;
  #define START(P0,P1) do{ const float rm=rowmax(P0,P1); resc=false; \
    { const float dl=rm; mhat=fadd_s(mhat,dl); \
      _Pragma("unroll") for(int r=0;r<16;++r){P0[r]=fsub_s(P0[r],dl);P1[r]=fsub_s(P1[r],dl);} \
      } \
    _Pragma("unroll") for(int r=0;r<16;++r)P0[r]=__builtin_amdgcn_exp2f(P0[r]); }while(0)
  #define RESC() do{ if(resc){ asm volatile("s_waitcnt lgkmcnt(0)":::"memory"); \
      _Pragma("unroll") for(int d_=0;d_<2;++d_) _Pragma("unroll") for(int r=0;r<16;++r)o[d_][r]*=wsf[crow(r,hi)]; } }while(0)
  f32x16 pA0,pA1,pB0,pB1;
  #define KBLD(X0,X1,tt) do{ const lds_f4p cb_=(lds_f4p)(c2l+(tt)*256); \
    _Pragma("unroll") for(int g_=0;g_<4;++g_){ const f32x4v a_=cb_[2*g_], b_=cb_[2*g_+8]; \
      X0[4*g_+0]=a_[0]-mhat; X0[4*g_+1]=a_[1]-mhat; X0[4*g_+2]=a_[2]-mhat; X0[4*g_+3]=a_[3]-mhat; \
      X1[4*g_+0]=b_[0]-mhat; X1[4*g_+1]=b_[1]-mhat; X1[4*g_+2]=b_[2]-mhat; X1[4*g_+3]=b_[3]-mhat; } }while(0)
  int sl_prev=0,sl_cur=0,sl_next=SLOTB;
  #define ROT() do{sl_prev=sl_cur;sl_cur=sl_next;sl_next=(sl_next==(NSLOT-1)*SLOTB)?0:sl_next+SLOTB;}while(0)
  DMA_K(2,2*SLOTB);
  WAIT_BAR(3);
  KBLD(pA0,pA1,0);
  qkt(pA0,pA1,Kbase,qr,r32,hi);asm volatile("s_nop 15\n\ts_nop 7":"+v"(pA0),"+v"(pA1));CMASK(pA0,pA1,0);
  START(pA0,pA1);
  KBLD(pB0,pB1,1);
  _Pragma("unroll") for(int r=0;r<16;++r)pA1[r]=__builtin_amdgcn_exp2f(pA1[r]);
  WAIT_BAR(0);
  DMA_K(3,0);DMA_V(1,SLOTB);
  ROT();
  kload8(kf,kp0+sl_cur);
  WAIT_BAR(2);
  s16x4 vlo[8],vhi[8]; u32x4 pw0,pw1,pw2,pw3;
  #define PKW(P,B) cvtpk_s(P[B],P[B+1])
  #define PAF(k) __builtin_bit_cast(bf16x8,pw##k)
  #define VFR(i) (bf16x8){vlo[i][0],vlo[i][1],vlo[i][2],vlo[i][3],vhi[i][0],vhi[i][1],vhi[i][2],vhi[i][3]}
  #define PIN(x) asm volatile("":"+v"(x))
  #define MX3(a,b,c) __builtin_fmaxf(__builtin_fmaxf((a),(b)),(c))
  #define GAPA(MF,A0,A1,A2,A3,W0,W1,PW) do{ MF; sacc+=A0; sacc+=A1; sacc+=A2; sacc+=A3; PIN(sacc); W0; W1; PIN(PW); SBAR(); }while(0)
  #define EX(v) __builtin_amdgcn_exp2f(v)
  #define GAPB(MF,X,B) do{ MF; X[B]=EX(X[B]); X[B+1]=EX(X[B+1]); X[B+2]=EX(X[B+2]); X[B+3]=EX(X[B+3]); PIN(X); SBAR(); }while(0)
  #define VRD(i) do{ vlo[i]=vtr(vp_+(((i)>>2)*4096+((i)&3)*1024)); vhi[i]=vtr(vp_+(((i)>>2)*4096+((i)&3)*1024+512)); }while(0)
  #define KRD(G,j) do{ if(G){ kload2(kf,kp0+sl_next,j); SBAR(); } }while(0)
  #define STEP(C0,C1,P0,P1,t,GK,GV,GL) do{ SBAR(); \
    const lds_cptr vp_=vp0+sl_prev; \
    VRD(0); SBAR(); float sacc=(P0[0]+P0[1]); \
    GAPA(C0=__builtin_amdgcn_mfma_f32_32x32x16_bf16(kf[0],qr[0],C0,0,0,0), P0[2],P0[3],P0[4],P0[5],     pw0[0]=PKW(P0,0), pw0[1]=PKW(P0,2), pw0); \
    VRD(4); SBAR(); GAPA(C1=__builtin_amdgcn_mfma_f32_32x32x16_bf16(kf[1],qr[0],C1,0,0,0), P0[6],P0[7],P0[8],P0[9],     pw0[2]=PKW(P0,4), pw0[3]=PKW(P0,6), pw0); \
    VRD(1); SBAR(); GAPA(C0=__builtin_amdgcn_mfma_f32_32x32x16_bf16(kf[2],qr[1],C0,0,0,0),   P0[10],P0[11],P0[12],P0[13], pw1[0]=PKW(P0,8), pw1[1]=PKW(P0,10), pw1); \
    VRD(5); SBAR(); GAPA(C1=__builtin_amdgcn_mfma_f32_32x32x16_bf16(kf[3],qr[1],C1,0,0,0),   P0[14],P0[15],P1[0],P1[1],   pw1[2]=PKW(P0,12),pw1[3]=PKW(P0,14), pw1); \
    VRD(2); SBAR(); GAPA(C0=__builtin_amdgcn_mfma_f32_32x32x16_bf16(kf[4],qr[2],C0,0,0,0),   P1[2],P1[3],P1[4],P1[5],     pw2[0]=PKW(P1,0), pw2[1]=PKW(P1,2), pw2); \
    VRD(6); SBAR(); GAPA(C1=__builtin_amdgcn_mfma_f32_32x32x16_bf16(kf[5],qr[2],C1,0,0,0),   P1[6],P1[7],P1[8],P1[9],     pw2[2]=PKW(P1,4), pw2[3]=PKW(P1,6), pw2); \
    VRD(3); SBAR(); GAPA(C0=__builtin_amdgcn_mfma_f32_32x32x16_bf16(kf[6],qr[3],C0,0,0,0),   P1[10],P1[11],P1[12],P1[13], pw3[0]=PKW(P1,8), pw3[1]=PKW(P1,10), pw3); \
    VRD(7); SBAR(); GAPA(C1=__builtin_amdgcn_mfma_f32_32x32x16_bf16(kf[7],qr[3],C1,0,0,0),   P1[14],P1[15],0.f,0.f,       pw3[2]=PKW(P1,12),pw3[3]=PKW(P1,14), pw3); \
    l_reg+=sacc; \
    if(GK){DMA_K((t)+3,sl_cur);} if(GV){DMA_V((t)+1,sl_next);} \
    CMASK(C0,C1,t); \
    { float a=MX3(C0[0],C0[1],C1[0]),b=MX3(C0[2],C0[3],C1[1]); a=MX3(a,C1[2],C1[3]); \
      _Pragma("unroll") for(int r=4;r<16;r+=4){a=MX3(a,C0[r],C0[r+1]);b=MX3(b,C0[r+2],C0[r+3]);a=MX3(a,C1[r],C1[r+1]);b=MX3(b,C1[r+2],C1[r+3]);} \
      float rm=__builtin_fmaxf(a,b); { auto rr=__builtin_amdgcn_permlane32_swap(__float_as_uint(rm),__float_as_uint(rm),false,false); rm=__builtin_fmaxf(__uint_as_float(rr[0]),__uint_as_float(rr[1])); } \
      resc=false; \
      if(__builtin_expect(__any(rm>(float)THRL),0)){ const float dl=__builtin_fmaxf(rm,0.f); mhat+=dl; \
        _Pragma("unroll") for(int r=0;r<16;++r){C0[r]-=dl;C1[r]-=dl;} \
        const float f=__builtin_amdgcn_exp2f(-dl); l_reg*=f; if(hi==0)wsf[r32]=f; resc=true; } } \
    SBAR(); \
    GAPB(o[0]=__builtin_amdgcn_mfma_f32_32x32x16_bf16(PAF(0),VFR(0),o[0],0,0,0), C0,0); \
    GAPB(o[1]=__builtin_amdgcn_mfma_f32_32x32x16_bf16(PAF(0),VFR(4),o[1],0,0,0), C0,4); \
    KRD(GL,0); GAPB(o[0]=__builtin_amdgcn_mfma_f32_32x32x16_bf16(PAF(1),VFR(1),o[0],0,0,0), C0,8); \
    KRD(GL,1); GAPB(o[1]=__builtin_amdgcn_mfma_f32_32x32x16_bf16(PAF(1),VFR(5),o[1],0,0,0), C0,12); \
    KRD(GL,2); GAPB(o[0]=__builtin_amdgcn_mfma_f32_32x32x16_bf16(PAF(2),VFR(2),o[0],0,0,0), C1,0); \
    KRD(GL,3); GAPB(o[1]=__builtin_amdgcn_mfma_f32_32x32x16_bf16(PAF(2),VFR(6),o[1],0,0,0), C1,4); \
    GAPB(o[0]=__builtin_amdgcn_mfma_f32_32x32x16_bf16(PAF(3),VFR(3),o[0],0,0,0), C1,8); \
    GAPB(o[1]=__builtin_amdgcn_mfma_f32_32x32x16_bf16(PAF(3),VFR(7),o[1],0,0,0), C1,12); \
    if(GL){ KBLD(P0,P1,(t)+1); } \
    }while(0)
  int t=1;
  #undef CMASK
  #define CMASK(P0,P1,t) do{}while(0)
  for(;t+5<NT;t+=2){
    STEP(pB0,pB1,pA0,pA1,t,true,true,true);     WAIT_BAR(2); RESC(); ROT();
    STEP(pA0,pA1,pB0,pB1,t+1,true,true,true);   WAIT_BAR(2); RESC(); ROT();
  }
  #undef CMASK
  #define CMASK(P0,P1,t) do{int jb_=(t)-(NT-4); if(jb_>=0)cmask(P0,P1,jb_,qrel,hi);}while(0)
  #define ENDW(tt) do{ if((tt)+3<NT){WAIT_BAR(2);} else if((tt)+2<NT){WAIT_BAR(1);} else {WAIT_BAR(0);} }while(0)
  for(;t+1<NT;t+=2){
    STEP(pB0,pB1,pA0,pA1,t,(t+3<NT),(t+1<NT),(t+1<NT));       ENDW(t);   RESC(); ROT();
    STEP(pA0,pA1,pB0,pB1,t+1,(t+4<NT),(t+2<NT),(t+2<NT));     ENDW(t+1); RESC(); ROT();
  }
  STEP(pB0,pB1,pA0,pA1,NT-1,false,false,false); RESC();
  { float sacc=pB0[0]+pB0[1]; _Pragma("unroll") for(int r=2;r<16;++r)sacc+=pB0[r]; _Pragma("unroll") for(int r=0;r<16;++r)sacc+=pB1[r]; l_reg+=sacc;
    pw0=(u32x4){PKW(pB0,0),PKW(pB0,2),PKW(pB0,4),PKW(pB0,6)};pw1=(u32x4){PKW(pB0,8),PKW(pB0,10),PKW(pB0,12),PKW(pB0,14)};pw2=(u32x4){PKW(pB1,0),PKW(pB1,2),PKW(pB1,4),PKW(pB1,6)};pw3=(u32x4){PKW(pB1,8),PKW(pB1,10),PKW(pB1,12),PKW(pB1,14)};
    SBAR(); pv(o,vb0+sl_cur,PAF(0),PAF(1),PAF(2),PAF(3)); }
  #undef PKW
  #undef PAF
  #undef VFR
  #undef PIN
  #undef MX3
  #undef GAPA
  #undef GAPB
  #undef EX
  #undef VRD
  #undef KRD
  #undef STEP
  #undef ENDW
  {auto rr=__builtin_amdgcn_permlane32_swap(__float_as_uint(l_reg),__float_as_uint(l_reg),false,false);l_reg=__uint_as_float(rr[0])+__uint_as_float(rr[1]);}
  if(hi==0)wsf[32+r32]=l_reg;asm volatile("s_waitcnt lgkmcnt(0)":::"memory");
  float rli[16];
  #pragma unroll
  for(int r=0;r<16;++r)rli[r]=__builtin_amdgcn_rcpf(wsf[32+crow(r,hi)]);
  bf16*Ow=O+(rowbase+q0+wid*QBLK)*OPITCH+h*D;
  { bf16*stg=(bf16*)(shm+LDS_OST)+wid*2048;
    #pragma unroll
    for(int r=0;r<16;++r){const int orow=crow(r,hi);
      #pragma unroll
      for(int d0=0;d0<2;++d0)stg[orow*64+d0*32+r32]=__float2bfloat16(o[d0][r]*rli[r]);}
    asm volatile("s_waitcnt lgkmcnt(0)":::"memory");
    #pragma unroll
    for(int i=0;i<4;++i){const int row=i*8+(lane>>3),ch=lane&7; const u32x4 v=*(const u32x4*)(stg+row*64+ch*8); ATTN_STORE16(Ow+(long)row*OPITCH+ch*8,v);} }
  asm volatile("s_waitcnt lgkmcnt(0)\n\ts_barrier":::"memory");
  #undef DMA_K
  #undef DMA_V
  #undef CMASK
  #undef START
  #undef RESC
  #undef ROT
  #undef KBLD
}
constexpr int ATTN_LDS_BYTES=LDS_BYTES;
struct AttnTensors { const bf16* Q; const bf16* K; const bf16* V; bf16* O; const float* NC2; const int* TS; };
struct AttnUnit { int bh; int qb; };
struct QueueOrder {
  unsigned* cnt; volatile __attribute__((address_space(3))) unsigned* slot;
  __device__ __forceinline__ bool next(int,AttnUnit&u)const{
    if(threadIdx.x==0)*slot=__hip_atomic_fetch_add(cnt,1u,__ATOMIC_RELAXED,__HIP_MEMORY_SCOPE_AGENT);
    __syncthreads(); const unsigned n=*slot; if(n>=(unsigned)(BATCH*NHEAD*NQB))return false; u.qb=NQB-1-(int)(n>>6); u.bh=(int)(n&63u); return true; }
  __device__ __forceinline__ void a_ready(const AttnUnit&)const{}
  __device__ __forceinline__ void done(const AttnUnit&)const{}
};
struct StaticOrder {
  int vcu;
  __device__ __forceinline__ explicit StaticOrder(int grid,int block):vcu((block%8)*(grid/8)+block/8){}
  __device__ __forceinline__ bool next(int i,AttnUnit&u)const{ if(i>=8)return false; const int s=vcu&3; u.bh=vcu>>2; u.qb=8*(i>>1)+((i&1)?7-s:s); return true; }
  __device__ __forceinline__ void a_ready(const AttnUnit&)const{}
  __device__ __forceinline__ void done(const AttnUnit&)const{}
};
template<class Sched,int THRL=8> __device__ __forceinline__ void attn_phase(char*lds,const AttnTensors&T,const Sched&S){
  AttnUnit u;
  for(int i=0;S.next(i,u);++i){ S.a_ready(u); attn_unit<THRL>(u.bh/NHEAD,u.bh%NHEAD,u.qb,T.Q,T.K,T.V,T.O,T.NC2,__builtin_amdgcn_readfirstlane(T.TS[u.bh*NQB+u.qb]),lds); S.done(u); }
}
#undef SBAR
#undef WAIT_BAR
}
namespace xat {
#define XLAS __attribute__((address_space(3)))
typedef unsigned short bf16_t;
typedef short bf16x8 __attribute__((ext_vector_type(8)));
typedef float f32x16 __attribute__((ext_vector_type(16)));
typedef unsigned u32x4 __attribute__((ext_vector_type(4)));
typedef unsigned u32x2 __attribute__((ext_vector_type(2)));
constexpr int KROW = 272, VROW = 520, LDS_K = 0, LDS_V = 256 * KROW, LDS_END = LDS_V + 128 * VROW;
__device__ __forceinline__ unsigned cvtpk(float lo, float hi) { unsigned r; asm volatile("v_cvt_pk_bf16_f32 %0, %1, %2" : "=v"(r) : "v"(lo), "v"(hi)); return r; }
__device__ __forceinline__ void load_kv(const bf16_t* MKbh, const bf16_t* MVtbh, XLAS unsigned char* lds, int tid) {
    for (int i = tid; i < 4096; i += 512) { const int row = i >> 4, ch = i & 15; const u32x4 v = *(const u32x4*)(MKbh + row * 128 + ch * 8); *(XLAS u32x4*)(lds + LDS_K + row * KROW + ch * 16) = v; }
    for (int i = tid; i < 4096; i += 512) { const int row = i >> 5, ch = i & 31; const u32x4 v = *(const u32x4*)(MVtbh + row * 256 + ch * 8);
        XLAS u32x2* p = (XLAS u32x2*)(lds + LDS_V + row * VROW + ch * 16); p[0] = (u32x2){v.x, v.y}; p[1] = (u32x2){v.z, v.w}; }
}
__device__ __forceinline__ void unit(const bf16_t* MQ, bf16_t* MO, int b, int h, int qblk, XLAS unsigned char* lds) {
    int tid = threadIdx.x; asm volatile("" : "+v"(tid)); const int lane = tid & 63, r32 = lane & 31, hi = lane >> 5, wid = tid >> 6;
    const size_t row = (size_t)b * 8192 + qblk * 256 + wid * 32 + r32;
    const bf16_t* qp = MQ + row * 512 + h * 128 + hi * 8;
    bf16x8 qr[8];
#pragma unroll
    for (int d0 = 0; d0 < 8; ++d0) qr[d0] = *(const bf16x8*)(qp + d0 * 16);
    f32x16 S[8];
#pragma unroll
    for (int kb = 0; kb < 8; ++kb) { S[kb] = f32x16{};
#pragma unroll
        for (int d0 = 0; d0 < 8; ++d0) { const bf16x8 kf = *(const XLAS bf16x8*)(lds + LDS_K + (32 * kb + r32) * KROW + d0 * 32 + hi * 16);
            S[kb] = __builtin_amdgcn_mfma_f32_32x32x16_bf16(kf, qr[d0], S[kb], 0, 0, 0); }
        __builtin_amdgcn_sched_barrier(0); }
    float m = S[0][0];
#pragma unroll
    for (int kb = 0; kb < 8; ++kb)
#pragma unroll
        for (int r = 0; r < 16; ++r) m = fmaxf(m, S[kb][r]);
    m = fmaxf(m, __shfl_xor(m, 32));
    float l = 0.f;
#pragma unroll
    for (int kb = 0; kb < 8; ++kb)
#pragma unroll
        for (int r = 0; r < 16; ++r) { const float p = __builtin_amdgcn_exp2f(S[kb][r] - m); S[kb][r] = p; l += p; }
    l += __shfl_xor(l, 32);
    u32x4 pw[8][2];
#pragma unroll
    for (int kb = 0; kb < 8; ++kb)
#pragma unroll
        for (int sp = 0; sp < 2; ++sp) { pw[kb][sp].x = cvtpk(S[kb][8 * sp + 0], S[kb][8 * sp + 1]); pw[kb][sp].y = cvtpk(S[kb][8 * sp + 2], S[kb][8 * sp + 3]); pw[kb][sp].z = cvtpk(S[kb][8 * sp + 4], S[kb][8 * sp + 5]); pw[kb][sp].w = cvtpk(S[kb][8 * sp + 6], S[kb][8 * sp + 7]); }
    __builtin_amdgcn_sched_barrier(0);
    f32x16 o[4];
#pragma unroll
    for (int db = 0; db < 4; ++db) o[db] = f32x16{};
#pragma unroll
    for (int kb = 0; kb < 8; ++kb)
#pragma unroll
        for (int sp = 0; sp < 2; ++sp) {
            const bf16x8 pk = __builtin_bit_cast(bf16x8, pw[kb][sp]);
#pragma unroll
            for (int db = 0; db < 4; ++db) { const XLAS unsigned char* vb = lds + LDS_V + (32 * db + r32) * VROW + (32 * kb + 16 * sp + 4 * hi) * 2;
                const u32x2 lo = *(const XLAS u32x2*)vb, hh = *(const XLAS u32x2*)(vb + 16);
                const u32x4 vw = (u32x4){lo.x, lo.y, hh.x, hh.y};
                o[db] = __builtin_amdgcn_mfma_f32_32x32x16_bf16(__builtin_bit_cast(bf16x8, vw), pk, o[db], 0, 0, 0); }
            __builtin_amdgcn_sched_barrier(0); }
    const float inv = 1.0f / l;
    bf16_t* op = MO + row * 512 + h * 128 + 4 * hi;
#pragma unroll
    for (int db = 0; db < 4; ++db)
#pragma unroll
        for (int g = 0; g < 4; ++g) { u32x2 w; w.x = cvtpk(o[db][4 * g + 0] * inv, o[db][4 * g + 1] * inv); w.y = cvtpk(o[db][4 * g + 2] * inv, o[db][4 * g + 3] * inv);
            *(u32x2*)(op + 32 * db + 8 * g) = w; }
}
}

namespace cg = cooperative_groups;
#define LAS __attribute__((address_space(3)))
typedef unsigned short bf16;
typedef unsigned v4u __attribute__((ext_vector_type(4)));
typedef unsigned v2u __attribute__((ext_vector_type(2)));
typedef float f32x4 __attribute__((ext_vector_type(4)));
constexpr int NWAVES = 8;
constexpr int DM = 1024, BATCH = 8, SEQ = 8192, MTOK = BATCH * SEQ, DEPTH = 2, NIN = 2056, NINP = 2304, DFF = 2816, MEMLEN = 256;
constexpr float EPS = 1e-6f;
constexpr size_t MiB = 1u << 20;
constexpr size_t WS_W = 1 * MiB, WS_WSTRIDE = 28 * MiB;
constexpr size_t WO_IN = 0, WO_OUT = 5 * MiB, WO_MQ = 7 * MiB, WO_MKV = 8 * MiB, WO_MO = 10 * MiB, WO_GU = 11 * MiB, WO_D = 22 * MiB;
constexpr size_t WS_BAR = 65536, WS_BAR_BYTES = 16384;
constexpr int XBST_OFF = 141312;
constexpr size_t WS_QCNT = 0, WS_TS = 4096;
constexpr size_t WS_LF = 58 * MiB, WS_NC2 = 60 * MiB, WS_SSQ = 62 * MiB, WS_MN = 66 * MiB, WS_MK = 74 * MiB, WS_MVT = 78 * MiB;
constexpr size_t WS_HB = 96 * MiB, WS_Q = 224 * MiB, WS_K = 288 * MiB, WS_V = 352 * MiB, WS_P = 416 * MiB, WS_CAT = 480 * MiB, WS_MQ = 608 * MiB, WS_MO = 672 * MiB, WS_END = 736 * MiB;
constexpr size_t WS_ACT = 224 * MiB;
static_assert(WS_ACT + (size_t)MTOK * DFF * 2 <= WS_MQ, "ACT overlay");
constexpr int RING_BYTES = 131072, EPIX_OFF = 132096, LDS_BYTES = 147456;

__device__ __forceinline__ unsigned f2bf(float f) { unsigned u = __builtin_bit_cast(unsigned, f); return (u + 0x7fffu + ((u >> 16) & 1u)) >> 16; }
__device__ __forceinline__ unsigned pk2(float lo, float hi) { return f2bf(lo) | (f2bf(hi) << 16); }
__device__ __forceinline__ float wave_sum(float v) {
#pragma unroll
    for (int o = 1; o < 64; o <<= 1) v += __shfl_xor(v, o);
    return v;
}
__device__ __forceinline__ void tr_item(const float* W, int N, int k0, int n0, const float* g, bf16* WT, int Kdst, int drow0, LAS float* scr, int lane) {
    const int nn = lane & 31; const bool ok = (n0 + nn) < N;
#pragma unroll 8
    for (int i = 0; i < 32; ++i) { const int kk = 2 * i + (lane >> 5); float v = ok ? W[(size_t)(k0 + kk) * N + n0 + nn] : 0.f; if (g) v *= g[k0 + kk]; scr[kk * 33 + nn] = v; }
    asm volatile("s_waitcnt lgkmcnt(0)" ::: "memory");
    const int c = lane & 7;
#pragma unroll
    for (int j = 0; j < 4; ++j) { const int n = (lane >> 3) + 8 * j; const LAS float* s = scr + (8 * c) * 33 + n;
        v4u o; o.x = pk2(s[0 * 33], s[1 * 33]); o.y = pk2(s[2 * 33], s[3 * 33]); o.z = pk2(s[4 * 33], s[5 * 33]); o.w = pk2(s[6 * 33], s[7 * 33]);
        *(v4u*)(WT + (size_t)(drow0 + n) * Kdst + k0 + 8 * c) = o; }
    asm volatile("s_waitcnt lgkmcnt(0)" ::: "memory");
}

#ifndef PHMASK
#define PHMASK 0x3ff
#endif
#define XB_TMO      128
#define XB_XCNT(j)  (256  + 64 * (j))
#define XB_XSUB(j)  (1280 + 64 * (j))
#define XB_XGEN(j)  (2304 + 64 * (j))
#define XB_TOP      3328
#define XB_TOPGEN   3392
#define XCD_BAR_WORDS 3456
#define XB_SPIN_CAP (1u << 18)

__device__ __forceinline__ unsigned xb_ld(unsigned* p)              { return __hip_atomic_load(p, __ATOMIC_RELAXED, __HIP_MEMORY_SCOPE_AGENT); }
__device__ __forceinline__ unsigned xb_add(unsigned* p, unsigned v) { return __hip_atomic_fetch_add(p, v, __ATOMIC_RELAXED, __HIP_MEMORY_SCOPE_AGENT); }
__device__ __forceinline__ unsigned xb_xcc_id() { return (unsigned)__builtin_amdgcn_s_getreg((3 << 11) | 20) & 0xFu; }
#define XB_SPIN(cond, bar) do { unsigned _sp = 0; while (cond) { __builtin_amdgcn_s_sleep(1); \
    if ((++_sp & 255u) == 0u) { if (xb_ld(&(bar)[XB_TMO])) break; if (_sp > XB_SPIN_CAP) { atomicAdd(&(bar)[XB_TMO], 1u); break; } } } } while (0)

struct XcdBarrier {
    unsigned* bar; unsigned x;
    volatile LAS unsigned* st;
};

__device__ __forceinline__ XcdBarrier xcd_barrier_post(unsigned* bar, volatile LAS unsigned* st) {
    XcdBarrier b; b.bar = bar; b.x = xb_xcc_id(); b.st = st;
    if (threadIdx.x == 0) (void)xb_add(&bar[XB_XCNT(b.x)], 1u);
    return b;
}
__device__ __forceinline__ void xcd_barrier_complete(unsigned* bar, unsigned x, unsigned& nloc, unsigned& nx) {
    const unsigned G = gridDim.x * gridDim.y * gridDim.z;
    unsigned sum, cnt, mine, sp = 0u;
    for (;;) {
        sum = 0u; cnt = 0u; mine = 0u;
#pragma unroll
        for (unsigned j = 0; j < 16; ++j) { const unsigned c = xb_ld(&bar[XB_XCNT(j)]); sum += c; cnt += (c > 0u) ? 1u : 0u; mine = (j == x) ? c : mine; }
        if (sum == G) break;
        __builtin_amdgcn_s_sleep(1);
        if ((++sp & 255u) == 0u) { if (xb_ld(&bar[XB_TMO])) break; if (sp > XB_SPIN_CAP) { atomicAdd(&bar[XB_TMO], 1u); break; } }
    }
    nloc = mine > 0u ? mine : 1u; nx = cnt > 0u ? cnt : 1u;
}

__device__ __forceinline__ void xcd_barrier(const XcdBarrier& b) {
    asm volatile("s_waitcnt vmcnt(0)" ::: "memory");
    __syncthreads();
    if (threadIdx.x == 0) {
        unsigned* bar = b.bar;
        __builtin_amdgcn_s_waitcnt(0);
        unsigned nloc = b.st[0], nx = b.st[1];
        if (nloc == 0u) { xcd_barrier_complete(bar, b.x, nloc, nx); b.st[0] = nloc; b.st[1] = nx; }
        const unsigned old = xb_add(&bar[XB_XSUB(b.x)], 1u);
        const unsigned gen = old / nloc;
        if (old + 1u == (gen + 1u) * nloc) {
            __builtin_amdgcn_fence(__ATOMIC_RELEASE, "agent");
            asm volatile("s_waitcnt vmcnt(0)" ::: "memory");
            const unsigned og = xb_add(&bar[XB_TOP], 1u);
            const unsigned tg = og / nx;
            if (og + 1u == (tg + 1u) * nx) xb_add(&bar[XB_TOPGEN], 1u);
            else XB_SPIN(xb_ld(&bar[XB_TOPGEN]) == tg, bar);
            __builtin_amdgcn_fence(__ATOMIC_ACQUIRE, "agent");
            xb_add(&bar[XB_XGEN(b.x)], 1u);
            asm volatile("s_waitcnt vmcnt(0)" ::: "memory");
        } else {
            XB_SPIN(xb_ld(&bar[XB_XGEN(b.x)]) == gen, bar);
            __builtin_amdgcn_fence(__ATOMIC_ACQUIRE, "agent");
            asm volatile("s_waitcnt vmcnt(0)" ::: "memory");
        }
    }
    __syncthreads();
}

__device__ __forceinline__ unsigned long long karg(int k) {
    const __attribute__((address_space(4))) unsigned long long* ka = (const __attribute__((address_space(4))) unsigned long long*)__builtin_amdgcn_kernarg_segment_ptr();
    asm volatile("" : "+s"(ka)); return ka[k];
}
#ifdef USE_CG_SYNC
#define GSYNC() grid.sync()
#else
#define GSYNC() xcd_barrier(xbar)
#endif
struct Args { const float* in[20]; float* out; unsigned char* ws; };

__global__ void __launch_bounds__(NWAVES * 64, 2) fwd_megakernel(Args args) {
    extern __shared__ __attribute__((aligned(16))) unsigned char lds[];
    cg::grid_group grid = cg::this_grid();
    LAS unsigned char* const L = (LAS unsigned char*)lds;
    const int wave = __builtin_amdgcn_readfirstlane((int)threadIdx.x >> 6);
    const int G = gridDim.x, bx = blockIdx.x;
    const int vcu = (G % 8 == 0) ? (bx % 8) * (G / 8) + bx / 8 : bx;
    LAS float* const EX = (LAS float*)(L + EPIX_OFF);
    if (threadIdx.x < 2) ((LAS unsigned*)(L + XBST_OFF))[threadIdx.x] = 0u;
    __syncthreads();
    const XcdBarrier xbar = xcd_barrier_post((unsigned*)((unsigned char*)karg(21) + WS_BAR), (volatile LAS unsigned*)(L + XBST_OFF));
#define DEFPTRS \
    int tid = threadIdx.x; asm volatile("" : "+v"(tid)); const int lane = tid & 63; (void)lane; \
    unsigned char* const ws = (unsigned char*)karg(21); float* const out = (float*)karg(20); (void)out; \
    bf16* const HB = (bf16*)(ws + WS_HB); bf16* const Qb = (bf16*)(ws + WS_Q); bf16* const Kb = (bf16*)(ws + WS_K); bf16* const Vb = (bf16*)(ws + WS_V); bf16* const Pb = (bf16*)(ws + WS_P); \
    bf16* const CAT = (bf16*)(ws + WS_CAT); bf16* const MQ = (bf16*)(ws + WS_MQ); bf16* const MO = (bf16*)(ws + WS_MO); bf16* const ACT = (bf16*)(ws + WS_ACT); \
    float* const LF = (float*)(ws + WS_LF); float* const NC2 = (float*)(ws + WS_NC2); float* const SSQ = (float*)(ws + WS_SSQ); \
    bf16* const MN = (bf16*)(ws + WS_MN); bf16* const MK = (bf16*)(ws + WS_MK); bf16* const MVT = (bf16*)(ws + WS_MVT); \
    (void)HB; (void)Qb; (void)Kb; (void)Vb; (void)Pb; (void)CAT; (void)MQ; (void)MO; (void)ACT; (void)LF; (void)NC2; (void)SSQ; (void)MN; (void)MK; (void)MVT;
#define IN(k) ((const float*)karg(k))

    if constexpr ((PHMASK >> 0) & 1) { DEFPTRS
        LAS float* scr = (LAS float*)(L + wave * 16384);
        const int gw = vcu * NWAVES + wave, NGW = G * NWAVES;
        constexpr int I_IN = 16 * 72, I_OUT = 8 * 32, I_MQ = 16 * 16, I_MKV = 16 * 32, I_MO = 8 * 32, I_GU = 16 * 176, I_D = 44 * 32, I_L = I_IN + I_OUT + I_MQ + I_MKV + I_MO + I_GU + I_D;
        for (int it = gw; it < DEPTH * I_L; it += NGW) {
            const int l = it / I_L; int r = it % I_L; unsigned char* wl = ws + WS_W + (size_t)l * WS_WSTRIDE;
            if (r < I_IN) { const int kb = r / 72, nb = r % 72; tr_item(IN(3) + (size_t)l * DM * NIN, NIN, 64 * kb, 32 * nb, IN(2) + l * DM, (bf16*)(wl + WO_IN), DM, 32 * nb, scr, lane); continue; } r -= I_IN;
            if (r < I_OUT) { const int kb = r / 32, nb = r % 32; tr_item(IN(9) + (size_t)l * DM * DM, DM, 64 * kb, 32 * nb, nullptr, (bf16*)(wl + WO_OUT), DM, 32 * nb, scr, lane); continue; } r -= I_OUT;
            if (r < I_MQ) { const int kb = r / 16, nb = r % 16; tr_item(IN(12) + (size_t)l * DM * 512, 512, 64 * kb, 32 * nb, IN(10) + l * DM, (bf16*)(wl + WO_MQ), DM, 32 * nb, scr, lane); continue; } r -= I_MQ;
            if (r < I_MKV) { const int kb = r / 32, nb = r % 32; tr_item(IN(13) + (size_t)l * DM * 1024, 1024, 64 * kb, 32 * nb, nullptr, (bf16*)(wl + WO_MKV), DM, 32 * nb, scr, lane); continue; } r -= I_MKV;
            if (r < I_MO) { const int kb = r / 32, nb = r % 32; tr_item(IN(16) + (size_t)l * 512 * DM, DM, 64 * kb, 32 * nb, nullptr, (bf16*)(wl + WO_MO), 512, 32 * nb, scr, lane); continue; } r -= I_MO;
            if (r < I_GU) { const int kb = r / 176, nb = r % 176; const int n0 = 32 * nb; const int drow = (n0 < DFF) ? (n0 / 128) * 256 + (n0 % 128) : ((n0 - DFF) / 128) * 256 + 128 + ((n0 - DFF) % 128);
                tr_item(IN(18) + (size_t)l * DM * 2 * DFF, 2 * DFF, 64 * kb, n0, IN(17) + l * DM, (bf16*)(wl + WO_GU), DM, drow, scr, lane); continue; } r -= I_GU;
            { const int kb = r / 32, nb = r % 32; tr_item(IN(19) + (size_t)l * DFF * DM, DM, 64 * kb, 32 * nb, nullptr, (bf16*)(wl + WO_D), DFF, 32 * nb, scr, lane); }
        }
        if (bx == 0 && tid < DEPTH) ((unsigned*)(ws + WS_QCNT))[tid * 64] = 0u;
        for (int idx = bx * 512 + tid; idx < DEPTH * 512 * 1024; idx += G * 512) {
            const int l = idx / (512 * 1024), rem = idx % (512 * 1024), kc = rem / 1024, n = rem % 1024, g = kc >> 7, c = kc & 127;
            const float* wp = IN(7) + ((size_t)(l * 4 + g) * 128 + c) * 128; const float* ps = IN(8) + l * 512 + g * 128; const float* wo = IN(9) + (size_t)l * DM * DM + (size_t)(512 + g * 128) * DM + n;
            float a = 0.f;
            for (int d = 0; d < 128; ++d) a += wp[d] * ps[d] * wo[(size_t)d * DM];
            ((bf16*)(ws + WS_W + (size_t)l * WS_WSTRIDE + WO_OUT))[(size_t)n * DM + 512 + kc] = (bf16)f2bf(a);
        }
        for (int m = gw; m < MTOK; m += NGW) {
            const f32x4* xr = (const f32x4*)(IN(0) + (size_t)m * DM) + lane; f32x4 v[4]; float s = 0.f;
#pragma unroll
            for (int j = 0; j < 4; ++j) { v[j] = xr[64 * j]; s += (v[j].x * v[j].x + v[j].y * v[j].y) + (v[j].z * v[j].z + v[j].w * v[j].w); }
            s = wave_sum(s);
            v2u* o8 = (v2u*)(HB + (size_t)m * DM) + lane;
#pragma unroll
            for (int j = 0; j < 4; ++j) o8[64 * j] = (v2u){pk2(v[j].x, v[j].y), pk2(v[j].z, v[j].w)};
            if (lane < 16) SSQ[(size_t)m * 16 + lane] = (lane == 0) ? s : 0.f;
        }
        for (int m = gw; m < DEPTH * BATCH * MEMLEN; m += NGW) {
            const int l = m / (BATCH * MEMLEN), rr = m % (BATCH * MEMLEN);
            const f32x4* xr = (const f32x4*)(IN(1) + (size_t)rr * DM) + lane; const f32x4* gr = (const f32x4*)(IN(11) + l * DM) + lane; f32x4 v[4]; float s = 0.f;
#pragma unroll
            for (int j = 0; j < 4; ++j) { v[j] = xr[64 * j]; s += (v[j].x * v[j].x + v[j].y * v[j].y) + (v[j].z * v[j].z + v[j].w * v[j].w); }
            const float rstd = 1.0f / sqrtf(wave_sum(s) * (1.0f / DM) + EPS);
            v2u* o8 = (v2u*)(MN + (size_t)m * DM) + lane;
#pragma unroll
            for (int j = 0; j < 4; ++j) { const f32x4 gg = gr[64 * j]; o8[64 * j] = (v2u){pk2(v[j].x * rstd * gg.x, v[j].y * rstd * gg.y), pk2(v[j].z * rstd * gg.z, v[j].w * rstd * gg.w)}; }
        }
    }
    grid.sync();

    for (int l = 0; l < DEPTH; ++l) {
        if constexpr ((PHMASK >> 1) & 1) { DEFPTRS
            pg8::Gemm g{HB, (const bf16*)(ws + WS_W + (size_t)l * WS_WSTRIDE + WO_IN), MTOK, NINP, DM}; pg8::StaticOrder S; S.init(MTOK, NINP, G, bx);
            pg8::EpiInProj E{SSQ, Qb, Kb, Vb, Pb, LF, IN(5) + l * 64, IN(6) + l * 64, IN(4) + l * 8, EX, 0.125f * pg8::LOG2E};
            pg8::gemm_phase<pg8::EpiInProj, pg8::StaticOrder, true, true>(L, g, S, E);
        }
        GSYNC();
        if constexpr ((PHMASK >> 2) & 1) { DEFPTRS
            if (bx < 64) {
                const int b = bx >> 3, h = bx & 7; const float* src = LF + ((size_t)b * SEQ + tid * 16) * 8 + h; float v[16]; float s = 0.f;
#pragma unroll
                for (int j = 0; j < 16; ++j) { s += src[j * 8]; v[j] = s; }
                LAS float* sc = (LAS float*)L; sc[tid] = s; __syncthreads();
                for (int off = 1; off < 512; off <<= 1) { const float t = (tid >= off) ? sc[tid - off] : 0.f; __syncthreads(); sc[tid] += t; __syncthreads(); }
                const float excl = sc[tid] - s; float* dst = NC2 + (size_t)bx * SEQ + tid * 16; LAS float* ncl = (LAS float*)(L + 4096) + tid * 16;
#pragma unroll
                for (int j = 0; j < 16; j += 4) { const f32x4 nv = (f32x4){-(excl + v[j]), -(excl + v[j + 1]), -(excl + v[j + 2]), -(excl + v[j + 3])}; *(f32x4*)(dst + j) = nv; *(LAS f32x4*)(ncl + j) = nv; }
                __syncthreads();
                if (tid < 32) {
                    float gq = 0.f, gk = 0.f; const float* gqp = IN(5) + l * 64; const float* gkp = IN(6) + l * 64;
                    for (int d = 0; d < 64; ++d) { gq = fmaxf(gq, fabsf(gqp[d])); gk = fmaxf(gk, fabsf(gkp[d])); }
                    const float thresh = 2.0f * (64.0f * gq * gk * 0.125f * pg8::LOG2E) + 30.0f;
                    const LAS float* nc = (const LAS float*)(L + 4096); const float ref = nc[256 * tid]; int t = 0;
                    while (t < 4 * tid && ref - nc[64 * t + 63] > thresh) ++t;
                    ((int*)(ws + WS_TS))[bx * 32 + tid] = t & ~1;
                }
                __syncthreads();
            } else if (l == 0 && bx < 128) {
                const int l2 = (bx - 64) >> 5;
                pg8::Gemm g{MN + (size_t)l2 * BATCH * MEMLEN * DM, (const bf16*)(ws + WS_W + (size_t)l2 * WS_WSTRIDE + WO_MKV), BATCH * MEMLEN, 1024, DM};
                pg8::RangeOrder S{4, 64 + 32 * l2, 32, bx};
                pg8::EpiHead128<1> E{nullptr, MK + (size_t)l2 * BATCH * 4 * MEMLEN * 128, MVT + (size_t)l2 * BATCH * 4 * MEMLEN * 128, IN(15) + l2 * 128, EX, 1.0f};
                pg8::gemm_phase<pg8::EpiHead128<1>, pg8::RangeOrder, true, true>(L, g, S, E);
            }
            for (int task = bx * 512 + tid; task < (MTOK / 32) * 64; task += G * 512) {
                const int cgp = task & 63, r0 = (task >> 6) * 32, t0 = r0 & (SEQ - 1), w = 2 << (cgp >> 4);
                const bf16* pp = Pb + (size_t)r0 * 512 + cgp * 8; bf16* op = CAT + (size_t)r0 * DM + 512 + cgp * 8;
                float sum[8];
#pragma unroll
                for (int j = 0; j < 8; ++j) sum[j] = 0.f;
                for (int j = 1; j < w; ++j) if (t0 - j >= 0) { const v4u u = *(const v4u*)(pp - (ptrdiff_t)j * 512);
                    sum[0] += __uint_as_float(u.x << 16); sum[1] += __uint_as_float(u.x & 0xffff0000u); sum[2] += __uint_as_float(u.y << 16); sum[3] += __uint_as_float(u.y & 0xffff0000u);
                    sum[4] += __uint_as_float(u.z << 16); sum[5] += __uint_as_float(u.z & 0xffff0000u); sum[6] += __uint_as_float(u.w << 16); sum[7] += __uint_as_float(u.w & 0xffff0000u); }
                for (int i = 0; i < 32; ++i) {
                    const v4u u = *(const v4u*)(pp + (size_t)i * 512); float cur[8];
                    cur[0] = __uint_as_float(u.x << 16); cur[1] = __uint_as_float(u.x & 0xffff0000u); cur[2] = __uint_as_float(u.y << 16); cur[3] = __uint_as_float(u.y & 0xffff0000u);
                    cur[4] = __uint_as_float(u.z << 16); cur[5] = __uint_as_float(u.z & 0xffff0000u); cur[6] = __uint_as_float(u.w << 16); cur[7] = __uint_as_float(u.w & 0xffff0000u);
                    const int t = t0 + i; const float rc = 1.0f / (float)((t + 1 < w) ? t + 1 : w); float o[8];
#pragma unroll
                    for (int j = 0; j < 8; ++j) { sum[j] += cur[j]; o[j] = sum[j] * rc - cur[j]; }
                    *(v4u*)(op + (size_t)i * DM) = (v4u){pk2(o[0], o[1]), pk2(o[2], o[3]), pk2(o[4], o[5]), pk2(o[6], o[7])};
                    if (t + 1 - w >= 0) { const v4u q = *(const v4u*)(pp + (ptrdiff_t)(i + 1 - w) * 512);
                        sum[0] -= __uint_as_float(q.x << 16); sum[1] -= __uint_as_float(q.x & 0xffff0000u); sum[2] -= __uint_as_float(q.y << 16); sum[3] -= __uint_as_float(q.y & 0xffff0000u);
                        sum[4] -= __uint_as_float(q.z << 16); sum[5] -= __uint_as_float(q.z & 0xffff0000u); sum[6] -= __uint_as_float(q.w << 16); sum[7] -= __uint_as_float(q.w & 0xffff0000u); }
                }
            }
        }
        GSYNC();
        if constexpr ((PHMASK >> 3) & 1) { DEFPTRS
            const attn_body::AttnTensors AT{(const attn_body::bf16*)Qb, (const attn_body::bf16*)Kb, (const attn_body::bf16*)Vb, (attn_body::bf16*)CAT, NC2, (const int*)(ws + WS_TS)};
            const attn_body::QueueOrder S{(unsigned*)(ws + WS_QCNT) + l * 64, (volatile LAS unsigned*)(L + attn_body::ATTN_LDS_BYTES)};
            attn_body::attn_phase<attn_body::QueueOrder, 20>((char*)lds, AT, S);
        }
        GSYNC();
        if constexpr ((PHMASK >> 4) & 1) { DEFPTRS
            pg8::Gemm g{CAT, (const bf16*)(ws + WS_W + (size_t)l * WS_WSTRIDE + WO_OUT), MTOK, DM, DM}; pg8::StaticOrder S; S.init(MTOK, DM, G, bx);
            pg8::EpiResid E{(l == 0) ? IN(0) : nullptr, nullptr, HB, SSQ};
            pg8::gemm_phase<pg8::EpiResid, pg8::StaticOrder, true, true>(L, g, S, E);
        }
        GSYNC();
        if constexpr ((PHMASK >> 5) & 1) { DEFPTRS
            pg8::Gemm g{HB, (const bf16*)(ws + WS_W + (size_t)l * WS_WSTRIDE + WO_MQ), MTOK, 512, DM}; pg8::StaticOrder S; S.init(MTOK, 512, G, bx);
            pg8::EpiHead128<0> E{SSQ, MQ, nullptr, IN(14) + l * 128, EX, 0.08838834764831845f * pg8::LOG2E};
            pg8::gemm_phase<pg8::EpiHead128<0>, pg8::StaticOrder, true, true>(L, g, S, E);
        }
        GSYNC();
        if constexpr ((PHMASK >> 6) & 1) { DEFPTRS
            const int bh = vcu >> 3, b = bh >> 2, h = bh & 3;
            if (bh < BATCH * 4) {
                xat::load_kv(MK + ((size_t)l * BATCH * 4 + bh) * MEMLEN * 128, MVT + ((size_t)l * BATCH * 4 + bh) * MEMLEN * 128, L, tid);
                __syncthreads();
                for (int i = 0; i < 4; ++i) xat::unit(MQ, MO, b, h, (vcu & 7) * 4 + i, L);
                __syncthreads();
            }
        }
        GSYNC();
        if constexpr ((PHMASK >> 7) & 1) { DEFPTRS
            pg8::Gemm g{MO, (const bf16*)(ws + WS_W + (size_t)l * WS_WSTRIDE + WO_MO), MTOK, DM, 512}; pg8::StaticOrder S; S.init(MTOK, DM, G, bx);
            pg8::EpiResid E{nullptr, nullptr, HB, SSQ};
            pg8::gemm_phase<pg8::EpiResid, pg8::StaticOrder, true, true>(L, g, S, E);
        }
        GSYNC();
        if constexpr ((PHMASK >> 8) & 1) { DEFPTRS
            pg8::Gemm g{HB, (const bf16*)(ws + WS_W + (size_t)l * WS_WSTRIDE + WO_GU), MTOK, 2 * DFF, DM}; pg8::StaticOrder S; S.init(MTOK, 2 * DFF, G, bx);
            pg8::EpiSwiglu E{SSQ, ACT, EX};
            pg8::gemm_phase<pg8::EpiSwiglu, pg8::StaticOrder, true, true>(L, g, S, E);
        }
        GSYNC();
        if constexpr ((PHMASK >> 9) & 1) { DEFPTRS
            pg8::Gemm g{ACT, (const bf16*)(ws + WS_W + (size_t)l * WS_WSTRIDE + WO_D), MTOK, DM, DFF}; pg8::StaticOrder S; S.init(MTOK, DM, G, bx);
            pg8::EpiResid E{nullptr, (l == DEPTH - 1) ? out : nullptr, HB, SSQ};
            pg8::gemm_phase<pg8::EpiResid, pg8::StaticOrder, true, true>(L, g, S, E);
        }
        if (l + 1 < DEPTH) GSYNC();
    }
}

extern "C" void kernel_launch(void* const* d_in, const int* in_sizes, int n_in, void* d_out, int out_size, void* d_ws, size_t ws_size, hipStream_t stream) {
    static int grid = 0;
    if (grid == 0) {
        if (n_in != 20 || out_size != MTOK * DM || ws_size < WS_END) { fprintf(stderr, "kernel_launch: unexpected shapes (n_in %d, out %d, ws %zu)\n", n_in, out_size, ws_size); grid = -1; return; }
        int dev = 0, cus = 0, per_cu = 0;
        if (hipGetDevice(&dev) != hipSuccess || hipDeviceGetAttribute(&cus, hipDeviceAttributeMultiprocessorCount, dev) != hipSuccess) { grid = -1; return; }
        if (hipFuncSetAttribute((const void*)fwd_megakernel, hipFuncAttributeMaxDynamicSharedMemorySize, LDS_BYTES) != hipSuccess) { fprintf(stderr, "kernel_launch: hipFuncSetAttribute failed\n"); grid = -1; return; }
        if (hipOccupancyMaxActiveBlocksPerMultiprocessor(&per_cu, (const void*)fwd_megakernel, NWAVES * 64, LDS_BYTES) != hipSuccess || per_cu < 1) { fprintf(stderr, "kernel_launch: occupancy query says %d\n", per_cu); per_cu = 1; }
        (void)hipGetLastError();
        grid = cus * 1;
        if (grid != 256) fprintf(stderr, "kernel_launch: %d CUs; the unit orders assume 256\n", grid);
    }
    if (grid < 0) return;
    if (hipMemsetAsync((char*)d_ws + WS_BAR, 0, WS_BAR_BYTES, stream) != hipSuccess) { fprintf(stderr, "kernel_launch: hipMemsetAsync failed\n"); return; }
    Args a{};
    for (int i = 0; i < 20; ++i) a.in[i] = (const float*)d_in[i];
    a.out = (float*)d_out; a.ws = (unsigned char*)d_ws;
    void* kargs[] = {&a};
    hipError_t e = hipLaunchCooperativeKernel((const void*)fwd_megakernel, dim3(grid), dim3(NWAVES * 64), kargs, LDS_BYTES, stream);
    if (e != hipSuccess) fprintf(stderr, "kernel_launch: cooperative launch failed: %s (grid %d)\n", hipGetErrorString(e), grid);
}
```

```cpp
#include <hip/hip_runtime.h>
#include <hip/hip_cooperative_groups.h>
#include <cstdio>
#include <cstdint>
#include <cstddef>
namespace pg8 {
#define PG8_LAS __attribute__((address_space(3)))
typedef unsigned short bf16_t;
typedef short bf16x8 __attribute__((ext_vector_type(8)));
typedef float f32x4 __attribute__((ext_vector_type(4)));
typedef unsigned u32x4 __attribute__((ext_vector_type(4)));
constexpr int BM = 256, BK = 64, HALF = 128, HTB = HALF * BK * 2  , STAGE_BYTES = 8 * HTB, NXCD = 8, WGM = 8;

__host__ __device__ __forceinline__ int lds_byte(int r, int c) { const int st = (r >> 4) * 2 + (c >> 5), rr = r & 15, cc = c & 31, ob = rr * 64 + cc * 2; return st * 1024 + (ob ^ (((ob >> 9) & 1) << 5)); }
__host__ __device__ __forceinline__ void stage_rc(int b, int& R, int& C) { const int st = b / 1024, sb = b % 1024, swz = sb ^ (((sb >> 9) & 1) << 5); R = (st >> 1) * 16 + swz / 64; C = (st & 1) * 32 + (swz % 64) / 2; }
__host__ __device__ __forceinline__ int perm32(int rho) { const int n = rho >> 4, i = rho & 15; return 8 * (i >> 2) + 4 * n + (i & 3); }

struct Unit { int pm, pn; };
struct Gemm { const bf16_t* A; const bf16_t* Bt; int M, N, K; };

struct StaticOrder {
    int nM, nN, nwg, G, c;
    __host__ __device__ void init(int M, int N, int G_, int c_) { nM = M / BM; nN = N / BM; nwg = nM * nN; G = G_; c = c_; }
    __host__ __device__ bool next(int i, Unit& u) const {
        const long L = (long)i * G + c; if (L >= nwg) return false;
        int wgid = (int)L; { const int q = nwg / NXCD, r = nwg % NXCD, xcd = wgid % NXCD, off = wgid / NXCD; wgid = (xcd < r ? xcd * (q + 1) : r * (q + 1) + (xcd - r) * q) + off; }
        const int nig = WGM * nN, gid = wgid / nig, fm = gid * WGM, gsz = (nM - fm) < WGM ? (nM - fm) : WGM;
        u.pm = fm + ((wgid % nig) % gsz); u.pn = (wgid % nig) / gsz; return true;
    }
    __device__ __forceinline__ void a_ready(const Unit&) const {}
    __device__ __forceinline__ void done(const Unit&) const {}
};

__device__ __forceinline__ unsigned cvt_pk_bf16(float lo, float hi) { unsigned r; asm volatile("v_cvt_pk_bf16_f32 %0, %1, %2" : "=v"(r) : "v"(lo), "v"(hi)); return r; }
typedef unsigned u32x2 __attribute__((ext_vector_type(2)));
constexpr float RMS_EPS = 1e-6f;
constexpr float LOG2E = 1.4426950408889634f;
__device__ __forceinline__ void epi_bar() { asm volatile("s_waitcnt lgkmcnt(0)\n\ts_barrier" ::: "memory"); }
__device__ __forceinline__ float sum4(f32x4 a) { return (a[0] + a[1]) + (a[2] + a[3]); }
__device__ __forceinline__ float sumsq4(f32x4 v) { return (v[0] * v[0] + v[1] * v[1]) + (v[2] * v[2] + v[3] * v[3]); }
__device__ __forceinline__ float rstd_row(const float* ssq, int row) {
    const f32x4* p = (const f32x4*)(ssq + (size_t)row * 16);
    const f32x4 a = p[0], b = p[1], c = p[2], d = p[3];
    return __builtin_amdgcn_rsqf(((sum4(a) + sum4(b)) + (sum4(c) + sum4(d))) * (1.0f / 1024.0f) + RMS_EPS);
}
__device__ __forceinline__ void rstd_to_lds(const float* ssq, int row0, PG8_LAS float* RS) {
    const int t = threadIdx.x; if (t < 256) RS[t] = rstd_row(ssq, row0 + t);
}
__device__ __forceinline__ u32x4 pack8(f32x4 a, f32x4 b) { u32x4 w; w.x = cvt_pk_bf16(a[0], a[1]); w.y = cvt_pk_bf16(a[2], a[3]); w.z = cvt_pk_bf16(b[0], b[1]); w.w = cvt_pk_bf16(b[2], b[3]); return w; }
__device__ __forceinline__ float log2sigmoid(float x) { return LOG2E * (fminf(x, 0.f) - log1pf(expf(-fabsf(x)))); }

struct EpiResid {
    static constexpr bool PERM = true, AFTER_DRAIN = false;
    const float* basef; float* outf; bf16_t* hb; float* ssq; const bf16_t* fw; float* fp;
    __device__ __forceinline__ void tail(const f32x4& o0, const f32x4& o1, size_t off, float& s) const {
        if (outf) { *(f32x4*)(outf + off) = o0; *(f32x4*)(outf + off + 4) = o1; }
        else { *(u32x4*)(hb + off) = pack8(o0, o1); s += sumsq4(o0) + sumsq4(o1); }
    }
    __device__ __forceinline__ void operator()(const f32x4 (&acc)[2][2][4][2], const Unit& u, int wr, int wc, int fr, int fq) const {
        const int col0 = u.pn * BM + wc * 32 + 8 * fq, row0 = u.pm * BM + wr * 64 + fr; const size_t off0 = (size_t)row0 * 1024 + col0;
        if (basef) {
#pragma unroll
            for (int ai = 0; ai < 2; ++ai) {
                f32x4 bf[4][2][2];
#pragma unroll
                for (int m = 0; m < 4; ++m)
#pragma unroll
                    for (int bj = 0; bj < 2; ++bj) { const float* p = basef + off0 + (size_t)(ai * HALF + m * 16) * 1024 + bj * HALF; bf[m][bj][0] = *(const f32x4*)p; bf[m][bj][1] = *(const f32x4*)(p + 4); }
                asm volatile("" ::: "memory");
#pragma unroll
                for (int m = 0; m < 4; ++m) { const size_t off = off0 + (size_t)(ai * HALF + m * 16) * 1024; float s = 0.f;
#pragma unroll
                    for (int bj = 0; bj < 2; ++bj) tail(bf[m][bj][0] + acc[ai][bj][m][0], bf[m][bj][1] + acc[ai][bj][m][1], off + bj * HALF, s);
                    if (!outf) { s += __shfl_xor(s, 16); s += __shfl_xor(s, 32); if (fq == 0) ssq[(size_t)(row0 + ai * HALF + m * 16) * 16 + u.pn * 4 + wc] = s; } }
                asm volatile("" ::: "memory");
            }
        } else {
            u32x4 bw[2][4][2]; bf16x8 wfr[2];
            if (fw) { wfr[0] = *(const bf16x8*)(fw + (size_t)fr * 1024 + col0); wfr[1] = *(const bf16x8*)(fw + (size_t)fr * 1024 + col0 + HALF); }
#pragma unroll
            for (int ai = 0; ai < 2; ++ai)
#pragma unroll
                for (int m = 0; m < 4; ++m)
#pragma unroll
                    for (int bj = 0; bj < 2; ++bj) bw[ai][m][bj] = *(const u32x4*)(hb + off0 + (size_t)(ai * HALF + m * 16) * 1024 + bj * HALF);
            asm volatile("" ::: "memory");
#pragma unroll
            for (int ai = 0; ai < 2; ++ai)
#pragma unroll
                for (int m = 0; m < 4; ++m) { const size_t off = off0 + (size_t)(ai * HALF + m * 16) * 1024; float s = 0.f; f32x4 fd = (f32x4){0.f, 0.f, 0.f, 0.f};
#pragma unroll
                    for (int bj = 0; bj < 2; ++bj) { const u32x4 w = bw[ai][m][bj];
                        const f32x4 b0 = (f32x4){__uint_as_float(w.x << 16), __uint_as_float(w.x & 0xffff0000u), __uint_as_float(w.y << 16), __uint_as_float(w.y & 0xffff0000u)};
                        const f32x4 b1 = (f32x4){__uint_as_float(w.z << 16), __uint_as_float(w.z & 0xffff0000u), __uint_as_float(w.w << 16), __uint_as_float(w.w & 0xffff0000u)};
                        const f32x4 o0 = b0 + acc[ai][bj][m][0], o1 = b1 + acc[ai][bj][m][1];
                        tail(o0, o1, off + bj * HALF, s);
                        if (fw) fd = __builtin_amdgcn_mfma_f32_16x16x32_bf16(wfr[bj], __builtin_bit_cast(bf16x8, pack8(o0, o1)), fd, 0, 0, 0); }
                    if (!outf) { s += __shfl_xor(s, 16); s += __shfl_xor(s, 32); if (fq == 0) ssq[(size_t)(row0 + ai * HALF + m * 16) * 16 + u.pn * 4 + wc] = s; }
                    if (fw && fq < 2) *(f32x4*)(fp + ((size_t)(row0 + ai * HALF + m * 16) * 16 + u.pn * 4 + wc) * 8 + 4 * fq) = fd;
                    asm volatile("" ::: "memory"); }
        }
    }
};

struct EpiInProj {
    static constexpr bool PERM = true, AFTER_DRAIN = false;
    const float* ssq; bf16_t *Q, *K, *V, *P; float* LF; const float *gq, *gk, *bfg; PG8_LAS float* X; float qscale; mutable int last_pm;
    __device__ __forceinline__ void operator()(const f32x4 (&acc)[2][2][4][2], const Unit& u, int wr, int wc, int fr, int fq) const {
        const int pn = u.pn, rl0 = wr * 64 + fr; PG8_LAS float* RS = X + 2048;
        const bool newpm = (u.pm != last_pm); last_pm = u.pm;
        if (newpm) rstd_to_lds(ssq, u.pm * BM, RS);
        if (pn < 4) {
#pragma unroll
            for (int ai = 0; ai < 2; ++ai)
#pragma unroll
                for (int m = 0; m < 4; ++m)
#pragma unroll
                    for (int bj = 0; bj < 2; ++bj) { float s = sumsq4(acc[ai][bj][m][0]) + sumsq4(acc[ai][bj][m][1]);
                        s += __shfl_xor(s, 16); s += __shfl_xor(s, 32);
                        if (fq == 0) X[(ai * HALF + rl0 + m * 16) * 8 + bj * 4 + wc] = s; }
        }
        if (newpm || pn < 4) epi_bar();
        if (pn < 4) {
            const float* g = (pn < 2) ? gq : gk; const float extra = (pn < 2) ? qscale : 1.0f; bf16_t* O = (pn < 2) ? Q : K;
            const int dcol = (wc & 1) * 32 + 8 * fq; const f32x4 g0 = *(const f32x4*)(g + dcol) * extra, g1 = *(const f32x4*)(g + dcol + 4) * extra;
            const int colb = (pn & 1) * 256 + wc * 32 + 8 * fq;
#pragma unroll
            for (int ai = 0; ai < 2; ++ai)
#pragma unroll
                for (int m = 0; m < 4; ++m) { const int rl = ai * HALF + rl0 + m * 16; bf16_t* rowp = O + (size_t)(u.pm * BM + rl) * 512 + colb; const float rsv = RS[rl];
#pragma unroll
                    for (int bj = 0; bj < 2; ++bj) { const float hs = X[rl * 8 + bj * 4 + (wc & 2)] + X[rl * 8 + bj * 4 + (wc & 2) + 1];
                        const float sc = rsv * __builtin_amdgcn_rsqf(hs * rsv * rsv * (1.0f / 64.0f) + RMS_EPS);
                        *(u32x4*)(rowp + bj * HALF) = pack8(acc[ai][bj][m][0] * sc * g0, acc[ai][bj][m][1] * sc * g1); }
                    asm volatile("" ::: "memory"); }
        } else if (pn < 8) {
            bf16_t* O = (pn < 6) ? V : P; const int colb = (pn & 1) * 256 + wc * 32 + 8 * fq;
#pragma unroll
            for (int ai = 0; ai < 2; ++ai)
#pragma unroll
                for (int m = 0; m < 4; ++m) { bf16_t* rowp = O + (size_t)(u.pm * BM + ai * HALF + rl0 + m * 16) * 512 + colb; const float rsv = RS[ai * HALF + rl0 + m * 16];
#pragma unroll
                    for (int bj = 0; bj < 2; ++bj) *(u32x4*)(rowp + bj * HALF) = pack8(acc[ai][bj][m][0] * rsv, acc[ai][bj][m][1] * rsv);
                    asm volatile("" ::: "memory"); }
        } else {
            if (wc == 0 && fq == 0) {
                const f32x4 b0 = *(const f32x4*)(bfg), b1 = *(const f32x4*)(bfg + 4);
#pragma unroll
                for (int ai = 0; ai < 2; ++ai)
#pragma unroll
                    for (int m = 0; m < 4; ++m) { float* lp = LF + (size_t)(u.pm * BM + ai * HALF + rl0 + m * 16) * 8; const float rsv = RS[ai * HALF + rl0 + m * 16];
                        const f32x4 z0 = acc[ai][0][m][0] * rsv + b0, z1 = acc[ai][0][m][1] * rsv + b1;
                        *(f32x4*)(lp) = (f32x4){log2sigmoid(z0[0]), log2sigmoid(z0[1]), log2sigmoid(z0[2]), log2sigmoid(z0[3])};
                        *(f32x4*)(lp + 4) = (f32x4){log2sigmoid(z1[0]), log2sigmoid(z1[1]), log2sigmoid(z1[2]), log2sigmoid(z1[3])}; }
            }
        }
    }
};

template <int MODE> struct EpiHead128 {
    static constexpr bool PERM = true, AFTER_DRAIN = false;
    const float* ssq; bf16_t* O; bf16_t* O2; const float* g; PG8_LAS float* X; float oscale;
    __device__ __forceinline__ void operator()(const f32x4 (&acc)[2][2][4][2], const Unit& u, int wr, int wc, int fr, int fq) const {
        const int pn = u.pn, rl0 = wr * 64 + fr; PG8_LAS float* RS = X + 2048;
        if (MODE == 0) rstd_to_lds(ssq, u.pm * BM, RS);
        if (MODE == 0 || pn < 2) {
#pragma unroll
            for (int ai = 0; ai < 2; ++ai)
#pragma unroll
                for (int m = 0; m < 4; ++m)
#pragma unroll
                    for (int bj = 0; bj < 2; ++bj) { float s = sumsq4(acc[ai][bj][m][0]) + sumsq4(acc[ai][bj][m][1]);
                        s += __shfl_xor(s, 16); s += __shfl_xor(s, 32);
                        if (fq == 0) X[(ai * HALF + rl0 + m * 16) * 8 + bj * 4 + wc] = s; }
            epi_bar();
            const int d0 = wc * 32 + 8 * fq; const f32x4 g0 = *(const f32x4*)(g + d0) * oscale, g1 = *(const f32x4*)(g + d0 + 4) * oscale;
#pragma unroll
            for (int ai = 0; ai < 2; ++ai)
#pragma unroll
                for (int m = 0; m < 4; ++m) { const int rl = ai * HALF + rl0 + m * 16; const float rsv = (MODE == 0) ? RS[rl] : 1.0f;
#pragma unroll
                    for (int bj = 0; bj < 2; ++bj) { const f32x4 xs = *(const PG8_LAS f32x4*)(X + rl * 8 + bj * 4);
                        const float sc = rsv * __builtin_amdgcn_rsqf(sum4(xs) * rsv * rsv * (1.0f / 128.0f) + RMS_EPS);
                        bf16_t* dst = (MODE == 0) ? O + (size_t)(u.pm * BM + rl) * 512 + pn * 256 + bj * HALF + d0
                                                  : O + ((size_t)(u.pm * 4 + 2 * pn + bj) * 256 + rl) * 128 + d0;
                        *(u32x4*)dst = pack8(acc[ai][bj][m][0] * sc * g0, acc[ai][bj][m][1] * sc * g1); }
                    asm volatile("" ::: "memory"); }
        } else {
            const int d0 = wc * 32 + 8 * fq;
#pragma unroll
            for (int ai = 0; ai < 2; ++ai)
#pragma unroll
                for (int m = 0; m < 4; ++m) { const int rl = ai * HALF + rl0 + m * 16;
#pragma unroll
                    for (int bj = 0; bj < 2; ++bj) { bf16_t* dst = O2 + ((size_t)(u.pm * 4 + 2 * (pn - 2) + bj) * 128 + d0) * 256 + rl;
                        const u32x4 w = pack8(acc[ai][bj][m][0], acc[ai][bj][m][1]);
                        dst[0 * 256] = (bf16_t)(w.x & 0xffffu); dst[1 * 256] = (bf16_t)(w.x >> 16); dst[2 * 256] = (bf16_t)(w.y & 0xffffu); dst[3 * 256] = (bf16_t)(w.y >> 16);
                        dst[4 * 256] = (bf16_t)(w.z & 0xffffu); dst[5 * 256] = (bf16_t)(w.z >> 16); dst[6 * 256] = (bf16_t)(w.w & 0xffffu); dst[7 * 256] = (bf16_t)(w.w >> 16); }
                    asm volatile("" ::: "memory"); }
        }
    }
};

struct EpiSwiglu {
    static constexpr bool PERM = true, AFTER_DRAIN = false;
    const float* ssq; bf16_t* ACT; PG8_LAS float* X; mutable int last_pm;
    __device__ __forceinline__ static f32x4 swi(f32x4 gt, f32x4 up) { f32x4 r;
#pragma unroll
        for (int j = 0; j < 4; ++j) { const float e = __builtin_amdgcn_exp2f(-LOG2E * gt[j]); r[j] = gt[j] * __builtin_amdgcn_rcpf(1.0f + e) * up[j]; }
        return r; }
    __device__ __forceinline__ void operator()(const f32x4 (&acc)[2][2][4][2], const Unit& u, int wr, int wc, int fr, int fq) const {
        const int rl0 = wr * 64 + fr, colb = u.pn * 128 + wc * 32 + 8 * fq; PG8_LAS float* RS = X + 2048;
        if (u.pm != last_pm) { last_pm = u.pm; rstd_to_lds(ssq, u.pm * BM, RS); epi_bar(); }
#pragma unroll
        for (int ai = 0; ai < 2; ++ai)
#pragma unroll
            for (int m = 0; m < 4; ++m) { const int row = u.pm * BM + ai * HALF + rl0 + m * 16; const float rs = RS[ai * HALF + rl0 + m * 16];
                const f32x4 a0 = swi(acc[ai][0][m][0] * rs, acc[ai][1][m][0] * rs), a1 = swi(acc[ai][0][m][1] * rs, acc[ai][1][m][1] * rs);
                *(u32x4*)(ACT + (size_t)row * 2816 + colb) = pack8(a0, a1); asm volatile("" ::: "memory"); }
    }
};

struct RangeOrder {
    int nN, c0, n, c;
    __host__ __device__ bool next(int i, Unit& u) const { const int k = c - c0; if (i != 0 || k < 0 || k >= n) return false; u.pm = k / nN; u.pn = k % nN; return true; }
    __device__ __forceinline__ void a_ready(const Unit&) const {}
    __device__ __forceinline__ void done(const Unit&) const {}
};
template <class Epi, class Sched, bool ALIGN_EPI = false, bool SP2 = false>
__device__ __forceinline__ void gemm_phase(PG8_LAS unsigned char* lds, const Gemm g, const Sched& S, const Epi& E) {
    int tid_l = threadIdx.x; asm volatile("" : "+v"(tid_l));
    const int tid = tid_l, wid = __builtin_amdgcn_readfirstlane(tid >> 6), lane = tid & 63, wr = wid >> 2, wc = wid & 3, fr = lane & 15, fq = lane >> 4;
    const int K = g.K, nt = K / BK;
    unsigned voffA[2], voffB[2];
#pragma unroll
    for (int i = 0; i < 2; ++i) { int R, C; stage_rc(tid * 16 + i * 8192, R, C); const int Rb = Epi::PERM ? ((R & ~31) + perm32(R & 31)) : R;
        voffA[i] = (unsigned)(R * K + C) * 2u; voffB[i] = (unsigned)(Rb * K + C) * 2u; }
    const size_t kstep = (size_t)(BK * 2);
    const size_t hstep = (size_t)HALF * K * 2;
    const size_t tstep = 2 * hstep;
    const unsigned ldsw = (unsigned)wid * 1024u;
    const int aoff = lds_byte(wr * 64 + fr, fq * 8), boff = lds_byte(wc * 32 + fr, fq * 8);
#define PG8_SA(b, h) (((b) * 2 + (h)) * HTB)
#define PG8_SB(b, h) ((4 + (b) * 2 + (h)) * HTB)
#define PG8_STAGE(bufoff, gbase, voff) do { _Pragma("unroll") for (int _i = 0; _i < 2; ++_i) \
        __builtin_amdgcn_global_load_lds((const unsigned*)((const char*)(gbase) + (voff)[_i]), (PG8_LAS unsigned*)(lds + (bufoff) + ldsw + _i * 8192), 16, 0, 0); } while (0)
#define PG8_LDA(dst, b, h) do { _Pragma("unroll") for (int m = 0; m < 4; ++m) _Pragma("unroll") for (int k = 0; k < 2; ++k) dst[m][k] = *(const PG8_LAS bf16x8*)(lds + PG8_SA(b, h) + aoff + m * 2048 + k * 1024); } while (0)
#define PG8_LDB(dst, b, h) do { _Pragma("unroll") for (int n = 0; n < 2; ++n) _Pragma("unroll") for (int k = 0; k < 2; ++k) dst[n][k] = *(const PG8_LAS bf16x8*)(lds + PG8_SB(b, h) + boff + n * 2048 + k * 1024); } while (0)
#define PG8_MMA(ai, bj, At, Bt) do { __builtin_amdgcn_s_setprio(1); _Pragma("unroll") for (int m = 0; m < 4; ++m) _Pragma("unroll") for (int n = 0; n < 2; ++n) _Pragma("unroll") for (int k = 0; k < 2; ++k) \
        acc[ai][bj][m][n] = __builtin_amdgcn_mfma_f32_16x16x32_bf16(Bt[n][k], At[m][k], acc[ai][bj][m][n], 0, 0, 0); __builtin_amdgcn_s_setprio(0); } while (0)
#define PG8_WAIT_V(n) asm volatile("s_waitcnt vmcnt(" #n ")" ::: "memory")
#define PG8_WAIT_L(n) asm volatile("s_waitcnt lgkmcnt(" #n ")" ::: "memory")
#define PG8_BAR __builtin_amdgcn_s_barrier()
#define PG8_SCHED __builtin_amdgcn_sched_barrier(0)
    Unit cur, nxt; int ui = 0;
    if (!S.next(0, cur)) return;
    f32x4 acc[2][2][4][2];
#pragma unroll
    for (int a = 0; a < 2; ++a)
#pragma unroll
        for (int b = 0; b < 2; ++b)
#pragma unroll
            for (int m = 0; m < 4; ++m)
#pragma unroll
                for (int n = 0; n < 2; ++n) acc[a][b][m][n] = (f32x4){0.f, 0.f, 0.f, 0.f};
    bf16x8 At[4][2], B0[2][2], B1[2][2];
    const char* cA = (const char*)g.A + (size_t)cur.pm * tstep; const char* cB = (const char*)g.Bt + (size_t)cur.pn * tstep;
    S.a_ready(cur);
    if constexpr (SP2) {
        PG8_STAGE(PG8_SB(0, 0), cB, voffB); PG8_STAGE(PG8_SB(0, 1), cB + hstep, voffB); PG8_STAGE(PG8_SA(0, 0), cA, voffA); PG8_STAGE(PG8_SA(0, 1), cA + hstep, voffA);
        if (wr == 1) PG8_BAR;
        PG8_WAIT_V(2); PG8_BAR;
        PG8_STAGE(PG8_SB(1, 0), cB + kstep, voffB); PG8_STAGE(PG8_SA(1, 0), cA + kstep, voffA); PG8_STAGE(PG8_SB(1, 1), cB + hstep + kstep, voffB);
        PG8_WAIT_V(6); PG8_BAR;
    } else {
        PG8_STAGE(PG8_SB(0, 0), cB, voffB); PG8_STAGE(PG8_SA(0, 0), cA, voffA); PG8_STAGE(PG8_SB(0, 1), cB + hstep, voffB); PG8_STAGE(PG8_SA(0, 1), cA + hstep, voffA);
        if (wr == 1) PG8_BAR;
        PG8_WAIT_V(4); PG8_BAR;
        PG8_STAGE(PG8_SB(1, 0), cB + kstep, voffB); PG8_STAGE(PG8_SA(1, 0), cA + kstep, voffA); PG8_STAGE(PG8_SB(1, 1), cB + hstep + kstep, voffB);
        PG8_WAIT_V(6); PG8_BAR;
    }
    for (;;) {
        const bool has_next = S.next(ui + 1, nxt);
        const char* nA = has_next ? (const char*)g.A + (size_t)nxt.pm * tstep : cA; const char* nB = has_next ? (const char*)g.Bt + (size_t)nxt.pn * tstep : cB;
        for (int t = 0; t < nt; t += 2) {
            const bool last = (t == nt - 2);
            const char* a1 = cA + (size_t)(t + 1) * kstep;
            const char* a2 = last ? nA : cA + (size_t)(t + 2) * kstep; const char* b2 = last ? nB : cB + (size_t)(t + 2) * kstep;
            const char* a3 = a2 + kstep; const char* b3 = b2 + kstep;
            if (last && has_next) S.a_ready(nxt);
            if constexpr (SP2) {
            PG8_LDB(B0, 0, 0); PG8_LDB(B1, 0, 1); PG8_SCHED; PG8_LDA(At, 0, 0); PG8_STAGE(PG8_SA(1, 1), a1 + hstep, voffA);
            PG8_WAIT_V(8); PG8_WAIT_L(0); PG8_BAR; PG8_MMA(0, 0, At, B0); PG8_MMA(0, 1, At, B1); PG8_BAR; PG8_SCHED;
            PG8_LDA(At, 0, 1); PG8_STAGE(PG8_SB(0, 0), b2, voffB); PG8_STAGE(PG8_SB(0, 1), b2 + hstep, voffB); PG8_STAGE(PG8_SA(0, 0), a2, voffA);
            PG8_WAIT_V(8); PG8_WAIT_L(0); PG8_BAR; PG8_MMA(1, 0, At, B0); PG8_MMA(1, 1, At, B1); PG8_BAR; PG8_SCHED;
            PG8_LDB(B0, 1, 0); PG8_LDB(B1, 1, 1); PG8_SCHED; PG8_LDA(At, 1, 0); PG8_STAGE(PG8_SA(0, 1), a2 + hstep, voffA);
            PG8_WAIT_V(8); PG8_WAIT_L(0); PG8_BAR; PG8_MMA(0, 0, At, B0); PG8_MMA(0, 1, At, B1); PG8_BAR; PG8_SCHED;
            PG8_LDA(At, 1, 1); PG8_STAGE(PG8_SB(1, 0), b3, voffB); PG8_STAGE(PG8_SB(1, 1), b3 + hstep, voffB); PG8_STAGE(PG8_SA(1, 0), a3, voffA);
            PG8_WAIT_V(8); PG8_WAIT_L(0); PG8_BAR; PG8_MMA(1, 0, At, B0); PG8_MMA(1, 1, At, B1); PG8_BAR; PG8_SCHED;
            } else {
            PG8_LDB(B0, 0, 0); PG8_SCHED; PG8_LDA(At, 0, 0); PG8_STAGE(PG8_SA(1, 1), a1 + hstep, voffA);
            PG8_WAIT_L(8); PG8_BAR; PG8_WAIT_L(0); PG8_MMA(0, 0, At, B0); PG8_BAR; PG8_SCHED;
            PG8_LDB(B1, 0, 1); PG8_STAGE(PG8_SB(0, 0), b2, voffB);
            PG8_BAR; PG8_WAIT_L(0); PG8_MMA(0, 1, At, B1); PG8_BAR;
            PG8_LDA(At, 0, 1); PG8_STAGE(PG8_SA(0, 0), a2, voffA);
            PG8_BAR; PG8_WAIT_L(0); PG8_MMA(1, 0, At, B0); PG8_BAR; PG8_SCHED;
            PG8_STAGE(PG8_SB(0, 1), b2 + hstep, voffB);
            PG8_WAIT_V(6); PG8_BAR; PG8_MMA(1, 1, At, B1); PG8_BAR;
            PG8_LDB(B0, 1, 0); PG8_SCHED; PG8_LDA(At, 1, 0); PG8_STAGE(PG8_SA(0, 1), a2 + hstep, voffA);
            PG8_WAIT_L(8); PG8_BAR; PG8_WAIT_L(0); PG8_MMA(0, 0, At, B0); PG8_BAR; PG8_SCHED;
            PG8_LDB(B1, 1, 1); PG8_STAGE(PG8_SB(1, 0), b3, voffB);
            PG8_BAR; PG8_WAIT_L(0); PG8_MMA(0, 1, At, B1); PG8_BAR;
            PG8_LDA(At, 1, 1); PG8_STAGE(PG8_SA(1, 0), a3, voffA);
            PG8_BAR; PG8_WAIT_L(0); PG8_MMA(1, 0, At, B0); PG8_BAR; PG8_SCHED;
            PG8_STAGE(PG8_SB(1, 1), b3 + hstep, voffB);
            PG8_WAIT_V(6); PG8_BAR; PG8_MMA(1, 1, At, B1); PG8_BAR;
            }
        }
        if constexpr (ALIGN_EPI) { if (wr == 0) PG8_BAR; }
        if constexpr (!Epi::AFTER_DRAIN) { E(acc, cur, wr, wc, fr, fq); S.done(cur); }
        if (!has_next) break;
#pragma unroll
        for (int a = 0; a < 2; ++a)
#pragma unroll
            for (int b = 0; b < 2; ++b)
#pragma unroll
                for (int m = 0; m < 4; ++m)
#pragma unroll
                    for (int n = 0; n < 2; ++n) acc[a][b][m][n] = (f32x4){0.f, 0.f, 0.f, 0.f};
        cur = nxt; cA = nA; cB = nB; ++ui;
        if constexpr (ALIGN_EPI) { if (wr == 1) PG8_BAR; }
    }
    PG8_WAIT_V(0);
    if constexpr (!ALIGN_EPI) { if (wr == 0) PG8_BAR; }
    PG8_BAR;
    if constexpr (Epi::AFTER_DRAIN) { E.fused(acc, cur, wr, wc, fr, fq, lds, wid, lane); S.done(cur); }
#undef PG8_SA
#undef PG8_SB
#undef PG8_STAGE
#undef PG8_LDA
#undef PG8_LDB
#undef PG8_MMA
#undef PG8_WAIT_V
#undef PG8_WAIT_L
#undef PG8_BAR
#undef PG8_SCHED
}
}
#include <hip/hip_bf16.h>
#include <cmath>
namespace attn_body {
using bf16=__hip_bfloat16;
using bf16x8=__attribute__((ext_vector_type(8)))short;
using s16x4=__attribute__((ext_vector_type(4)))short;
using f32x16=__attribute__((ext_vector_type(16)))float;
using u32x4=__attribute__((ext_vector_type(4)))unsigned;
using f32x4v=__attribute__((ext_vector_type(4)))float;
typedef const __attribute__((address_space(3))) f32x4v* lds_f4p;
constexpr int BATCH=8,NHEAD=8,SEQ=8192,D=64,DM=NHEAD*D,OPITCH=1024;
constexpr int NW=8,QBLK=32,QB=QBLK*NW,KVBLK=64,NQB=SEQ/QB;
constexpr int ATTN_PITCH=DM, ATTN_UNIT_ROWS=QB;
__device__ __forceinline__ int crow(int r,int hi){return (r&3)+8*(r>>2)+4*hi;}
#define SBAR() __builtin_amdgcn_sched_barrier(0)
__device__ __forceinline__ void cmask(f32x16&p0,f32x16&p1,int jb,int qrel,int hi){
  const float NEG=-INFINITY; int kb=64*jb+4*hi;
  #pragma unroll
  for(int r=0;r<16;++r){int kv=kb+(r&3)+8*(r>>2); if(kv>qrel)p0[r]=NEG; if(kv+32>qrel)p1[r]=NEG;}
}

constexpr int NSLOT=3, SLOTB=8192;
constexpr int LDS_K=0, LDS_V=NSLOT*SLOTB, LDS_WS=2*NSLOT*SLOTB, LDS_OST=LDS_WS+NW*64*4, LDS_C2=LDS_OST+NW*4096, LDS_BYTES=LDS_C2+SEQ*4, LDS_TSL=LDS_BYTES+1024;
constexpr float C2=0.125f*1.4426950408889634f;
__device__ __forceinline__ void glds16(const void*gsrc,unsigned lds_dst){unsigned keep;
  asm volatile("s_mov_b32 %0, m0\n\ts_mov_b32 m0, %2\n\ts_nop 0\n\tglobal_load_lds_dwordx4 %1, off\n\ts_mov_b32 m0, %0":"=&s"(keep):"v"(gsrc),"s"(lds_dst):"memory");}
__device__ __forceinline__ float max3f(float a,float b,float c){float r;asm("v_max3_f32 %0, %1, %2, %3":"=v"(r):"v"(a),"v"(b),"v"(c));return r;}
__device__ __forceinline__ float max2f(float a,float b){float r;asm("v_max_f32_e32 %0, %1, %2":"=v"(r):"v"(a),"v"(b));return r;}
__device__ __forceinline__ float fadd_s(float a,float b){float r;asm("v_add_f32_e32 %0, %1, %2":"=v"(r):"v"(a),"v"(b));return r;}
__device__ __forceinline__ float fsub_s(float a,float b){float r;asm("v_sub_f32_e32 %0, %1, %2":"=v"(r):"v"(a),"v"(b));return r;}
typedef float f32x2_t __attribute__((ext_vector_type(2))); typedef __bf16 bf16x2_t __attribute__((ext_vector_type(2)));
__device__ __forceinline__ unsigned cvtpk_s(float lo,float hi){f32x2_t v={lo,hi};bf16x2_t b=__builtin_convertvector(v,bf16x2_t);return __builtin_bit_cast(unsigned,b);}
#define WAIT_BAR(N) asm volatile("s_waitcnt vmcnt(" #N ") lgkmcnt(0)\n\ts_barrier":::"memory")

__device__ __forceinline__ void qkt(f32x16&p0,f32x16&p1,const char*Kslot,const bf16x8*qr,int r32,int hi){
  const char*kb=Kslot+hi*1024+r32*16;
  #pragma unroll
  for(int d0=0;d0<4;++d0){
    const bf16x8 b0=*reinterpret_cast<const bf16x8*>(kb+d0*2048);
    const bf16x8 b1=*reinterpret_cast<const bf16x8*>(kb+d0*2048+512);
    p0=__builtin_amdgcn_mfma_f32_32x32x16_bf16(b0,qr[d0],p0,0,0,0);p1=__builtin_amdgcn_mfma_f32_32x32x16_bf16(b1,qr[d0],p1,0,0,0);}
}
typedef __attribute__((address_space(3))) const char* lds_cptr;
typedef short v4i16_t __attribute__((ext_vector_type(4)));
__device__ __forceinline__ void kload8(bf16x8*kf,lds_cptr kp){
  kf[0]=*(const __attribute__((address_space(3))) bf16x8*)(kp);      kf[1]=*(const __attribute__((address_space(3))) bf16x8*)(kp+512);
  kf[2]=*(const __attribute__((address_space(3))) bf16x8*)(kp+2048); kf[3]=*(const __attribute__((address_space(3))) bf16x8*)(kp+2560);
  kf[4]=*(const __attribute__((address_space(3))) bf16x8*)(kp+4096); kf[5]=*(const __attribute__((address_space(3))) bf16x8*)(kp+4608);
  kf[6]=*(const __attribute__((address_space(3))) bf16x8*)(kp+6144); kf[7]=*(const __attribute__((address_space(3))) bf16x8*)(kp+6656);
}
__device__ __forceinline__ void kload2(bf16x8*kf,lds_cptr kp,int j){ kf[2*j]=*(const __attribute__((address_space(3))) bf16x8*)(kp+j*2048); kf[2*j+1]=*(const __attribute__((address_space(3))) bf16x8*)(kp+j*2048+512); }
__device__ __forceinline__ s16x4 vtr(lds_cptr p){ return __builtin_bit_cast(s16x4,__builtin_amdgcn_ds_read_tr16_b64_v4i16((__attribute__((address_space(3))) v4i16_t*)p)); }
__device__ __forceinline__ float rowmax(const f32x16&p0,const f32x16&p1){
  float a=max3f(p0[0],p0[1],p1[0]),b=max3f(p0[2],p0[3],p1[1]);a=max3f(a,p1[2],p1[3]);
  #pragma unroll
  for(int r=4;r<16;r+=4){a=max3f(a,p0[r],p0[r+1]);b=max3f(b,p0[r+2],p0[r+3]);a=max3f(a,p1[r],p1[r+1]);b=max3f(b,p1[r+2],p1[r+3]);}
  const float m=max2f(a,b);
  auto rr=__builtin_amdgcn_permlane32_swap(__float_as_uint(m),__float_as_uint(m),false,false);
  return max2f(__uint_as_float(rr[0]),__uint_as_float(rr[1]));
}
__device__ __forceinline__ void pv(f32x16*o,int vb,bf16x8 pa0,bf16x8 pa1,bf16x8 pa2,bf16x8 pa3){
  #pragma unroll
  for(int d0=0;d0<2;++d0){s16x4 lo[4],hi[4];
    #pragma unroll
    for(int ks=0;ks<4;++ks){
      asm volatile("ds_read_b64_tr_b16 %0,%1 offset:%c2":"=&v"(lo[ks]):"v"(vb),"i"(d0*4096+ks*1024):"memory");
      asm volatile("ds_read_b64_tr_b16 %0,%1 offset:%c2":"=&v"(hi[ks]):"v"(vb),"i"(d0*4096+ks*1024+512):"memory");}
    asm volatile("s_waitcnt lgkmcnt(0)":::"memory");SBAR();
    #define PK(k) (bf16x8){lo[k][0],lo[k][1],lo[k][2],lo[k][3],hi[k][0],hi[k][1],hi[k][2],hi[k][3]}
    o[d0]=__builtin_amdgcn_mfma_f32_32x32x16_bf16(pa0,PK(0),o[d0],0,0,0);
    o[d0]=__builtin_amdgcn_mfma_f32_32x32x16_bf16(pa1,PK(1),o[d0],0,0,0);
    o[d0]=__builtin_amdgcn_mfma_f32_32x32x16_bf16(pa2,PK(2),o[d0],0,0,0);
    o[d0]=__builtin_amdgcn_mfma_f32_32x32x16_bf16(pa3,PK(3),o[d0],0,0,0);
    #undef PK
  }
}

#ifndef ATTN_STORE16
#define ATTN_STORE16(p,v) (*(u32x4*)(p)=(v))
#endif
template<int THRL,class SchedT> __device__ __forceinline__ void attn_unit(const SchedT&Sq,int b,int h,int qb,const bf16*Q,const bf16*__restrict__ K,const bf16*__restrict__ V,bf16*O,const float*__restrict__ NC2,int ts,char*shm){
  int tid_l=threadIdx.x; asm volatile("":"+v"(tid_l)); const int tid=tid_l,lane=tid&63,r32=lane&31,hi=lane>>5; const int wid=__builtin_amdgcn_readfirstlane(tid>>6);
  const long rowbase=(long)b*SEQ; const int q0=qb*QB;
  const bf16*Qw=Q+(rowbase+q0+wid*QBLK)*DM+h*D;
  const bf16*Kh=K+(rowbase+(long)ts*KVBLK)*DM+h*D,*Vh=V+(rowbase+(long)ts*KVBLK)*DM+h*D;
  const unsigned lds0=(unsigned)(uintptr_t)shm;
  float*wsf=(float*)(shm+LDS_WS)+wid*64;
  const bf16*ksrc=Kh+(long)lane*DM+wid*8;
  const bf16*vsrc=Vh+(long)(16*(wid&3)+(lane>>2))*DM+(wid>>2)*32+(lane&3)*8;
  const unsigned kdst=lds0+LDS_K+wid*1024, vdst=lds0+LDS_V+wid*1024;
  #define DMA_K(t,slot) glds16(ksrc+(long)(t)*KVBLK*DM,(unsigned)__builtin_amdgcn_readfirstlane(kdst+(slot)))
  #define DMA_V(t,slot) glds16(vsrc+(long)(t)*KVBLK*DM,(unsigned)__builtin_amdgcn_readfirstlane(vdst+(slot)))
  const int vb0=(int)(lds0+LDS_V)+((lane>>4)&1)*32+(lane&3)*8+(4*hi+((lane&15)>>2))*64;
  const char*Kbase=shm+LDS_K; bf16x8 kf[8];
  const lds_cptr shm3=(lds_cptr)shm; const lds_cptr c2l=shm3+LDS_C2+16*hi; const lds_cptr kp0=shm3+LDS_K+hi*1024+r32*16; const lds_cptr vp0=shm3+LDS_V+((lane>>4)&1)*32+(lane&3)*8+(4*hi+((lane&15)>>2))*64;
  const int NT=(q0+QB)/KVBLK-ts;
  DMA_K(0,0);DMA_V(0,0);DMA_K(1,SLOTB);
  bf16x8 qr[4];
  #pragma unroll
  for(int d0=0;d0<4;++d0)qr[d0]=*reinterpret_cast<const bf16x8*>(&Qw[(long)r32*DM+d0*16+hi*8]);
  { const float*cg_=NC2+(long)(b*NHEAD+h)*SEQ+ts*KVBLK; float*cl_=(float*)(shm+LDS_C2); const int nq_=q0+QB-ts*KVBLK;
    for(int i_=tid*4;i_<nq_;i_+=NW*64*4)*(f32x4v*)(cl_+i_)=*(const f32x4v*)(cg_+i_); }
  float mhat=0.f,l_reg=0.f;f32x16 o[2];o[0]=f32x16{};o[1]=f32x16{};
  const int qrel=wid*QBLK+r32;
  #define CMASK(P0,P1,t) do{int jb_=(t)-(NT-4); if(jb_>=0)cmask(P0,P1,jb_,qrel,hi);}while(0)
  bool resc=false;
  #define START(P0,P1) do{ const float rm=rowmax(P0,P1); resc=false; \
    { const float dl=rm; mhat=fadd_s(mhat,dl); \
      _Pragma("unroll") for(int r=0;r<16;++r){P0[r]=fsub_s(P0[r],dl);P1[r]=fsub_s(P1[r],dl);} \
      } \
    _Pragma("unroll") for(int r=0;r<16;++r)P0[r]=__builtin_amdgcn_exp2f(P0[r]); }while(0)
  #define RESC() do{ if(resc){ asm volatile("s_waitcnt lgkmcnt(0)":::"memory"); \
      _Pragma("unroll") for(int d_=0;d_<2;++d_) _Pragma("unroll") for(int r=0;r<16;++r)o[d_][r]*=wsf[crow(r,hi)]; } }while(0)
  f32x16 pA0,pA1,pB0,pB1;
  #define KBLD(X0,X1,tt) do{ const lds_f4p cb_=(lds_f4p)(c2l+(tt)*256); \
    _Pragma("unroll") for(int g_=0;g_<4;++g_){ const f32x4v a_=cb_[2*g_], b_=cb_[2*g_+8]; \
      X0[4*g_+0]=a_[0]-mhat; X0[4*g_+1]=a_[1]-mhat; X0[4*g_+2]=a_[2]-mhat; X0[4*g_+3]=a_[3]-mhat; \
      X1[4*g_+0]=b_[0]-mhat; X1[4*g_+1]=b_[1]-mhat; X1[4*g_+2]=b_[2]-mhat; X1[4*g_+3]=b_[3]-mhat; } }while(0)
  int sl_prev=0,sl_cur=0,sl_next=SLOTB;
  #define ROT() do{sl_prev=sl_cur;sl_cur=sl_next;sl_next=(sl_next==(NSLOT-1)*SLOTB)?0:sl_next+SLOTB;}while(0)
  DMA_K(2,2*SLOTB);
  WAIT_BAR(3);
  KBLD(pA0,pA1,0);
  qkt(pA0,pA1,Kbase,qr,r32,hi);asm volatile("s_nop 15\n\ts_nop 7":"+v"(pA0),"+v"(pA1));CMASK(pA0,pA1,0);
  START(pA0,pA1);
  KBLD(pB0,pB1,1);
  _Pragma("unroll") for(int r=0;r<16;++r)pA1[r]=__builtin_amdgcn_exp2f(pA1[r]);
  WAIT_BAR(0);
  DMA_K(3,0);DMA_V(1,SLOTB);
  ROT();
  kload8(kf,kp0+sl_cur);
  WAIT_BAR(2);
  s16x4 vlo[8],vhi[8]; u32x4 pw0,pw1,pw2,pw3;
  #define PKW(P,B) cvtpk_s(P[B],P[B+1])
  #define PAF(k) __builtin_bit_cast(bf16x8,pw##k)
  #define VFR(i) (bf16x8){vlo[i][0],vlo[i][1],vlo[i][2],vlo[i][3],vhi[i][0],vhi[i][1],vhi[i][2],vhi[i][3]}
  #define PIN(x) asm volatile("":"+v"(x))
  #define MX3(a,b,c) __builtin_fmaxf(__builtin_fmaxf((a),(b)),(c))
  #define GAPA(MF,A0,A1,A2,A3,W0,W1,PW) do{ MF; sacc+=A0; sacc+=A1; sacc+=A2; sacc+=A3; PIN(sacc); W0; W1; PIN(PW); SBAR(); }while(0)
  #define EX(v) __builtin_amdgcn_exp2f(v)
  #define GAPB(MF,X,B) do{ MF; X[B]=EX(X[B]); X[B+1]=EX(X[B+1]); X[B+2]=EX(X[B+2]); X[B+3]=EX(X[B+3]); PIN(X); SBAR(); }while(0)
  #define VRD(i) do{ vlo[i]=vtr(vp_+(((i)>>2)*4096+((i)&3)*1024)); vhi[i]=vtr(vp_+(((i)>>2)*4096+((i)&3)*1024+512)); }while(0)
  #define KBQ(X,g_,i_) do{ const f32x4v a_=cb_[i_]; X[4*(g_)+0]=a_[0]; X[4*(g_)+1]=a_[1]; X[4*(g_)+2]=a_[2]; X[4*(g_)+3]=a_[3]; }while(0)
  #define KBQ2(G,XA,ga,ia,XB,gb,ib) do{ if(G){ KBQ(XA,ga,ia); KBQ(XB,gb,ib); SBAR(); } }while(0)
  #define KRD(G,j) do{ if(G){ kload2(kf,kp0+sl_next,j); SBAR(); } }while(0)
  #define STEP(C0,C1,P0,P1,t,GK,GV,GL) do{ SBAR(); \
    const lds_cptr vp_=vp0+sl_prev; \
    VRD(0); SBAR(); float sacc=(P0[0]+P0[1]); \
    GAPA(C0=__builtin_amdgcn_mfma_f32_32x32x16_bf16(kf[0],qr[0],C0,0,0,0), P0[2],P0[3],P0[4],P0[5],     pw0[0]=PKW(P0,0), pw0[1]=PKW(P0,2), pw0); \
    VRD(4); SBAR(); GAPA(C1=__builtin_amdgcn_mfma_f32_32x32x16_bf16(kf[1],qr[0],C1,0,0,0), P0[6],P0[7],P0[8],P0[9],     pw0[2]=PKW(P0,4), pw0[3]=PKW(P0,6), pw0); \
    VRD(1); SBAR(); GAPA(C0=__builtin_amdgcn_mfma_f32_32x32x16_bf16(kf[2],qr[1],C0,0,0,0),   P0[10],P0[11],P0[12],P0[13], pw1[0]=PKW(P0,8), pw1[1]=PKW(P0,10), pw1); \
    VRD(5); SBAR(); GAPA(C1=__builtin_amdgcn_mfma_f32_32x32x16_bf16(kf[3],qr[1],C1,0,0,0),   P0[14],P0[15],P1[0],P1[1],   pw1[2]=PKW(P0,12),pw1[3]=PKW(P0,14), pw1); \
    VRD(2); SBAR(); GAPA(C0=__builtin_amdgcn_mfma_f32_32x32x16_bf16(kf[4],qr[2],C0,0,0,0),   P1[2],P1[3],P1[4],P1[5],     pw2[0]=PKW(P1,0), pw2[1]=PKW(P1,2), pw2); \
    VRD(6); SBAR(); GAPA(C1=__builtin_amdgcn_mfma_f32_32x32x16_bf16(kf[5],qr[2],C1,0,0,0),   P1[6],P1[7],P1[8],P1[9],     pw2[2]=PKW(P1,4), pw2[3]=PKW(P1,6), pw2); \
    VRD(3); SBAR(); GAPA(C0=__builtin_amdgcn_mfma_f32_32x32x16_bf16(kf[6],qr[3],C0,0,0,0),   P1[10],P1[11],P1[12],P1[13], pw3[0]=PKW(P1,8), pw3[1]=PKW(P1,10), pw3); \
    VRD(7); SBAR(); GAPA(C1=__builtin_amdgcn_mfma_f32_32x32x16_bf16(kf[7],qr[3],C1,0,0,0),   P1[14],P1[15],0.f,0.f,       pw3[2]=PKW(P1,12),pw3[3]=PKW(P1,14), pw3); \
    l_reg+=sacc; \
    if(GK){DMA_K((t)+3,sl_cur);} if(GV){DMA_V((t)+1,sl_next);} \
    CMASK(C0,C1,t); \
    { float a=MX3(C0[0],C0[1],C1[0]),b=MX3(C0[2],C0[3],C1[1]); a=MX3(a,C1[2],C1[3]); \
      _Pragma("unroll") for(int r=4;r<16;r+=4){a=MX3(a,C0[r],C0[r+1]);b=MX3(b,C0[r+2],C0[r+3]);a=MX3(a,C1[r],C1[r+1]);b=MX3(b,C1[r+2],C1[r+3]);} \
      float rm=__builtin_fmaxf(a,b); { auto rr=__builtin_amdgcn_permlane32_swap(__float_as_uint(rm),__float_as_uint(rm),false,false); rm=__builtin_fmaxf(__uint_as_float(rr[0]),__uint_as_float(rr[1])); } \
      resc=false; \
      if(__builtin_expect(__any(rm>(float)THRL),0)){ const float dl=__builtin_fmaxf(rm,0.f); mhat+=dl; \
        _Pragma("unroll") for(int r=0;r<16;++r){C0[r]-=dl;C1[r]-=dl;} \
        const float f=__builtin_amdgcn_exp2f(-dl); l_reg*=f; if(hi==0)wsf[r32]=f; resc=true; } } \
    SBAR(); \
    const lds_f4p cb_=(lds_f4p)(c2l+((t)+1)*256);     \
    KBQ2(GL,P0,0,0,P0,1,2); GAPB(o[0]=__builtin_amdgcn_mfma_f32_32x32x16_bf16(PAF(0),VFR(0),o[0],0,0,0), C0,0); \
    KBQ2(GL,P0,2,4,P0,3,6); GAPB(o[1]=__builtin_amdgcn_mfma_f32_32x32x16_bf16(PAF(0),VFR(4),o[1],0,0,0), C0,4); \
    KRD(GL,0); GAPB(o[0]=__builtin_amdgcn_mfma_f32_32x32x16_bf16(PAF(1),VFR(1),o[0],0,0,0), C0,8); \
    KRD(GL,1); GAPB(o[1]=__builtin_amdgcn_mfma_f32_32x32x16_bf16(PAF(1),VFR(5),o[1],0,0,0), C0,12); \
    KRD(GL,2); GAPB(o[0]=__builtin_amdgcn_mfma_f32_32x32x16_bf16(PAF(2),VFR(2),o[0],0,0,0), C1,0); \
    KRD(GL,3); GAPB(o[1]=__builtin_amdgcn_mfma_f32_32x32x16_bf16(PAF(2),VFR(6),o[1],0,0,0), C1,4); \
    KBQ2(GL,P1,0,8,P1,1,10); GAPB(o[0]=__builtin_amdgcn_mfma_f32_32x32x16_bf16(PAF(3),VFR(3),o[0],0,0,0), C1,8); \
    KBQ2(GL,P1,2,12,P1,3,14); GAPB(o[1]=__builtin_amdgcn_mfma_f32_32x32x16_bf16(PAF(3),VFR(7),o[1],0,0,0), C1,12); \
    if(GL){ _Pragma("unroll") for(int r=0;r<16;++r){P0[r]-=mhat;P1[r]-=mhat;} } \
    }while(0)
  int t=1;
  #undef CMASK
  #define CMASK(P0,P1,t) do{}while(0)
  for(;t+5<NT;t+=2){
    STEP(pB0,pB1,pA0,pA1,t,true,true,true);     WAIT_BAR(2); RESC(); ROT();
    STEP(pA0,pA1,pB0,pB1,t+1,true,true,true);   WAIT_BAR(2); RESC(); ROT();
  }
  #undef CMASK
  #define CMASK(P0,P1,t) do{int jb_=(t)-(NT-4); if(jb_>=0)cmask(P0,P1,jb_,qrel,hi);}while(0)
  #define ENDW(tt) do{ if((tt)+3<NT){WAIT_BAR(2);} else if((tt)+2<NT){WAIT_BAR(1);} else {WAIT_BAR(0);} }while(0)
  for(;t+1<NT;t+=2){
    STEP(pB0,pB1,pA0,pA1,t,(t+3<NT),(t+1<NT),(t+1<NT));       ENDW(t);   RESC(); ROT();
    STEP(pA0,pA1,pB0,pB1,t+1,(t+4<NT),(t+2<NT),(t+2<NT));     ENDW(t+1); RESC(); ROT();
  }
  STEP(pB0,pB1,pA0,pA1,NT-1,false,false,false); RESC();
  { float sacc=pB0[0]+pB0[1]; _Pragma("unroll") for(int r=2;r<16;++r)sacc+=pB0[r]; _Pragma("unroll") for(int r=0;r<16;++r)sacc+=pB1[r]; l_reg+=sacc;
    pw0=(u32x4){PKW(pB0,0),PKW(pB0,2),PKW(pB0,4),PKW(pB0,6)};pw1=(u32x4){PKW(pB0,8),PKW(pB0,10),PKW(pB0,12),PKW(pB0,14)};pw2=(u32x4){PKW(pB1,0),PKW(pB1,2),PKW(pB1,4),PKW(pB1,6)};pw3=(u32x4){PKW(pB1,8),PKW(pB1,10),PKW(pB1,12),PKW(pB1,14)};
    SBAR(); pv(o,vb0+sl_cur,PAF(0),PAF(1),PAF(2),PAF(3)); }
  #undef PKW
  #undef PAF
  #undef VFR
  #undef PIN
  #undef MX3
  #undef GAPA
  #undef GAPB
  #undef EX
  #undef VRD
  #undef KRD
  #undef KBQ
  #undef KBQ2
  #undef STEP
  #undef ENDW
  Sq.prefetch();
  {auto rr=__builtin_amdgcn_permlane32_swap(__float_as_uint(l_reg),__float_as_uint(l_reg),false,false);l_reg=__uint_as_float(rr[0])+__uint_as_float(rr[1]);}
  if(hi==0)wsf[32+r32]=l_reg;asm volatile("s_waitcnt lgkmcnt(0)":::"memory");
  float rli[16];
  #pragma unroll
  for(int r=0;r<16;++r)rli[r]=__builtin_amdgcn_rcpf(wsf[32+crow(r,hi)]);
  bf16*Ow=O+(rowbase+q0+wid*QBLK)*OPITCH+h*D;
  { bf16*stg=(bf16*)(shm+LDS_OST)+wid*2048;
    #pragma unroll
    for(int r=0;r<16;++r){const int orow=crow(r,hi);
      #pragma unroll
      for(int d0=0;d0<2;++d0)stg[orow*64+d0*32+r32]=__float2bfloat16(o[d0][r]*rli[r]);}
    asm volatile("s_waitcnt lgkmcnt(0)":::"memory");
    #pragma unroll
    for(int i=0;i<4;++i){const int row=i*8+(lane>>3),ch=lane&7; const u32x4 v=*(const u32x4*)(stg+row*64+ch*8); ATTN_STORE16(Ow+(long)row*OPITCH+ch*8,v);} }
  asm volatile("s_waitcnt lgkmcnt(0)\n\ts_barrier":::"memory");
  #undef DMA_K
  #undef DMA_V
  #undef CMASK
  #undef START
  #undef RESC
  #undef ROT
  #undef KBLD
}
constexpr int ATTN_LDS_BYTES=LDS_BYTES;
struct AttnTensors { const bf16* Q; const bf16* K; const bf16* V; bf16* O; const float* NC2; const int* TS; };
struct AttnUnit { int bh; int qb; };
struct QueueOrder {
  unsigned* cnt; volatile __attribute__((address_space(3))) unsigned* slot; mutable unsigned pend;
  __device__ __forceinline__ void prefetch()const{ if(threadIdx.x==0)pend=__hip_atomic_fetch_add(cnt,1u,__ATOMIC_RELAXED,__HIP_MEMORY_SCOPE_AGENT); }
  __device__ __forceinline__ bool next(int i,AttnUnit&u)const{
    if(i==0)prefetch();
    if(threadIdx.x==0)*slot=pend;
    __syncthreads(); const unsigned n=*slot; if(n>=(unsigned)(BATCH*NHEAD*NQB))return false; u.qb=NQB-1-(int)(n>>6); u.bh=(int)(n&63u); return true; }
  __device__ __forceinline__ void a_ready(const AttnUnit&)const{}
  __device__ __forceinline__ void done(const AttnUnit&)const{}
};
struct StaticOrder {
  int vcu;
  __device__ __forceinline__ explicit StaticOrder(int grid,int block):vcu((block%8)*(grid/8)+block/8){}
  __device__ __forceinline__ bool next(int i,AttnUnit&u)const{ if(i>=8)return false; const int s=vcu&3; u.bh=vcu>>2; u.qb=8*(i>>1)+((i&1)?7-s:s); return true; }
  __device__ __forceinline__ void a_ready(const AttnUnit&)const{}
  __device__ __forceinline__ void done(const AttnUnit&)const{}
  __device__ __forceinline__ void prefetch()const{}
};
template<class Sched,int THRL=8> __device__ __forceinline__ void attn_phase(char*lds,const AttnTensors&T,const Sched&S){
  AttnUnit u;
  for(int i=0;S.next(i,u);++i){ S.a_ready(u); attn_unit<THRL,Sched>(S,u.bh/NHEAD,u.bh%NHEAD,u.qb,T.Q,T.K,T.V,T.O,T.NC2,__builtin_amdgcn_readfirstlane(((const __attribute__((address_space(3))) int*)(lds_cptr)lds)[(LDS_TSL>>2)+u.bh*NQB+u.qb]),lds); S.done(u); }
}
#undef SBAR
#undef WAIT_BAR
}
namespace xat {
#define XLAS __attribute__((address_space(3)))
typedef unsigned short bf16_t;
typedef short bf16x8 __attribute__((ext_vector_type(8)));
typedef float f32x16 __attribute__((ext_vector_type(16)));
typedef unsigned u32x4 __attribute__((ext_vector_type(4)));
typedef unsigned u32x2 __attribute__((ext_vector_type(2)));
constexpr int KROW = 272, VROW = 520, LDS_K = 0, LDS_V = 256 * KROW, LDS_END = LDS_V + 128 * VROW;
__device__ __forceinline__ unsigned cvtpk(float lo, float hi) { unsigned r; asm volatile("v_cvt_pk_bf16_f32 %0, %1, %2" : "=v"(r) : "v"(lo), "v"(hi)); return r; }
__device__ __forceinline__ void load_kv(const bf16_t* MKbh, const bf16_t* MVtbh, XLAS unsigned char* lds, int tid) {
    for (int i = tid; i < 4096; i += 512) { const int row = i >> 4, ch = i & 15; const u32x4 v = *(const u32x4*)(MKbh + row * 128 + ch * 8); *(XLAS u32x4*)(lds + LDS_K + row * KROW + ch * 16) = v; }
    for (int i = tid; i < 4096; i += 512) { const int row = i >> 5, ch = i & 31; const u32x4 v = *(const u32x4*)(MVtbh + row * 256 + ch * 8);
        XLAS u32x2* p = (XLAS u32x2*)(lds + LDS_V + row * VROW + ch * 16); p[0] = (u32x2){v.x, v.y}; p[1] = (u32x2){v.z, v.w}; }
}
__device__ __forceinline__ void unit(const bf16_t* MQ, bf16_t* MO, int b, int h, int qblk, XLAS unsigned char* lds) {
    int tid = threadIdx.x; asm volatile("" : "+v"(tid)); const int lane = tid & 63, r32 = lane & 31, hi = lane >> 5, wid = tid >> 6;
    const size_t row = (size_t)b * 8192 + qblk * 256 + wid * 32 + r32;
    const bf16_t* qp = MQ + row * 512 + h * 128 + hi * 8;
    bf16x8 qr[8];
#pragma unroll
    for (int d0 = 0; d0 < 8; ++d0) qr[d0] = *(const bf16x8*)(qp + d0 * 16);
    f32x16 S[8];
#pragma unroll
    for (int kb = 0; kb < 8; ++kb) { S[kb] = f32x16{};
#pragma unroll
        for (int d0 = 0; d0 < 8; ++d0) { const bf16x8 kf = *(const XLAS bf16x8*)(lds + LDS_K + (32 * kb + r32) * KROW + d0 * 32 + hi * 16);
            S[kb] = __builtin_amdgcn_mfma_f32_32x32x16_bf16(kf, qr[d0], S[kb], 0, 0, 0); }
        __builtin_amdgcn_sched_barrier(0); }
    float m = S[0][0];
#pragma unroll
    for (int kb = 0; kb < 8; ++kb)
#pragma unroll
        for (int r = 0; r < 16; ++r) m = fmaxf(m, S[kb][r]);
    m = fmaxf(m, __shfl_xor(m, 32));
    float l = 0.f;
#pragma unroll
    for (int kb = 0; kb < 8; ++kb)
#pragma unroll
        for (int r = 0; r < 16; ++r) { const float p = __builtin_amdgcn_exp2f(S[kb][r] - m); S[kb][r] = p; l += p; }
    l += __shfl_xor(l, 32);
    u32x4 pw[8][2];
#pragma unroll
    for (int kb = 0; kb < 8; ++kb)
#pragma unroll
        for (int sp = 0; sp < 2; ++sp) { pw[kb][sp].x = cvtpk(S[kb][8 * sp + 0], S[kb][8 * sp + 1]); pw[kb][sp].y = cvtpk(S[kb][8 * sp + 2], S[kb][8 * sp + 3]); pw[kb][sp].z = cvtpk(S[kb][8 * sp + 4], S[kb][8 * sp + 5]); pw[kb][sp].w = cvtpk(S[kb][8 * sp + 6], S[kb][8 * sp + 7]); }
    __builtin_amdgcn_sched_barrier(0);
    f32x16 o[4];
#pragma unroll
    for (int db = 0; db < 4; ++db) o[db] = f32x16{};
#pragma unroll
    for (int kb = 0; kb < 8; ++kb)
#pragma unroll
        for (int sp = 0; sp < 2; ++sp) {
            const bf16x8 pk = __builtin_bit_cast(bf16x8, pw[kb][sp]);
#pragma unroll
            for (int db = 0; db < 4; ++db) { const XLAS unsigned char* vb = lds + LDS_V + (32 * db + r32) * VROW + (32 * kb + 16 * sp + 4 * hi) * 2;
                const u32x2 lo = *(const XLAS u32x2*)vb, hh = *(const XLAS u32x2*)(vb + 16);
                const u32x4 vw = (u32x4){lo.x, lo.y, hh.x, hh.y};
                o[db] = __builtin_amdgcn_mfma_f32_32x32x16_bf16(__builtin_bit_cast(bf16x8, vw), pk, o[db], 0, 0, 0); }
            __builtin_amdgcn_sched_barrier(0); }
    const float inv = 1.0f / l;
    bf16_t* op = MO + row * 512 + h * 128 + 4 * hi;
#pragma unroll
    for (int db = 0; db < 4; ++db)
#pragma unroll
        for (int g = 0; g < 4; ++g) { u32x2 w; w.x = cvtpk(o[db][4 * g + 0] * inv, o[db][4 * g + 1] * inv); w.y = cvtpk(o[db][4 * g + 2] * inv, o[db][4 * g + 3] * inv);
            *(u32x2*)(op + 32 * db + 8 * g) = w; }
}
}

namespace cg = cooperative_groups;
#define LAS __attribute__((address_space(3)))
typedef unsigned short bf16;
typedef unsigned v4u __attribute__((ext_vector_type(4)));
typedef unsigned v2u __attribute__((ext_vector_type(2)));
typedef float f32x4 __attribute__((ext_vector_type(4)));
constexpr int NWAVES = 8;
constexpr int DM = 1024, BATCH = 8, SEQ = 8192, MTOK = BATCH * SEQ, DEPTH = 2, NIN = 2056, NINP = 2304, DFF = 2816, MEMLEN = 256;
constexpr float EPS = 1e-6f;
constexpr size_t MiB = 1u << 20;
constexpr size_t WS_W = 1 * MiB, WS_WSTRIDE = 28 * MiB;
constexpr size_t WO_IN = 0, WO_OUT = 5 * MiB, WO_MQ = 7 * MiB, WO_MKV = 8 * MiB, WO_MO = 10 * MiB, WO_GU = 11 * MiB, WO_D = 22 * MiB;
constexpr size_t WS_BAR = 65536, WS_BAR_BYTES = 16384;
constexpr int XBST_OFF = 141312;
constexpr size_t WS_QCNT = 0, WS_TS = 4096;
constexpr size_t WS_LF = 58 * MiB, WS_NC2 = 60 * MiB, WS_SSQ = 62 * MiB, WS_MN = 66 * MiB, WS_MK = 74 * MiB, WS_MVT = 78 * MiB;
constexpr size_t WS_HB = 96 * MiB, WS_Q = 224 * MiB, WS_K = 288 * MiB, WS_V = 352 * MiB, WS_P = 416 * MiB, WS_CAT = 480 * MiB, WS_MQ = 608 * MiB, WS_MO = 672 * MiB, WS_FP = 736 * MiB, WS_END = 768 * MiB;
constexpr size_t WS_ACT = 224 * MiB;
static_assert(WS_ACT + (size_t)MTOK * DFF * 2 <= WS_MQ, "ACT overlay");
constexpr int RING_BYTES = 131072, EPIX_OFF = 132096, LDS_BYTES = 147456;

__device__ __forceinline__ unsigned f2bf(float f) { unsigned u = __builtin_bit_cast(unsigned, f); return (u + 0x7fffu + ((u >> 16) & 1u)) >> 16; }
__device__ __forceinline__ unsigned pk2(float lo, float hi) { return f2bf(lo) | (f2bf(hi) << 16); }
__device__ __forceinline__ float wave_sum(float v) {
#pragma unroll
    for (int o = 1; o < 64; o <<= 1) v += __shfl_xor(v, o);
    return v;
}
__device__ __forceinline__ void tr_item(const float* W, int N, int k0, int n0, const float* g, bf16* WT, int Kdst, int drow0, LAS float* scr, int lane) {
    const int nq = (lane & 15) * 4; const bool ok = (n0 + nq) < N;
    f32x4 v[16];
#pragma unroll
    for (int i = 0; i < 16; ++i) { const int kk = 4 * i + (lane >> 4); v[i] = ok ? *(const f32x4*)(W + (size_t)(k0 + kk) * N + n0 + nq) : (f32x4){0.f, 0.f, 0.f, 0.f}; if (g) v[i] = v[i] * g[k0 + kk]; }
#pragma unroll
    for (int i = 0; i < 16; ++i) { const int kk = 4 * i + (lane >> 4); LAS float* d = scr + kk * 65 + nq; d[0] = v[i].x; d[1] = v[i].y; d[2] = v[i].z; d[3] = v[i].w; }
    asm volatile("s_waitcnt lgkmcnt(0)" ::: "memory");
    const int c = lane & 7;
#pragma unroll
    for (int j = 0; j < 8; ++j) { const int n = (lane >> 3) + 8 * j; const LAS float* s = scr + (8 * c) * 65 + n;
        v4u o; o.x = pk2(s[0 * 65], s[1 * 65]); o.y = pk2(s[2 * 65], s[3 * 65]); o.z = pk2(s[4 * 65], s[5 * 65]); o.w = pk2(s[6 * 65], s[7 * 65]);
        *(v4u*)(WT + (size_t)(drow0 + n) * Kdst + k0 + 8 * c) = o; }
    asm volatile("s_waitcnt lgkmcnt(0)" ::: "memory");
}

#ifndef PHMASK
#define PHMASK 0x3ff
#endif
#define XB_TMO      128
#define XB_XCNT(j)  (256  + 64 * (j))
#define XB_XSUB(j)  (1280 + 64 * (j))
#define XB_XGEN(j)  (2304 + 64 * (j))
#define XB_TOP      3328
#define XB_TOPGEN   3392
#define XCD_BAR_WORDS 3456
#define XB_SPIN_CAP (1u << 18)

__device__ __forceinline__ unsigned xb_ld(unsigned* p)              { return __hip_atomic_load(p, __ATOMIC_RELAXED, __HIP_MEMORY_SCOPE_AGENT); }
__device__ __forceinline__ unsigned xb_add(unsigned* p, unsigned v) { return __hip_atomic_fetch_add(p, v, __ATOMIC_RELAXED, __HIP_MEMORY_SCOPE_AGENT); }
__device__ __forceinline__ unsigned xb_xcc_id() { return (unsigned)__builtin_amdgcn_s_getreg((3 << 11) | 20) & 0xFu; }
#define XB_SPIN(cond, bar) do { unsigned _sp = 0; while (cond) { __builtin_amdgcn_s_sleep(1); \
    if ((++_sp & 255u) == 0u) { if (xb_ld(&(bar)[XB_TMO])) break; if (_sp > XB_SPIN_CAP) { atomicAdd(&(bar)[XB_TMO], 1u); break; } } } } while (0)

struct XcdBarrier {
    unsigned* bar; unsigned x;
    volatile LAS unsigned* st;
};

__device__ __forceinline__ XcdBarrier xcd_barrier_post(unsigned* bar, volatile LAS unsigned* st) {
    XcdBarrier b; b.bar = bar; b.x = xb_xcc_id(); b.st = st;
    if (threadIdx.x == 0) (void)xb_add(&bar[XB_XCNT(b.x)], 1u);
    return b;
}
__device__ __forceinline__ void xcd_barrier_complete(unsigned* bar, unsigned x, unsigned& nloc, unsigned& nx) {
    const unsigned G = gridDim.x * gridDim.y * gridDim.z;
    unsigned sum, cnt, mine, sp = 0u;
    for (;;) {
        sum = 0u; cnt = 0u; mine = 0u;
#pragma unroll
        for (unsigned j = 0; j < 16; ++j) { const unsigned c = xb_ld(&bar[XB_XCNT(j)]); sum += c; cnt += (c > 0u) ? 1u : 0u; mine = (j == x) ? c : mine; }
        if (sum == G) break;
        __builtin_amdgcn_s_sleep(1);
        if ((++sp & 255u) == 0u) { if (xb_ld(&bar[XB_TMO])) break; if (sp > XB_SPIN_CAP) { atomicAdd(&bar[XB_TMO], 1u); break; } }
    }
    nloc = mine > 0u ? mine : 1u; nx = cnt > 0u ? cnt : 1u;
}

__device__ __forceinline__ void xcd_barrier(const XcdBarrier& b) {
    asm volatile("s_waitcnt vmcnt(0)" ::: "memory");
    __syncthreads();
    if (threadIdx.x == 0) {
        unsigned* bar = b.bar;
        __builtin_amdgcn_s_waitcnt(0);
        unsigned nloc = b.st[0], nx = b.st[1];
        if (nloc == 0u) { xcd_barrier_complete(bar, b.x, nloc, nx); b.st[0] = nloc; b.st[1] = nx; }
        const unsigned old = xb_add(&bar[XB_XSUB(b.x)], 1u);
        const unsigned gen = old / nloc;
        if (old + 1u == (gen + 1u) * nloc) {
            __builtin_amdgcn_fence(__ATOMIC_RELEASE, "agent");
            asm volatile("s_waitcnt vmcnt(0)" ::: "memory");
            const unsigned og = xb_add(&bar[XB_TOP], 1u);
            const unsigned tg = og / nx;
            if (og + 1u == (tg + 1u) * nx) xb_add(&bar[XB_TOPGEN], 1u);
            else XB_SPIN(xb_ld(&bar[XB_TOPGEN]) == tg, bar);
            __builtin_amdgcn_fence(__ATOMIC_ACQUIRE, "agent");
            xb_add(&bar[XB_XGEN(b.x)], 1u);
            asm volatile("s_waitcnt vmcnt(0)" ::: "memory");
        } else {
            XB_SPIN(xb_ld(&bar[XB_XGEN(b.x)]) == gen, bar);
            __builtin_amdgcn_fence(__ATOMIC_ACQUIRE, "agent");
            asm volatile("s_waitcnt vmcnt(0)" ::: "memory");
        }
    }
    __syncthreads();
}

#define GAS1 __attribute__((address_space(1)))
__device__ __forceinline__ unsigned long long karg(int k) {
    const __attribute__((address_space(4))) unsigned long long* ka = (const __attribute__((address_space(4))) unsigned long long*)__builtin_amdgcn_kernarg_segment_ptr();
    asm volatile("" : "+s"(ka)); return ka[k];
}
#define MIX_UNPACK(u, f) do { f[0] = __uint_as_float(u.x << 16); f[1] = __uint_as_float(u.x & 0xffff0000u); f[2] = __uint_as_float(u.y << 16); f[3] = __uint_as_float(u.y & 0xffff0000u); \
    f[4] = __uint_as_float(u.z << 16); f[5] = __uint_as_float(u.z & 0xffff0000u); f[6] = __uint_as_float(u.w << 16); f[7] = __uint_as_float(u.w & 0xffff0000u); } while (0)
template <int W> __device__ __forceinline__ void mix_rows16(const bf16* Pb, bf16* CAT, int r0, int colgrp) {
    const int t0 = r0 & (SEQ - 1);
    const bf16* pp = Pb + (size_t)r0 * 512 + colgrp * 8; bf16* op = CAT + (size_t)r0 * DM + 512 + colgrp * 8;
    v4u rw[W - 1 + 16];
#pragma unroll
    for (int k = 0; k < W - 1 + 16; ++k) { const int rel = k - (W - 1); rw[k] = *(const v4u*)(pp + (ptrdiff_t)((t0 + rel >= 0) ? rel : 0) * 512); }
    float sum[8];
#pragma unroll
    for (int j = 0; j < 8; ++j) sum[j] = 0.f;
#pragma unroll
    for (int k = 0; k < W - 1; ++k) { const float m = (t0 + k - (W - 1) >= 0) ? 1.0f : 0.0f; float f[8]; MIX_UNPACK(rw[k], f);
#pragma unroll
        for (int j = 0; j < 8; ++j) sum[j] += m * f[j]; }
#pragma unroll
    for (int i = 0; i < 16; ++i) { float cur[8]; asm volatile("" : "+v"(rw[W - 1 + i]));
        MIX_UNPACK(rw[W - 1 + i], cur);
        const int t = t0 + i; const float rc = 1.0f / (float)((t + 1 < W) ? t + 1 : W); float o[8];
#pragma unroll
        for (int j = 0; j < 8; ++j) { sum[j] += cur[j]; o[j] = sum[j] * rc - cur[j]; }
        *(v4u*)(op + (size_t)i * DM) = (v4u){pk2(o[0], o[1]), pk2(o[2], o[3]), pk2(o[4], o[5]), pk2(o[6], o[7])};
        { const float m = (t + 1 - W >= 0) ? 1.0f : 0.0f; float f[8]; asm volatile("" : "+v"(rw[i])); MIX_UNPACK(rw[i], f);
#pragma unroll
            for (int j = 0; j < 8; ++j) sum[j] -= m * f[j]; } }
}

#ifdef USE_CG_SYNC
#define GSYNC() grid.sync()
#else
#define GSYNC() xcd_barrier(xbar)
#endif
#ifdef TIMING
#ifndef MASKA
#define MASKA 0
#endif
#ifndef MASKB
#define MASKB 0
#endif
#define TSTAMP(id) do { const unsigned long long t_ = __builtin_amdgcn_s_memrealtime(); const unsigned long long d_ = t_ - t_prev; t_prev = t_; if ((MASKA >> (id)) & 1) accA += d_; if ((MASKB >> (id)) & 1) accB += d_; } while (0)
#else
#define TSTAMP(id) do {} while (0)
#endif
struct Args { const float* in[20]; float* out; unsigned char* ws; };

__global__ void __launch_bounds__(NWAVES * 64, 2) fwd_megakernel(Args args) {
    extern __shared__ __attribute__((aligned(16))) unsigned char lds[];
    cg::grid_group grid = cg::this_grid();
    LAS unsigned char* const L = (LAS unsigned char*)lds;
    const int wave = __builtin_amdgcn_readfirstlane((int)threadIdx.x >> 6);
    const int G = gridDim.x, bx = blockIdx.x;
    const int vcu = (G % 8 == 0) ? (bx % 8) * (G / 8) + bx / 8 : bx;
    LAS float* const EX = (LAS float*)(L + EPIX_OFF);
    if (threadIdx.x < 2) ((LAS unsigned*)(L + XBST_OFF))[threadIdx.x] = 0u;
    __syncthreads();
    const XcdBarrier xbar = xcd_barrier_post((unsigned*)((unsigned char*)(GAS1 unsigned char*)karg(21) + WS_BAR), (volatile LAS unsigned*)(L + XBST_OFF));
#define DEFPTRS \
    int tid = threadIdx.x; asm volatile("" : "+v"(tid)); const int lane = tid & 63; (void)lane; \
    unsigned char* const ws = (unsigned char*)(GAS1 unsigned char*)karg(21); float* const out = (float*)(GAS1 float*)karg(20); (void)out; \
    bf16* const HB = (bf16*)(ws + WS_HB); bf16* const Qb = (bf16*)(ws + WS_Q); bf16* const Kb = (bf16*)(ws + WS_K); bf16* const Vb = (bf16*)(ws + WS_V); bf16* const Pb = (bf16*)(ws + WS_P); \
    bf16* const CAT = (bf16*)(ws + WS_CAT); bf16* const MQ = (bf16*)(ws + WS_MQ); bf16* const MO = (bf16*)(ws + WS_MO); bf16* const ACT = (bf16*)(ws + WS_ACT); \
    float* const LF = (float*)(ws + WS_LF); float* const NC2 = (float*)(ws + WS_NC2); float* const SSQ = (float*)(ws + WS_SSQ); \
    bf16* const MN = (bf16*)(ws + WS_MN); bf16* const MK = (bf16*)(ws + WS_MK); bf16* const MVT = (bf16*)(ws + WS_MVT); \
    (void)HB; (void)Qb; (void)Kb; (void)Vb; (void)Pb; (void)CAT; (void)MQ; (void)MO; (void)ACT; (void)LF; (void)NC2; (void)SSQ; (void)MN; (void)MK; (void)MVT;
#define IN(k) ((const float*)(GAS1 const float*)karg(k))

#ifdef TIMING
    unsigned long long t_prev = __builtin_amdgcn_s_memrealtime(), accA = 0, accB = 0;
#endif
    if constexpr ((PHMASK >> 0) & 1) { DEFPTRS
        LAS float* scr = (LAS float*)(L + wave * 16640);
        const int gw = vcu * NWAVES + wave, NGW = G * NWAVES;
        constexpr int I_IN = 16 * 36, I_OUT = 8 * 16, I_MQ = 16 * 8, I_MKV = 16 * 16, I_MO = 8 * 16, I_GU = 16 * 88, I_D = 44 * 16, I_L = I_IN + I_OUT + I_MQ + I_MKV + I_MO + I_GU + I_D;
        for (int it = gw; it < DEPTH * I_L; it += NGW) {
            const int l = it / I_L; int r = it % I_L; unsigned char* wl = ws + WS_W + (size_t)l * WS_WSTRIDE;
            if (r < I_IN) { const int kb = r / 36, nb = r % 36; tr_item(IN(3) + (size_t)l * DM * NIN, NIN, 64 * kb, 64 * nb, IN(2) + l * DM, (bf16*)(wl + WO_IN), DM, 64 * nb, scr, lane); continue; } r -= I_IN;
            if (r < I_OUT) { const int kb = r / 16, nb = r % 16; tr_item(IN(9) + (size_t)l * DM * DM, DM, 64 * kb, 64 * nb, nullptr, (bf16*)(wl + WO_OUT), DM, 64 * nb, scr, lane); continue; } r -= I_OUT;
            if (r < I_MQ) { const int kb = r / 8, nb = r % 8; tr_item(IN(12) + (size_t)l * DM * 512, 512, 64 * kb, 64 * nb, IN(10) + l * DM, (bf16*)(wl + WO_MQ), DM, 64 * nb, scr, lane); continue; } r -= I_MQ;
            if (r < I_MKV) { const int kb = r / 16, nb = r % 16; tr_item(IN(13) + (size_t)l * DM * 1024, 1024, 64 * kb, 64 * nb, nullptr, (bf16*)(wl + WO_MKV), DM, 64 * nb, scr, lane); continue; } r -= I_MKV;
            if (r < I_MO) { const int kb = r / 16, nb = r % 16; tr_item(IN(16) + (size_t)l * 512 * DM, DM, 64 * kb, 64 * nb, nullptr, (bf16*)(wl + WO_MO), 512, 64 * nb, scr, lane); continue; } r -= I_MO;
            if (r < I_GU) { const int kb = r / 88, nb = r % 88; const int n0 = 64 * nb; const int drow = (n0 < DFF) ? (n0 / 128) * 256 + (n0 % 128) : ((n0 - DFF) / 128) * 256 + 128 + ((n0 - DFF) % 128);
                tr_item(IN(18) + (size_t)l * DM * 2 * DFF, 2 * DFF, 64 * kb, n0, IN(17) + l * DM, (bf16*)(wl + WO_GU), DM, drow, scr, lane); continue; } r -= I_GU;
            { const int kb = r / 16, nb = r % 16; tr_item(IN(19) + (size_t)l * DFF * DM, DM, 64 * kb, 64 * nb, nullptr, (bf16*)(wl + WO_D), DFF, 64 * nb, scr, lane); }
        }
        if (bx == 0 && tid < DEPTH) ((unsigned*)(ws + WS_QCNT))[tid * 64] = 0u;
        for (int tw = __builtin_amdgcn_readfirstlane(bx * 8 + wave); tw < DEPTH * 64 * 16; tw += G * 8) {
            const int l = tw / 1024, rem = tw % 1024, kc8 = rem >> 4, n = (rem & 15) * 64 + lane, g = kc8 >> 4, c0 = (kc8 & 15) * 8;
            const float* wp = IN(7) + ((size_t)(l * 4 + g) * 128 + c0) * 128; const float* ps = IN(8) + l * 512 + g * 128; const float* wo = IN(9) + (size_t)l * DM * DM + (size_t)(512 + g * 128) * DM + n;
            float a[8];
#pragma unroll
            for (int j = 0; j < 8; ++j) a[j] = 0.f;
#pragma unroll 32
            for (int d = 0; d < 128; ++d) { const float wv = wo[(size_t)d * DM] * ps[d];
#pragma unroll
                for (int j = 0; j < 8; ++j) a[j] += wp[j * 128 + d] * wv; }
            *(v4u*)((bf16*)(ws + WS_W + (size_t)l * WS_WSTRIDE + WO_OUT) + (size_t)n * DM + 512 + g * 128 + c0) = (v4u){pk2(a[0], a[1]), pk2(a[2], a[3]), pk2(a[4], a[5]), pk2(a[6], a[7])};
        }
        {
            f32x4 wf[4][4][2];
#pragma unroll
            for (int j = 0; j < 4; ++j)
#pragma unroll
                for (int c = 0; c < 4; ++c) { const int k = 256 * j + 4 * lane + c; const float gk = IN(2)[k]; const float* wr = IN(3) + (size_t)k * NIN + 2048;
                    wf[j][c][0] = *(const f32x4*)wr * gk; wf[j][c][1] = *(const f32x4*)(wr + 4) * gk; }
            const float bfo = IN(4)[lane & 7];
        for (int m0 = gw * 4; m0 < MTOK; m0 += NGW * 4) {
            f32x4 v[4][4]; float sq[4];
#pragma unroll
            for (int r = 0; r < 4; ++r) { const f32x4* xr = (const f32x4*)(IN(0) + (size_t)(m0 + r) * DM) + lane;
#pragma unroll
                for (int j = 0; j < 4; ++j) v[r][j] = xr[64 * j]; }
#pragma unroll
            for (int r = 0; r < 4; ++r) { float s = 0.f;
#pragma unroll
                for (int j = 0; j < 4; ++j) s += (v[r][j].x * v[r][j].x + v[r][j].y * v[r][j].y) + (v[r][j].z * v[r][j].z + v[r][j].w * v[r][j].w);
                sq[r] = wave_sum(s); }
#pragma unroll
            for (int r = 0; r < 4; ++r) { v2u* o8 = (v2u*)(HB + (size_t)(m0 + r) * DM) + lane;
#pragma unroll
                for (int j = 0; j < 4; ++j) o8[64 * j] = (v2u){pk2(v[r][j].x, v[r][j].y), pk2(v[r][j].z, v[r][j].w)};
                if (lane < 16) SSQ[(size_t)(m0 + r) * 16 + lane] = (lane == 0) ? sq[r] : 0.f;
                f32x4 d0 = (f32x4){0.f, 0.f, 0.f, 0.f}, d1 = d0;
#pragma unroll
                for (int j = 0; j < 4; ++j) { d0 += wf[j][0][0] * v[r][j].x + wf[j][1][0] * v[r][j].y + wf[j][2][0] * v[r][j].z + wf[j][3][0] * v[r][j].w;
                                              d1 += wf[j][0][1] * v[r][j].x + wf[j][1][1] * v[r][j].y + wf[j][2][1] * v[r][j].z + wf[j][3][1] * v[r][j].w; }
                float f8[8] = {d0.x, d0.y, d0.z, d0.w, d1.x, d1.y, d1.z, d1.w};
#pragma unroll
                for (int o = 0; o < 8; ++o) f8[o] = wave_sum(f8[o]);
                float mine = f8[0];
#pragma unroll
                for (int o = 1; o < 8; ++o) mine = ((lane & 7) == o) ? f8[o] : mine;
                const float rstd = __builtin_amdgcn_rsqf(sq[r] * (1.0f / DM) + EPS);
                if (lane < 8) LF[(size_t)(m0 + r) * 8 + lane] = pg8::log2sigmoid(mine * rstd + bfo); }
        }
        }
        for (int m = gw; m < DEPTH * BATCH * MEMLEN; m += NGW) {
            const int l = m / (BATCH * MEMLEN), rr = m % (BATCH * MEMLEN);
            const f32x4* xr = (const f32x4*)(IN(1) + (size_t)rr * DM) + lane; const f32x4* gr = (const f32x4*)(IN(11) + l * DM) + lane; f32x4 v[4]; float s = 0.f;
#pragma unroll
            for (int j = 0; j < 4; ++j) { v[j] = xr[64 * j]; s += (v[j].x * v[j].x + v[j].y * v[j].y) + (v[j].z * v[j].z + v[j].w * v[j].w); }
            const float rstd = 1.0f / sqrtf(wave_sum(s) * (1.0f / DM) + EPS);
            v2u* o8 = (v2u*)(MN + (size_t)m * DM) + lane;
#pragma unroll
            for (int j = 0; j < 4; ++j) { const f32x4 gg = gr[64 * j]; o8[64 * j] = (v2u){pk2(v[j].x * rstd * gg.x, v[j].y * rstd * gg.y), pk2(v[j].z * rstd * gg.z, v[j].w * rstd * gg.w)}; }
        }
    }
    grid.sync();
    TSTAMP(0);

    for (int l = 0; l < DEPTH; ++l) {
        if constexpr ((PHMASK >> 1) & 1) { DEFPTRS
            const int nin = 2048;
            if (l > 0) {
                const float* FPb = (const float*)(ws + WS_FP); const float* bfp = IN(4) + l * 8;
                for (int row = bx * 512 + tid; row < MTOK; row += G * 512) {
                    const f32x4* p = (const f32x4*)(FPb + (size_t)row * 128); f32x4 a0 = p[0], a1 = p[1];
#pragma unroll
                    for (int si = 1; si < 16; ++si) { a0 += p[2 * si]; a1 += p[2 * si + 1]; }
                    const float rs = pg8::rstd_row(SSQ, row); const f32x4 b0 = *(const f32x4*)bfp, b1 = *(const f32x4*)(bfp + 4);
                    const f32x4 z0 = a0 * rs + b0, z1 = a1 * rs + b1;
                    *(f32x4*)(LF + (size_t)row * 8) = (f32x4){pg8::log2sigmoid(z0[0]), pg8::log2sigmoid(z0[1]), pg8::log2sigmoid(z0[2]), pg8::log2sigmoid(z0[3])};
                    *(f32x4*)(LF + (size_t)row * 8 + 4) = (f32x4){pg8::log2sigmoid(z1[0]), pg8::log2sigmoid(z1[1]), pg8::log2sigmoid(z1[2]), pg8::log2sigmoid(z1[3])};
                }
            }
            pg8::Gemm g{HB, (const bf16*)(ws + WS_W + (size_t)l * WS_WSTRIDE + WO_IN), MTOK, nin, DM}; pg8::StaticOrder S; S.init(MTOK, nin, G, bx);
            pg8::EpiInProj E{SSQ, Qb, Kb, Vb, Pb, LF, IN(5) + l * 64, IN(6) + l * 64, IN(4) + l * 8, EX, 0.125f * pg8::LOG2E, -1};
            pg8::gemm_phase<pg8::EpiInProj, pg8::StaticOrder, true, true>(L, g, S, E);
#ifdef EXP_DUP_G1
            pg8::gemm_phase<pg8::EpiInProj, pg8::StaticOrder, true, true>(L, g, S, E);
#endif
        }
        GSYNC(); TSTAMP(1);
        if constexpr ((PHMASK >> 2) & 1) { DEFPTRS
            if (bx < 64) {
                const int b = bx >> 3, h = bx & 7; const float* src = LF + ((size_t)b * SEQ + tid * 16) * 8 + h; float v[16]; float s = 0.f;
#pragma unroll
                for (int j = 0; j < 16; ++j) { s += src[j * 8]; v[j] = s; }
                LAS float* sc = (LAS float*)L; sc[tid] = s; __syncthreads();
                for (int off = 1; off < 512; off <<= 1) { const float t = (tid >= off) ? sc[tid - off] : 0.f; __syncthreads(); sc[tid] += t; __syncthreads(); }
                const float excl = sc[tid] - s; float* dst = NC2 + (size_t)bx * SEQ + tid * 16; LAS float* ncl = (LAS float*)(L + 4096) + tid * 16;
#pragma unroll
                for (int j = 0; j < 16; j += 4) { const f32x4 nv = (f32x4){-(excl + v[j]), -(excl + v[j + 1]), -(excl + v[j + 2]), -(excl + v[j + 3])}; *(f32x4*)(dst + j) = nv; *(LAS f32x4*)(ncl + j) = nv; }
                __syncthreads();
                if (tid < 32) {
                    float gq = 0.f, gk = 0.f; const float* gqp = IN(5) + l * 64; const float* gkp = IN(6) + l * 64;
                    for (int d = 0; d < 64; ++d) { gq = fmaxf(gq, fabsf(gqp[d])); gk = fmaxf(gk, fabsf(gkp[d])); }
                    const float thresh = 2.0f * (64.0f * gq * gk * 0.125f * pg8::LOG2E) + 20.0f;
                    const LAS float* nc = (const LAS float*)(L + 4096); const float ref = nc[256 * tid]; int t = 0, hi = 4 * tid;
                    while (t < hi) { const int mid = (t + hi) >> 1; if (ref - nc[64 * mid + 63] > thresh) t = mid + 1; else hi = mid; }
                    ((int*)(ws + WS_TS))[bx * 32 + tid] = t & ~1;
                }
                __syncthreads();
            } else if (l == 0 && bx < 128) {
                const int l2 = (bx - 64) >> 5;
                pg8::Gemm g{MN + (size_t)l2 * BATCH * MEMLEN * DM, (const bf16*)(ws + WS_W + (size_t)l2 * WS_WSTRIDE + WO_MKV), BATCH * MEMLEN, 1024, DM};
                pg8::RangeOrder S{4, 64 + 32 * l2, 32, bx};
                pg8::EpiHead128<1> E{nullptr, MK + (size_t)l2 * BATCH * 4 * MEMLEN * 128, MVT + (size_t)l2 * BATCH * 4 * MEMLEN * 128, IN(15) + l2 * 128, EX, 1.0f};
                pg8::gemm_phase<pg8::EpiHead128<1>, pg8::RangeOrder, true, true>(L, g, S, E);
            }
            const bool kvcu = (l == 0 && bx >= 64 && bx < 128);
            const int nmix = (l == 0) ? G - 64 : G, mixid = (l == 0 && bx >= 128) ? bx - 64 : bx;
            if (!kvcu) for (int T = mixid * 512 + tid; T < (MTOK / 16) * 64; T += nmix * 512) {
                const int wv = T >> 6, g = __builtin_amdgcn_readfirstlane(wv & 3), r0 = ((wv >> 2) * 4 + (lane >> 4)) * 16, colgrp = g * 16 + (lane & 15);
                if (g == 0) mix_rows16<2>(Pb, CAT, r0, colgrp); else if (g == 1) mix_rows16<4>(Pb, CAT, r0, colgrp); else if (g == 2) mix_rows16<8>(Pb, CAT, r0, colgrp); else mix_rows16<16>(Pb, CAT, r0, colgrp);
            }
        }
        GSYNC(); TSTAMP(2);
        if constexpr ((PHMASK >> 3) & 1) { DEFPTRS
            const attn_body::AttnTensors AT{(const attn_body::bf16*)Qb, (const attn_body::bf16*)Kb, (const attn_body::bf16*)Vb, (attn_body::bf16*)CAT, NC2, (const int*)(ws + WS_TS)};
            { const int* tsg = (const int*)(ws + WS_TS); LAS int* tsl = (LAS int*)(L + attn_body::LDS_TSL); for (int i = tid; i < 2048; i += 512) tsl[i] = tsg[i]; }
            const attn_body::QueueOrder S{(unsigned*)(ws + WS_QCNT) + l * 64, (volatile LAS unsigned*)(L + attn_body::ATTN_LDS_BYTES), 0u};
            attn_body::attn_phase<attn_body::QueueOrder, 20>((char*)lds, AT, S);
        }
        GSYNC(); TSTAMP(3);
        if constexpr ((PHMASK >> 4) & 1) { DEFPTRS
            pg8::Gemm g{CAT, (const bf16*)(ws + WS_W + (size_t)l * WS_WSTRIDE + WO_OUT), MTOK, DM, DM}; pg8::StaticOrder S; S.init(MTOK, DM, G, bx);
            pg8::EpiResid E{nullptr, nullptr, HB, SSQ, nullptr, nullptr};
            pg8::gemm_phase<pg8::EpiResid, pg8::StaticOrder, false, true>(L, g, S, E);
        }
        GSYNC(); TSTAMP(4);
        if constexpr ((PHMASK >> 5) & 1) { DEFPTRS
            pg8::Gemm g{HB, (const bf16*)(ws + WS_W + (size_t)l * WS_WSTRIDE + WO_MQ), MTOK, 512, DM}; pg8::StaticOrder S; S.init(MTOK, 512, G, bx);
            pg8::EpiHead128<0> E{SSQ, MQ, nullptr, IN(14) + l * 128, EX, 0.08838834764831845f * pg8::LOG2E};
            pg8::gemm_phase<pg8::EpiHead128<0>, pg8::StaticOrder, true, true>(L, g, S, E);
#ifdef EXP_DUP_G3
            pg8::gemm_phase<pg8::EpiHead128<0>, pg8::StaticOrder, true, true>(L, g, S, E);
#endif
        }
        GSYNC(); TSTAMP(5);
        if constexpr ((PHMASK >> 6) & 1) { DEFPTRS
            const int bh = vcu >> 3, b = bh >> 2, h = bh & 3;
            if (bh < BATCH * 4) {
                xat::load_kv(MK + ((size_t)l * BATCH * 4 + bh) * MEMLEN * 128, MVT + ((size_t)l * BATCH * 4 + bh) * MEMLEN * 128, L, tid);
                __syncthreads();
                for (int i = 0; i < 4; ++i) xat::unit(MQ, MO, b, h, (vcu & 7) * 4 + i, L);
                __syncthreads();
            }
        }
        GSYNC(); TSTAMP(6);
        if constexpr ((PHMASK >> 7) & 1) { DEFPTRS
            pg8::Gemm g{MO, (const bf16*)(ws + WS_W + (size_t)l * WS_WSTRIDE + WO_MO), MTOK, DM, 512}; pg8::StaticOrder S; S.init(MTOK, DM, G, bx);
            pg8::EpiResid E{nullptr, nullptr, HB, SSQ, nullptr, nullptr};
            pg8::gemm_phase<pg8::EpiResid, pg8::StaticOrder, false, true>(L, g, S, E);
        }
        GSYNC(); TSTAMP(7);
        if constexpr ((PHMASK >> 8) & 1) { DEFPTRS
            pg8::Gemm g{HB, (const bf16*)(ws + WS_W + (size_t)l * WS_WSTRIDE + WO_GU), MTOK, 2 * DFF, DM}; pg8::StaticOrder S; S.init(MTOK, 2 * DFF, G, bx);
            pg8::EpiSwiglu E{SSQ, ACT, EX, -1};
            pg8::gemm_phase<pg8::EpiSwiglu, pg8::StaticOrder, true, true>(L, g, S, E);
        }
        GSYNC(); TSTAMP(8);
        if constexpr ((PHMASK >> 9) & 1) { DEFPTRS
            pg8::Gemm g{ACT, (const bf16*)(ws + WS_W + (size_t)l * WS_WSTRIDE + WO_D), MTOK, DM, DFF}; pg8::StaticOrder S; S.init(MTOK, DM, G, bx);
            pg8::EpiResid E{nullptr, (l == DEPTH - 1) ? out : nullptr, HB, SSQ, (l + 1 < DEPTH) ? (const bf16*)(ws + WS_W + (size_t)(l + 1) * WS_WSTRIDE + WO_IN) + (size_t)2048 * DM : nullptr, (float*)(ws + WS_FP)};
            pg8::gemm_phase<pg8::EpiResid, pg8::StaticOrder, false, true>(L, g, S, E);
        }
#ifdef TIMING
        GSYNC(); TSTAMP(9);
#else
        if (l + 1 < DEPTH) GSYNC();
#endif
    }
#ifdef TIMING
    {
        DEFPTRS
#ifdef TIMING_CAL
        const unsigned long long n = 1000000ull;
#else
        const unsigned long long n = (accA / 400ull) + 1000ull * (accB / 400ull);
#endif
        if (bx == 0) for (unsigned long long i = tid; i < n; i += 512) out[i] += 0.125f;
    }
#endif
}

extern "C" void kernel_launch(void* const* d_in, const int* in_sizes, int n_in, void* d_out, int out_size, void* d_ws, size_t ws_size, hipStream_t stream) {
    static int grid = 0;
    if (grid == 0) {
        if (n_in != 20 || out_size != MTOK * DM || ws_size < WS_END) { fprintf(stderr, "kernel_launch: unexpected shapes (n_in %d, out %d, ws %zu)\n", n_in, out_size, ws_size); grid = -1; return; }
        int dev = 0, cus = 0, per_cu = 0;
        if (hipGetDevice(&dev) != hipSuccess || hipDeviceGetAttribute(&cus, hipDeviceAttributeMultiprocessorCount, dev) != hipSuccess) { grid = -1; return; }
        if (hipFuncSetAttribute((const void*)fwd_megakernel, hipFuncAttributeMaxDynamicSharedMemorySize, LDS_BYTES) != hipSuccess) { fprintf(stderr, "kernel_launch: hipFuncSetAttribute failed\n"); grid = -1; return; }
        if (hipOccupancyMaxActiveBlocksPerMultiprocessor(&per_cu, (const void*)fwd_megakernel, NWAVES * 64, LDS_BYTES) != hipSuccess || per_cu < 1) { fprintf(stderr, "kernel_launch: occupancy query says %d\n", per_cu); per_cu = 1; }
        (void)hipGetLastError();
        grid = cus * 1;
        if (grid != 256) fprintf(stderr, "kernel_launch: %d CUs; the unit orders assume 256\n", grid);
    }
    if (grid < 0) return;
    if (hipMemsetAsync((char*)d_ws + WS_BAR, 0, WS_BAR_BYTES, stream) != hipSuccess) { fprintf(stderr, "kernel_launch: hipMemsetAsync failed\n"); return; }
    Args a{};
    for (int i = 0; i < 20; ++i) a.in[i] = (const float*)d_in[i];
    a.out = (float*)d_out; a.ws = (unsigned char*)d_ws;
    void* kargs[] = {&a};
    hipError_t e = hipLaunchCooperativeKernel((const void*)fwd_megakernel, dim3(grid), dim3(NWAVES * 64), kargs, LDS_BYTES, stream);
    if (e != hipSuccess) fprintf(stderr, "kernel_launch: cooperative launch failed: %s (grid %d)\n", hipGetErrorString(e), grid);
}
```

```cpp
#include <hip/hip_runtime.h>
#include <hip/hip_cooperative_groups.h>
#include <cstdio>
#include <cstdint>
#include <cstddef>
namespace pg8 {
#define PG8_LAS __attribute__((address_space(3)))
typedef unsigned short bf16_t;
typedef short bf16x8 __attribute__((ext_vector_type(8)));
typedef float f32x4 __attribute__((ext_vector_type(4)));
typedef unsigned u32x4 __attribute__((ext_vector_type(4)));
constexpr int BM = 256, BK = 64, HALF = 128, HTB = HALF * BK * 2  , STAGE_BYTES = 8 * HTB, NXCD = 8, WGM = 8;

__host__ __device__ __forceinline__ int lds_byte(int r, int c) { const int st = (r >> 4) * 2 + (c >> 5), rr = r & 15, cc = c & 31, ob = rr * 64 + cc * 2; return st * 1024 + (ob ^ (((ob >> 9) & 1) << 5)); }
__host__ __device__ __forceinline__ void stage_rc(int b, int& R, int& C) { const int st = b / 1024, sb = b % 1024, swz = sb ^ (((sb >> 9) & 1) << 5); R = (st >> 1) * 16 + swz / 64; C = (st & 1) * 32 + (swz % 64) / 2; }
__host__ __device__ __forceinline__ int perm32(int rho) { const int n = rho >> 4, i = rho & 15; return 8 * (i >> 2) + 4 * n + (i & 3); }

struct Unit { int pm, pn; };
struct Gemm { const bf16_t* A; const bf16_t* Bt; int M, N, K; };

struct StaticOrder {
    int nM, nN, nwg, G, c;
    __host__ __device__ void init(int M, int N, int G_, int c_) { nM = M / BM; nN = N / BM; nwg = nM * nN; G = G_; c = c_; }
    __host__ __device__ bool next(int i, Unit& u) const {
        const long L = (long)i * G + c; if (L >= nwg) return false;
        int wgid = (int)L; { const int q = nwg / NXCD, r = nwg % NXCD, xcd = wgid % NXCD, off = wgid / NXCD; wgid = (xcd < r ? xcd * (q + 1) : r * (q + 1) + (xcd - r) * q) + off; }
        const int nig = WGM * nN, gid = wgid / nig, fm = gid * WGM, gsz = (nM - fm) < WGM ? (nM - fm) : WGM;
        u.pm = fm + ((wgid % nig) % gsz); u.pn = (wgid % nig) / gsz; return true;
    }
    __device__ __forceinline__ void a_ready(const Unit&) const {}
    __device__ __forceinline__ void done(const Unit&) const {}
};

__device__ __forceinline__ unsigned cvt_pk_bf16(float lo, float hi) { unsigned r; asm volatile("v_cvt_pk_bf16_f32 %0, %1, %2" : "=v"(r) : "v"(lo), "v"(hi)); return r; }
typedef unsigned u32x2 __attribute__((ext_vector_type(2)));
constexpr float RMS_EPS = 1e-6f;
constexpr float LOG2E = 1.4426950408889634f;
__device__ __forceinline__ void epi_bar() { asm volatile("s_waitcnt lgkmcnt(0)\n\ts_barrier" ::: "memory"); }
__device__ __forceinline__ float sum4(f32x4 a) { return (a[0] + a[1]) + (a[2] + a[3]); }
__device__ __forceinline__ float sumsq4(f32x4 v) { return (v[0] * v[0] + v[1] * v[1]) + (v[2] * v[2] + v[3] * v[3]); }
__device__ __forceinline__ float rstd_row(const float* ssq, int row) {
    const f32x4* p = (const f32x4*)(ssq + (size_t)row * 16);
    const f32x4 a = p[0], b = p[1], c = p[2], d = p[3];
    return __builtin_amdgcn_rsqf(((sum4(a) + sum4(b)) + (sum4(c) + sum4(d))) * (1.0f / 1024.0f) + RMS_EPS);
}
__device__ __forceinline__ void rstd_to_lds(const float* ssq, int row0, PG8_LAS float* RS) {
    const int t = threadIdx.x; if (t < 256) RS[t] = rstd_row(ssq, row0 + t);
}
__device__ __forceinline__ u32x4 pack8(f32x4 a, f32x4 b) { u32x4 w; w.x = cvt_pk_bf16(a[0], a[1]); w.y = cvt_pk_bf16(a[2], a[3]); w.z = cvt_pk_bf16(b[0], b[1]); w.w = cvt_pk_bf16(b[2], b[3]); return w; }
__device__ __forceinline__ float log2sigmoid(float x) { return LOG2E * (fminf(x, 0.f) - log1pf(expf(-fabsf(x)))); }

struct EpiResid {
    static constexpr bool PERM = true, AFTER_DRAIN = false;
    const float* basef; float* outf; bf16_t* hb; float* ssq; const bf16_t* fw; float* fp;
    __device__ __forceinline__ void tail(const f32x4& o0, const f32x4& o1, size_t off, float& s) const {
        if (outf) { __builtin_nontemporal_store(o0, (f32x4*)(outf + off)); __builtin_nontemporal_store(o1, (f32x4*)(outf + off + 4)); }
        else { *(u32x4*)(hb + off) = pack8(o0, o1); s += sumsq4(o0) + sumsq4(o1); }
    }
    __device__ __forceinline__ void operator()(const f32x4 (&acc)[2][2][4][2], const Unit& u, int wr, int wc, int fr, int fq) const {
        const int col0 = u.pn * BM + wc * 32 + 8 * fq, row0 = u.pm * BM + wr * 64 + fr; const size_t off0 = (size_t)row0 * 1024 + col0;
        if (basef) {
#pragma unroll
            for (int ai = 0; ai < 2; ++ai) {
                f32x4 bf[4][2][2];
#pragma unroll
                for (int m = 0; m < 4; ++m)
#pragma unroll
                    for (int bj = 0; bj < 2; ++bj) { const float* p = basef + off0 + (size_t)(ai * HALF + m * 16) * 1024 + bj * HALF; bf[m][bj][0] = *(const f32x4*)p; bf[m][bj][1] = *(const f32x4*)(p + 4); }
                asm volatile("" ::: "memory");
#pragma unroll
                for (int m = 0; m < 4; ++m) { const size_t off = off0 + (size_t)(ai * HALF + m * 16) * 1024; float s = 0.f;
#pragma unroll
                    for (int bj = 0; bj < 2; ++bj) tail(bf[m][bj][0] + acc[ai][bj][m][0], bf[m][bj][1] + acc[ai][bj][m][1], off + bj * HALF, s);
                    if (!outf) { s += __shfl_xor(s, 16); s += __shfl_xor(s, 32); if (fq == 0) ssq[(size_t)(row0 + ai * HALF + m * 16) * 16 + u.pn * 4 + wc] = s; } }
                asm volatile("" ::: "memory");
            }
        } else {
            u32x4 bw[2][4][2]; bf16x8 wfr[2];
            if (fw) { wfr[0] = *(const bf16x8*)(fw + (size_t)fr * 1024 + col0); wfr[1] = *(const bf16x8*)(fw + (size_t)fr * 1024 + col0 + HALF); }
#pragma unroll
            for (int ai = 0; ai < 2; ++ai)
#pragma unroll
                for (int m = 0; m < 4; ++m)
#pragma unroll
                    for (int bj = 0; bj < 2; ++bj) bw[ai][m][bj] = *(const u32x4*)(hb + off0 + (size_t)(ai * HALF + m * 16) * 1024 + bj * HALF);
            asm volatile("" ::: "memory");
#pragma unroll
            for (int ai = 0; ai < 2; ++ai)
#pragma unroll
                for (int m = 0; m < 4; ++m) { const size_t off = off0 + (size_t)(ai * HALF + m * 16) * 1024; float s = 0.f; f32x4 fd = (f32x4){0.f, 0.f, 0.f, 0.f};
#pragma unroll
                    for (int bj = 0; bj < 2; ++bj) { const u32x4 w = bw[ai][m][bj];
                        const f32x4 b0 = (f32x4){__uint_as_float(w.x << 16), __uint_as_float(w.x & 0xffff0000u), __uint_as_float(w.y << 16), __uint_as_float(w.y & 0xffff0000u)};
                        const f32x4 b1 = (f32x4){__uint_as_float(w.z << 16), __uint_as_float(w.z & 0xffff0000u), __uint_as_float(w.w << 16), __uint_as_float(w.w & 0xffff0000u)};
                        const f32x4 o0 = b0 + acc[ai][bj][m][0], o1 = b1 + acc[ai][bj][m][1];
                        tail(o0, o1, off + bj * HALF, s);
                        if (fw) fd = __builtin_amdgcn_mfma_f32_16x16x32_bf16(wfr[bj], __builtin_bit_cast(bf16x8, pack8(o0, o1)), fd, 0, 0, 0); }
                    if (!outf) { s += __shfl_xor(s, 16); s += __shfl_xor(s, 32); if (fq == 0) ssq[(size_t)(row0 + ai * HALF + m * 16) * 16 + u.pn * 4 + wc] = s; }
                    if (fw && fq < 2) *(f32x4*)(fp + ((size_t)(row0 + ai * HALF + m * 16) * 16 + u.pn * 4 + wc) * 8 + 4 * fq) = fd;
                    asm volatile("" ::: "memory"); }
        }
    }
};

struct EpiInProj {
    static constexpr bool PERM = true, AFTER_DRAIN = false;
    const float* ssq; bf16_t *Q, *K, *V, *P; float* LF; const float *gq, *gk, *bfg; PG8_LAS float* X; float qscale; mutable int last_pm;
    __device__ __forceinline__ void operator()(const f32x4 (&acc)[2][2][4][2], const Unit& u, int wr, int wc, int fr, int fq) const {
        const int pn = u.pn, rl0 = wr * 64 + fr; PG8_LAS float* RS = X + 2048;
        const bool newpm = (u.pm != last_pm); last_pm = u.pm;
        if (newpm) rstd_to_lds(ssq, u.pm * BM, RS);
        if (pn < 4) {
#pragma unroll
            for (int ai = 0; ai < 2; ++ai)
#pragma unroll
                for (int m = 0; m < 4; ++m)
#pragma unroll
                    for (int bj = 0; bj < 2; ++bj) { float s = sumsq4(acc[ai][bj][m][0]) + sumsq4(acc[ai][bj][m][1]);
                        s += __shfl_xor(s, 16); s += __shfl_xor(s, 32);
                        if (fq == 0) X[(ai * HALF + rl0 + m * 16) * 8 + bj * 4 + wc] = s; }
        }
        if (newpm || pn < 4) epi_bar();
        if (pn < 4) {
            const float* g = (pn < 2) ? gq : gk; const float extra = (pn < 2) ? qscale : 1.0f; bf16_t* O = (pn < 2) ? Q : K;
            const int dcol = (wc & 1) * 32 + 8 * fq; const f32x4 g0 = *(const f32x4*)(g + dcol) * extra, g1 = *(const f32x4*)(g + dcol + 4) * extra;
            const int colb = (pn & 1) * 256 + wc * 32 + 8 * fq;
#pragma unroll
            for (int ai = 0; ai < 2; ++ai)
#pragma unroll
                for (int m = 0; m < 4; ++m) { const int rl = ai * HALF + rl0 + m * 16; bf16_t* rowp = O + (size_t)(u.pm * BM + rl) * 512 + colb; const float rsv = RS[rl];
#pragma unroll
                    for (int bj = 0; bj < 2; ++bj) { const float hs = X[rl * 8 + bj * 4 + (wc & 2)] + X[rl * 8 + bj * 4 + (wc & 2) + 1];
                        const float sc = rsv * __builtin_amdgcn_rsqf(hs * rsv * rsv * (1.0f / 64.0f) + RMS_EPS);
                        *(u32x4*)(rowp + bj * HALF) = pack8(acc[ai][bj][m][0] * sc * g0, acc[ai][bj][m][1] * sc * g1); }
                    asm volatile("" ::: "memory"); }
        } else if (pn < 8) {
            bf16_t* O = (pn < 6) ? V : P; const int colb = (pn & 1) * 256 + wc * 32 + 8 * fq;
#pragma unroll
            for (int ai = 0; ai < 2; ++ai)
#pragma unroll
                for (int m = 0; m < 4; ++m) { bf16_t* rowp = O + (size_t)(u.pm * BM + ai * HALF + rl0 + m * 16) * 512 + colb; const float rsv = RS[ai * HALF + rl0 + m * 16];
#pragma unroll
                    for (int bj = 0; bj < 2; ++bj) *(u32x4*)(rowp + bj * HALF) = pack8(acc[ai][bj][m][0] * rsv, acc[ai][bj][m][1] * rsv);
                    asm volatile("" ::: "memory"); }
        } else {
            if (wc == 0 && fq == 0) {
                const f32x4 b0 = *(const f32x4*)(bfg), b1 = *(const f32x4*)(bfg + 4);
#pragma unroll
                for (int ai = 0; ai < 2; ++ai)
#pragma unroll
                    for (int m = 0; m < 4; ++m) { float* lp = LF + (size_t)(u.pm * BM + ai * HALF + rl0 + m * 16) * 8; const float rsv = RS[ai * HALF + rl0 + m * 16];
                        const f32x4 z0 = acc[ai][0][m][0] * rsv + b0, z1 = acc[ai][0][m][1] * rsv + b1;
                        *(f32x4*)(lp) = (f32x4){log2sigmoid(z0[0]), log2sigmoid(z0[1]), log2sigmoid(z0[2]), log2sigmoid(z0[3])};
                        *(f32x4*)(lp + 4) = (f32x4){log2sigmoid(z1[0]), log2sigmoid(z1[1]), log2sigmoid(z1[2]), log2sigmoid(z1[3])}; }
            }
        }
    }
};

template <int MODE> struct EpiHead128 {
    static constexpr bool PERM = true, AFTER_DRAIN = false;
    const float* ssq; bf16_t* O; bf16_t* O2; const float* g; PG8_LAS float* X; float oscale;
    __device__ __forceinline__ void operator()(const f32x4 (&acc)[2][2][4][2], const Unit& u, int wr, int wc, int fr, int fq) const {
        const int pn = u.pn, rl0 = wr * 64 + fr; PG8_LAS float* RS = X + 2048;
        if (MODE == 0) rstd_to_lds(ssq, u.pm * BM, RS);
        if (MODE == 0 || pn < 2) {
#pragma unroll
            for (int ai = 0; ai < 2; ++ai)
#pragma unroll
                for (int m = 0; m < 4; ++m)
#pragma unroll
                    for (int bj = 0; bj < 2; ++bj) { float s = sumsq4(acc[ai][bj][m][0]) + sumsq4(acc[ai][bj][m][1]);
                        s += __shfl_xor(s, 16); s += __shfl_xor(s, 32);
                        if (fq == 0) X[(ai * HALF + rl0 + m * 16) * 8 + bj * 4 + wc] = s; }
            epi_bar();
            const int d0 = wc * 32 + 8 * fq; const f32x4 g0 = *(const f32x4*)(g + d0) * oscale, g1 = *(const f32x4*)(g + d0 + 4) * oscale;
#pragma unroll
            for (int ai = 0; ai < 2; ++ai)
#pragma unroll
                for (int m = 0; m < 4; ++m) { const int rl = ai * HALF + rl0 + m * 16; const float rsv = (MODE == 0) ? RS[rl] : 1.0f;
#pragma unroll
                    for (int bj = 0; bj < 2; ++bj) { const f32x4 xs = *(const PG8_LAS f32x4*)(X + rl * 8 + bj * 4);
                        const float sc = rsv * __builtin_amdgcn_rsqf(sum4(xs) * rsv * rsv * (1.0f / 128.0f) + RMS_EPS);
                        bf16_t* dst = (MODE == 0) ? O + (size_t)(u.pm * BM + rl) * 512 + pn * 256 + bj * HALF + d0
                                                  : O + ((size_t)(u.pm * 4 + 2 * pn + bj) * 256 + rl) * 128 + d0;
                        *(u32x4*)dst = pack8(acc[ai][bj][m][0] * sc * g0, acc[ai][bj][m][1] * sc * g1); }
                    asm volatile("" ::: "memory"); }
        } else {
            const int d0 = wc * 32 + 8 * fq;
#pragma unroll
            for (int ai = 0; ai < 2; ++ai)
#pragma unroll
                for (int m = 0; m < 4; ++m) { const int rl = ai * HALF + rl0 + m * 16;
#pragma unroll
                    for (int bj = 0; bj < 2; ++bj) { bf16_t* dst = O2 + ((size_t)(u.pm * 4 + 2 * (pn - 2) + bj) * 128 + d0) * 256 + rl;
                        const u32x4 w = pack8(acc[ai][bj][m][0], acc[ai][bj][m][1]);
                        dst[0 * 256] = (bf16_t)(w.x & 0xffffu); dst[1 * 256] = (bf16_t)(w.x >> 16); dst[2 * 256] = (bf16_t)(w.y & 0xffffu); dst[3 * 256] = (bf16_t)(w.y >> 16);
                        dst[4 * 256] = (bf16_t)(w.z & 0xffffu); dst[5 * 256] = (bf16_t)(w.z >> 16); dst[6 * 256] = (bf16_t)(w.w & 0xffffu); dst[7 * 256] = (bf16_t)(w.w >> 16); }
                    asm volatile("" ::: "memory"); }
        }
    }
};

struct EpiSwiglu {
    static constexpr bool PERM = true, AFTER_DRAIN = false;
    const float* ssq; bf16_t* ACT; PG8_LAS float* X; mutable int last_pm;
    __device__ __forceinline__ static f32x4 swi(f32x4 gt, f32x4 up) { f32x4 r;
#pragma unroll
        for (int j = 0; j < 4; ++j) { const float e = __builtin_amdgcn_exp2f(-LOG2E * gt[j]); r[j] = gt[j] * __builtin_amdgcn_rcpf(1.0f + e) * up[j]; }
        return r; }
    __device__ __forceinline__ void operator()(const f32x4 (&acc)[2][2][4][2], const Unit& u, int wr, int wc, int fr, int fq) const {
        const int rl0 = wr * 64 + fr, colb = u.pn * 128 + wc * 32 + 8 * fq; PG8_LAS float* RS = X + 2048;
        if (u.pm != last_pm) { last_pm = u.pm; rstd_to_lds(ssq, u.pm * BM, RS); epi_bar(); }
#pragma unroll
        for (int ai = 0; ai < 2; ++ai)
#pragma unroll
            for (int m = 0; m < 4; ++m) { const int row = u.pm * BM + ai * HALF + rl0 + m * 16; const float rs = RS[ai * HALF + rl0 + m * 16];
                const f32x4 a0 = swi(acc[ai][0][m][0] * rs, acc[ai][1][m][0] * rs), a1 = swi(acc[ai][0][m][1] * rs, acc[ai][1][m][1] * rs);
                *(u32x4*)(ACT + (size_t)row * 2816 + colb) = pack8(a0, a1); asm volatile("" ::: "memory"); }
    }
};

struct RangeOrder {
    int nN, c0, n, c;
    __host__ __device__ bool next(int i, Unit& u) const { const int k = c - c0; if (i != 0 || k < 0 || k >= n) return false; u.pm = k / nN; u.pn = k % nN; return true; }
    __device__ __forceinline__ void a_ready(const Unit&) const {}
    __device__ __forceinline__ void done(const Unit&) const {}
};
template <class Epi, class Sched, bool ALIGN_EPI = false, bool SP2 = false>
__device__ __forceinline__ void gemm_phase(PG8_LAS unsigned char* lds, const Gemm g, const Sched& S, const Epi& E) {
    int tid_l = threadIdx.x; asm volatile("" : "+v"(tid_l));
    const int tid = tid_l, wid = __builtin_amdgcn_readfirstlane(tid >> 6), lane = tid & 63, wr = wid >> 2, wc = wid & 3, fr = lane & 15, fq = lane >> 4;
    const int K = g.K, nt = K / BK;
    unsigned voffA[2], voffB[2];
#pragma unroll
    for (int i = 0; i < 2; ++i) { int R, C; stage_rc(tid * 16 + i * 8192, R, C); const int Rb = Epi::PERM ? ((R & ~31) + perm32(R & 31)) : R;
        voffA[i] = (unsigned)(R * K + C) * 2u; voffB[i] = (unsigned)(Rb * K + C) * 2u; }
    const size_t kstep = (size_t)(BK * 2);
    const size_t hstep = (size_t)HALF * K * 2;
    const size_t tstep = 2 * hstep;
    const unsigned ldsw = (unsigned)wid * 1024u;
    const int aoff = lds_byte(wr * 64 + fr, fq * 8), boff = lds_byte(wc * 32 + fr, fq * 8);
#define PG8_SA(b, h) (((b) * 2 + (h)) * HTB)
#define PG8_SB(b, h) ((4 + (b) * 2 + (h)) * HTB)
#define PG8_STAGE(bufoff, gbase, voff) do { _Pragma("unroll") for (int _i = 0; _i < 2; ++_i) \
        __builtin_amdgcn_global_load_lds((const unsigned*)((const char*)(gbase) + (voff)[_i]), (PG8_LAS unsigned*)(lds + (bufoff) + ldsw + _i * 8192), 16, 0, 0); } while (0)
#define PG8_LDA(dst, b, h) do { _Pragma("unroll") for (int m = 0; m < 4; ++m) _Pragma("unroll") for (int k = 0; k < 2; ++k) dst[m][k] = *(const PG8_LAS bf16x8*)(lds + PG8_SA(b, h) + aoff + m * 2048 + k * 1024); } while (0)
#define PG8_LDB(dst, b, h) do { _Pragma("unroll") for (int n = 0; n < 2; ++n) _Pragma("unroll") for (int k = 0; k < 2; ++k) dst[n][k] = *(const PG8_LAS bf16x8*)(lds + PG8_SB(b, h) + boff + n * 2048 + k * 1024); } while (0)
#define PG8_MMA(ai, bj, At, Bt) do { __builtin_amdgcn_s_setprio(1); _Pragma("unroll") for (int m = 0; m < 4; ++m) _Pragma("unroll") for (int n = 0; n < 2; ++n) _Pragma("unroll") for (int k = 0; k < 2; ++k) \
        acc[ai][bj][m][n] = __builtin_amdgcn_mfma_f32_16x16x32_bf16(Bt[n][k], At[m][k], acc[ai][bj][m][n], 0, 0, 0); __builtin_amdgcn_s_setprio(0); } while (0)
#define PG8_WAIT_V(n) asm volatile("s_waitcnt vmcnt(" #n ")" ::: "memory")
#define PG8_WAIT_L(n) asm volatile("s_waitcnt lgkmcnt(" #n ")" ::: "memory")
#define PG8_BAR __builtin_amdgcn_s_barrier()
#define PG8_SCHED __builtin_amdgcn_sched_barrier(0)
    Unit cur, nxt; int ui = 0;
    if (!S.next(0, cur)) return;
    f32x4 acc[2][2][4][2];
#pragma unroll
    for (int a = 0; a < 2; ++a)
#pragma unroll
        for (int b = 0; b < 2; ++b)
#pragma unroll
            for (int m = 0; m < 4; ++m)
#pragma unroll
                for (int n = 0; n < 2; ++n) acc[a][b][m][n] = (f32x4){0.f, 0.f, 0.f, 0.f};
    bf16x8 At[4][2], B0[2][2], B1[2][2];
    const char* cA = (const char*)g.A + (size_t)cur.pm * tstep; const char* cB = (const char*)g.Bt + (size_t)cur.pn * tstep;
    S.a_ready(cur);
    if constexpr (SP2) {
        PG8_STAGE(PG8_SB(0, 0), cB, voffB); PG8_STAGE(PG8_SB(0, 1), cB + hstep, voffB); PG8_STAGE(PG8_SA(0, 0), cA, voffA); PG8_STAGE(PG8_SA(0, 1), cA + hstep, voffA);
        if (wr == 1) PG8_BAR;
        PG8_WAIT_V(2); PG8_BAR;
        PG8_STAGE(PG8_SB(1, 0), cB + kstep, voffB); PG8_STAGE(PG8_SA(1, 0), cA + kstep, voffA); PG8_STAGE(PG8_SB(1, 1), cB + hstep + kstep, voffB);
        PG8_WAIT_V(6); PG8_BAR;
    } else {
        PG8_STAGE(PG8_SB(0, 0), cB, voffB); PG8_STAGE(PG8_SA(0, 0), cA, voffA); PG8_STAGE(PG8_SB(0, 1), cB + hstep, voffB); PG8_STAGE(PG8_SA(0, 1), cA + hstep, voffA);
        if (wr == 1) PG8_BAR;
        PG8_WAIT_V(4); PG8_BAR;
        PG8_STAGE(PG8_SB(1, 0), cB + kstep, voffB); PG8_STAGE(PG8_SA(1, 0), cA + kstep, voffA); PG8_STAGE(PG8_SB(1, 1), cB + hstep + kstep, voffB);
        PG8_WAIT_V(6); PG8_BAR;
    }
    for (;;) {
        const bool has_next = S.next(ui + 1, nxt);
        const char* nA = has_next ? (const char*)g.A + (size_t)nxt.pm * tstep : cA; const char* nB = has_next ? (const char*)g.Bt + (size_t)nxt.pn * tstep : cB;
        for (int t = 0; t < nt; t += 2) {
            const bool last = (t == nt - 2);
            const char* a1 = cA + (size_t)(t + 1) * kstep;
            const char* a2 = last ? nA : cA + (size_t)(t + 2) * kstep; const char* b2 = last ? nB : cB + (size_t)(t + 2) * kstep;
            const char* a3 = a2 + kstep; const char* b3 = b2 + kstep;
            if (last && has_next) S.a_ready(nxt);
            if constexpr (SP2) {
            PG8_LDB(B0, 0, 0); PG8_LDB(B1, 0, 1); PG8_SCHED; PG8_LDA(At, 0, 0); PG8_STAGE(PG8_SA(1, 1), a1 + hstep, voffA);
            PG8_WAIT_V(8); PG8_WAIT_L(0); PG8_BAR; PG8_MMA(0, 0, At, B0); PG8_MMA(0, 1, At, B1); PG8_BAR; PG8_SCHED;
            PG8_LDA(At, 0, 1); PG8_STAGE(PG8_SB(0, 0), b2, voffB); PG8_STAGE(PG8_SB(0, 1), b2 + hstep, voffB); PG8_STAGE(PG8_SA(0, 0), a2, voffA);
            PG8_WAIT_V(8); PG8_WAIT_L(0); PG8_BAR; PG8_MMA(1, 0, At, B0); PG8_MMA(1, 1, At, B1); PG8_BAR; PG8_SCHED;
            PG8_LDB(B0, 1, 0); PG8_LDB(B1, 1, 1); PG8_SCHED; PG8_LDA(At, 1, 0); PG8_STAGE(PG8_SA(0, 1), a2 + hstep, voffA);
            PG8_WAIT_V(8); PG8_WAIT_L(0); PG8_BAR; PG8_MMA(0, 0, At, B0); PG8_MMA(0, 1, At, B1); PG8_BAR; PG8_SCHED;
            PG8_LDA(At, 1, 1); PG8_STAGE(PG8_SB(1, 0), b3, voffB); PG8_STAGE(PG8_SB(1, 1), b3 + hstep, voffB); PG8_STAGE(PG8_SA(1, 0), a3, voffA);
            PG8_WAIT_V(8); PG8_WAIT_L(0); PG8_BAR; PG8_MMA(1, 0, At, B0); PG8_MMA(1, 1, At, B1); PG8_BAR; PG8_SCHED;
            } else {
            PG8_LDB(B0, 0, 0); PG8_SCHED; PG8_LDA(At, 0, 0); PG8_STAGE(PG8_SA(1, 1), a1 + hstep, voffA);
            PG8_WAIT_L(8); PG8_BAR; PG8_WAIT_L(0); PG8_MMA(0, 0, At, B0); PG8_BAR; PG8_SCHED;
            PG8_LDB(B1, 0, 1); PG8_STAGE(PG8_SB(0, 0), b2, voffB);
            PG8_BAR; PG8_WAIT_L(0); PG8_MMA(0, 1, At, B1); PG8_BAR;
            PG8_LDA(At, 0, 1); PG8_STAGE(PG8_SA(0, 0), a2, voffA);
            PG8_BAR; PG8_WAIT_L(0); PG8_MMA(1, 0, At, B0); PG8_BAR; PG8_SCHED;
            PG8_STAGE(PG8_SB(0, 1), b2 + hstep, voffB);
            PG8_WAIT_V(6); PG8_BAR; PG8_MMA(1, 1, At, B1); PG8_BAR;
            PG8_LDB(B0, 1, 0); PG8_SCHED; PG8_LDA(At, 1, 0); PG8_STAGE(PG8_SA(0, 1), a2 + hstep, voffA);
            PG8_WAIT_L(8); PG8_BAR; PG8_WAIT_L(0); PG8_MMA(0, 0, At, B0); PG8_BAR; PG8_SCHED;
            PG8_LDB(B1, 1, 1); PG8_STAGE(PG8_SB(1, 0), b3, voffB);
            PG8_BAR; PG8_WAIT_L(0); PG8_MMA(0, 1, At, B1); PG8_BAR;
            PG8_LDA(At, 1, 1); PG8_STAGE(PG8_SA(1, 0), a3, voffA);
            PG8_BAR; PG8_WAIT_L(0); PG8_MMA(1, 0, At, B0); PG8_BAR; PG8_SCHED;
            PG8_STAGE(PG8_SB(1, 1), b3 + hstep, voffB);
            PG8_WAIT_V(6); PG8_BAR; PG8_MMA(1, 1, At, B1); PG8_BAR;
            }
        }
        if constexpr (ALIGN_EPI) { if (wr == 0) PG8_BAR; }
        if constexpr (!Epi::AFTER_DRAIN) { E(acc, cur, wr, wc, fr, fq); S.done(cur); }
        if (!has_next) break;
#pragma unroll
        for (int a = 0; a < 2; ++a)
#pragma unroll
            for (int b = 0; b < 2; ++b)
#pragma unroll
                for (int m = 0; m < 4; ++m)
#pragma unroll
                    for (int n = 0; n < 2; ++n) acc[a][b][m][n] = (f32x4){0.f, 0.f, 0.f, 0.f};
        cur = nxt; cA = nA; cB = nB; ++ui;
        if constexpr (ALIGN_EPI) { if (wr == 1) PG8_BAR; }
    }
    PG8_WAIT_V(0);
    if constexpr (!ALIGN_EPI) { if (wr == 0) PG8_BAR; }
    PG8_BAR;
    if constexpr (Epi::AFTER_DRAIN) { E.fused(acc, cur, wr, wc, fr, fq, lds, wid, lane); S.done(cur); }
#undef PG8_SA
#undef PG8_SB
#undef PG8_STAGE
#undef PG8_LDA
#undef PG8_LDB
#undef PG8_MMA
#undef PG8_WAIT_V
#undef PG8_WAIT_L
#undef PG8_BAR
#undef PG8_SCHED
}
}
#include <hip/hip_bf16.h>
#include <cmath>
namespace attn_body {
using bf16=__hip_bfloat16;
using bf16x8=__attribute__((ext_vector_type(8)))short;
using s16x4=__attribute__((ext_vector_type(4)))short;
using f32x16=__attribute__((ext_vector_type(16)))float;
using u32x4=__attribute__((ext_vector_type(4)))unsigned;
using f32x4v=__attribute__((ext_vector_type(4)))float;
typedef const __attribute__((address_space(3))) f32x4v* lds_f4p;
constexpr int BATCH=8,NHEAD=8,SEQ=8192,D=64,DM=NHEAD*D,OPITCH=1024;
constexpr int NW=8,QBLK=32,QB=QBLK*NW,KVBLK=64,NQB=SEQ/QB;
constexpr int ATTN_PITCH=DM, ATTN_UNIT_ROWS=QB;
__device__ __forceinline__ int crow(int r,int hi){return (r&3)+8*(r>>2)+4*hi;}
#define SBAR() __builtin_amdgcn_sched_barrier(0)
__device__ __forceinline__ void cmask(f32x16&p0,f32x16&p1,int jb,int qrel,int hi){
  const float NEG=-INFINITY; int kb=64*jb+4*hi;
  #pragma unroll
  for(int r=0;r<16;++r){int kv=kb+(r&3)+8*(r>>2); if(kv>qrel)p0[r]=NEG; if(kv+32>qrel)p1[r]=NEG;}
}

constexpr int NSLOT=3, SLOTB=8192;
constexpr int LDS_K=0, LDS_V=NSLOT*SLOTB, LDS_WS=2*NSLOT*SLOTB, LDS_OST=LDS_WS+NW*64*4, LDS_C2=LDS_OST+NW*4096, LDS_BYTES=LDS_C2+SEQ*4, LDS_TSL=LDS_BYTES+1024;
constexpr float C2=0.125f*1.4426950408889634f;
__device__ __forceinline__ void glds16(const void*gsrc,unsigned lds_dst){unsigned keep;
  asm volatile("s_mov_b32 %0, m0\n\ts_mov_b32 m0, %2\n\ts_nop 0\n\tglobal_load_lds_dwordx4 %1, off\n\ts_mov_b32 m0, %0":"=&s"(keep):"v"(gsrc),"s"(lds_dst):"memory");}
__device__ __forceinline__ float max3f(float a,float b,float c){float r;asm("v_max3_f32 %0, %1, %2, %3":"=v"(r):"v"(a),"v"(b),"v"(c));return r;}
__device__ __forceinline__ float max2f(float a,float b){float r;asm("v_max_f32_e32 %0, %1, %2":"=v"(r):"v"(a),"v"(b));return r;}
__device__ __forceinline__ float fadd_s(float a,float b){float r;asm("v_add_f32_e32 %0, %1, %2":"=v"(r):"v"(a),"v"(b));return r;}
__device__ __forceinline__ float fsub_s(float a,float b){float r;asm("v_sub_f32_e32 %0, %1, %2":"=v"(r):"v"(a),"v"(b));return r;}
typedef float f32x2_t __attribute__((ext_vector_type(2))); typedef __bf16 bf16x2_t __attribute__((ext_vector_type(2)));
__device__ __forceinline__ unsigned cvtpk_s(float lo,float hi){f32x2_t v={lo,hi};bf16x2_t b=__builtin_convertvector(v,bf16x2_t);return __builtin_bit_cast(unsigned,b);}
#define WAIT_BAR(N) asm volatile("s_waitcnt vmcnt(" #N ") lgkmcnt(0)\n\ts_barrier":::"memory")

__device__ __forceinline__ void qkt(f32x16&p0,f32x16&p1,const char*Kslot,const bf16x8*qr,int r32,int hi){
  const char*kb=Kslot+hi*1024+r32*16;
  #pragma unroll
  for(int d0=0;d0<4;++d0){
    const bf16x8 b0=*reinterpret_cast<const bf16x8*>(kb+d0*2048);
    const bf16x8 b1=*reinterpret_cast<const bf16x8*>(kb+d0*2048+512);
    p0=__builtin_amdgcn_mfma_f32_32x32x16_bf16(b0,qr[d0],p0,0,0,0);p1=__builtin_amdgcn_mfma_f32_32x32x16_bf16(b1,qr[d0],p1,0,0,0);}
}
typedef __attribute__((address_space(3))) const char* lds_cptr;
typedef short v4i16_t __attribute__((ext_vector_type(4)));
__device__ __forceinline__ void kload8(bf16x8*kf,lds_cptr kp){
  kf[0]=*(const __attribute__((address_space(3))) bf16x8*)(kp);      kf[1]=*(const __attribute__((address_space(3))) bf16x8*)(kp+512);
  kf[2]=*(const __attribute__((address_space(3))) bf16x8*)(kp+2048); kf[3]=*(const __attribute__((address_space(3))) bf16x8*)(kp+2560);
  kf[4]=*(const __attribute__((address_space(3))) bf16x8*)(kp+4096); kf[5]=*(const __attribute__((address_space(3))) bf16x8*)(kp+4608);
  kf[6]=*(const __attribute__((address_space(3))) bf16x8*)(kp+6144); kf[7]=*(const __attribute__((address_space(3))) bf16x8*)(kp+6656);
}
__device__ __forceinline__ void kload2(bf16x8*kf,lds_cptr kp,int j){ kf[2*j]=*(const __attribute__((address_space(3))) bf16x8*)(kp+j*2048); kf[2*j+1]=*(const __attribute__((address_space(3))) bf16x8*)(kp+j*2048+512); }
__device__ __forceinline__ s16x4 vtr(lds_cptr p){ return __builtin_bit_cast(s16x4,__builtin_amdgcn_ds_read_tr16_b64_v4i16((__attribute__((address_space(3))) v4i16_t*)p)); }
__device__ __forceinline__ float rowmax(const f32x16&p0,const f32x16&p1){
  float a=max3f(p0[0],p0[1],p1[0]),b=max3f(p0[2],p0[3],p1[1]);a=max3f(a,p1[2],p1[3]);
  #pragma unroll
  for(int r=4;r<16;r+=4){a=max3f(a,p0[r],p0[r+1]);b=max3f(b,p0[r+2],p0[r+3]);a=max3f(a,p1[r],p1[r+1]);b=max3f(b,p1[r+2],p1[r+3]);}
  const float m=max2f(a,b);
  auto rr=__builtin_amdgcn_permlane32_swap(__float_as_uint(m),__float_as_uint(m),false,false);
  return max2f(__uint_as_float(rr[0]),__uint_as_float(rr[1]));
}
__device__ __forceinline__ void pv(f32x16*o,int vb,bf16x8 pa0,bf16x8 pa1,bf16x8 pa2,bf16x8 pa3){
  #pragma unroll
  for(int d0=0;d0<2;++d0){s16x4 lo[4],hi[4];
    #pragma unroll
    for(int ks=0;ks<4;++ks){
      asm volatile("ds_read_b64_tr_b16 %0,%1 offset:%c2":"=&v"(lo[ks]):"v"(vb),"i"(d0*4096+ks*1024):"memory");
      asm volatile("ds_read_b64_tr_b16 %0,%1 offset:%c2":"=&v"(hi[ks]):"v"(vb),"i"(d0*4096+ks*1024+512):"memory");}
    asm volatile("s_waitcnt lgkmcnt(0)":::"memory");SBAR();
    #define PK(k) (bf16x8){lo[k][0],lo[k][1],lo[k][2],lo[k][3],hi[k][0],hi[k][1],hi[k][2],hi[k][3]}
    o[d0]=__builtin_amdgcn_mfma_f32_32x32x16_bf16(pa0,PK(0),o[d0],0,0,0);
    o[d0]=__builtin_amdgcn_mfma_f32_32x32x16_bf16(pa1,PK(1),o[d0],0,0,0);
    o[d0]=__builtin_amdgcn_mfma_f32_32x32x16_bf16(pa2,PK(2),o[d0],0,0,0);
    o[d0]=__builtin_amdgcn_mfma_f32_32x32x16_bf16(pa3,PK(3),o[d0],0,0,0);
    #undef PK
  }
}

#ifndef ATTN_STORE16
#define ATTN_STORE16(p,v) (*(u32x4*)(p)=(v))
#endif
template<int THRL,class SchedT> __device__ __forceinline__ void attn_unit(const SchedT&Sq,int b,int h,int qb,const bf16*Q,const bf16*__restrict__ K,const bf16*__restrict__ V,bf16*O,const float*__restrict__ NC2,int ts,char*shm){
  int tid_l=threadIdx.x; asm volatile("":"+v"(tid_l)); const int tid=tid_l,lane=tid&63,r32=lane&31,hi=lane>>5; const int wid=__builtin_amdgcn_readfirstlane(tid>>6);
  const long rowbase=(long)b*SEQ; const int q0=qb*QB;
  const bf16*Qw=Q+(rowbase+q0+wid*QBLK)*DM+h*D;
  const bf16*Kh=K+(rowbase+(long)ts*KVBLK)*DM+h*D,*Vh=V+(rowbase+(long)ts*KVBLK)*DM+h*D;
  const unsigned lds0=(unsigned)(uintptr_t)shm;
  float*wsf=(float*)(shm+LDS_WS)+wid*64;
  const bf16*ksrc=Kh+(long)lane*DM+wid*8;
  const bf16*vsrc=Vh+(long)(16*(wid&3)+(lane>>2))*DM+(wid>>2)*32+(lane&3)*8;
  const unsigned kdst=lds0+LDS_K+wid*1024, vdst=lds0+LDS_V+wid*1024;
  #define DMA_K(t,slot) glds16(ksrc+(long)(t)*KVBLK*DM,(unsigned)__builtin_amdgcn_readfirstlane(kdst+(slot)))
  #define DMA_V(t,slot) glds16(vsrc+(long)(t)*KVBLK*DM,(unsigned)__builtin_amdgcn_readfirstlane(vdst+(slot)))
  const int vb0=(int)(lds0+LDS_V)+((lane>>4)&1)*32+(lane&3)*8+(4*hi+((lane&15)>>2))*64;
  const char*Kbase=shm+LDS_K; bf16x8 kf[8];
  const lds_cptr shm3=(lds_cptr)shm; const lds_cptr c2l=shm3+LDS_C2+16*hi; const lds_cptr kp0=shm3+LDS_K+hi*1024+r32*16; const lds_cptr vp0=shm3+LDS_V+((lane>>4)&1)*32+(lane&3)*8+(4*hi+((lane&15)>>2))*64;
  const int NT=(q0+QB)/KVBLK-ts;
  DMA_K(0,0);DMA_V(0,0);DMA_K(1,SLOTB);
  bf16x8 qr[4];
  #pragma unroll
  for(int d0=0;d0<4;++d0)qr[d0]=*reinterpret_cast<const bf16x8*>(&Qw[(long)r32*DM+d0*16+hi*8]);
  { const float*cg_=NC2+(long)(b*NHEAD+h)*SEQ+ts*KVBLK; float*cl_=(float*)(shm+LDS_C2); const int nq_=q0+QB-ts*KVBLK;
    for(int i_=tid*4;i_<nq_;i_+=NW*64*4)*(f32x4v*)(cl_+i_)=*(const f32x4v*)(cg_+i_); }
  float mhat=0.f,l_reg=0.f;f32x16 o[2];o[0]=f32x16{};o[1]=f32x16{};
  const int qrel=wid*QBLK+r32;
  #define CMASK(P0,P1,t) do{int jb_=(t)-(NT-4); if(jb_>=0)cmask(P0,P1,jb_,qrel,hi);}while(0)
  bool resc=false;
  #define START(P0,P1) do{ const float rm=rowmax(P0,P1); resc=false; \
    { const float dl=rm; mhat=fadd_s(mhat,dl); \
      _Pragma("unroll") for(int r=0;r<16;++r){P0[r]=fsub_s(P0[r],dl);P1[r]=fsub_s(P1[r],dl);} \
      } \
    _Pragma("unroll") for(int r=0;r<16;++r)P0[r]=__builtin_amdgcn_exp2f(P0[r]); }while(0)
  #define RESC() do{ if(resc){ asm volatile("s_waitcnt lgkmcnt(0)":::"memory"); \
      _Pragma("unroll") for(int d_=0;d_<2;++d_) _Pragma("unroll") for(int r=0;r<16;++r)o[d_][r]*=wsf[crow(r,hi)]; } }while(0)
  f32x16 pA0,pA1,pB0,pB1;
  #define KBLD(X0,X1,tt) do{ const lds_f4p cb_=(lds_f4p)(c2l+(tt)*256); \
    _Pragma("unroll") for(int g_=0;g_<4;++g_){ const f32x4v a_=cb_[2*g_], b_=cb_[2*g_+8]; \
      X0[4*g_+0]=a_[0]-mhat; X0[4*g_+1]=a_[1]-mhat; X0[4*g_+2]=a_[2]-mhat; X0[4*g_+3]=a_[3]-mhat; \
      X1[4*g_+0]=b_[0]-mhat; X1[4*g_+1]=b_[1]-mhat; X1[4*g_+2]=b_[2]-mhat; X1[4*g_+3]=b_[3]-mhat; } }while(0)
  int sl_prev=0,sl_cur=0,sl_next=SLOTB;
  #define ROT() do{sl_prev=sl_cur;sl_cur=sl_next;sl_next=(sl_next==(NSLOT-1)*SLOTB)?0:sl_next+SLOTB;}while(0)
  DMA_K(2,2*SLOTB);
  WAIT_BAR(3);
  KBLD(pA0,pA1,0);
  qkt(pA0,pA1,Kbase,qr,r32,hi);asm volatile("s_nop 15\n\ts_nop 7":"+v"(pA0),"+v"(pA1));CMASK(pA0,pA1,0);
  START(pA0,pA1);
  KBLD(pB0,pB1,1);
  _Pragma("unroll") for(int r=0;r<16;++r)pA1[r]=__builtin_amdgcn_exp2f(pA1[r]);
  WAIT_BAR(0);
  DMA_K(3,0);DMA_V(1,SLOTB);
  ROT();
  kload8(kf,kp0+sl_cur);
  WAIT_BAR(2);
  s16x4 vlo[8],vhi[8]; u32x4 pw0,pw1,pw2,pw3;
  #define PKW(P,B) cvtpk_s(P[B],P[B+1])
  #define PAF(k) __builtin_bit_cast(bf16x8,pw##k)
  #define VFR(i) (bf16x8){vlo[i][0],vlo[i][1],vlo[i][2],vlo[i][3],vhi[i][0],vhi[i][1],vhi[i][2],vhi[i][3]}
  #define PIN(x) asm volatile("":"+v"(x))
  #define MX3(a,b,c) __builtin_fmaxf(__builtin_fmaxf((a),(b)),(c))
  #define GAPA(MF,A0,A1,A2,A3,W0,W1,PW) do{ MF; sacc+=A0; sacc+=A1; sacc+=A2; sacc+=A3; PIN(sacc); W0; W1; PIN(PW); SBAR(); }while(0)
  #define EX(v) __builtin_amdgcn_exp2f(v)
  #define GAPB(MF,X,B) do{ MF; X[B]=EX(X[B]); X[B+1]=EX(X[B+1]); X[B+2]=EX(X[B+2]); X[B+3]=EX(X[B+3]); PIN(X); SBAR(); }while(0)
  #define VRD(i) do{ vlo[i]=vtr(vp_+(((i)>>2)*4096+((i)&3)*1024)); vhi[i]=vtr(vp_+(((i)>>2)*4096+((i)&3)*1024+512)); }while(0)
  #define KBQ(X,g_,i_) do{ const f32x4v a_=cb_[i_]; X[4*(g_)+0]=a_[0]; X[4*(g_)+1]=a_[1]; X[4*(g_)+2]=a_[2]; X[4*(g_)+3]=a_[3]; }while(0)
  #define KBQ2(G,XA,ga,ia,XB,gb,ib) do{ if(G){ KBQ(XA,ga,ia); KBQ(XB,gb,ib); SBAR(); } }while(0)
  #define KRD(G,j) do{ if(G){ kload2(kf,kp0+sl_next,j); SBAR(); } }while(0)
  #define STEP(C0,C1,P0,P1,t,GK,GV,GL) do{ SBAR(); \
    const lds_cptr vp_=vp0+sl_prev; \
    VRD(0); SBAR(); float sacc=(P0[0]+P0[1]); \
    GAPA(C0=__builtin_amdgcn_mfma_f32_32x32x16_bf16(kf[0],qr[0],C0,0,0,0), P0[2],P0[3],P0[4],P0[5],     pw0[0]=PKW(P0,0), pw0[1]=PKW(P0,2), pw0); \
    VRD(4); SBAR(); GAPA(C1=__builtin_amdgcn_mfma_f32_32x32x16_bf16(kf[1],qr[0],C1,0,0,0), P0[6],P0[7],P0[8],P0[9],     pw0[2]=PKW(P0,4), pw0[3]=PKW(P0,6), pw0); \
    VRD(1); SBAR(); GAPA(C0=__builtin_amdgcn_mfma_f32_32x32x16_bf16(kf[2],qr[1],C0,0,0,0),   P0[10],P0[11],P0[12],P0[13], pw1[0]=PKW(P0,8), pw1[1]=PKW(P0,10), pw1); \
    VRD(5); SBAR(); GAPA(C1=__builtin_amdgcn_mfma_f32_32x32x16_bf16(kf[3],qr[1],C1,0,0,0),   P0[14],P0[15],P1[0],P1[1],   pw1[2]=PKW(P0,12),pw1[3]=PKW(P0,14), pw1); \
    VRD(2); SBAR(); GAPA(C0=__builtin_amdgcn_mfma_f32_32x32x16_bf16(kf[4],qr[2],C0,0,0,0),   P1[2],P1[3],P1[4],P1[5],     pw2[0]=PKW(P1,0), pw2[1]=PKW(P1,2), pw2); \
    VRD(6); SBAR(); GAPA(C1=__builtin_amdgcn_mfma_f32_32x32x16_bf16(kf[5],qr[2],C1,0,0,0),   P1[6],P1[7],P1[8],P1[9],     pw2[2]=PKW(P1,4), pw2[3]=PKW(P1,6), pw2); \
    VRD(3); SBAR(); GAPA(C0=__builtin_amdgcn_mfma_f32_32x32x16_bf16(kf[6],qr[3],C0,0,0,0),   P1[10],P1[11],P1[12],P1[13], pw3[0]=PKW(P1,8), pw3[1]=PKW(P1,10), pw3); \
    VRD(7); SBAR(); GAPA(C1=__builtin_amdgcn_mfma_f32_32x32x16_bf16(kf[7],qr[3],C1,0,0,0),   P1[14],P1[15],0.f,0.f,       pw3[2]=PKW(P1,12),pw3[3]=PKW(P1,14), pw3); \
    l_reg+=sacc; \
    if(GK){DMA_K((t)+3,sl_cur);} if(GV){DMA_V((t)+1,sl_next);} \
    CMASK(C0,C1,t); \
    { float a=MX3(C0[0],C0[1],C1[0]),b=MX3(C0[2],C0[3],C1[1]); a=MX3(a,C1[2],C1[3]); \
      _Pragma("unroll") for(int r=4;r<16;r+=4){a=MX3(a,C0[r],C0[r+1]);b=MX3(b,C0[r+2],C0[r+3]);a=MX3(a,C1[r],C1[r+1]);b=MX3(b,C1[r+2],C1[r+3]);} \
      float rm=__builtin_fmaxf(a,b); { auto rr=__builtin_amdgcn_permlane32_swap(__float_as_uint(rm),__float_as_uint(rm),false,false); rm=__builtin_fmaxf(__uint_as_float(rr[0]),__uint_as_float(rr[1])); } \
      resc=false; \
      if(__builtin_expect(__any(rm>(float)THRL),0)){ const float dl=__builtin_fmaxf(rm,0.f); mhat+=dl; \
        _Pragma("unroll") for(int r=0;r<16;++r){C0[r]-=dl;C1[r]-=dl;} \
        const float f=__builtin_amdgcn_exp2f(-dl); l_reg*=f; if(hi==0)wsf[r32]=f; resc=true; } } \
    SBAR(); \
    const lds_f4p cb_=(lds_f4p)(c2l+((t)+1)*256);     \
    KBQ2(GL,P0,0,0,P0,1,2); GAPB(o[0]=__builtin_amdgcn_mfma_f32_32x32x16_bf16(PAF(0),VFR(0),o[0],0,0,0), C0,0); \
    KBQ2(GL,P0,2,4,P0,3,6); GAPB(o[1]=__builtin_amdgcn_mfma_f32_32x32x16_bf16(PAF(0),VFR(4),o[1],0,0,0), C0,4); \
    KRD(GL,0); GAPB(o[0]=__builtin_amdgcn_mfma_f32_32x32x16_bf16(PAF(1),VFR(1),o[0],0,0,0), C0,8); \
    KRD(GL,1); GAPB(o[1]=__builtin_amdgcn_mfma_f32_32x32x16_bf16(PAF(1),VFR(5),o[1],0,0,0), C0,12); \
    KRD(GL,2); GAPB(o[0]=__builtin_amdgcn_mfma_f32_32x32x16_bf16(PAF(2),VFR(2),o[0],0,0,0), C1,0); \
    KRD(GL,3); GAPB(o[1]=__builtin_amdgcn_mfma_f32_32x32x16_bf16(PAF(2),VFR(6),o[1],0,0,0), C1,4); \
    KBQ2(GL,P1,0,8,P1,1,10); GAPB(o[0]=__builtin_amdgcn_mfma_f32_32x32x16_bf16(PAF(3),VFR(3),o[0],0,0,0), C1,8); \
    KBQ2(GL,P1,2,12,P1,3,14); GAPB(o[1]=__builtin_amdgcn_mfma_f32_32x32x16_bf16(PAF(3),VFR(7),o[1],0,0,0), C1,12); \
    if(GL){ _Pragma("unroll") for(int r=0;r<16;++r){P0[r]-=mhat;P1[r]-=mhat;} } \
    }while(0)
  int t=1;
  #undef CMASK
  #define CMASK(P0,P1,t) do{}while(0)
  for(;t+5<NT;t+=2){
    STEP(pB0,pB1,pA0,pA1,t,true,true,true);     WAIT_BAR(2); RESC(); ROT();
    STEP(pA0,pA1,pB0,pB1,t+1,true,true,true);   WAIT_BAR(2); RESC(); ROT();
  }
  #undef CMASK
  #define CMASK(P0,P1,t) do{int jb_=(t)-(NT-4); if(jb_>=0)cmask(P0,P1,jb_,qrel,hi);}while(0)
  #define ENDW(tt) do{ if((tt)+3<NT){WAIT_BAR(2);} else if((tt)+2<NT){WAIT_BAR(1);} else {WAIT_BAR(0);} }while(0)
  for(;t+1<NT;t+=2){
    STEP(pB0,pB1,pA0,pA1,t,(t+3<NT),(t+1<NT),(t+1<NT));       ENDW(t);   RESC(); ROT();
    STEP(pA0,pA1,pB0,pB1,t+1,(t+4<NT),(t+2<NT),(t+2<NT));     ENDW(t+1); RESC(); ROT();
  }
  STEP(pB0,pB1,pA0,pA1,NT-1,false,false,false); RESC();
  { float sacc=pB0[0]+pB0[1]; _Pragma("unroll") for(int r=2;r<16;++r)sacc+=pB0[r]; _Pragma("unroll") for(int r=0;r<16;++r)sacc+=pB1[r]; l_reg+=sacc;
    pw0=(u32x4){PKW(pB0,0),PKW(pB0,2),PKW(pB0,4),PKW(pB0,6)};pw1=(u32x4){PKW(pB0,8),PKW(pB0,10),PKW(pB0,12),PKW(pB0,14)};pw2=(u32x4){PKW(pB1,0),PKW(pB1,2),PKW(pB1,4),PKW(pB1,6)};pw3=(u32x4){PKW(pB1,8),PKW(pB1,10),PKW(pB1,12),PKW(pB1,14)};
    SBAR(); pv(o,vb0+sl_cur,PAF(0),PAF(1),PAF(2),PAF(3)); }
  #undef PKW
  #undef PAF
  #undef VFR
  #undef PIN
  #undef MX3
  #undef GAPA
  #undef GAPB
  #undef EX
  #undef VRD
  #undef KRD
  #undef KBQ
  #undef KBQ2
  #undef STEP
  #undef ENDW
  Sq.prefetch();
  {auto rr=__builtin_amdgcn_permlane32_swap(__float_as_uint(l_reg),__float_as_uint(l_reg),false,false);l_reg=__uint_as_float(rr[0])+__uint_as_float(rr[1]);}
  if(hi==0)wsf[32+r32]=l_reg;asm volatile("s_waitcnt lgkmcnt(0)":::"memory");
  float rli[16];
  #pragma unroll
  for(int r=0;r<16;++r)rli[r]=__builtin_amdgcn_rcpf(wsf[32+crow(r,hi)]);
  bf16*Ow=O+(rowbase+q0+wid*QBLK)*OPITCH+h*D;
  { bf16*stg=(bf16*)(shm+LDS_OST)+wid*2048;
    #pragma unroll
    for(int r=0;r<16;++r){const int orow=crow(r,hi);
      #pragma unroll
      for(int d0=0;d0<2;++d0)stg[orow*64+d0*32+r32]=__float2bfloat16(o[d0][r]*rli[r]);}
    asm volatile("s_waitcnt lgkmcnt(0)":::"memory");
    #pragma unroll
    for(int i=0;i<4;++i){const int row=i*8+(lane>>3),ch=lane&7; const u32x4 v=*(const u32x4*)(stg+row*64+ch*8); ATTN_STORE16(Ow+(long)row*OPITCH+ch*8,v);} }
  asm volatile("s_waitcnt lgkmcnt(0)\n\ts_barrier":::"memory");
  #undef DMA_K
  #undef DMA_V
  #undef CMASK
  #undef START
  #undef RESC
  #undef ROT
  #undef KBLD
}
constexpr int ATTN_LDS_BYTES=LDS_BYTES;
struct AttnTensors { const bf16* Q; const bf16* K; const bf16* V; bf16* O; const float* NC2; const int* TS; };
struct AttnUnit { int bh; int qb; };
struct QueueOrder {
  unsigned* cnt; volatile __attribute__((address_space(3))) unsigned* slot; mutable unsigned pend;
  __device__ __forceinline__ void prefetch()const{ if(threadIdx.x==0)pend=__hip_atomic_fetch_add(cnt,1u,__ATOMIC_RELAXED,__HIP_MEMORY_SCOPE_AGENT); }
  __device__ __forceinline__ bool next(int i,AttnUnit&u)const{
    if(i==0)prefetch();
    if(threadIdx.x==0)*slot=pend;
    __syncthreads(); const unsigned n=*slot; if(n>=(unsigned)(BATCH*NHEAD*NQB))return false; u.qb=NQB-1-(int)(n>>6); u.bh=(int)(n&63u); return true; }
  __device__ __forceinline__ void a_ready(const AttnUnit&)const{}
  __device__ __forceinline__ void done(const AttnUnit&)const{}
};
struct StaticOrder {
  int vcu;
  __device__ __forceinline__ explicit StaticOrder(int grid,int block):vcu((block%8)*(grid/8)+block/8){}
  __device__ __forceinline__ bool next(int i,AttnUnit&u)const{ if(i>=8)return false; const int s=vcu&3; u.bh=vcu>>2; u.qb=8*(i>>1)+((i&1)?7-s:s); return true; }
  __device__ __forceinline__ void a_ready(const AttnUnit&)const{}
  __device__ __forceinline__ void done(const AttnUnit&)const{}
  __device__ __forceinline__ void prefetch()const{}
};
template<class Sched,int THRL=8> __device__ __forceinline__ void attn_phase(char*lds,const AttnTensors&T,const Sched&S){
  AttnUnit u;
  for(int i=0;S.next(i,u);++i){ S.a_ready(u); attn_unit<THRL,Sched>(S,u.bh/NHEAD,u.bh%NHEAD,u.qb,T.Q,T.K,T.V,T.O,T.NC2,__builtin_amdgcn_readfirstlane(((const __attribute__((address_space(3))) int*)(lds_cptr)lds)[(LDS_TSL>>2)+u.bh*NQB+u.qb]),lds); S.done(u); }
}
#undef SBAR
#undef WAIT_BAR
}
namespace xat {
#define XLAS __attribute__((address_space(3)))
typedef unsigned short bf16_t;
typedef short bf16x8 __attribute__((ext_vector_type(8)));
typedef float f32x16 __attribute__((ext_vector_type(16)));
typedef unsigned u32x4 __attribute__((ext_vector_type(4)));
typedef unsigned u32x2 __attribute__((ext_vector_type(2)));
constexpr int KROW = 272, VROW = 520, LDS_K = 0, LDS_V = 256 * KROW, LDS_END = LDS_V + 128 * VROW;
__device__ __forceinline__ unsigned cvtpk(float lo, float hi) { unsigned r; asm volatile("v_cvt_pk_bf16_f32 %0, %1, %2" : "=v"(r) : "v"(lo), "v"(hi)); return r; }
__device__ __forceinline__ void load_kv(const bf16_t* MKbh, const bf16_t* MVtbh, XLAS unsigned char* lds, int tid) {
    for (int i = tid; i < 4096; i += 512) { const int row = i >> 4, ch = i & 15; const u32x4 v = *(const u32x4*)(MKbh + row * 128 + ch * 8); *(XLAS u32x4*)(lds + LDS_K + row * KROW + ch * 16) = v; }
    for (int i = tid; i < 4096; i += 512) { const int row = i >> 5, ch = i & 31; const u32x4 v = *(const u32x4*)(MVtbh + row * 256 + ch * 8);
        XLAS u32x2* p = (XLAS u32x2*)(lds + LDS_V + row * VROW + ch * 16); p[0] = (u32x2){v.x, v.y}; p[1] = (u32x2){v.z, v.w}; }
}
__device__ __forceinline__ void unit(const bf16_t* MQ, bf16_t* MO, int b, int h, int qblk, XLAS unsigned char* lds) {
    int tid = threadIdx.x; asm volatile("" : "+v"(tid)); const int lane = tid & 63, r32 = lane & 31, hi = lane >> 5, wid = tid >> 6;
    const size_t row = (size_t)b * 8192 + qblk * 256 + wid * 32 + r32;
    const bf16_t* qp = MQ + row * 512 + h * 128 + hi * 8;
    bf16x8 qr[8];
#pragma unroll
    for (int d0 = 0; d0 < 8; ++d0) qr[d0] = *(const bf16x8*)(qp + d0 * 16);
    f32x16 S[8];
#pragma unroll
    for (int kb = 0; kb < 8; ++kb) { S[kb] = f32x16{};
#pragma unroll
        for (int d0 = 0; d0 < 8; ++d0) { const bf16x8 kf = *(const XLAS bf16x8*)(lds + LDS_K + (32 * kb + r32) * KROW + d0 * 32 + hi * 16);
            S[kb] = __builtin_amdgcn_mfma_f32_32x32x16_bf16(kf, qr[d0], S[kb], 0, 0, 0); }
        __builtin_amdgcn_sched_barrier(0); }
    float m = S[0][0];
#pragma unroll
    for (int kb = 0; kb < 8; ++kb)
#pragma unroll
        for (int r = 0; r < 16; ++r) m = fmaxf(m, S[kb][r]);
    m = fmaxf(m, __shfl_xor(m, 32));
    float l = 0.f;
#pragma unroll
    for (int kb = 0; kb < 8; ++kb)
#pragma unroll
        for (int r = 0; r < 16; ++r) { const float p = __builtin_amdgcn_exp2f(S[kb][r] - m); S[kb][r] = p; l += p; }
    l += __shfl_xor(l, 32);
    u32x4 pw[8][2];
#pragma unroll
    for (int kb = 0; kb < 8; ++kb)
#pragma unroll
        for (int sp = 0; sp < 2; ++sp) { pw[kb][sp].x = cvtpk(S[kb][8 * sp + 0], S[kb][8 * sp + 1]); pw[kb][sp].y = cvtpk(S[kb][8 * sp + 2], S[kb][8 * sp + 3]); pw[kb][sp].z = cvtpk(S[kb][8 * sp + 4], S[kb][8 * sp + 5]); pw[kb][sp].w = cvtpk(S[kb][8 * sp + 6], S[kb][8 * sp + 7]); }
    __builtin_amdgcn_sched_barrier(0);
    f32x16 o[4];
#pragma unroll
    for (int db = 0; db < 4; ++db) o[db] = f32x16{};
#pragma unroll
    for (int kb = 0; kb < 8; ++kb)
#pragma unroll
        for (int sp = 0; sp < 2; ++sp) {
            const bf16x8 pk = __builtin_bit_cast(bf16x8, pw[kb][sp]);
#pragma unroll
            for (int db = 0; db < 4; ++db) { const XLAS unsigned char* vb = lds + LDS_V + (32 * db + r32) * VROW + (32 * kb + 16 * sp + 4 * hi) * 2;
                const u32x2 lo = *(const XLAS u32x2*)vb, hh = *(const XLAS u32x2*)(vb + 16);
                const u32x4 vw = (u32x4){lo.x, lo.y, hh.x, hh.y};
                o[db] = __builtin_amdgcn_mfma_f32_32x32x16_bf16(__builtin_bit_cast(bf16x8, vw), pk, o[db], 0, 0, 0); }
            __builtin_amdgcn_sched_barrier(0); }
    const float inv = 1.0f / l;
    bf16_t* op = MO + row * 512 + h * 128 + 4 * hi;
#pragma unroll
    for (int db = 0; db < 4; ++db)
#pragma unroll
        for (int g = 0; g < 4; ++g) { u32x2 w; w.x = cvtpk(o[db][4 * g + 0] * inv, o[db][4 * g + 1] * inv); w.y = cvtpk(o[db][4 * g + 2] * inv, o[db][4 * g + 3] * inv);
            *(u32x2*)(op + 32 * db + 8 * g) = w; }
}
}

namespace cg = cooperative_groups;
#define LAS __attribute__((address_space(3)))
typedef unsigned short bf16;
typedef unsigned v4u __attribute__((ext_vector_type(4)));
typedef unsigned v2u __attribute__((ext_vector_type(2)));
typedef float f32x4 __attribute__((ext_vector_type(4)));
constexpr int NWAVES = 8;
constexpr int DM = 1024, BATCH = 8, SEQ = 8192, MTOK = BATCH * SEQ, DEPTH = 2, NIN = 2056, NINP = 2304, DFF = 2816, MEMLEN = 256;
constexpr float EPS = 1e-6f;
constexpr size_t MiB = 1u << 20;
constexpr size_t WS_W = 1 * MiB, WS_WSTRIDE = 28 * MiB;
constexpr size_t WO_IN = 0, WO_OUT = 5 * MiB, WO_MQ = 7 * MiB, WO_MKV = 8 * MiB, WO_MO = 10 * MiB, WO_GU = 11 * MiB, WO_D = 22 * MiB;
constexpr size_t WS_BAR = 65536, WS_BAR_BYTES = 16384;
constexpr int XBST_OFF = 141312;
constexpr size_t WS_QCNT = 0, WS_TS = 4096;
constexpr size_t WS_LF = 58 * MiB, WS_NC2 = 60 * MiB, WS_SSQ = 62 * MiB, WS_MN = 66 * MiB, WS_MK = 74 * MiB, WS_MVT = 78 * MiB;
constexpr size_t WS_HB = 96 * MiB, WS_Q = 224 * MiB, WS_K = 288 * MiB, WS_V = 352 * MiB, WS_P = 416 * MiB, WS_CAT = 480 * MiB, WS_MQ = 608 * MiB, WS_MO = 672 * MiB, WS_FP = 736 * MiB, WS_END = 768 * MiB;
constexpr size_t WS_ACT = 224 * MiB;
static_assert(WS_ACT + (size_t)MTOK * DFF * 2 <= WS_MQ, "ACT overlay");
constexpr int RING_BYTES = 131072, EPIX_OFF = 132096, LDS_BYTES = 147456;

__device__ __forceinline__ unsigned f2bf(float f) { unsigned u = __builtin_bit_cast(unsigned, f); return (u + 0x7fffu + ((u >> 16) & 1u)) >> 16; }
__device__ __forceinline__ unsigned pk2(float lo, float hi) { return f2bf(lo) | (f2bf(hi) << 16); }
__device__ __forceinline__ float wave_sum(float v) {
#pragma unroll
    for (int o = 1; o < 64; o <<= 1) v += __shfl_xor(v, o);
    return v;
}
__device__ __forceinline__ void tr_item(const float* W, int N, int k0, int n0, const float* g, bf16* WT, int Kdst, int drow0, LAS float* scr, int lane) {
    const int nq = (lane & 15) * 4; const bool ok = (n0 + nq) < N;
    f32x4 v[16];
#pragma unroll
    for (int i = 0; i < 16; ++i) { const int kk = 4 * i + (lane >> 4); v[i] = ok ? __builtin_nontemporal_load((const f32x4*)(W + (size_t)(k0 + kk) * N + n0 + nq)) : (f32x4){0.f, 0.f, 0.f, 0.f}; if (g) v[i] = v[i] * g[k0 + kk]; }
#pragma unroll
    for (int i = 0; i < 16; ++i) { const int kk = 4 * i + (lane >> 4); LAS float* d = scr + kk * 65 + nq; d[0] = v[i].x; d[1] = v[i].y; d[2] = v[i].z; d[3] = v[i].w; }
    asm volatile("s_waitcnt lgkmcnt(0)" ::: "memory");
    const int c = lane & 7;
#pragma unroll
    for (int j = 0; j < 8; ++j) { const int n = (lane >> 3) + 8 * j; const LAS float* s = scr + (8 * c) * 65 + n;
        v4u o; o.x = pk2(s[0 * 65], s[1 * 65]); o.y = pk2(s[2 * 65], s[3 * 65]); o.z = pk2(s[4 * 65], s[5 * 65]); o.w = pk2(s[6 * 65], s[7 * 65]);
        *(v4u*)(WT + (size_t)(drow0 + n) * Kdst + k0 + 8 * c) = o; }
    asm volatile("s_waitcnt lgkmcnt(0)" ::: "memory");
}

#ifndef PHMASK
#define PHMASK 0x3ff
#endif
#define XB_TMO      128
#define XB_XCNT(j)  (256  + 64 * (j))
#define XB_XSUB(j)  (1280 + 64 * (j))
#define XB_XGEN(j)  (2304 + 64 * (j))
#define XB_TOP      3328
#define XB_TOPGEN   3392
#define XCD_BAR_WORDS 3456
#define XB_SPIN_CAP (1u << 18)

__device__ __forceinline__ unsigned xb_ld(unsigned* p)              { return __hip_atomic_load(p, __ATOMIC_RELAXED, __HIP_MEMORY_SCOPE_AGENT); }
__device__ __forceinline__ unsigned xb_add(unsigned* p, unsigned v) { return __hip_atomic_fetch_add(p, v, __ATOMIC_RELAXED, __HIP_MEMORY_SCOPE_AGENT); }
__device__ __forceinline__ unsigned xb_xcc_id() { return (unsigned)__builtin_amdgcn_s_getreg((3 << 11) | 20) & 0xFu; }
#define XB_SPIN(cond, bar) do { unsigned _sp = 0; while (cond) { __builtin_amdgcn_s_sleep(1); \
    if ((++_sp & 255u) == 0u) { if (xb_ld(&(bar)[XB_TMO])) break; if (_sp > XB_SPIN_CAP) { atomicAdd(&(bar)[XB_TMO], 1u); break; } } } } while (0)

struct XcdBarrier {
    unsigned* bar; unsigned x;
    volatile LAS unsigned* st;
};

__device__ __forceinline__ XcdBarrier xcd_barrier_post(unsigned* bar, volatile LAS unsigned* st) {
    XcdBarrier b; b.bar = bar; b.x = xb_xcc_id(); b.st = st;
    if (threadIdx.x == 0) (void)xb_add(&bar[XB_XCNT(b.x)], 1u);
    return b;
}
__device__ __forceinline__ void xcd_barrier_complete(unsigned* bar, unsigned x, unsigned& nloc, unsigned& nx) {
    const unsigned G = gridDim.x * gridDim.y * gridDim.z;
    unsigned sum, cnt, mine, sp = 0u;
    for (;;) {
        sum = 0u; cnt = 0u; mine = 0u;
#pragma unroll
        for (unsigned j = 0; j < 16; ++j) { const unsigned c = xb_ld(&bar[XB_XCNT(j)]); sum += c; cnt += (c > 0u) ? 1u : 0u; mine = (j == x) ? c : mine; }
        if (sum == G) break;
        __builtin_amdgcn_s_sleep(1);
        if ((++sp & 255u) == 0u) { if (xb_ld(&bar[XB_TMO])) break; if (sp > XB_SPIN_CAP) { atomicAdd(&bar[XB_TMO], 1u); break; } }
    }
    nloc = mine > 0u ? mine : 1u; nx = cnt > 0u ? cnt : 1u;
}

__device__ __forceinline__ void xcd_barrier(const XcdBarrier& b) {
    asm volatile("s_waitcnt vmcnt(0)" ::: "memory");
    __syncthreads();
    if (threadIdx.x == 0) {
        unsigned* bar = b.bar;
        __builtin_amdgcn_s_waitcnt(0);
        unsigned nloc = b.st[0], nx = b.st[1];
        if (nloc == 0u) { xcd_barrier_complete(bar, b.x, nloc, nx); b.st[0] = nloc; b.st[1] = nx; }
        const unsigned old = xb_add(&bar[XB_XSUB(b.x)], 1u);
        const unsigned gen = old / nloc;
        if (old + 1u == (gen + 1u) * nloc) {
            __builtin_amdgcn_fence(__ATOMIC_RELEASE, "agent");
            asm volatile("s_waitcnt vmcnt(0)" ::: "memory");
            const unsigned og = xb_add(&bar[XB_TOP], 1u);
            const unsigned tg = og / nx;
            if (og + 1u == (tg + 1u) * nx) xb_add(&bar[XB_TOPGEN], 1u);
            else XB_SPIN(xb_ld(&bar[XB_TOPGEN]) == tg, bar);
            __builtin_amdgcn_fence(__ATOMIC_ACQUIRE, "agent");
            xb_add(&bar[XB_XGEN(b.x)], 1u);
            asm volatile("s_waitcnt vmcnt(0)" ::: "memory");
        } else {
            XB_SPIN(xb_ld(&bar[XB_XGEN(b.x)]) == gen, bar);
            __builtin_amdgcn_fence(__ATOMIC_ACQUIRE, "agent");
            asm volatile("s_waitcnt vmcnt(0)" ::: "memory");
        }
    }
    __syncthreads();
}

#define GAS1 __attribute__((address_space(1)))
__device__ __forceinline__ unsigned long long karg(int k) {
    const __attribute__((address_space(4))) unsigned long long* ka = (const __attribute__((address_space(4))) unsigned long long*)__builtin_amdgcn_kernarg_segment_ptr();
    asm volatile("" : "+s"(ka)); return ka[k];
}
#define MIX_UNPACK(u, f) do { f[0] = __uint_as_float(u.x << 16); f[1] = __uint_as_float(u.x & 0xffff0000u); f[2] = __uint_as_float(u.y << 16); f[3] = __uint_as_float(u.y & 0xffff0000u); \
    f[4] = __uint_as_float(u.z << 16); f[5] = __uint_as_float(u.z & 0xffff0000u); f[6] = __uint_as_float(u.w << 16); f[7] = __uint_as_float(u.w & 0xffff0000u); } while (0)
template <int W> __device__ __forceinline__ void mix_rows16(const bf16* Pb, bf16* CAT, int r0, int colgrp) {
    const int t0 = r0 & (SEQ - 1);
    const bf16* pp = Pb + (size_t)r0 * 512 + colgrp * 8; bf16* op = CAT + (size_t)r0 * DM + 512 + colgrp * 8;
    v4u rw[W - 1 + 16];
#pragma unroll
    for (int k = 0; k < W - 1 + 16; ++k) { const int rel = k - (W - 1); rw[k] = *(const v4u*)(pp + (ptrdiff_t)((t0 + rel >= 0) ? rel : 0) * 512); }
    float sum[8];
#pragma unroll
    for (int j = 0; j < 8; ++j) sum[j] = 0.f;
#pragma unroll
    for (int k = 0; k < W - 1; ++k) { const float m = (t0 + k - (W - 1) >= 0) ? 1.0f : 0.0f; float f[8]; MIX_UNPACK(rw[k], f);
#pragma unroll
        for (int j = 0; j < 8; ++j) sum[j] += m * f[j]; }
#pragma unroll
    for (int i = 0; i < 16; ++i) { float cur[8]; asm volatile("" : "+v"(rw[W - 1 + i]));
        MIX_UNPACK(rw[W - 1 + i], cur);
        const int t = t0 + i; const float rc = 1.0f / (float)((t + 1 < W) ? t + 1 : W); float o[8];
#pragma unroll
        for (int j = 0; j < 8; ++j) { sum[j] += cur[j]; o[j] = sum[j] * rc - cur[j]; }
        *(v4u*)(op + (size_t)i * DM) = (v4u){pk2(o[0], o[1]), pk2(o[2], o[3]), pk2(o[4], o[5]), pk2(o[6], o[7])};
        { const float m = (t + 1 - W >= 0) ? 1.0f : 0.0f; float f[8]; asm volatile("" : "+v"(rw[i])); MIX_UNPACK(rw[i], f);
#pragma unroll
            for (int j = 0; j < 8; ++j) sum[j] -= m * f[j]; } }
}

#ifdef USE_CG_SYNC
#define GSYNC() grid.sync()
#else
#define GSYNC() xcd_barrier(xbar)
#endif
#ifdef TIMING
#ifndef MASKA
#define MASKA 0
#endif
#ifndef MASKB
#define MASKB 0
#endif
#define TSTAMP(id) do { const unsigned long long t_ = __builtin_amdgcn_s_memrealtime(); const unsigned long long d_ = t_ - t_prev; t_prev = t_; if ((MASKA >> (id)) & 1) accA += d_; if ((MASKB >> (id)) & 1) accB += d_; } while (0)
#else
#define TSTAMP(id) do {} while (0)
#endif
struct Args { const float* in[20]; float* out; unsigned char* ws; };

__global__ void __launch_bounds__(NWAVES * 64, 2) fwd_megakernel(Args args) {
    extern __shared__ __attribute__((aligned(16))) unsigned char lds[];
    cg::grid_group grid = cg::this_grid();
    LAS unsigned char* const L = (LAS unsigned char*)lds;
    const int wave = __builtin_amdgcn_readfirstlane((int)threadIdx.x >> 6);
    const int G = gridDim.x, bx = blockIdx.x;
    const int vcu = (G % 8 == 0) ? (bx % 8) * (G / 8) + bx / 8 : bx;
    LAS float* const EX = (LAS float*)(L + EPIX_OFF);
    if (threadIdx.x < 2) ((LAS unsigned*)(L + XBST_OFF))[threadIdx.x] = 0u;
    __syncthreads();
    const XcdBarrier xbar = xcd_barrier_post((unsigned*)((unsigned char*)(GAS1 unsigned char*)karg(21) + WS_BAR), (volatile LAS unsigned*)(L + XBST_OFF));
#define DEFPTRS \
    int tid = threadIdx.x; asm volatile("" : "+v"(tid)); const int lane = tid & 63; (void)lane; \
    unsigned char* const ws = (unsigned char*)(GAS1 unsigned char*)karg(21); float* const out = (float*)(GAS1 float*)karg(20); (void)out; \
    bf16* const HB = (bf16*)(ws + WS_HB); bf16* const Qb = (bf16*)(ws + WS_Q); bf16* const Kb = (bf16*)(ws + WS_K); bf16* const Vb = (bf16*)(ws + WS_V); bf16* const Pb = (bf16*)(ws + WS_P); \
    bf16* const CAT = (bf16*)(ws + WS_CAT); bf16* const MQ = (bf16*)(ws + WS_MQ); bf16* const MO = (bf16*)(ws + WS_MO); bf16* const ACT = (bf16*)(ws + WS_ACT); \
    float* const LF = (float*)(ws + WS_LF); float* const NC2 = (float*)(ws + WS_NC2); float* const SSQ = (float*)(ws + WS_SSQ); \
    bf16* const MN = (bf16*)(ws + WS_MN); bf16* const MK = (bf16*)(ws + WS_MK); bf16* const MVT = (bf16*)(ws + WS_MVT); \
    (void)HB; (void)Qb; (void)Kb; (void)Vb; (void)Pb; (void)CAT; (void)MQ; (void)MO; (void)ACT; (void)LF; (void)NC2; (void)SSQ; (void)MN; (void)MK; (void)MVT;
#define IN(k) ((const float*)(GAS1 const float*)karg(k))

#ifdef TIMING
    unsigned long long t_prev = __builtin_amdgcn_s_memrealtime(), accA = 0, accB = 0;
#endif
    if constexpr ((PHMASK >> 0) & 1) { DEFPTRS
        LAS float* scr = (LAS float*)(L + wave * 16640);
        const int gw = vcu * NWAVES + wave, NGW = G * NWAVES;
        constexpr int I_IN = 16 * 36, I_OUT = 8 * 16, I_MQ = 16 * 8, I_MKV = 16 * 16, I_MO = 8 * 16, I_GU = 16 * 88, I_D = 44 * 16, I_L = I_IN + I_OUT + I_MQ + I_MKV + I_MO + I_GU + I_D;
        for (int it = gw; it < DEPTH * I_L; it += NGW) {
            const int l = it / I_L; int r = it % I_L; unsigned char* wl = ws + WS_W + (size_t)l * WS_WSTRIDE;
            if (r < I_IN) { const int kb = r / 36, nb = r % 36; tr_item(IN(3) + (size_t)l * DM * NIN, NIN, 64 * kb, 64 * nb, IN(2) + l * DM, (bf16*)(wl + WO_IN), DM, 64 * nb, scr, lane); continue; } r -= I_IN;
            if (r < I_OUT) { const int kb = r / 16, nb = r % 16; tr_item(IN(9) + (size_t)l * DM * DM, DM, 64 * kb, 64 * nb, nullptr, (bf16*)(wl + WO_OUT), DM, 64 * nb, scr, lane); continue; } r -= I_OUT;
            if (r < I_MQ) { const int kb = r / 8, nb = r % 8; tr_item(IN(12) + (size_t)l * DM * 512, 512, 64 * kb, 64 * nb, IN(10) + l * DM, (bf16*)(wl + WO_MQ), DM, 64 * nb, scr, lane); continue; } r -= I_MQ;
            if (r < I_MKV) { const int kb = r / 16, nb = r % 16; tr_item(IN(13) + (size_t)l * DM * 1024, 1024, 64 * kb, 64 * nb, nullptr, (bf16*)(wl + WO_MKV), DM, 64 * nb, scr, lane); continue; } r -= I_MKV;
            if (r < I_MO) { const int kb = r / 16, nb = r % 16; tr_item(IN(16) + (size_t)l * 512 * DM, DM, 64 * kb, 64 * nb, nullptr, (bf16*)(wl + WO_MO), 512, 64 * nb, scr, lane); continue; } r -= I_MO;
            if (r < I_GU) { const int kb = r / 88, nb = r % 88; const int n0 = 64 * nb; const int drow = (n0 < DFF) ? (n0 / 128) * 256 + (n0 % 128) : ((n0 - DFF) / 128) * 256 + 128 + ((n0 - DFF) % 128);
                tr_item(IN(18) + (size_t)l * DM * 2 * DFF, 2 * DFF, 64 * kb, n0, IN(17) + l * DM, (bf16*)(wl + WO_GU), DM, drow, scr, lane); continue; } r -= I_GU;
            { const int kb = r / 16, nb = r % 16; tr_item(IN(19) + (size_t)l * DFF * DM, DM, 64 * kb, 64 * nb, nullptr, (bf16*)(wl + WO_D), DFF, 64 * nb, scr, lane); }
        }
        if (bx == 0 && tid < DEPTH) ((unsigned*)(ws + WS_QCNT))[tid * 64] = 0u;
        for (int tw = __builtin_amdgcn_readfirstlane(bx * 8 + wave); tw < DEPTH * 64 * 16; tw += G * 8) {
            const int l = tw / 1024, rem = tw % 1024, kc8 = rem >> 4, n = (rem & 15) * 64 + lane, g = kc8 >> 4, c0 = (kc8 & 15) * 8;
            const float* wp = IN(7) + ((size_t)(l * 4 + g) * 128 + c0) * 128; const float* ps = IN(8) + l * 512 + g * 128; const float* wo = IN(9) + (size_t)l * DM * DM + (size_t)(512 + g * 128) * DM + n;
            float a[8];
#pragma unroll
            for (int j = 0; j < 8; ++j) a[j] = 0.f;
#pragma unroll 8
            for (int d = 0; d < 128; ++d) { const float wv = wo[(size_t)d * DM] * ps[d];
#pragma unroll
                for (int j = 0; j < 8; ++j) a[j] += wp[j * 128 + d] * wv; }
            *(v4u*)((bf16*)(ws + WS_W + (size_t)l * WS_WSTRIDE + WO_OUT) + (size_t)n * DM + 512 + g * 128 + c0) = (v4u){pk2(a[0], a[1]), pk2(a[2], a[3]), pk2(a[4], a[5]), pk2(a[6], a[7])};
        }
        {
            f32x4 wf[4][4][2];
#pragma unroll
            for (int j = 0; j < 4; ++j)
#pragma unroll
                for (int c = 0; c < 4; ++c) { const int k = 256 * j + 4 * lane + c; const float gk = IN(2)[k]; const float* wr = IN(3) + (size_t)k * NIN + 2048;
                    wf[j][c][0] = *(const f32x4*)wr * gk; wf[j][c][1] = *(const f32x4*)(wr + 4) * gk; }
            const float bfo = IN(4)[lane & 7];
        for (int m0 = gw * 4; m0 < MTOK; m0 += NGW * 4) {
            f32x4 v[4][4]; float sq[4];
#pragma unroll
            for (int r = 0; r < 4; ++r) { const f32x4* xr = (const f32x4*)(IN(0) + (size_t)(m0 + r) * DM) + lane;
#pragma unroll
                for (int j = 0; j < 4; ++j) v[r][j] = __builtin_nontemporal_load(xr + 64 * j); }
#pragma unroll
            for (int r = 0; r < 4; ++r) { float s = 0.f;
#pragma unroll
                for (int j = 0; j < 4; ++j) s += (v[r][j].x * v[r][j].x + v[r][j].y * v[r][j].y) + (v[r][j].z * v[r][j].z + v[r][j].w * v[r][j].w);
                sq[r] = wave_sum(s); }
#pragma unroll
            for (int r = 0; r < 4; ++r) { v2u* o8 = (v2u*)(HB + (size_t)(m0 + r) * DM) + lane;
#pragma unroll
                for (int j = 0; j < 4; ++j) o8[64 * j] = (v2u){pk2(v[r][j].x, v[r][j].y), pk2(v[r][j].z, v[r][j].w)};
                if (lane < 16) SSQ[(size_t)(m0 + r) * 16 + lane] = (lane == 0) ? sq[r] : 0.f;
                f32x4 d0 = (f32x4){0.f, 0.f, 0.f, 0.f}, d1 = d0;
#pragma unroll
                for (int j = 0; j < 4; ++j) { d0 += wf[j][0][0] * v[r][j].x + wf[j][1][0] * v[r][j].y + wf[j][2][0] * v[r][j].z + wf[j][3][0] * v[r][j].w;
                                              d1 += wf[j][0][1] * v[r][j].x + wf[j][1][1] * v[r][j].y + wf[j][2][1] * v[r][j].z + wf[j][3][1] * v[r][j].w; }
                float f8[8] = {d0.x, d0.y, d0.z, d0.w, d1.x, d1.y, d1.z, d1.w};
#pragma unroll
                for (int o = 0; o < 8; ++o) f8[o] = wave_sum(f8[o]);
                float mine = f8[0];
#pragma unroll
                for (int o = 1; o < 8; ++o) mine = ((lane & 7) == o) ? f8[o] : mine;
                const float rstd = __builtin_amdgcn_rsqf(sq[r] * (1.0f / DM) + EPS);
                if (lane < 8) LF[(size_t)(m0 + r) * 8 + lane] = pg8::log2sigmoid(mine * rstd + bfo); }
        }
        }
        for (int m = gw; m < DEPTH * BATCH * MEMLEN; m += NGW) {
            const int l = m / (BATCH * MEMLEN), rr = m % (BATCH * MEMLEN);
            const f32x4* xr = (const f32x4*)(IN(1) + (size_t)rr * DM) + lane; const f32x4* gr = (const f32x4*)(IN(11) + l * DM) + lane; f32x4 v[4]; float s = 0.f;
#pragma unroll
            for (int j = 0; j < 4; ++j) { v[j] = xr[64 * j]; s += (v[j].x * v[j].x + v[j].y * v[j].y) + (v[j].z * v[j].z + v[j].w * v[j].w); }
            const float rstd = 1.0f / sqrtf(wave_sum(s) * (1.0f / DM) + EPS);
            v2u* o8 = (v2u*)(MN + (size_t)m * DM) + lane;
#pragma unroll
            for (int j = 0; j < 4; ++j) { const f32x4 gg = gr[64 * j]; o8[64 * j] = (v2u){pk2(v[j].x * rstd * gg.x, v[j].y * rstd * gg.y), pk2(v[j].z * rstd * gg.z, v[j].w * rstd * gg.w)}; }
        }
    }
    grid.sync();
    TSTAMP(0);

    for (int l = 0; l < DEPTH; ++l) {
        if constexpr ((PHMASK >> 1) & 1) { DEFPTRS
            const int nin = 2048;
            if (l > 0) {
                const float* FPb = (const float*)(ws + WS_FP); const float* bfp = IN(4) + l * 8;
                for (int row = bx * 512 + tid; row < MTOK; row += G * 512) {
                    const f32x4* p = (const f32x4*)(FPb + (size_t)row * 128); f32x4 a0 = p[0], a1 = p[1];
#pragma unroll
                    for (int si = 1; si < 16; ++si) { a0 += p[2 * si]; a1 += p[2 * si + 1]; }
                    const float rs = pg8::rstd_row(SSQ, row); const f32x4 b0 = *(const f32x4*)bfp, b1 = *(const f32x4*)(bfp + 4);
                    const f32x4 z0 = a0 * rs + b0, z1 = a1 * rs + b1;
                    *(f32x4*)(LF + (size_t)row * 8) = (f32x4){pg8::log2sigmoid(z0[0]), pg8::log2sigmoid(z0[1]), pg8::log2sigmoid(z0[2]), pg8::log2sigmoid(z0[3])};
                    *(f32x4*)(LF + (size_t)row * 8 + 4) = (f32x4){pg8::log2sigmoid(z1[0]), pg8::log2sigmoid(z1[1]), pg8::log2sigmoid(z1[2]), pg8::log2sigmoid(z1[3])};
                }
            }
            pg8::Gemm g{HB, (const bf16*)(ws + WS_W + (size_t)l * WS_WSTRIDE + WO_IN), MTOK, nin, DM}; pg8::StaticOrder S; S.init(MTOK, nin, G, bx);
            pg8::EpiInProj E{SSQ, Qb, Kb, Vb, Pb, LF, IN(5) + l * 64, IN(6) + l * 64, IN(4) + l * 8, EX, 0.125f * pg8::LOG2E, -1};
            pg8::gemm_phase<pg8::EpiInProj, pg8::StaticOrder, true, true>(L, g, S, E);
#ifdef EXP_DUP_G1
            pg8::gemm_phase<pg8::EpiInProj, pg8::StaticOrder, true, true>(L, g, S, E);
#endif
        }
        GSYNC(); TSTAMP(1);
        if constexpr ((PHMASK >> 2) & 1) { DEFPTRS
            if (bx < 64) {
                const int b = bx >> 3, h = bx & 7; const float* src = LF + ((size_t)b * SEQ + tid * 16) * 8 + h; float v[16]; float s = 0.f;
#pragma unroll
                for (int j = 0; j < 16; ++j) { s += src[j * 8]; v[j] = s; }
                LAS float* sc = (LAS float*)L; sc[tid] = s; __syncthreads();
                for (int off = 1; off < 512; off <<= 1) { const float t = (tid >= off) ? sc[tid - off] : 0.f; __syncthreads(); sc[tid] += t; __syncthreads(); }
                const float excl = sc[tid] - s; float* dst = NC2 + (size_t)bx * SEQ + tid * 16; LAS float* ncl = (LAS float*)(L + 4096) + tid * 16;
#pragma unroll
                for (int j = 0; j < 16; j += 4) { const f32x4 nv = (f32x4){-(excl + v[j]), -(excl + v[j + 1]), -(excl + v[j + 2]), -(excl + v[j + 3])}; *(f32x4*)(dst + j) = nv; *(LAS f32x4*)(ncl + j) = nv; }
                __syncthreads();
                if (tid < 32) {
                    float gq = 0.f, gk = 0.f; const float* gqp = IN(5) + l * 64; const float* gkp = IN(6) + l * 64;
                    for (int d = 0; d < 64; ++d) { gq = fmaxf(gq, fabsf(gqp[d])); gk = fmaxf(gk, fabsf(gkp[d])); }
                    const float thresh = 2.0f * (64.0f * gq * gk * 0.125f * pg8::LOG2E) + 20.0f;
                    const LAS float* nc = (const LAS float*)(L + 4096); const float ref = nc[256 * tid]; int t = 0;
                    while (t < 4 * tid && ref - nc[64 * t + 63] > thresh) ++t;
                    ((int*)(ws + WS_TS))[bx * 32 + tid] = t & ~1;
                }
                __syncthreads();
            } else if (l == 0 && bx < 128) {
                const int l2 = (bx - 64) >> 5;
                pg8::Gemm g{MN + (size_t)l2 * BATCH * MEMLEN * DM, (const bf16*)(ws + WS_W + (size_t)l2 * WS_WSTRIDE + WO_MKV), BATCH * MEMLEN, 1024, DM};
                pg8::RangeOrder S{4, 64 + 32 * l2, 32, bx};
                pg8::EpiHead128<1> E{nullptr, MK + (size_t)l2 * BATCH * 4 * MEMLEN * 128, MVT + (size_t)l2 * BATCH * 4 * MEMLEN * 128, IN(15) + l2 * 128, EX, 1.0f};
                pg8::gemm_phase<pg8::EpiHead128<1>, pg8::RangeOrder, true, true>(L, g, S, E);
            }
            for (int T = bx * 512 + tid; T < (MTOK / 16) * 64; T += G * 512) {
                const int wv = T >> 6, g = __builtin_amdgcn_readfirstlane(wv & 3), r0 = ((wv >> 2) * 4 + (lane >> 4)) * 16, colgrp = g * 16 + (lane & 15);
                if (g == 0) mix_rows16<2>(Pb, CAT, r0, colgrp); else if (g == 1) mix_rows16<4>(Pb, CAT, r0, colgrp); else if (g == 2) mix_rows16<8>(Pb, CAT, r0, colgrp); else mix_rows16<16>(Pb, CAT, r0, colgrp);
            }
        }
        GSYNC(); TSTAMP(2);
        if constexpr ((PHMASK >> 3) & 1) { DEFPTRS
            const attn_body::AttnTensors AT{(const attn_body::bf16*)Qb, (const attn_body::bf16*)Kb, (const attn_body::bf16*)Vb, (attn_body::bf16*)CAT, NC2, (const int*)(ws + WS_TS)};
            { const int* tsg = (const int*)(ws + WS_TS); LAS int* tsl = (LAS int*)(L + attn_body::LDS_TSL); for (int i = tid; i < 2048; i += 512) tsl[i] = tsg[i]; }
            const attn_body::QueueOrder S{(unsigned*)(ws + WS_QCNT) + l * 64, (volatile LAS unsigned*)(L + attn_body::ATTN_LDS_BYTES), 0u};
            attn_body::attn_phase<attn_body::QueueOrder, 20>((char*)lds, AT, S);
        }
        GSYNC(); TSTAMP(3);
        if constexpr ((PHMASK >> 4) & 1) { DEFPTRS
            pg8::Gemm g{CAT, (const bf16*)(ws + WS_W + (size_t)l * WS_WSTRIDE + WO_OUT), MTOK, DM, DM}; pg8::StaticOrder S; S.init(MTOK, DM, G, bx);
            pg8::EpiResid E{nullptr, nullptr, HB, SSQ, nullptr, nullptr};
            pg8::gemm_phase<pg8::EpiResid, pg8::StaticOrder, false, true>(L, g, S, E);
        }
        GSYNC(); TSTAMP(4);
        if constexpr ((PHMASK >> 5) & 1) { DEFPTRS
            pg8::Gemm g{HB, (const bf16*)(ws + WS_W + (size_t)l * WS_WSTRIDE + WO_MQ), MTOK, 512, DM}; pg8::StaticOrder S; S.init(MTOK, 512, G, bx);
            pg8::EpiHead128<0> E{SSQ, MQ, nullptr, IN(14) + l * 128, EX, 0.08838834764831845f * pg8::LOG2E};
            pg8::gemm_phase<pg8::EpiHead128<0>, pg8::StaticOrder, true, true>(L, g, S, E);
#ifdef EXP_DUP_G3
            pg8::gemm_phase<pg8::EpiHead128<0>, pg8::StaticOrder, true, true>(L, g, S, E);
#endif
        }
        GSYNC(); TSTAMP(5);
        if constexpr ((PHMASK >> 6) & 1) { DEFPTRS
            const int bh = vcu >> 3, b = bh >> 2, h = bh & 3;
            if (bh < BATCH * 4) {
                xat::load_kv(MK + ((size_t)l * BATCH * 4 + bh) * MEMLEN * 128, MVT + ((size_t)l * BATCH * 4 + bh) * MEMLEN * 128, L, tid);
                __syncthreads();
                for (int i = 0; i < 4; ++i) xat::unit(MQ, MO, b, h, (vcu & 7) * 4 + i, L);
                __syncthreads();
            }
        }
        GSYNC(); TSTAMP(6);
        if constexpr ((PHMASK >> 7) & 1) { DEFPTRS
            pg8::Gemm g{MO, (const bf16*)(ws + WS_W + (size_t)l * WS_WSTRIDE + WO_MO), MTOK, DM, 512}; pg8::StaticOrder S; S.init(MTOK, DM, G, bx);
            pg8::EpiResid E{nullptr, nullptr, HB, SSQ, nullptr, nullptr};
            pg8::gemm_phase<pg8::EpiResid, pg8::StaticOrder, false, true>(L, g, S, E);
        }
        GSYNC(); TSTAMP(7);
        if constexpr ((PHMASK >> 8) & 1) { DEFPTRS
            pg8::Gemm g{HB, (const bf16*)(ws + WS_W + (size_t)l * WS_WSTRIDE + WO_GU), MTOK, 2 * DFF, DM}; pg8::StaticOrder S; S.init(MTOK, 2 * DFF, G, bx);
            pg8::EpiSwiglu E{SSQ, ACT, EX, -1};
            pg8::gemm_phase<pg8::EpiSwiglu, pg8::StaticOrder, true, true>(L, g, S, E);
        }
        GSYNC(); TSTAMP(8);
        if constexpr ((PHMASK >> 9) & 1) { DEFPTRS
            pg8::Gemm g{ACT, (const bf16*)(ws + WS_W + (size_t)l * WS_WSTRIDE + WO_D), MTOK, DM, DFF}; pg8::StaticOrder S; S.init(MTOK, DM, G, bx);
            pg8::EpiResid E{nullptr, (l == DEPTH - 1) ? out : nullptr, HB, SSQ, (l + 1 < DEPTH) ? (const bf16*)(ws + WS_W + (size_t)(l + 1) * WS_WSTRIDE + WO_IN) + (size_t)2048 * DM : nullptr, (float*)(ws + WS_FP)};
            pg8::gemm_phase<pg8::EpiResid, pg8::StaticOrder, false, true>(L, g, S, E);
        }
#ifdef TIMING
        GSYNC(); TSTAMP(9);
#else
        if (l + 1 < DEPTH) GSYNC();
#endif
    }
#ifdef TIMING
    {
        DEFPTRS
#ifdef TIMING_CAL
        const unsigned long long n = 1000000ull;
#else
        const unsigned long long n = (accA / 400ull) + 1000ull * (accB / 400ull);
#endif
        if (bx == 0) for (unsigned long long i = tid; i < n; i += 512) out[i] += 0.125f;
    }
#endif
}

extern "C" void kernel_launch(void* const* d_in, const int* in_sizes, int n_in, void* d_out, int out_size, void* d_ws, size_t ws_size, hipStream_t stream) {
    static int grid = 0;
    if (grid == 0) {
        if (n_in != 20 || out_size != MTOK * DM || ws_size < WS_END) { fprintf(stderr, "kernel_launch: unexpected shapes (n_in %d, out %d, ws %zu)\n", n_in, out_size, ws_size); grid = -1; return; }
        int dev = 0, cus = 0, per_cu = 0;
        if (hipGetDevice(&dev) != hipSuccess || hipDeviceGetAttribute(&cus, hipDeviceAttributeMultiprocessorCount, dev) != hipSuccess) { grid = -1; return; }
        if (hipFuncSetAttribute((const void*)fwd_megakernel, hipFuncAttributeMaxDynamicSharedMemorySize, LDS_BYTES) != hipSuccess) { fprintf(stderr, "kernel_launch: hipFuncSetAttribute failed\n"); grid = -1; return; }
        if (hipOccupancyMaxActiveBlocksPerMultiprocessor(&per_cu, (const void*)fwd_megakernel, NWAVES * 64, LDS_BYTES) != hipSuccess || per_cu < 1) { fprintf(stderr, "kernel_launch: occupancy query says %d\n", per_cu); per_cu = 1; }
        (void)hipGetLastError();
        grid = cus * 1;
        if (grid != 256) fprintf(stderr, "kernel_launch: %d CUs; the unit orders assume 256\n", grid);
    }
    if (grid < 0) return;
    if (hipMemsetAsync((char*)d_ws + WS_BAR, 0, WS_BAR_BYTES, stream) != hipSuccess) { fprintf(stderr, "kernel_launch: hipMemsetAsync failed\n"); return; }
    Args a{};
    for (int i = 0; i < 20; ++i) a.in[i] = (const float*)d_in[i];
    a.out = (float*)d_out; a.ws = (unsigned char*)d_ws;
    void* kargs[] = {&a};
    hipError_t e = hipLaunchCooperativeKernel((const void*)fwd_megakernel, dim3(grid), dim3(NWAVES * 64), kargs, LDS_BYTES, stream);
    if (e != hipSuccess) fprintf(stderr, "kernel_launch: cooperative launch failed: %s (grid %d)\n", hipGetErrorString(e), grid);
}
```

```cpp
#include <hip/hip_runtime.h>
#include <hip/hip_cooperative_groups.h>
#include <cstdio>
#include <cstdint>
#include <cstddef>
namespace pg8 {
#define PG8_LAS __attribute__((address_space(3)))
typedef unsigned short bf16_t;
typedef short bf16x8 __attribute__((ext_vector_type(8)));
typedef float f32x4 __attribute__((ext_vector_type(4)));
typedef unsigned u32x4 __attribute__((ext_vector_type(4)));
constexpr int BM = 256, BK = 64, HALF = 128, HTB = HALF * BK * 2  , STAGE_BYTES = 8 * HTB, NXCD = 8, WGM = 8;

__host__ __device__ __forceinline__ int lds_byte(int r, int c) { const int st = (r >> 4) * 2 + (c >> 5), rr = r & 15, cc = c & 31, ob = rr * 64 + cc * 2; return st * 1024 + (ob ^ (((ob >> 9) & 1) << 5)); }
__host__ __device__ __forceinline__ void stage_rc(int b, int& R, int& C) { const int st = b / 1024, sb = b % 1024, swz = sb ^ (((sb >> 9) & 1) << 5); R = (st >> 1) * 16 + swz / 64; C = (st & 1) * 32 + (swz % 64) / 2; }
__host__ __device__ __forceinline__ int perm32(int rho) { const int n = rho >> 4, i = rho & 15; return 8 * (i >> 2) + 4 * n + (i & 3); }

struct Unit { int pm, pn; };
struct Gemm { const bf16_t* A; const bf16_t* Bt; int M, N, K; };

struct StaticOrder {
    int nM, nN, nwg, G, c;
    __host__ __device__ void init(int M, int N, int G_, int c_) { nM = M / BM; nN = N / BM; nwg = nM * nN; G = G_; c = c_; }
    __host__ __device__ bool next(int i, Unit& u) const {
        const long L = (long)i * G + c; if (L >= nwg) return false;
        int wgid = (int)L; { const int q = nwg / NXCD, r = nwg % NXCD, xcd = wgid % NXCD, off = wgid / NXCD; wgid = (xcd < r ? xcd * (q + 1) : r * (q + 1) + (xcd - r) * q) + off; }
        const int nig = WGM * nN, gid = wgid / nig, fm = gid * WGM, gsz = (nM - fm) < WGM ? (nM - fm) : WGM;
        u.pm = fm + ((wgid % nig) % gsz); u.pn = (wgid % nig) / gsz; return true;
    }
    __device__ __forceinline__ void a_ready(const Unit&) const {}
    __device__ __forceinline__ void done(const Unit&) const {}
};

__device__ __forceinline__ unsigned cvt_pk_bf16(float lo, float hi) { unsigned r; asm volatile("v_cvt_pk_bf16_f32 %0, %1, %2" : "=v"(r) : "v"(lo), "v"(hi)); return r; }
typedef unsigned u32x2 __attribute__((ext_vector_type(2)));
constexpr float RMS_EPS = 1e-6f;
constexpr float LOG2E = 1.4426950408889634f;
__device__ __forceinline__ void epi_bar() { asm volatile("s_waitcnt lgkmcnt(0)\n\ts_barrier" ::: "memory"); }
__device__ __forceinline__ float sum4(f32x4 a) { return (a[0] + a[1]) + (a[2] + a[3]); }
__device__ __forceinline__ float sumsq4(f32x4 v) { return (v[0] * v[0] + v[1] * v[1]) + (v[2] * v[2] + v[3] * v[3]); }
__device__ __forceinline__ float rstd_row(const float* ssq, int row) {
    const f32x4* p = (const f32x4*)(ssq + (size_t)row * 16);
    const f32x4 a = p[0], b = p[1], c = p[2], d = p[3];
    return __builtin_amdgcn_rsqf(((sum4(a) + sum4(b)) + (sum4(c) + sum4(d))) * (1.0f / 1024.0f) + RMS_EPS);
}
__device__ __forceinline__ void rstd_to_lds(const float* ssq, int row0, PG8_LAS float* RS) {
    const int t = threadIdx.x; if (t < 256) RS[t] = rstd_row(ssq, row0 + t);
}
__device__ __forceinline__ u32x4 pack8(f32x4 a, f32x4 b) { u32x4 w; w.x = cvt_pk_bf16(a[0], a[1]); w.y = cvt_pk_bf16(a[2], a[3]); w.z = cvt_pk_bf16(b[0], b[1]); w.w = cvt_pk_bf16(b[2], b[3]); return w; }
__device__ __forceinline__ float log2sigmoid(float x) { return LOG2E * (fminf(x, 0.f) - log1pf(expf(-fabsf(x)))); }

struct EpiResid {
    static constexpr bool PERM = true, AFTER_DRAIN = false;
    const float* basef; float* outf; bf16_t* hb; float* ssq; const bf16_t* fw; float* fp;
    __device__ __forceinline__ void tail(const f32x4& o0, const f32x4& o1, size_t off, float& s) const {
        if (outf) { __builtin_nontemporal_store(o0, (f32x4*)(outf + off)); __builtin_nontemporal_store(o1, (f32x4*)(outf + off + 4)); }
        else { *(u32x4*)(hb + off) = pack8(o0, o1); s += sumsq4(o0) + sumsq4(o1); }
    }
    __device__ __forceinline__ void operator()(const f32x4 (&acc)[2][2][4][2], const Unit& u, int wr, int wc, int fr, int fq) const {
        const int col0 = u.pn * BM + wc * 32 + 8 * fq, row0 = u.pm * BM + wr * 64 + fr; const size_t off0 = (size_t)row0 * 1024 + col0;
        if (basef) {
#pragma unroll
            for (int ai = 0; ai < 2; ++ai) {
                f32x4 bf[4][2][2];
#pragma unroll
                for (int m = 0; m < 4; ++m)
#pragma unroll
                    for (int bj = 0; bj < 2; ++bj) { const float* p = basef + off0 + (size_t)(ai * HALF + m * 16) * 1024 + bj * HALF; bf[m][bj][0] = *(const f32x4*)p; bf[m][bj][1] = *(const f32x4*)(p + 4); }
                asm volatile("" ::: "memory");
#pragma unroll
                for (int m = 0; m < 4; ++m) { const size_t off = off0 + (size_t)(ai * HALF + m * 16) * 1024; float s = 0.f;
#pragma unroll
                    for (int bj = 0; bj < 2; ++bj) tail(bf[m][bj][0] + acc[ai][bj][m][0], bf[m][bj][1] + acc[ai][bj][m][1], off + bj * HALF, s);
                    if (!outf) { s += __shfl_xor(s, 16); s += __shfl_xor(s, 32); if (fq == 0) ssq[(size_t)(row0 + ai * HALF + m * 16) * 16 + u.pn * 4 + wc] = s; } }
                asm volatile("" ::: "memory");
            }
        } else {
            u32x4 bw[2][4][2]; bf16x8 wfr[2];
            if (fw) { wfr[0] = *(const bf16x8*)(fw + (size_t)fr * 1024 + col0); wfr[1] = *(const bf16x8*)(fw + (size_t)fr * 1024 + col0 + HALF); }
#pragma unroll
            for (int ai = 0; ai < 2; ++ai)
#pragma unroll
                for (int m = 0; m < 4; ++m)
#pragma unroll
                    for (int bj = 0; bj < 2; ++bj) bw[ai][m][bj] = *(const u32x4*)(hb + off0 + (size_t)(ai * HALF + m * 16) * 1024 + bj * HALF);
            asm volatile("" ::: "memory");
#pragma unroll
            for (int ai = 0; ai < 2; ++ai)
#pragma unroll
                for (int m = 0; m < 4; ++m) { const size_t off = off0 + (size_t)(ai * HALF + m * 16) * 1024; float s = 0.f; f32x4 fd = (f32x4){0.f, 0.f, 0.f, 0.f};
#pragma unroll
                    for (int bj = 0; bj < 2; ++bj) { const u32x4 w = bw[ai][m][bj];
                        const f32x4 b0 = (f32x4){__uint_as_float(w.x << 16), __uint_as_float(w.x & 0xffff0000u), __uint_as_float(w.y << 16), __uint_as_float(w.y & 0xffff0000u)};
                        const f32x4 b1 = (f32x4){__uint_as_float(w.z << 16), __uint_as_float(w.z & 0xffff0000u), __uint_as_float(w.w << 16), __uint_as_float(w.w & 0xffff0000u)};
                        const f32x4 o0 = b0 + acc[ai][bj][m][0], o1 = b1 + acc[ai][bj][m][1];
                        tail(o0, o1, off + bj * HALF, s);
                        if (fw) fd = __builtin_amdgcn_mfma_f32_16x16x32_bf16(wfr[bj], __builtin_bit_cast(bf16x8, pack8(o0, o1)), fd, 0, 0, 0); }
                    if (!outf) { s += __shfl_xor(s, 16); s += __shfl_xor(s, 32); if (fq == 0) ssq[(size_t)(row0 + ai * HALF + m * 16) * 16 + u.pn * 4 + wc] = s; }
                    if (fw && fq < 2) *(f32x4*)(fp + ((size_t)(row0 + ai * HALF + m * 16) * 16 + u.pn * 4 + wc) * 8 + 4 * fq) = fd;
                    asm volatile("" ::: "memory"); }
        }
    }
};

struct EpiInProj {
    static constexpr bool PERM = true, AFTER_DRAIN = false;
    const float* ssq; bf16_t *Q, *K, *V, *P; float* LF; const float *gq, *gk, *bfg; PG8_LAS float* X; float qscale; mutable int last_pm;
    __device__ __forceinline__ void operator()(const f32x4 (&acc)[2][2][4][2], const Unit& u, int wr, int wc, int fr, int fq) const {
        const int pn = u.pn, rl0 = wr * 64 + fr; PG8_LAS float* RS = X + 2048;
        const bool newpm = (u.pm != last_pm); last_pm = u.pm;
        if (newpm) rstd_to_lds(ssq, u.pm * BM, RS);
        if (pn < 4) {
#pragma unroll
            for (int ai = 0; ai < 2; ++ai)
#pragma unroll
                for (int m = 0; m < 4; ++m)
#pragma unroll
                    for (int bj = 0; bj < 2; ++bj) { float s = sumsq4(acc[ai][bj][m][0]) + sumsq4(acc[ai][bj][m][1]);
                        s += __shfl_xor(s, 16); s += __shfl_xor(s, 32);
                        if (fq == 0) X[(ai * HALF + rl0 + m * 16) * 8 + bj * 4 + wc] = s; }
        }
        if (newpm || pn < 4) epi_bar();
        if (pn < 4) {
            const float* g = (pn < 2) ? gq : gk; const float extra = (pn < 2) ? qscale : 1.0f; bf16_t* O = (pn < 2) ? Q : K;
            const int dcol = (wc & 1) * 32 + 8 * fq; const f32x4 g0 = *(const f32x4*)(g + dcol) * extra, g1 = *(const f32x4*)(g + dcol + 4) * extra;
            const int colb = (pn & 1) * 256 + wc * 32 + 8 * fq;
#pragma unroll
            for (int ai = 0; ai < 2; ++ai)
#pragma unroll
                for (int m = 0; m < 4; ++m) { const int rl = ai * HALF + rl0 + m * 16; bf16_t* rowp = O + (size_t)(u.pm * BM + rl) * 512 + colb; const float rsv = RS[rl];
#pragma unroll
                    for (int bj = 0; bj < 2; ++bj) { const float hs = X[rl * 8 + bj * 4 + (wc & 2)] + X[rl * 8 + bj * 4 + (wc & 2) + 1];
                        const float sc = rsv * __builtin_amdgcn_rsqf(hs * rsv * rsv * (1.0f / 64.0f) + RMS_EPS);
                        *(u32x4*)(rowp + bj * HALF) = pack8(acc[ai][bj][m][0] * sc * g0, acc[ai][bj][m][1] * sc * g1); }
                    asm volatile("" ::: "memory"); }
        } else if (pn < 8) {
            bf16_t* O = (pn < 6) ? V : P; const int colb = (pn & 1) * 256 + wc * 32 + 8 * fq;
#pragma unroll
            for (int ai = 0; ai < 2; ++ai)
#pragma unroll
                for (int m = 0; m < 4; ++m) { bf16_t* rowp = O + (size_t)(u.pm * BM + ai * HALF + rl0 + m * 16) * 512 + colb; const float rsv = RS[ai * HALF + rl0 + m * 16];
#pragma unroll
                    for (int bj = 0; bj < 2; ++bj) *(u32x4*)(rowp + bj * HALF) = pack8(acc[ai][bj][m][0] * rsv, acc[ai][bj][m][1] * rsv);
                    asm volatile("" ::: "memory"); }
        } else {
            if (wc == 0 && fq == 0) {
                const f32x4 b0 = *(const f32x4*)(bfg), b1 = *(const f32x4*)(bfg + 4);
#pragma unroll
                for (int ai = 0; ai < 2; ++ai)
#pragma unroll
                    for (int m = 0; m < 4; ++m) { float* lp = LF + (size_t)(u.pm * BM + ai * HALF + rl0 + m * 16) * 8; const float rsv = RS[ai * HALF + rl0 + m * 16];
                        const f32x4 z0 = acc[ai][0][m][0] * rsv + b0, z1 = acc[ai][0][m][1] * rsv + b1;
                        *(f32x4*)(lp) = (f32x4){log2sigmoid(z0[0]), log2sigmoid(z0[1]), log2sigmoid(z0[2]), log2sigmoid(z0[3])};
                        *(f32x4*)(lp + 4) = (f32x4){log2sigmoid(z1[0]), log2sigmoid(z1[1]), log2sigmoid(z1[2]), log2sigmoid(z1[3])}; }
            }
        }
    }
};

template <int MODE> struct EpiHead128 {
    static constexpr bool PERM = true, AFTER_DRAIN = false;
    const float* ssq; bf16_t* O; bf16_t* O2; const float* g; PG8_LAS float* X; float oscale;
    __device__ __forceinline__ void operator()(const f32x4 (&acc)[2][2][4][2], const Unit& u, int wr, int wc, int fr, int fq) const {
        const int pn = u.pn, rl0 = wr * 64 + fr; PG8_LAS float* RS = X + 2048;
        if (MODE == 0) rstd_to_lds(ssq, u.pm * BM, RS);
        if (MODE == 0 || pn < 2) {
#pragma unroll
            for (int ai = 0; ai < 2; ++ai)
#pragma unroll
                for (int m = 0; m < 4; ++m)
#pragma unroll
                    for (int bj = 0; bj < 2; ++bj) { float s = sumsq4(acc[ai][bj][m][0]) + sumsq4(acc[ai][bj][m][1]);
                        s += __shfl_xor(s, 16); s += __shfl_xor(s, 32);
                        if (fq == 0) X[(ai * HALF + rl0 + m * 16) * 8 + bj * 4 + wc] = s; }
            epi_bar();
            const int d0 = wc * 32 + 8 * fq; const f32x4 g0 = *(const f32x4*)(g + d0) * oscale, g1 = *(const f32x4*)(g + d0 + 4) * oscale;
#pragma unroll
            for (int ai = 0; ai < 2; ++ai)
#pragma unroll
                for (int m = 0; m < 4; ++m) { const int rl = ai * HALF + rl0 + m * 16; const float rsv = (MODE == 0) ? RS[rl] : 1.0f;
#pragma unroll
                    for (int bj = 0; bj < 2; ++bj) { const f32x4 xs = *(const PG8_LAS f32x4*)(X + rl * 8 + bj * 4);
                        const float sc = rsv * __builtin_amdgcn_rsqf(sum4(xs) * rsv * rsv * (1.0f / 128.0f) + RMS_EPS);
                        bf16_t* dst = (MODE == 0) ? O + (size_t)(u.pm * BM + rl) * 512 + pn * 256 + bj * HALF + d0
                                                  : O + ((size_t)(u.pm * 4 + 2 * pn + bj) * 256 + rl) * 128 + d0;
                        *(u32x4*)dst = pack8(acc[ai][bj][m][0] * sc * g0, acc[ai][bj][m][1] * sc * g1); }
                    asm volatile("" ::: "memory"); }
        } else {
            const int d0 = wc * 32 + 8 * fq;
#pragma unroll
            for (int ai = 0; ai < 2; ++ai)
#pragma unroll
                for (int m = 0; m < 4; ++m) { const int rl = ai * HALF + rl0 + m * 16;
#pragma unroll
                    for (int bj = 0; bj < 2; ++bj) { bf16_t* dst = O2 + ((size_t)(u.pm * 4 + 2 * (pn - 2) + bj) * 128 + d0) * 256 + rl;
                        const u32x4 w = pack8(acc[ai][bj][m][0], acc[ai][bj][m][1]);
                        dst[0 * 256] = (bf16_t)(w.x & 0xffffu); dst[1 * 256] = (bf16_t)(w.x >> 16); dst[2 * 256] = (bf16_t)(w.y & 0xffffu); dst[3 * 256] = (bf16_t)(w.y >> 16);
                        dst[4 * 256] = (bf16_t)(w.z & 0xffffu); dst[5 * 256] = (bf16_t)(w.z >> 16); dst[6 * 256] = (bf16_t)(w.w & 0xffffu); dst[7 * 256] = (bf16_t)(w.w >> 16); }
                    asm volatile("" ::: "memory"); }
        }
    }
};

struct EpiSwiglu {
    static constexpr bool PERM = true, AFTER_DRAIN = false;
    const float* ssq; bf16_t* ACT; PG8_LAS float* X; mutable int last_pm;
    __device__ __forceinline__ static f32x4 swi(f32x4 gt, f32x4 up) { f32x4 r;
#pragma unroll
        for (int j = 0; j < 4; ++j) { const float e = __builtin_amdgcn_exp2f(-LOG2E * gt[j]); r[j] = gt[j] * __builtin_amdgcn_rcpf(1.0f + e) * up[j]; }
        return r; }
    __device__ __forceinline__ void operator()(const f32x4 (&acc)[2][2][4][2], const Unit& u, int wr, int wc, int fr, int fq) const {
        const int rl0 = wr * 64 + fr, colb = u.pn * 128 + wc * 32 + 8 * fq; PG8_LAS float* RS = X + 2048;
        if (u.pm != last_pm) { last_pm = u.pm; rstd_to_lds(ssq, u.pm * BM, RS); epi_bar(); }
#pragma unroll
        for (int ai = 0; ai < 2; ++ai)
#pragma unroll
            for (int m = 0; m < 4; ++m) { const int row = u.pm * BM + ai * HALF + rl0 + m * 16; const float rs = RS[ai * HALF + rl0 + m * 16];
                const f32x4 a0 = swi(acc[ai][0][m][0] * rs, acc[ai][1][m][0] * rs), a1 = swi(acc[ai][0][m][1] * rs, acc[ai][1][m][1] * rs);
                *(u32x4*)(ACT + (size_t)row * 2816 + colb) = pack8(a0, a1); asm volatile("" ::: "memory"); }
    }
};

struct RangeOrder {
    int nN, c0, n, c;
    __host__ __device__ bool next(int i, Unit& u) const { const int k = c - c0; if (i != 0 || k < 0 || k >= n) return false; u.pm = k / nN; u.pn = k % nN; return true; }
    __device__ __forceinline__ void a_ready(const Unit&) const {}
    __device__ __forceinline__ void done(const Unit&) const {}
};
template <class Epi, class Sched, bool ALIGN_EPI = false, bool SP2 = false>
__device__ __forceinline__ void gemm_phase(PG8_LAS unsigned char* lds, const Gemm g, const Sched& S, const Epi& E) {
    int tid_l = threadIdx.x; asm volatile("" : "+v"(tid_l));
    const int tid = tid_l, wid = __builtin_amdgcn_readfirstlane(tid >> 6), lane = tid & 63, wr = wid >> 2, wc = wid & 3, fr = lane & 15, fq = lane >> 4;
    const int K = g.K, nt = K / BK;
    unsigned voffA[2], voffB[2];
#pragma unroll
    for (int i = 0; i < 2; ++i) { int R, C; stage_rc(tid * 16 + i * 8192, R, C); const int Rb = Epi::PERM ? ((R & ~31) + perm32(R & 31)) : R;
        voffA[i] = (unsigned)(R * K + C) * 2u; voffB[i] = (unsigned)(Rb * K + C) * 2u; }
    const size_t kstep = (size_t)(BK * 2);
    const size_t hstep = (size_t)HALF * K * 2;
    const size_t tstep = 2 * hstep;
    const unsigned ldsw = (unsigned)wid * 1024u;
    const int aoff = lds_byte(wr * 64 + fr, fq * 8), boff = lds_byte(wc * 32 + fr, fq * 8);
#define PG8_SA(b, h) (((b) * 2 + (h)) * HTB)
#define PG8_SB(b, h) ((4 + (b) * 2 + (h)) * HTB)
#define PG8_STAGE(bufoff, gbase, voff) do { _Pragma("unroll") for (int _i = 0; _i < 2; ++_i) \
        __builtin_amdgcn_global_load_lds((const unsigned*)((const char*)(gbase) + (voff)[_i]), (PG8_LAS unsigned*)(lds + (bufoff) + ldsw + _i * 8192), 16, 0, 0); } while (0)
#define PG8_LDA(dst, b, h) do { _Pragma("unroll") for (int m = 0; m < 4; ++m) _Pragma("unroll") for (int k = 0; k < 2; ++k) dst[m][k] = *(const PG8_LAS bf16x8*)(lds + PG8_SA(b, h) + aoff + m * 2048 + k * 1024); } while (0)
#define PG8_LDB(dst, b, h) do { _Pragma("unroll") for (int n = 0; n < 2; ++n) _Pragma("unroll") for (int k = 0; k < 2; ++k) dst[n][k] = *(const PG8_LAS bf16x8*)(lds + PG8_SB(b, h) + boff + n * 2048 + k * 1024); } while (0)
#define PG8_MMA(ai, bj, At, Bt) do { __builtin_amdgcn_s_setprio(1); _Pragma("unroll") for (int m = 0; m < 4; ++m) _Pragma("unroll") for (int n = 0; n < 2; ++n) _Pragma("unroll") for (int k = 0; k < 2; ++k) \
        acc[ai][bj][m][n] = __builtin_amdgcn_mfma_f32_16x16x32_bf16(Bt[n][k], At[m][k], acc[ai][bj][m][n], 0, 0, 0); __builtin_amdgcn_s_setprio(0); } while (0)
#define PG8_WAIT_V(n) asm volatile("s_waitcnt vmcnt(" #n ")" ::: "memory")
#define PG8_WAIT_L(n) asm volatile("s_waitcnt lgkmcnt(" #n ")" ::: "memory")
#define PG8_BAR __builtin_amdgcn_s_barrier()
#define PG8_SCHED __builtin_amdgcn_sched_barrier(0)
    Unit cur, nxt; int ui = 0;
    if (!S.next(0, cur)) return;
    f32x4 acc[2][2][4][2];
#pragma unroll
    for (int a = 0; a < 2; ++a)
#pragma unroll
        for (int b = 0; b < 2; ++b)
#pragma unroll
            for (int m = 0; m < 4; ++m)
#pragma unroll
                for (int n = 0; n < 2; ++n) acc[a][b][m][n] = (f32x4){0.f, 0.f, 0.f, 0.f};
    bf16x8 At[4][2], B0[2][2], B1[2][2];
    const char* cA = (const char*)g.A + (size_t)cur.pm * tstep; const char* cB = (const char*)g.Bt + (size_t)cur.pn * tstep;
    S.a_ready(cur);
    if constexpr (SP2) {
        PG8_STAGE(PG8_SB(0, 0), cB, voffB); PG8_STAGE(PG8_SB(0, 1), cB + hstep, voffB); PG8_STAGE(PG8_SA(0, 0), cA, voffA); PG8_STAGE(PG8_SA(0, 1), cA + hstep, voffA);
        if (wr == 1) PG8_BAR;
        PG8_WAIT_V(2); PG8_BAR;
        PG8_STAGE(PG8_SB(1, 0), cB + kstep, voffB); PG8_STAGE(PG8_SA(1, 0), cA + kstep, voffA); PG8_STAGE(PG8_SB(1, 1), cB + hstep + kstep, voffB);
        PG8_WAIT_V(6); PG8_BAR;
    } else {
        PG8_STAGE(PG8_SB(0, 0), cB, voffB); PG8_STAGE(PG8_SA(0, 0), cA, voffA); PG8_STAGE(PG8_SB(0, 1), cB + hstep, voffB); PG8_STAGE(PG8_SA(0, 1), cA + hstep, voffA);
        if (wr == 1) PG8_BAR;
        PG8_WAIT_V(4); PG8_BAR;
        PG8_STAGE(PG8_SB(1, 0), cB + kstep, voffB); PG8_STAGE(PG8_SA(1, 0), cA + kstep, voffA); PG8_STAGE(PG8_SB(1, 1), cB + hstep + kstep, voffB);
        PG8_WAIT_V(6); PG8_BAR;
    }
    for (;;) {
        const bool has_next = S.next(ui + 1, nxt);
        const char* nA = has_next ? (const char*)g.A + (size_t)nxt.pm * tstep : cA; const char* nB = has_next ? (const char*)g.Bt + (size_t)nxt.pn * tstep : cB;
        for (int t = 0; t < nt; t += 2) {
            const bool last = (t == nt - 2);
            const char* a1 = cA + (size_t)(t + 1) * kstep;
            const char* a2 = last ? nA : cA + (size_t)(t + 2) * kstep; const char* b2 = last ? nB : cB + (size_t)(t + 2) * kstep;
            const char* a3 = a2 + kstep; const char* b3 = b2 + kstep;
            if (last && has_next) S.a_ready(nxt);
            if constexpr (SP2) {
            PG8_LDB(B0, 0, 0); PG8_LDB(B1, 0, 1); PG8_SCHED; PG8_LDA(At, 0, 0); PG8_STAGE(PG8_SA(1, 1), a1 + hstep, voffA);
            PG8_WAIT_V(8); PG8_WAIT_L(0); PG8_BAR; PG8_MMA(0, 0, At, B0); PG8_MMA(0, 1, At, B1); PG8_BAR; PG8_SCHED;
            PG8_LDA(At, 0, 1); PG8_STAGE(PG8_SB(0, 0), b2, voffB); PG8_STAGE(PG8_SB(0, 1), b2 + hstep, voffB); PG8_STAGE(PG8_SA(0, 0), a2, voffA);
            PG8_WAIT_V(8); PG8_WAIT_L(0); PG8_BAR; PG8_MMA(1, 0, At, B0); PG8_MMA(1, 1, At, B1); PG8_BAR; PG8_SCHED;
            PG8_LDB(B0, 1, 0); PG8_LDB(B1, 1, 1); PG8_SCHED; PG8_LDA(At, 1, 0); PG8_STAGE(PG8_SA(0, 1), a2 + hstep, voffA);
            PG8_WAIT_V(8); PG8_WAIT_L(0); PG8_BAR; PG8_MMA(0, 0, At, B0); PG8_MMA(0, 1, At, B1); PG8_BAR; PG8_SCHED;
            PG8_LDA(At, 1, 1); PG8_STAGE(PG8_SB(1, 0), b3, voffB); PG8_STAGE(PG8_SB(1, 1), b3 + hstep, voffB); PG8_STAGE(PG8_SA(1, 0), a3, voffA);
            PG8_WAIT_V(8); PG8_WAIT_L(0); PG8_BAR; PG8_MMA(1, 0, At, B0); PG8_MMA(1, 1, At, B1); PG8_BAR; PG8_SCHED;
            } else {
            PG8_LDB(B0, 0, 0); PG8_SCHED; PG8_LDA(At, 0, 0); PG8_STAGE(PG8_SA(1, 1), a1 + hstep, voffA);
            PG8_WAIT_L(8); PG8_BAR; PG8_WAIT_L(0); PG8_MMA(0, 0, At, B0); PG8_BAR; PG8_SCHED;
            PG8_LDB(B1, 0, 1); PG8_STAGE(PG8_SB(0, 0), b2, voffB);
            PG8_BAR; PG8_WAIT_L(0); PG8_MMA(0, 1, At, B1); PG8_BAR;
            PG8_LDA(At, 0, 1); PG8_STAGE(PG8_SA(0, 0), a2, voffA);
            PG8_BAR; PG8_WAIT_L(0); PG8_MMA(1, 0, At, B0); PG8_BAR; PG8_SCHED;
            PG8_STAGE(PG8_SB(0, 1), b2 + hstep, voffB);
            PG8_WAIT_V(6); PG8_BAR; PG8_MMA(1, 1, At, B1); PG8_BAR;
            PG8_LDB(B0, 1, 0); PG8_SCHED; PG8_LDA(At, 1, 0); PG8_STAGE(PG8_SA(0, 1), a2 + hstep, voffA);
            PG8_WAIT_L(8); PG8_BAR; PG8_WAIT_L(0); PG8_MMA(0, 0, At, B0); PG8_BAR; PG8_SCHED;
            PG8_LDB(B1, 1, 1); PG8_STAGE(PG8_SB(1, 0), b3, voffB);
            PG8_BAR; PG8_WAIT_L(0); PG8_MMA(0, 1, At, B1); PG8_BAR;
            PG8_LDA(At, 1, 1); PG8_STAGE(PG8_SA(1, 0), a3, voffA);
            PG8_BAR; PG8_WAIT_L(0); PG8_MMA(1, 0, At, B0); PG8_BAR; PG8_SCHED;
            PG8_STAGE(PG8_SB(1, 1), b3 + hstep, voffB);
            PG8_WAIT_V(6); PG8_BAR; PG8_MMA(1, 1, At, B1); PG8_BAR;
            }
        }
        if constexpr (ALIGN_EPI) { if (wr == 0) PG8_BAR; }
        if constexpr (!Epi::AFTER_DRAIN) { E(acc, cur, wr, wc, fr, fq); S.done(cur); }
        if (!has_next) break;
#pragma unroll
        for (int a = 0; a < 2; ++a)
#pragma unroll
            for (int b = 0; b < 2; ++b)
#pragma unroll
                for (int m = 0; m < 4; ++m)
#pragma unroll
                    for (int n = 0; n < 2; ++n) acc[a][b][m][n] = (f32x4){0.f, 0.f, 0.f, 0.f};
        cur = nxt; cA = nA; cB = nB; ++ui;
        if constexpr (ALIGN_EPI) { if (wr == 1) PG8_BAR; }
    }
    PG8_WAIT_V(0);
    if constexpr (!ALIGN_EPI) { if (wr == 0) PG8_BAR; }
    PG8_BAR;
    if constexpr (Epi::AFTER_DRAIN) { E.fused(acc, cur, wr, wc, fr, fq, lds, wid, lane); S.done(cur); }
#undef PG8_SA
#undef PG8_SB
#undef PG8_STAGE
#undef PG8_LDA
#undef PG8_LDB
#undef PG8_MMA
#undef PG8_WAIT_V
#undef PG8_WAIT_L
#undef PG8_BAR
#undef PG8_SCHED
}
}
#include <hip/hip_bf16.h>
#include <cmath>
namespace attn_body {
using bf16=__hip_bfloat16;
using bf16x8=__attribute__((ext_vector_type(8)))short;
using s16x4=__attribute__((ext_vector_type(4)))short;
using f32x16=__attribute__((ext_vector_type(16)))float;
using u32x4=__attribute__((ext_vector_type(4)))unsigned;
using f32x4v=__attribute__((ext_vector_type(4)))float;
typedef const __attribute__((address_space(3))) f32x4v* lds_f4p;
constexpr int BATCH=8,NHEAD=8,SEQ=8192,D=64,DM=NHEAD*D,OPITCH=1024;
constexpr int NW=8,QBLK=32,QB=QBLK*NW,KVBLK=64,NQB=SEQ/QB;
constexpr int ATTN_PITCH=DM, ATTN_UNIT_ROWS=QB;
__device__ __forceinline__ int crow(int r,int hi){return (r&3)+8*(r>>2)+4*hi;}
#define SBAR() __builtin_amdgcn_sched_barrier(0)
__device__ __forceinline__ void cmask(f32x16&p0,f32x16&p1,int jb,int qrel,int hi){
  const float NEG=-INFINITY; int kb=64*jb+4*hi;
  #pragma unroll
  for(int r=0;r<16;++r){int kv=kb+(r&3)+8*(r>>2); if(kv>qrel)p0[r]=NEG; if(kv+32>qrel)p1[r]=NEG;}
}

constexpr int NSLOT=3, SLOTB=8192;
constexpr int LDS_K=0, LDS_V=NSLOT*SLOTB, LDS_WS=2*NSLOT*SLOTB, LDS_OST=LDS_WS+NW*64*4, LDS_C2=LDS_OST+NW*4096, LDS_BYTES=LDS_C2+SEQ*4, LDS_TSL=LDS_BYTES+1024;
constexpr float C2=0.125f*1.4426950408889634f;
__device__ __forceinline__ void glds16(const void*gsrc,unsigned lds_dst){unsigned keep;
  asm volatile("s_mov_b32 %0, m0\n\ts_mov_b32 m0, %2\n\ts_nop 0\n\tglobal_load_lds_dwordx4 %1, off\n\ts_mov_b32 m0, %0":"=&s"(keep):"v"(gsrc),"s"(lds_dst):"memory");}
__device__ __forceinline__ float max3f(float a,float b,float c){float r;asm("v_max3_f32 %0, %1, %2, %3":"=v"(r):"v"(a),"v"(b),"v"(c));return r;}
__device__ __forceinline__ float max2f(float a,float b){float r;asm("v_max_f32_e32 %0, %1, %2":"=v"(r):"v"(a),"v"(b));return r;}
__device__ __forceinline__ float fadd_s(float a,float b){float r;asm("v_add_f32_e32 %0, %1, %2":"=v"(r):"v"(a),"v"(b));return r;}
__device__ __forceinline__ float fsub_s(float a,float b){float r;asm("v_sub_f32_e32 %0, %1, %2":"=v"(r):"v"(a),"v"(b));return r;}
typedef float f32x2_t __attribute__((ext_vector_type(2))); typedef __bf16 bf16x2_t __attribute__((ext_vector_type(2)));
__device__ __forceinline__ unsigned cvtpk_s(float lo,float hi){f32x2_t v={lo,hi};bf16x2_t b=__builtin_convertvector(v,bf16x2_t);return __builtin_bit_cast(unsigned,b);}
#define WAIT_BAR(N) asm volatile("s_waitcnt vmcnt(" #N ") lgkmcnt(0)\n\ts_barrier":::"memory")

__device__ __forceinline__ void qkt(f32x16&p0,f32x16&p1,const char*Kslot,const bf16x8*qr,int r32,int hi){
  const char*kb=Kslot+hi*1024+r32*16;
  #pragma unroll
  for(int d0=0;d0<4;++d0){
    const bf16x8 b0=*reinterpret_cast<const bf16x8*>(kb+d0*2048);
    const bf16x8 b1=*reinterpret_cast<const bf16x8*>(kb+d0*2048+512);
    p0=__builtin_amdgcn_mfma_f32_32x32x16_bf16(b0,qr[d0],p0,0,0,0);p1=__builtin_amdgcn_mfma_f32_32x32x16_bf16(b1,qr[d0],p1,0,0,0);}
}
typedef __attribute__((address_space(3))) const char* lds_cptr;
typedef short v4i16_t __attribute__((ext_vector_type(4)));
__device__ __forceinline__ void kload8(bf16x8*kf,lds_cptr kp){
  kf[0]=*(const __attribute__((address_space(3))) bf16x8*)(kp);      kf[1]=*(const __attribute__((address_space(3))) bf16x8*)(kp+512);
  kf[2]=*(const __attribute__((address_space(3))) bf16x8*)(kp+2048); kf[3]=*(const __attribute__((address_space(3))) bf16x8*)(kp+2560);
  kf[4]=*(const __attribute__((address_space(3))) bf16x8*)(kp+4096); kf[5]=*(const __attribute__((address_space(3))) bf16x8*)(kp+4608);
  kf[6]=*(const __attribute__((address_space(3))) bf16x8*)(kp+6144); kf[7]=*(const __attribute__((address_space(3))) bf16x8*)(kp+6656);
}
__device__ __forceinline__ void kload2(bf16x8*kf,lds_cptr kp,int j){ kf[2*j]=*(const __attribute__((address_space(3))) bf16x8*)(kp+j*2048); kf[2*j+1]=*(const __attribute__((address_space(3))) bf16x8*)(kp+j*2048+512); }
__device__ __forceinline__ s16x4 vtr(lds_cptr p){ return __builtin_bit_cast(s16x4,__builtin_amdgcn_ds_read_tr16_b64_v4i16((__attribute__((address_space(3))) v4i16_t*)p)); }
__device__ __forceinline__ float rowmax(const f32x16&p0,const f32x16&p1){
  float a=max3f(p0[0],p0[1],p1[0]),b=max3f(p0[2],p0[3],p1[1]);a=max3f(a,p1[2],p1[3]);
  #pragma unroll
  for(int r=4;r<16;r+=4){a=max3f(a,p0[r],p0[r+1]);b=max3f(b,p0[r+2],p0[r+3]);a=max3f(a,p1[r],p1[r+1]);b=max3f(b,p1[r+2],p1[r+3]);}
  const float m=max2f(a,b);
  auto rr=__builtin_amdgcn_permlane32_swap(__float_as_uint(m),__float_as_uint(m),false,false);
  return max2f(__uint_as_float(rr[0]),__uint_as_float(rr[1]));
}
__device__ __forceinline__ void pv(f32x16*o,int vb,bf16x8 pa0,bf16x8 pa1,bf16x8 pa2,bf16x8 pa3){
  #pragma unroll
  for(int d0=0;d0<2;++d0){s16x4 lo[4],hi[4];
    #pragma unroll
    for(int ks=0;ks<4;++ks){
      asm volatile("ds_read_b64_tr_b16 %0,%1 offset:%c2":"=&v"(lo[ks]):"v"(vb),"i"(d0*4096+ks*1024):"memory");
      asm volatile("ds_read_b64_tr_b16 %0,%1 offset:%c2":"=&v"(hi[ks]):"v"(vb),"i"(d0*4096+ks*1024+512):"memory");}
    asm volatile("s_waitcnt lgkmcnt(0)":::"memory");SBAR();
    #define PK(k) (bf16x8){lo[k][0],lo[k][1],lo[k][2],lo[k][3],hi[k][0],hi[k][1],hi[k][2],hi[k][3]}
    o[d0]=__builtin_amdgcn_mfma_f32_32x32x16_bf16(pa0,PK(0),o[d0],0,0,0);
    o[d0]=__builtin_amdgcn_mfma_f32_32x32x16_bf16(pa1,PK(1),o[d0],0,0,0);
    o[d0]=__builtin_amdgcn_mfma_f32_32x32x16_bf16(pa2,PK(2),o[d0],0,0,0);
    o[d0]=__builtin_amdgcn_mfma_f32_32x32x16_bf16(pa3,PK(3),o[d0],0,0,0);
    #undef PK
  }
}

#ifndef ATTN_STORE16
#define ATTN_STORE16(p,v) (*(u32x4*)(p)=(v))
#endif
template<int THRL,class SchedT> __device__ __forceinline__ void attn_unit(const SchedT&Sq,int b,int h,int qb,const bf16*Q,const bf16*__restrict__ K,const bf16*__restrict__ V,bf16*O,const float*__restrict__ NC2,int ts,char*shm){
  int tid_l=threadIdx.x; asm volatile("":"+v"(tid_l)); const int tid=tid_l,lane=tid&63,r32=lane&31,hi=lane>>5; const int wid=__builtin_amdgcn_readfirstlane(tid>>6);
  const long rowbase=(long)b*SEQ; const int q0=qb*QB;
  const bf16*Qw=Q+(rowbase+q0+wid*QBLK)*DM+h*D;
  const bf16*Kh=K+(rowbase+(long)ts*KVBLK)*DM+h*D,*Vh=V+(rowbase+(long)ts*KVBLK)*DM+h*D;
  const unsigned lds0=(unsigned)(uintptr_t)shm;
  float*wsf=(float*)(shm+LDS_WS)+wid*64;
  const bf16*ksrc=Kh+(long)lane*DM+wid*8;
  const bf16*vsrc=Vh+(long)(16*(wid&3)+(lane>>2))*DM+(wid>>2)*32+(lane&3)*8;
  const unsigned kdst=lds0+LDS_K+wid*1024, vdst=lds0+LDS_V+wid*1024;
  #define DMA_K(t,slot) glds16(ksrc+(long)(t)*KVBLK*DM,(unsigned)__builtin_amdgcn_readfirstlane(kdst+(slot)))
  #define DMA_V(t,slot) glds16(vsrc+(long)(t)*KVBLK*DM,(unsigned)__builtin_amdgcn_readfirstlane(vdst+(slot)))
  const int vb0=(int)(lds0+LDS_V)+((lane>>4)&1)*32+(lane&3)*8+(4*hi+((lane&15)>>2))*64;
  const char*Kbase=shm+LDS_K; bf16x8 kf[8];
  const lds_cptr shm3=(lds_cptr)shm; const lds_cptr c2l=shm3+LDS_C2+16*hi; const lds_cptr kp0=shm3+LDS_K+hi*1024+r32*16; const lds_cptr vp0=shm3+LDS_V+((lane>>4)&1)*32+(lane&3)*8+(4*hi+((lane&15)>>2))*64;
  const int NT=(q0+QB)/KVBLK-ts;
  DMA_K(0,0);DMA_V(0,0);DMA_K(1,SLOTB);
  bf16x8 qr[4];
  #pragma unroll
  for(int d0=0;d0<4;++d0)qr[d0]=*reinterpret_cast<const bf16x8*>(&Qw[(long)r32*DM+d0*16+hi*8]);
  { const float*cg_=NC2+(long)(b*NHEAD+h)*SEQ+ts*KVBLK; float*cl_=(float*)(shm+LDS_C2); const int nq_=q0+QB-ts*KVBLK;
    for(int i_=tid*4;i_<nq_;i_+=NW*64*4)*(f32x4v*)(cl_+i_)=*(const f32x4v*)(cg_+i_); }
  float mhat=0.f,l_reg=0.f;f32x16 o[2];o[0]=f32x16{};o[1]=f32x16{};
  const int qrel=wid*QBLK+r32;
  #define CMASK(P0,P1,t) do{int jb_=(t)-(NT-4); if(jb_>=0)cmask(P0,P1,jb_,qrel,hi);}while(0)
  bool resc=false;
  #define START(P0,P1) do{ const float rm=rowmax(P0,P1); resc=false; \
    { const float dl=rm; mhat=fadd_s(mhat,dl); \
      _Pragma("unroll") for(int r=0;r<16;++r){P0[r]=fsub_s(P0[r],dl);P1[r]=fsub_s(P1[r],dl);} \
      } \
    _Pragma("unroll") for(int r=0;r<16;++r)P0[r]=__builtin_amdgcn_exp2f(P0[r]); }while(0)
  #define RESC() do{ if(resc){ asm volatile("s_waitcnt lgkmcnt(0)":::"memory"); \
      _Pragma("unroll") for(int d_=0;d_<2;++d_) _Pragma("unroll") for(int r=0;r<16;++r)o[d_][r]*=wsf[crow(r,hi)]; } }while(0)
  f32x16 pA0,pA1,pB0,pB1;
  #define KBLD(X0,X1,tt) do{ const lds_f4p cb_=(lds_f4p)(c2l+(tt)*256); \
    _Pragma("unroll") for(int g_=0;g_<4;++g_){ const f32x4v a_=cb_[2*g_], b_=cb_[2*g_+8]; \
      X0[4*g_+0]=a_[0]-mhat; X0[4*g_+1]=a_[1]-mhat; X0[4*g_+2]=a_[2]-mhat; X0[4*g_+3]=a_[3]-mhat; \
      X1[4*g_+0]=b_[0]-mhat; X1[4*g_+1]=b_[1]-mhat; X1[4*g_+2]=b_[2]-mhat; X1[4*g_+3]=b_[3]-mhat; } }while(0)
  int sl_prev=0,sl_cur=0,sl_next=SLOTB;
  #define ROT() do{sl_prev=sl_cur;sl_cur=sl_next;sl_next=(sl_next==(NSLOT-1)*SLOTB)?0:sl_next+SLOTB;}while(0)
  DMA_K(2,2*SLOTB);
  WAIT_BAR(3);
  KBLD(pA0,pA1,0);
  qkt(pA0,pA1,Kbase,qr,r32,hi);asm volatile("s_nop 15\n\ts_nop 7":"+v"(pA0),"+v"(pA1));CMASK(pA0,pA1,0);
  START(pA0,pA1);
  KBLD(pB0,pB1,1);
  _Pragma("unroll") for(int r=0;r<16;++r)pA1[r]=__builtin_amdgcn_exp2f(pA1[r]);
  WAIT_BAR(0);
  DMA_K(3,0);DMA_V(1,SLOTB);
  ROT();
  kload8(kf,kp0+sl_cur);
  WAIT_BAR(2);
  s16x4 vlo[8],vhi[8]; u32x4 pw0,pw1,pw2,pw3;
  #define PKW(P,B) cvtpk_s(P[B],P[B+1])
  #define PAF(k) __builtin_bit_cast(bf16x8,pw##k)
  #define VFR(i) (bf16x8){vlo[i][0],vlo[i][1],vlo[i][2],vlo[i][3],vhi[i][0],vhi[i][1],vhi[i][2],vhi[i][3]}
  #define PIN(x) asm volatile("":"+v"(x))
  #define MX3(a,b,c) __builtin_fmaxf(__builtin_fmaxf((a),(b)),(c))
  #define GAPA(MF,A0,A1,A2,A3,W0,W1,PW) do{ MF; sacc+=A0; sacc+=A1; sacc+=A2; sacc+=A3; PIN(sacc); W0; W1; PIN(PW); SBAR(); }while(0)
  #define EX(v) __builtin_amdgcn_exp2f(v)
  #define GAPB(MF,X,B) do{ MF; X[B]=EX(X[B]); X[B+1]=EX(X[B+1]); X[B+2]=EX(X[B+2]); X[B+3]=EX(X[B+3]); PIN(X); SBAR(); }while(0)
  #define VRD(i) do{ vlo[i]=vtr(vp_+(((i)>>2)*4096+((i)&3)*1024)); vhi[i]=vtr(vp_+(((i)>>2)*4096+((i)&3)*1024+512)); }while(0)
  #define KBQ(X,g_,i_) do{ const f32x4v a_=cb_[i_]; X[4*(g_)+0]=a_[0]; X[4*(g_)+1]=a_[1]; X[4*(g_)+2]=a_[2]; X[4*(g_)+3]=a_[3]; }while(0)
  #define KBQ2(G,XA,ga,ia,XB,gb,ib) do{ if(G){ KBQ(XA,ga,ia); KBQ(XB,gb,ib); SBAR(); } }while(0)
  #define KRD(G,j) do{ if(G){ kload2(kf,kp0+sl_next,j); SBAR(); } }while(0)
  #define STEP(C0,C1,P0,P1,t,GK,GV,GL) do{ SBAR(); \
    const lds_cptr vp_=vp0+sl_prev; \
    VRD(0); SBAR(); float sacc=(P0[0]+P0[1]); \
    GAPA(C0=__builtin_amdgcn_mfma_f32_32x32x16_bf16(kf[0],qr[0],C0,0,0,0), P0[2],P0[3],P0[4],P0[5],     pw0[0]=PKW(P0,0), pw0[1]=PKW(P0,2), pw0); \
    VRD(4); SBAR(); GAPA(C1=__builtin_amdgcn_mfma_f32_32x32x16_bf16(kf[1],qr[0],C1,0,0,0), P0[6],P0[7],P0[8],P0[9],     pw0[2]=PKW(P0,4), pw0[3]=PKW(P0,6), pw0); \
    VRD(1); SBAR(); GAPA(C0=__builtin_amdgcn_mfma_f32_32x32x16_bf16(kf[2],qr[1],C0,0,0,0),   P0[10],P0[11],P0[12],P0[13], pw1[0]=PKW(P0,8), pw1[1]=PKW(P0,10), pw1); \
    VRD(5); SBAR(); GAPA(C1=__builtin_amdgcn_mfma_f32_32x32x16_bf16(kf[3],qr[1],C1,0,0,0),   P0[14],P0[15],P1[0],P1[1],   pw1[2]=PKW(P0,12),pw1[3]=PKW(P0,14), pw1); \
    VRD(2); SBAR(); GAPA(C0=__builtin_amdgcn_mfma_f32_32x32x16_bf16(kf[4],qr[2],C0,0,0,0),   P1[2],P1[3],P1[4],P1[5],     pw2[0]=PKW(P1,0), pw2[1]=PKW(P1,2), pw2); \
    VRD(6); SBAR(); GAPA(C1=__builtin_amdgcn_mfma_f32_32x32x16_bf16(kf[5],qr[2],C1,0,0,0),   P1[6],P1[7],P1[8],P1[9],     pw2[2]=PKW(P1,4), pw2[3]=PKW(P1,6), pw2); \
    VRD(3); SBAR(); GAPA(C0=__builtin_amdgcn_mfma_f32_32x32x16_bf16(kf[6],qr[3],C0,0,0,0),   P1[10],P1[11],P1[12],P1[13], pw3[0]=PKW(P1,8), pw3[1]=PKW(P1,10), pw3); \
    VRD(7); SBAR(); GAPA(C1=__builtin_amdgcn_mfma_f32_32x32x16_bf16(kf[7],qr[3],C1,0,0,0),   P1[14],P1[15],0.f,0.f,       pw3[2]=PKW(P1,12),pw3[3]=PKW(P1,14), pw3); \
    l_reg+=sacc; \
    if(GK){DMA_K((t)+3,sl_cur);} if(GV){DMA_V((t)+1,sl_next);} \
    CMASK(C0,C1,t); \
    { float a=MX3(C0[0],C0[1],C1[0]),b=MX3(C0[2],C0[3],C1[1]); a=MX3(a,C1[2],C1[3]); \
      _Pragma("unroll") for(int r=4;r<16;r+=4){a=MX3(a,C0[r],C0[r+1]);b=MX3(b,C0[r+2],C0[r+3]);a=MX3(a,C1[r],C1[r+1]);b=MX3(b,C1[r+2],C1[r+3]);} \
      float rm=__builtin_fmaxf(a,b); { auto rr=__builtin_amdgcn_permlane32_swap(__float_as_uint(rm),__float_as_uint(rm),false,false); rm=__builtin_fmaxf(__uint_as_float(rr[0]),__uint_as_float(rr[1])); } \
      resc=false; \
      if(__builtin_expect(__any(rm>(float)THRL),0)){ const float dl=__builtin_fmaxf(rm,0.f); mhat+=dl; \
        _Pragma("unroll") for(int r=0;r<16;++r){C0[r]-=dl;C1[r]-=dl;} \
        const float f=__builtin_amdgcn_exp2f(-dl); l_reg*=f; if(hi==0)wsf[r32]=f; resc=true; } } \
    SBAR(); \
    const lds_f4p cb_=(lds_f4p)(c2l+((t)+1)*256);     \
    KBQ2(GL,P0,0,0,P0,1,2); GAPB(o[0]=__builtin_amdgcn_mfma_f32_32x32x16_bf16(PAF(0),VFR(0),o[0],0,0,0), C0,0); \
    KBQ2(GL,P0,2,4,P0,3,6); GAPB(o[1]=__builtin_amdgcn_mfma_f32_32x32x16_bf16(PAF(0),VFR(4),o[1],0,0,0), C0,4); \
    KRD(GL,0); GAPB(o[0]=__builtin_amdgcn_mfma_f32_32x32x16_bf16(PAF(1),VFR(1),o[0],0,0,0), C0,8); \
    KRD(GL,1); GAPB(o[1]=__builtin_amdgcn_mfma_f32_32x32x16_bf16(PAF(1),VFR(5),o[1],0,0,0), C0,12); \
    KRD(GL,2); GAPB(o[0]=__builtin_amdgcn_mfma_f32_32x32x16_bf16(PAF(2),VFR(2),o[0],0,0,0), C1,0); \
    KRD(GL,3); GAPB(o[1]=__builtin_amdgcn_mfma_f32_32x32x16_bf16(PAF(2),VFR(6),o[1],0,0,0), C1,4); \
    KBQ2(GL,P1,0,8,P1,1,10); GAPB(o[0]=__builtin_amdgcn_mfma_f32_32x32x16_bf16(PAF(3),VFR(3),o[0],0,0,0), C1,8); \
    KBQ2(GL,P1,2,12,P1,3,14); GAPB(o[1]=__builtin_amdgcn_mfma_f32_32x32x16_bf16(PAF(3),VFR(7),o[1],0,0,0), C1,12); \
    if(GL){ _Pragma("unroll") for(int r=0;r<16;++r){P0[r]-=mhat;P1[r]-=mhat;} } \
    }while(0)
  int t=1;
  #undef CMASK
  #define CMASK(P0,P1,t) do{}while(0)
  for(;t+5<NT;t+=2){
    STEP(pB0,pB1,pA0,pA1,t,true,true,true);     WAIT_BAR(2); RESC(); ROT();
    STEP(pA0,pA1,pB0,pB1,t+1,true,true,true);   WAIT_BAR(2); RESC(); ROT();
  }
  #undef CMASK
  #define CMASK(P0,P1,t) do{int jb_=(t)-(NT-4); if(jb_>=0)cmask(P0,P1,jb_,qrel,hi);}while(0)
  #define ENDW(tt) do{ if((tt)+3<NT){WAIT_BAR(2);} else if((tt)+2<NT){WAIT_BAR(1);} else {WAIT_BAR(0);} }while(0)
  for(;t+1<NT;t+=2){
    STEP(pB0,pB1,pA0,pA1,t,(t+3<NT),(t+1<NT),(t+1<NT));       ENDW(t);   RESC(); ROT();
    STEP(pA0,pA1,pB0,pB1,t+1,(t+4<NT),(t+2<NT),(t+2<NT));     ENDW(t+1); RESC(); ROT();
  }
  STEP(pB0,pB1,pA0,pA1,NT-1,false,false,false); RESC();
  { float sacc=pB0[0]+pB0[1]; _Pragma("unroll") for(int r=2;r<16;++r)sacc+=pB0[r]; _Pragma("unroll") for(int r=0;r<16;++r)sacc+=pB1[r]; l_reg+=sacc;
    pw0=(u32x4){PKW(pB0,0),PKW(pB0,2),PKW(pB0,4),PKW(pB0,6)};pw1=(u32x4){PKW(pB0,8),PKW(pB0,10),PKW(pB0,12),PKW(pB0,14)};pw2=(u32x4){PKW(pB1,0),PKW(pB1,2),PKW(pB1,4),PKW(pB1,6)};pw3=(u32x4){PKW(pB1,8),PKW(pB1,10),PKW(pB1,12),PKW(pB1,14)};
    SBAR(); pv(o,vb0+sl_cur,PAF(0),PAF(1),PAF(2),PAF(3)); }
  #undef PKW
  #undef PAF
  #undef VFR
  #undef PIN
  #undef MX3
  #undef GAPA
  #undef GAPB
  #undef EX
  #undef VRD
  #undef KRD
  #undef KBQ
  #undef KBQ2
  #undef STEP
  #undef ENDW
  Sq.prefetch();
  {auto rr=__builtin_amdgcn_permlane32_swap(__float_as_uint(l_reg),__float_as_uint(l_reg),false,false);l_reg=__uint_as_float(rr[0])+__uint_as_float(rr[1]);}
  if(hi==0)wsf[32+r32]=l_reg;asm volatile("s_waitcnt lgkmcnt(0)":::"memory");
  float rli[16];
  #pragma unroll
  for(int r=0;r<16;++r)rli[r]=__builtin_amdgcn_rcpf(wsf[32+crow(r,hi)]);
  bf16*Ow=O+(rowbase+q0+wid*QBLK)*OPITCH+h*D;
  { bf16*stg=(bf16*)(shm+LDS_OST)+wid*2048;
    #pragma unroll
    for(int r=0;r<16;++r){const int orow=crow(r,hi);
      #pragma unroll
      for(int d0=0;d0<2;++d0)stg[orow*64+d0*32+r32]=__float2bfloat16(o[d0][r]*rli[r]);}
    asm volatile("s_waitcnt lgkmcnt(0)":::"memory");
    #pragma unroll
    for(int i=0;i<4;++i){const int row=i*8+(lane>>3),ch=lane&7; const u32x4 v=*(const u32x4*)(stg+row*64+ch*8); ATTN_STORE16(Ow+(long)row*OPITCH+ch*8,v);} }
  asm volatile("s_waitcnt lgkmcnt(0)\n\ts_barrier":::"memory");
  #undef DMA_K
  #undef DMA_V
  #undef CMASK
  #undef START
  #undef RESC
  #undef ROT
  #undef KBLD
}
constexpr int ATTN_LDS_BYTES=LDS_BYTES;
struct AttnTensors { const bf16* Q; const bf16* K; const bf16* V; bf16* O; const float* NC2; const int* TS; };
struct AttnUnit { int bh; int qb; };
struct QueueOrder {
  unsigned* cnt; volatile __attribute__((address_space(3))) unsigned* slot; mutable unsigned pend;
  __device__ __forceinline__ void prefetch()const{ if(threadIdx.x==0)pend=__hip_atomic_fetch_add(cnt,1u,__ATOMIC_RELAXED,__HIP_MEMORY_SCOPE_AGENT); }
  __device__ __forceinline__ bool next(int i,AttnUnit&u)const{
    if(i==0)prefetch();
    if(threadIdx.x==0)*slot=pend;
    __syncthreads(); const unsigned n=*slot; if(n>=(unsigned)(BATCH*NHEAD*NQB))return false; u.qb=NQB-1-(int)(n>>6); u.bh=(int)(n&63u); return true; }
  __device__ __forceinline__ void a_ready(const AttnUnit&)const{}
  __device__ __forceinline__ void done(const AttnUnit&)const{}
};
struct StaticOrder {
  int vcu;
  __device__ __forceinline__ explicit StaticOrder(int grid,int block):vcu((block%8)*(grid/8)+block/8){}
  __device__ __forceinline__ bool next(int i,AttnUnit&u)const{ if(i>=8)return false; const int s=vcu&3; u.bh=vcu>>2; u.qb=8*(i>>1)+((i&1)?7-s:s); return true; }
  __device__ __forceinline__ void a_ready(const AttnUnit&)const{}
  __device__ __forceinline__ void done(const AttnUnit&)const{}
  __device__ __forceinline__ void prefetch()const{}
};
template<class Sched,int THRL=8> __device__ __forceinline__ void attn_phase(char*lds,const AttnTensors&T,const Sched&S){
  AttnUnit u;
  for(int i=0;S.next(i,u);++i){ S.a_ready(u); attn_unit<THRL,Sched>(S,u.bh/NHEAD,u.bh%NHEAD,u.qb,T.Q,T.K,T.V,T.O,T.NC2,__builtin_amdgcn_readfirstlane(((const __attribute__((address_space(3))) int*)(lds_cptr)lds)[(LDS_TSL>>2)+u.bh*NQB+u.qb]),lds); S.done(u); }
}
#undef SBAR
#undef WAIT_BAR
}
namespace xat {
#define XLAS __attribute__((address_space(3)))
typedef unsigned short bf16_t;
typedef short bf16x8 __attribute__((ext_vector_type(8)));
typedef float f32x16 __attribute__((ext_vector_type(16)));
typedef unsigned u32x4 __attribute__((ext_vector_type(4)));
typedef unsigned u32x2 __attribute__((ext_vector_type(2)));
constexpr int KROW = 272, VROW = 520, LDS_K = 0, LDS_V = 256 * KROW, LDS_END = LDS_V + 128 * VROW;
__device__ __forceinline__ unsigned cvtpk(float lo, float hi) { unsigned r; asm volatile("v_cvt_pk_bf16_f32 %0, %1, %2" : "=v"(r) : "v"(lo), "v"(hi)); return r; }
__device__ __forceinline__ void load_kv(const bf16_t* MKbh, const bf16_t* MVtbh, XLAS unsigned char* lds, int tid) {
    for (int i = tid; i < 4096; i += 512) { const int row = i >> 4, ch = i & 15; const u32x4 v = *(const u32x4*)(MKbh + row * 128 + ch * 8); *(XLAS u32x4*)(lds + LDS_K + row * KROW + ch * 16) = v; }
    for (int i = tid; i < 4096; i += 512) { const int row = i >> 5, ch = i & 31; const u32x4 v = *(const u32x4*)(MVtbh + row * 256 + ch * 8);
        XLAS u32x2* p = (XLAS u32x2*)(lds + LDS_V + row * VROW + ch * 16); p[0] = (u32x2){v.x, v.y}; p[1] = (u32x2){v.z, v.w}; }
}
__device__ __forceinline__ void unit(const bf16_t* MQ, bf16_t* MO, int b, int h, int qblk, XLAS unsigned char* lds) {
    int tid = threadIdx.x; asm volatile("" : "+v"(tid)); const int lane = tid & 63, r32 = lane & 31, hi = lane >> 5, wid = tid >> 6;
    const size_t row = (size_t)b * 8192 + qblk * 256 + wid * 32 + r32;
    const bf16_t* qp = MQ + row * 512 + h * 128 + hi * 8;
    bf16x8 qr[8];
#pragma unroll
    for (int d0 = 0; d0 < 8; ++d0) qr[d0] = *(const bf16x8*)(qp + d0 * 16);
    f32x16 S[8];
#pragma unroll
    for (int kb = 0; kb < 8; ++kb) { S[kb] = f32x16{};
#pragma unroll
        for (int d0 = 0; d0 < 8; ++d0) { const bf16x8 kf = *(const XLAS bf16x8*)(lds + LDS_K + (32 * kb + r32) * KROW + d0 * 32 + hi * 16);
            S[kb] = __builtin_amdgcn_mfma_f32_32x32x16_bf16(kf, qr[d0], S[kb], 0, 0, 0); }
        __builtin_amdgcn_sched_barrier(0); }
    float m = S[0][0];
#pragma unroll
    for (int kb = 0; kb < 8; ++kb)
#pragma unroll
        for (int r = 0; r < 16; ++r) m = fmaxf(m, S[kb][r]);
    m = fmaxf(m, __shfl_xor(m, 32));
    float l = 0.f;
#pragma unroll
    for (int kb = 0; kb < 8; ++kb)
#pragma unroll
        for (int r = 0; r < 16; ++r) { const float p = __builtin_amdgcn_exp2f(S[kb][r] - m); S[kb][r] = p; l += p; }
    l += __shfl_xor(l, 32);
    u32x4 pw[8][2];
#pragma unroll
    for (int kb = 0; kb < 8; ++kb)
#pragma unroll
        for (int sp = 0; sp < 2; ++sp) { pw[kb][sp].x = cvtpk(S[kb][8 * sp + 0], S[kb][8 * sp + 1]); pw[kb][sp].y = cvtpk(S[kb][8 * sp + 2], S[kb][8 * sp + 3]); pw[kb][sp].z = cvtpk(S[kb][8 * sp + 4], S[kb][8 * sp + 5]); pw[kb][sp].w = cvtpk(S[kb][8 * sp + 6], S[kb][8 * sp + 7]); }
    __builtin_amdgcn_sched_barrier(0);
    f32x16 o[4];
#pragma unroll
    for (int db = 0; db < 4; ++db) o[db] = f32x16{};
#pragma unroll
    for (int kb = 0; kb < 8; ++kb)
#pragma unroll
        for (int sp = 0; sp < 2; ++sp) {
            const bf16x8 pk = __builtin_bit_cast(bf16x8, pw[kb][sp]);
#pragma unroll
            for (int db = 0; db < 4; ++db) { const XLAS unsigned char* vb = lds + LDS_V + (32 * db + r32) * VROW + (32 * kb + 16 * sp + 4 * hi) * 2;
                const u32x2 lo = *(const XLAS u32x2*)vb, hh = *(const XLAS u32x2*)(vb + 16);
                const u32x4 vw = (u32x4){lo.x, lo.y, hh.x, hh.y};
                o[db] = __builtin_amdgcn_mfma_f32_32x32x16_bf16(__builtin_bit_cast(bf16x8, vw), pk, o[db], 0, 0, 0); }
            __builtin_amdgcn_sched_barrier(0); }
    const float inv = 1.0f / l;
    bf16_t* op = MO + row * 512 + h * 128 + 4 * hi;
#pragma unroll
    for (int db = 0; db < 4; ++db)
#pragma unroll
        for (int g = 0; g < 4; ++g) { u32x2 w; w.x = cvtpk(o[db][4 * g + 0] * inv, o[db][4 * g + 1] * inv); w.y = cvtpk(o[db][4 * g + 2] * inv, o[db][4 * g + 3] * inv);
            *(u32x2*)(op + 32 * db + 8 * g) = w; }
}
}

namespace cg = cooperative_groups;
#define LAS __attribute__((address_space(3)))
typedef unsigned short bf16;
typedef unsigned v4u __attribute__((ext_vector_type(4)));
typedef unsigned v2u __attribute__((ext_vector_type(2)));
typedef float f32x4 __attribute__((ext_vector_type(4)));
constexpr int NWAVES = 8;
constexpr int DM = 1024, BATCH = 8, SEQ = 8192, MTOK = BATCH * SEQ, DEPTH = 2, NIN = 2056, NINP = 2304, DFF = 2816, MEMLEN = 256;
constexpr float EPS = 1e-6f;
constexpr size_t MiB = 1u << 20;
constexpr size_t WS_W = 1 * MiB, WS_WSTRIDE = 28 * MiB;
constexpr size_t WO_IN = 0, WO_OUT = 5 * MiB, WO_MQ = 7 * MiB, WO_MKV = 8 * MiB, WO_MO = 10 * MiB, WO_GU = 11 * MiB, WO_D = 22 * MiB;
constexpr size_t WS_BAR = 65536, WS_BAR_BYTES = 16384;
constexpr int XBST_OFF = 141312;
constexpr size_t WS_QCNT = 0, WS_TS = 4096;
constexpr size_t WS_LF = 58 * MiB, WS_NC2 = 60 * MiB, WS_SSQ = 62 * MiB, WS_MN = 66 * MiB, WS_MK = 74 * MiB, WS_MVT = 78 * MiB;
constexpr size_t WS_HB = 96 * MiB, WS_Q = 224 * MiB, WS_K = 288 * MiB, WS_V = 352 * MiB, WS_P = 416 * MiB, WS_CAT = 480 * MiB, WS_MQ = 608 * MiB, WS_MO = 672 * MiB, WS_FP = 736 * MiB, WS_END = 768 * MiB;
constexpr size_t WS_ACT = 224 * MiB;
static_assert(WS_ACT + (size_t)MTOK * DFF * 2 <= WS_MQ, "ACT overlay");
constexpr int RING_BYTES = 131072, EPIX_OFF = 132096, LDS_BYTES = 147456;

__device__ __forceinline__ unsigned f2bf(float f) { unsigned u = __builtin_bit_cast(unsigned, f); return (u + 0x7fffu + ((u >> 16) & 1u)) >> 16; }
__device__ __forceinline__ unsigned pk2(float lo, float hi) { return f2bf(lo) | (f2bf(hi) << 16); }
__device__ __forceinline__ float wave_sum(float v) {
#pragma unroll
    for (int o = 1; o < 64; o <<= 1) v += __shfl_xor(v, o);
    return v;
}
__device__ __forceinline__ void tr_item(const float* W, int N, int k0, int n0, const float* g, bf16* WT, int Kdst, int drow0, LAS float* scr, int lane) {
    const int nq = (lane & 15) * 4; const bool ok = (n0 + nq) < N;
    f32x4 v[16];
#pragma unroll
    for (int i = 0; i < 16; ++i) { const int kk = 4 * i + (lane >> 4); v[i] = ok ? __builtin_nontemporal_load((const f32x4*)(W + (size_t)(k0 + kk) * N + n0 + nq)) : (f32x4){0.f, 0.f, 0.f, 0.f}; if (g) v[i] = v[i] * g[k0 + kk]; }
#pragma unroll
    for (int i = 0; i < 16; ++i) { const int kk = 4 * i + (lane >> 4); LAS float* d = scr + kk * 65 + nq; d[0] = v[i].x; d[1] = v[i].y; d[2] = v[i].z; d[3] = v[i].w; }
    asm volatile("s_waitcnt lgkmcnt(0)" ::: "memory");
    const int c = lane & 7;
#pragma unroll
    for (int j = 0; j < 8; ++j) { const int n = (lane >> 3) + 8 * j; const LAS float* s = scr + (8 * c) * 65 + n;
        v4u o; o.x = pk2(s[0 * 65], s[1 * 65]); o.y = pk2(s[2 * 65], s[3 * 65]); o.z = pk2(s[4 * 65], s[5 * 65]); o.w = pk2(s[6 * 65], s[7 * 65]);
        *(v4u*)(WT + (size_t)(drow0 + n) * Kdst + k0 + 8 * c) = o; }
    asm volatile("s_waitcnt lgkmcnt(0)" ::: "memory");
}

#ifndef PHMASK
#define PHMASK 0x3ff
#endif
#define XB_TMO      128
#define XB_XCNT(j)  (256  + 64 * (j))
#define XB_XSUB(j)  (1280 + 64 * (j))
#define XB_XGEN(j)  (2304 + 64 * (j))
#define XB_TOP      3328
#define XB_TOPGEN   3392
#define XCD_BAR_WORDS 3456
#define XB_SPIN_CAP (1u << 18)

__device__ __forceinline__ unsigned xb_ld(unsigned* p)              { return __hip_atomic_load(p, __ATOMIC_RELAXED, __HIP_MEMORY_SCOPE_AGENT); }
__device__ __forceinline__ unsigned xb_add(unsigned* p, unsigned v) { return __hip_atomic_fetch_add(p, v, __ATOMIC_RELAXED, __HIP_MEMORY_SCOPE_AGENT); }
__device__ __forceinline__ unsigned xb_xcc_id() { return (unsigned)__builtin_amdgcn_s_getreg((3 << 11) | 20) & 0xFu; }
#define XB_SPIN(cond, bar) do { unsigned _sp = 0; while (cond) { __builtin_amdgcn_s_sleep(1); \
    if ((++_sp & 255u) == 0u) { if (xb_ld(&(bar)[XB_TMO])) break; if (_sp > XB_SPIN_CAP) { atomicAdd(&(bar)[XB_TMO], 1u); break; } } } } while (0)

struct XcdBarrier {
    unsigned* bar; unsigned x;
    volatile LAS unsigned* st;
};

__device__ __forceinline__ XcdBarrier xcd_barrier_post(unsigned* bar, volatile LAS unsigned* st) {
    XcdBarrier b; b.bar = bar; b.x = xb_xcc_id(); b.st = st;
    if (threadIdx.x == 0) (void)xb_add(&bar[XB_XCNT(b.x)], 1u);
    return b;
}
__device__ __forceinline__ void xcd_barrier_complete(unsigned* bar, unsigned x, unsigned& nloc, unsigned& nx) {
    const unsigned G = gridDim.x * gridDim.y * gridDim.z;
    unsigned sum, cnt, mine, sp = 0u;
    for (;;) {
        sum = 0u; cnt = 0u; mine = 0u;
#pragma unroll
        for (unsigned j = 0; j < 16; ++j) { const unsigned c = xb_ld(&bar[XB_XCNT(j)]); sum += c; cnt += (c > 0u) ? 1u : 0u; mine = (j == x) ? c : mine; }
        if (sum == G) break;
        __builtin_amdgcn_s_sleep(1);
        if ((++sp & 255u) == 0u) { if (xb_ld(&bar[XB_TMO])) break; if (sp > XB_SPIN_CAP) { atomicAdd(&bar[XB_TMO], 1u); break; } }
    }
    nloc = mine > 0u ? mine : 1u; nx = cnt > 0u ? cnt : 1u;
}

__device__ __forceinline__ void xcd_barrier(const XcdBarrier& b) {
    asm volatile("s_waitcnt vmcnt(0)" ::: "memory");
    __syncthreads();
    if (threadIdx.x == 0) {
        unsigned* bar = b.bar;
        __builtin_amdgcn_s_waitcnt(0);
        unsigned nloc = b.st[0], nx = b.st[1];
        if (nloc == 0u) { xcd_barrier_complete(bar, b.x, nloc, nx); b.st[0] = nloc; b.st[1] = nx; }
        const unsigned old = xb_add(&bar[XB_XSUB(b.x)], 1u);
        const unsigned gen = old / nloc;
        if (old + 1u == (gen + 1u) * nloc) {
            __builtin_amdgcn_fence(__ATOMIC_RELEASE, "agent");
            asm volatile("s_waitcnt vmcnt(0)" ::: "memory");
            const unsigned og = xb_add(&bar[XB_TOP], 1u);
            const unsigned tg = og / nx;
            if (og + 1u == (tg + 1u) * nx) xb_add(&bar[XB_TOPGEN], 1u);
            else XB_SPIN(xb_ld(&bar[XB_TOPGEN]) == tg, bar);
            __builtin_amdgcn_fence(__ATOMIC_ACQUIRE, "agent");
            xb_add(&bar[XB_XGEN(b.x)], 1u);
            asm volatile("s_waitcnt vmcnt(0)" ::: "memory");
        } else {
            XB_SPIN(xb_ld(&bar[XB_XGEN(b.x)]) == gen, bar);
            __builtin_amdgcn_fence(__ATOMIC_ACQUIRE, "agent");
            asm volatile("s_waitcnt vmcnt(0)" ::: "memory");
        }
    }
    __syncthreads();
}

#define GAS1 __attribute__((address_space(1)))
__device__ __forceinline__ unsigned long long karg(int k) {
    const __attribute__((address_space(4))) unsigned long long* ka = (const __attribute__((address_space(4))) unsigned long long*)__builtin_amdgcn_kernarg_segment_ptr();
    asm volatile("" : "+s"(ka)); return ka[k];
}
#define MIX_UNPACK(u, f) do { f[0] = __uint_as_float(u.x << 16); f[1] = __uint_as_float(u.x & 0xffff0000u); f[2] = __uint_as_float(u.y << 16); f[3] = __uint_as_float(u.y & 0xffff0000u); \
    f[4] = __uint_as_float(u.z << 16); f[5] = __uint_as_float(u.z & 0xffff0000u); f[6] = __uint_as_float(u.w << 16); f[7] = __uint_as_float(u.w & 0xffff0000u); } while (0)
template <int W> __device__ __forceinline__ void mix_rows16(const bf16* Pb, bf16* CAT, int r0, int colgrp) {
    const int t0 = r0 & (SEQ - 1);
    const bf16* pp = Pb + (size_t)r0 * 512 + colgrp * 8; bf16* op = CAT + (size_t)r0 * DM + 512 + colgrp * 8;
    v4u rw[W - 1 + 16];
#pragma unroll
    for (int k = 0; k < W - 1 + 16; ++k) { const int rel = k - (W - 1); rw[k] = *(const v4u*)(pp + (ptrdiff_t)((t0 + rel >= 0) ? rel : 0) * 512); }
    float sum[8];
#pragma unroll
    for (int j = 0; j < 8; ++j) sum[j] = 0.f;
#pragma unroll
    for (int k = 0; k < W - 1; ++k) { const float m = (t0 + k - (W - 1) >= 0) ? 1.0f : 0.0f; float f[8]; MIX_UNPACK(rw[k], f);
#pragma unroll
        for (int j = 0; j < 8; ++j) sum[j] += m * f[j]; }
#pragma unroll
    for (int i = 0; i < 16; ++i) { float cur[8]; asm volatile("" : "+v"(rw[W - 1 + i]));
        MIX_UNPACK(rw[W - 1 + i], cur);
        const int t = t0 + i; const float rc = 1.0f / (float)((t + 1 < W) ? t + 1 : W); float o[8];
#pragma unroll
        for (int j = 0; j < 8; ++j) { sum[j] += cur[j]; o[j] = sum[j] * rc - cur[j]; }
        *(v4u*)(op + (size_t)i * DM) = (v4u){pk2(o[0], o[1]), pk2(o[2], o[3]), pk2(o[4], o[5]), pk2(o[6], o[7])};
        { const float m = (t + 1 - W >= 0) ? 1.0f : 0.0f; float f[8]; asm volatile("" : "+v"(rw[i])); MIX_UNPACK(rw[i], f);
#pragma unroll
            for (int j = 0; j < 8; ++j) sum[j] -= m * f[j]; } }
}

#ifdef USE_CG_SYNC
#define GSYNC() grid.sync()
#else
#define GSYNC() xcd_barrier(xbar)
#endif
#ifdef TIMING
#ifndef MASKA
#define MASKA 0
#endif
#ifndef MASKB
#define MASKB 0
#endif
#define TSTAMP(id) do { const unsigned long long t_ = __builtin_amdgcn_s_memrealtime(); const unsigned long long d_ = t_ - t_prev; t_prev = t_; if ((MASKA >> (id)) & 1) accA += d_; if ((MASKB >> (id)) & 1) accB += d_; } while (0)
#else
#define TSTAMP(id) do {} while (0)
#endif
struct Args { const float* in[20]; float* out; unsigned char* ws; };

__global__ void __launch_bounds__(NWAVES * 64, 2) fwd_megakernel(Args args) {
    extern __shared__ __attribute__((aligned(16))) unsigned char lds[];
    cg::grid_group grid = cg::this_grid();
    LAS unsigned char* const L = (LAS unsigned char*)lds;
    const int wave = __builtin_amdgcn_readfirstlane((int)threadIdx.x >> 6);
    const int G = gridDim.x, bx = blockIdx.x;
    const int vcu = (G % 8 == 0) ? (bx % 8) * (G / 8) + bx / 8 : bx;
    LAS float* const EX = (LAS float*)(L + EPIX_OFF);
    if (threadIdx.x < 2) ((LAS unsigned*)(L + XBST_OFF))[threadIdx.x] = 0u;
    __syncthreads();
    const XcdBarrier xbar = xcd_barrier_post((unsigned*)((unsigned char*)(GAS1 unsigned char*)karg(21) + WS_BAR), (volatile LAS unsigned*)(L + XBST_OFF));
#define DEFPTRS \
    int tid = threadIdx.x; asm volatile("" : "+v"(tid)); const int lane = tid & 63; (void)lane; \
    unsigned char* const ws = (unsigned char*)(GAS1 unsigned char*)karg(21); float* const out = (float*)(GAS1 float*)karg(20); (void)out; \
    bf16* const HB = (bf16*)(ws + WS_HB); bf16* const Qb = (bf16*)(ws + WS_Q); bf16* const Kb = (bf16*)(ws + WS_K); bf16* const Vb = (bf16*)(ws + WS_V); bf16* const Pb = (bf16*)(ws + WS_P); \
    bf16* const CAT = (bf16*)(ws + WS_CAT); bf16* const MQ = (bf16*)(ws + WS_MQ); bf16* const MO = (bf16*)(ws + WS_MO); bf16* const ACT = (bf16*)(ws + WS_ACT); \
    float* const LF = (float*)(ws + WS_LF); float* const NC2 = (float*)(ws + WS_NC2); float* const SSQ = (float*)(ws + WS_SSQ); \
    bf16* const MN = (bf16*)(ws + WS_MN); bf16* const MK = (bf16*)(ws + WS_MK); bf16* const MVT = (bf16*)(ws + WS_MVT); \
    (void)HB; (void)Qb; (void)Kb; (void)Vb; (void)Pb; (void)CAT; (void)MQ; (void)MO; (void)ACT; (void)LF; (void)NC2; (void)SSQ; (void)MN; (void)MK; (void)MVT;
#define IN(k) ((const float*)(GAS1 const float*)karg(k))

#ifdef TIMING
    unsigned long long t_prev = __builtin_amdgcn_s_memrealtime(), accA = 0, accB = 0;
#endif
    if constexpr ((PHMASK >> 0) & 1) { DEFPTRS
        LAS float* scr = (LAS float*)(L + wave * 16640);
        const int gw = vcu * NWAVES + wave, NGW = G * NWAVES;
        constexpr int I_IN = 16 * 36, I_OUT = 8 * 16, I_MQ = 16 * 8, I_MKV = 16 * 16, I_MO = 8 * 16, I_GU = 16 * 88, I_D = 44 * 16, I_L = I_IN + I_OUT + I_MQ + I_MKV + I_MO + I_GU + I_D;
        for (int it = gw; it < DEPTH * I_L; it += NGW) {
            const int l = it / I_L; int r = it % I_L; unsigned char* wl = ws + WS_W + (size_t)l * WS_WSTRIDE;
            if (r < I_IN) { const int kb = r / 36, nb = r % 36; tr_item(IN(3) + (size_t)l * DM * NIN, NIN, 64 * kb, 64 * nb, IN(2) + l * DM, (bf16*)(wl + WO_IN), DM, 64 * nb, scr, lane); continue; } r -= I_IN;
            if (r < I_OUT) { const int kb = r / 16, nb = r % 16; tr_item(IN(9) + (size_t)l * DM * DM, DM, 64 * kb, 64 * nb, nullptr, (bf16*)(wl + WO_OUT), DM, 64 * nb, scr, lane); continue; } r -= I_OUT;
            if (r < I_MQ) { const int kb = r / 8, nb = r % 8; tr_item(IN(12) + (size_t)l * DM * 512, 512, 64 * kb, 64 * nb, IN(10) + l * DM, (bf16*)(wl + WO_MQ), DM, 64 * nb, scr, lane); continue; } r -= I_MQ;
            if (r < I_MKV) { const int kb = r / 16, nb = r % 16; tr_item(IN(13) + (size_t)l * DM * 1024, 1024, 64 * kb, 64 * nb, nullptr, (bf16*)(wl + WO_MKV), DM, 64 * nb, scr, lane); continue; } r -= I_MKV;
            if (r < I_MO) { const int kb = r / 16, nb = r % 16; tr_item(IN(16) + (size_t)l * 512 * DM, DM, 64 * kb, 64 * nb, nullptr, (bf16*)(wl + WO_MO), 512, 64 * nb, scr, lane); continue; } r -= I_MO;
            if (r < I_GU) { const int kb = r / 88, nb = r % 88; const int n0 = 64 * nb; const int drow = (n0 < DFF) ? (n0 / 128) * 256 + (n0 % 128) : ((n0 - DFF) / 128) * 256 + 128 + ((n0 - DFF) % 128);
                tr_item(IN(18) + (size_t)l * DM * 2 * DFF, 2 * DFF, 64 * kb, n0, IN(17) + l * DM, (bf16*)(wl + WO_GU), DM, drow, scr, lane); continue; } r -= I_GU;
            { const int kb = r / 16, nb = r % 16; tr_item(IN(19) + (size_t)l * DFF * DM, DM, 64 * kb, 64 * nb, nullptr, (bf16*)(wl + WO_D), DFF, 64 * nb, scr, lane); }
        }
        if (bx == 0 && tid < DEPTH) ((unsigned*)(ws + WS_QCNT))[tid * 64] = 0u;
        for (int tw = __builtin_amdgcn_readfirstlane(bx * 8 + wave); tw < DEPTH * 64 * 16; tw += G * 8) {
            const int l = tw / 1024, rem = tw % 1024, kc8 = rem >> 4, n = (rem & 15) * 64 + lane, g = kc8 >> 4, c0 = (kc8 & 15) * 8;
            const float* wp = IN(7) + ((size_t)(l * 4 + g) * 128 + c0) * 128; const float* ps = IN(8) + l * 512 + g * 128; const float* wo = IN(9) + (size_t)l * DM * DM + (size_t)(512 + g * 128) * DM + n;
            float a[8];
#pragma unroll
            for (int j = 0; j < 8; ++j) a[j] = 0.f;
#pragma unroll 8
            for (int d = 0; d < 128; ++d) { const float wv = wo[(size_t)d * DM] * ps[d];
#pragma unroll
                for (int j = 0; j < 8; ++j) a[j] += wp[j * 128 + d] * wv; }
            *(v4u*)((bf16*)(ws + WS_W + (size_t)l * WS_WSTRIDE + WO_OUT) + (size_t)n * DM + 512 + g * 128 + c0) = (v4u){pk2(a[0], a[1]), pk2(a[2], a[3]), pk2(a[4], a[5]), pk2(a[6], a[7])};
        }
        {
            f32x4 wf[4][4][2];
#pragma unroll
            for (int j = 0; j < 4; ++j)
#pragma unroll
                for (int c = 0; c < 4; ++c) { const int k = 256 * j + 4 * lane + c; const float gk = IN(2)[k]; const float* wr = IN(3) + (size_t)k * NIN + 2048;
                    wf[j][c][0] = *(const f32x4*)wr * gk; wf[j][c][1] = *(const f32x4*)(wr + 4) * gk; }
            const float bfo = IN(4)[lane & 7];
        for (int m0 = gw * 4; m0 < MTOK; m0 += NGW * 4) {
            f32x4 v[4][4]; float sq[4];
#pragma unroll
            for (int r = 0; r < 4; ++r) { const f32x4* xr = (const f32x4*)(IN(0) + (size_t)(m0 + r) * DM) + lane;
#pragma unroll
                for (int j = 0; j < 4; ++j) v[r][j] = __builtin_nontemporal_load(xr + 64 * j); }
#pragma unroll
            for (int r = 0; r < 4; ++r) { float s = 0.f;
#pragma unroll
                for (int j = 0; j < 4; ++j) s += (v[r][j].x * v[r][j].x + v[r][j].y * v[r][j].y) + (v[r][j].z * v[r][j].z + v[r][j].w * v[r][j].w);
                sq[r] = wave_sum(s); }
#pragma unroll
            for (int r = 0; r < 4; ++r) { v2u* o8 = (v2u*)(HB + (size_t)(m0 + r) * DM) + lane;
#pragma unroll
                for (int j = 0; j < 4; ++j) o8[64 * j] = (v2u){pk2(v[r][j].x, v[r][j].y), pk2(v[r][j].z, v[r][j].w)};
                if (lane < 16) SSQ[(size_t)(m0 + r) * 16 + lane] = (lane == 0) ? sq[r] : 0.f;
                f32x4 d0 = (f32x4){0.f, 0.f, 0.f, 0.f}, d1 = d0;
#pragma unroll
                for (int j = 0; j < 4; ++j) { d0 += wf[j][0][0] * v[r][j].x + wf[j][1][0] * v[r][j].y + wf[j][2][0] * v[r][j].z + wf[j][3][0] * v[r][j].w;
                                              d1 += wf[j][0][1] * v[r][j].x + wf[j][1][1] * v[r][j].y + wf[j][2][1] * v[r][j].z + wf[j][3][1] * v[r][j].w; }
                float f8[8] = {d0.x, d0.y, d0.z, d0.w, d1.x, d1.y, d1.z, d1.w};
#pragma unroll
                for (int o = 0; o < 8; ++o) f8[o] = wave_sum(f8[o]);
                float mine = f8[0];
#pragma unroll
                for (int o = 1; o < 8; ++o) mine = ((lane & 7) == o) ? f8[o] : mine;
                const float rstd = __builtin_amdgcn_rsqf(sq[r] * (1.0f / DM) + EPS);
                if (lane < 8) LF[(size_t)(m0 + r) * 8 + lane] = pg8::log2sigmoid(mine * rstd + bfo); }
        }
        }
        for (int m = gw; m < DEPTH * BATCH * MEMLEN; m += NGW) {
            const int l = m / (BATCH * MEMLEN), rr = m % (BATCH * MEMLEN);
            const f32x4* xr = (const f32x4*)(IN(1) + (size_t)rr * DM) + lane; const f32x4* gr = (const f32x4*)(IN(11) + l * DM) + lane; f32x4 v[4]; float s = 0.f;
#pragma unroll
            for (int j = 0; j < 4; ++j) { v[j] = xr[64 * j]; s += (v[j].x * v[j].x + v[j].y * v[j].y) + (v[j].z * v[j].z + v[j].w * v[j].w); }
            const float rstd = 1.0f / sqrtf(wave_sum(s) * (1.0f / DM) + EPS);
            v2u* o8 = (v2u*)(MN + (size_t)m * DM) + lane;
#pragma unroll
            for (int j = 0; j < 4; ++j) { const f32x4 gg = gr[64 * j]; o8[64 * j] = (v2u){pk2(v[j].x * rstd * gg.x, v[j].y * rstd * gg.y), pk2(v[j].z * rstd * gg.z, v[j].w * rstd * gg.w)}; }
        }
    }
    grid.sync();
    TSTAMP(0);

    for (int l = 0; l < DEPTH; ++l) {
        if constexpr ((PHMASK >> 1) & 1) { DEFPTRS
            const int nin = 2048;
            if (l > 0) {
                const float* FPb = (const float*)(ws + WS_FP); const float* bfp = IN(4) + l * 8;
                for (int row = bx * 512 + tid; row < MTOK; row += G * 512) {
                    const f32x4* p = (const f32x4*)(FPb + (size_t)row * 128); f32x4 a0 = p[0], a1 = p[1];
#pragma unroll
                    for (int si = 1; si < 16; ++si) { a0 += p[2 * si]; a1 += p[2 * si + 1]; }
                    const float rs = pg8::rstd_row(SSQ, row); const f32x4 b0 = *(const f32x4*)bfp, b1 = *(const f32x4*)(bfp + 4);
                    const f32x4 z0 = a0 * rs + b0, z1 = a1 * rs + b1;
                    *(f32x4*)(LF + (size_t)row * 8) = (f32x4){pg8::log2sigmoid(z0[0]), pg8::log2sigmoid(z0[1]), pg8::log2sigmoid(z0[2]), pg8::log2sigmoid(z0[3])};
                    *(f32x4*)(LF + (size_t)row * 8 + 4) = (f32x4){pg8::log2sigmoid(z1[0]), pg8::log2sigmoid(z1[1]), pg8::log2sigmoid(z1[2]), pg8::log2sigmoid(z1[3])};
                }
            }
            pg8::Gemm g{HB, (const bf16*)(ws + WS_W + (size_t)l * WS_WSTRIDE + WO_IN), MTOK, nin, DM}; pg8::StaticOrder S; S.init(MTOK, nin, G, bx);
            pg8::EpiInProj E{SSQ, Qb, Kb, Vb, Pb, LF, IN(5) + l * 64, IN(6) + l * 64, IN(4) + l * 8, EX, 0.125f * pg8::LOG2E, -1};
            pg8::gemm_phase<pg8::EpiInProj, pg8::StaticOrder, true, true>(L, g, S, E);
#ifdef EXP_DUP_G1
            pg8::gemm_phase<pg8::EpiInProj, pg8::StaticOrder, true, true>(L, g, S, E);
#endif
        }
        GSYNC(); TSTAMP(1);
        if constexpr ((PHMASK >> 2) & 1) { DEFPTRS
            if (bx < 64) {
                const int b = bx >> 3, h = bx & 7; const float* src = LF + ((size_t)b * SEQ + tid * 16) * 8 + h; float v[16]; float s = 0.f;
#pragma unroll
                for (int j = 0; j < 16; ++j) { s += src[j * 8]; v[j] = s; }
                LAS float* sc = (LAS float*)L; sc[tid] = s; __syncthreads();
                for (int off = 1; off < 512; off <<= 1) { const float t = (tid >= off) ? sc[tid - off] : 0.f; __syncthreads(); sc[tid] += t; __syncthreads(); }
                const float excl = sc[tid] - s; float* dst = NC2 + (size_t)bx * SEQ + tid * 16; LAS float* ncl = (LAS float*)(L + 4096) + tid * 16;
#pragma unroll
                for (int j = 0; j < 16; j += 4) { const f32x4 nv = (f32x4){-(excl + v[j]), -(excl + v[j + 1]), -(excl + v[j + 2]), -(excl + v[j + 3])}; *(f32x4*)(dst + j) = nv; *(LAS f32x4*)(ncl + j) = nv; }
                __syncthreads();
                if (tid < 32) {
                    float gq = 0.f, gk = 0.f; const float* gqp = IN(5) + l * 64; const float* gkp = IN(6) + l * 64;
                    for (int d = 0; d < 64; ++d) { gq = fmaxf(gq, fabsf(gqp[d])); gk = fmaxf(gk, fabsf(gkp[d])); }
                    const float thresh = 2.0f * (64.0f * gq * gk * 0.125f * pg8::LOG2E) + 20.0f;
                    const LAS float* nc = (const LAS float*)(L + 4096); const float ref = nc[256 * tid]; int t = 0;
                    while (t < 4 * tid && ref - nc[64 * t + 63] > thresh) ++t;
                    ((int*)(ws + WS_TS))[bx * 32 + tid] = t & ~1;
                }
                __syncthreads();
            } else if (l == 0 && bx < 128) {
                const int l2 = (bx - 64) >> 5;
                pg8::Gemm g{MN + (size_t)l2 * BATCH * MEMLEN * DM, (const bf16*)(ws + WS_W + (size_t)l2 * WS_WSTRIDE + WO_MKV), BATCH * MEMLEN, 1024, DM};
                pg8::RangeOrder S{4, 64 + 32 * l2, 32, bx};
                pg8::EpiHead128<1> E{nullptr, MK + (size_t)l2 * BATCH * 4 * MEMLEN * 128, MVT + (size_t)l2 * BATCH * 4 * MEMLEN * 128, IN(15) + l2 * 128, EX, 1.0f};
                pg8::gemm_phase<pg8::EpiHead128<1>, pg8::RangeOrder, true, true>(L, g, S, E);
            }
            const bool kvcu = (l == 0 && bx >= 64 && bx < 128);
            const int nmix = (l == 0) ? G - 64 : G, mixid = (l == 0 && bx >= 128) ? bx - 64 : bx;
            if (!kvcu) for (int T = mixid * 512 + tid; T < (MTOK / 16) * 64; T += nmix * 512) {
                const int wv = T >> 6, g = __builtin_amdgcn_readfirstlane(wv & 3), r0 = ((wv >> 2) * 4 + (lane >> 4)) * 16, colgrp = g * 16 + (lane & 15);
                if (g == 0) mix_rows16<2>(Pb, CAT, r0, colgrp); else if (g == 1) mix_rows16<4>(Pb, CAT, r0, colgrp); else if (g == 2) mix_rows16<8>(Pb, CAT, r0, colgrp); else mix_rows16<16>(Pb, CAT, r0, colgrp);
            }
        }
        GSYNC(); TSTAMP(2);
        if constexpr ((PHMASK >> 3) & 1) { DEFPTRS
            const attn_body::AttnTensors AT{(const attn_body::bf16*)Qb, (const attn_body::bf16*)Kb, (const attn_body::bf16*)Vb, (attn_body::bf16*)CAT, NC2, (const int*)(ws + WS_TS)};
            { const int* tsg = (const int*)(ws + WS_TS); LAS int* tsl = (LAS int*)(L + attn_body::LDS_TSL); for (int i = tid; i < 2048; i += 512) tsl[i] = tsg[i]; }
            const attn_body::QueueOrder S{(unsigned*)(ws + WS_QCNT) + l * 64, (volatile LAS unsigned*)(L + attn_body::ATTN_LDS_BYTES), 0u};
            attn_body::attn_phase<attn_body::QueueOrder, 20>((char*)lds, AT, S);
        }
        GSYNC(); TSTAMP(3);
        if constexpr ((PHMASK >> 4) & 1) { DEFPTRS
            pg8::Gemm g{CAT, (const bf16*)(ws + WS_W + (size_t)l * WS_WSTRIDE + WO_OUT), MTOK, DM, DM}; pg8::StaticOrder S; S.init(MTOK, DM, G, bx);
            pg8::EpiResid E{nullptr, nullptr, HB, SSQ, nullptr, nullptr};
            pg8::gemm_phase<pg8::EpiResid, pg8::StaticOrder, false, true>(L, g, S, E);
        }
        GSYNC(); TSTAMP(4);
        if constexpr ((PHMASK >> 5) & 1) { DEFPTRS
            pg8::Gemm g{HB, (const bf16*)(ws + WS_W + (size_t)l * WS_WSTRIDE + WO_MQ), MTOK, 512, DM}; pg8::StaticOrder S; S.init(MTOK, 512, G, bx);
            pg8::EpiHead128<0> E{SSQ, MQ, nullptr, IN(14) + l * 128, EX, 0.08838834764831845f * pg8::LOG2E};
            pg8::gemm_phase<pg8::EpiHead128<0>, pg8::StaticOrder, true, true>(L, g, S, E);
#ifdef EXP_DUP_G3
            pg8::gemm_phase<pg8::EpiHead128<0>, pg8::StaticOrder, true, true>(L, g, S, E);
#endif
        }
        GSYNC(); TSTAMP(5);
        if constexpr ((PHMASK >> 6) & 1) { DEFPTRS
            const int bh = vcu >> 3, b = bh >> 2, h = bh & 3;
            if (bh < BATCH * 4) {
                xat::load_kv(MK + ((size_t)l * BATCH * 4 + bh) * MEMLEN * 128, MVT + ((size_t)l * BATCH * 4 + bh) * MEMLEN * 128, L, tid);
                __syncthreads();
                for (int i = 0; i < 4; ++i) xat::unit(MQ, MO, b, h, (vcu & 7) * 4 + i, L);
                __syncthreads();
            }
        }
        GSYNC(); TSTAMP(6);
        if constexpr ((PHMASK >> 7) & 1) { DEFPTRS
            pg8::Gemm g{MO, (const bf16*)(ws + WS_W + (size_t)l * WS_WSTRIDE + WO_MO), MTOK, DM, 512}; pg8::StaticOrder S; S.init(MTOK, DM, G, bx);
            pg8::EpiResid E{nullptr, nullptr, HB, SSQ, nullptr, nullptr};
            pg8::gemm_phase<pg8::EpiResid, pg8::StaticOrder, false, true>(L, g, S, E);
        }
        GSYNC(); TSTAMP(7);
        if constexpr ((PHMASK >> 8) & 1) { DEFPTRS
            pg8::Gemm g{HB, (const bf16*)(ws + WS_W + (size_t)l * WS_WSTRIDE + WO_GU), MTOK, 2 * DFF, DM}; pg8::StaticOrder S; S.init(MTOK, 2 * DFF, G, bx);
            pg8::EpiSwiglu E{SSQ, ACT, EX, -1};
            pg8::gemm_phase<pg8::EpiSwiglu, pg8::StaticOrder, true, true>(L, g, S, E);
        }
        GSYNC(); TSTAMP(8);
        if constexpr ((PHMASK >> 9) & 1) { DEFPTRS
            pg8::Gemm g{ACT, (const bf16*)(ws + WS_W + (size_t)l * WS_WSTRIDE + WO_D), MTOK, DM, DFF}; pg8::StaticOrder S; S.init(MTOK, DM, G, bx);
            pg8::EpiResid E{nullptr, (l == DEPTH - 1) ? out : nullptr, HB, SSQ, (l + 1 < DEPTH) ? (const bf16*)(ws + WS_W + (size_t)(l + 1) * WS_WSTRIDE + WO_IN) + (size_t)2048 * DM : nullptr, (float*)(ws + WS_FP)};
            pg8::gemm_phase<pg8::EpiResid, pg8::StaticOrder, false, true>(L, g, S, E);
        }
#ifdef TIMING
        GSYNC(); TSTAMP(9);
#else
        if (l + 1 < DEPTH) GSYNC();
#endif
    }
#ifdef TIMING
    {
        DEFPTRS
#ifdef TIMING_CAL
        const unsigned long long n = 1000000ull;
#else
        const unsigned long long n = (accA / 400ull) + 1000ull * (accB / 400ull);
#endif
        if (bx == 0) for (unsigned long long i = tid; i < n; i += 512) out[i] += 0.125f;
    }
#endif
}

extern "C" void kernel_launch(void* const* d_in, const int* in_sizes, int n_in, void* d_out, int out_size, void* d_ws, size_t ws_size, hipStream_t stream) {
    static int grid = 0;
    if (grid == 0) {
        if (n_in != 20 || out_size != MTOK * DM || ws_size < WS_END) { fprintf(stderr, "kernel_launch: unexpected shapes (n_in %d, out %d, ws %zu)\n", n_in, out_size, ws_size); grid = -1; return; }
        int dev = 0, cus = 0, per_cu = 0;
        if (hipGetDevice(&dev) != hipSuccess || hipDeviceGetAttribute(&cus, hipDeviceAttributeMultiprocessorCount, dev) != hipSuccess) { grid = -1; return; }
        if (hipFuncSetAttribute((const void*)fwd_megakernel, hipFuncAttributeMaxDynamicSharedMemorySize, LDS_BYTES) != hipSuccess) { fprintf(stderr, "kernel_launch: hipFuncSetAttribute failed\n"); grid = -1; return; }
        if (hipOccupancyMaxActiveBlocksPerMultiprocessor(&per_cu, (const void*)fwd_megakernel, NWAVES * 64, LDS_BYTES) != hipSuccess || per_cu < 1) { fprintf(stderr, "kernel_launch: occupancy query says %d\n", per_cu); per_cu = 1; }
        (void)hipGetLastError();
        grid = cus * 1;
        if (grid != 256) fprintf(stderr, "kernel_launch: %d CUs; the unit orders assume 256\n", grid);
    }
    if (grid < 0) return;
    if (hipMemsetAsync((char*)d_ws + WS_BAR, 0, WS_BAR_BYTES, stream) != hipSuccess) { fprintf(stderr, "kernel_launch: hipMemsetAsync failed\n"); return; }
    Args a{};
    for (int i = 0; i < 20; ++i) a.in[i] = (const float*)d_in[i];
    a.out = (float*)d_out; a.ws = (unsigned char*)d_ws;
    void* kargs[] = {&a};
    hipError_t e = hipLaunchCooperativeKernel((const void*)fwd_megakernel, dim3(grid), dim3(NWAVES * 64), kargs, LDS_BYTES, stream);
    if (e != hipSuccess) fprintf(stderr, "kernel_launch: cooperative launch failed: %s (grid %d)\n", hipGetErrorString(e), grid);
}
```

```cpp
#include <hip/hip_runtime.h>
#include <hip/hip_cooperative_groups.h>
#include <cstdio>
#include <cstdint>
#include <cstddef>
namespace pg8 {
#define PG8_LAS __attribute__((address_space(3)))
typedef unsigned short bf16_t;
typedef short bf16x8 __attribute__((ext_vector_type(8)));
typedef float f32x4 __attribute__((ext_vector_type(4)));
typedef unsigned u32x4 __attribute__((ext_vector_type(4)));
constexpr int BM = 256, BK = 64, HALF = 128, HTB = HALF * BK * 2  , STAGE_BYTES = 8 * HTB, NXCD = 8, WGM = 8;

__host__ __device__ __forceinline__ int lds_byte(int r, int c) { const int st = (r >> 4) * 2 + (c >> 5), rr = r & 15, cc = c & 31, ob = rr * 64 + cc * 2; return st * 1024 + (ob ^ (((ob >> 9) & 1) << 5)); }
__host__ __device__ __forceinline__ void stage_rc(int b, int& R, int& C) { const int st = b / 1024, sb = b % 1024, swz = sb ^ (((sb >> 9) & 1) << 5); R = (st >> 1) * 16 + swz / 64; C = (st & 1) * 32 + (swz % 64) / 2; }
__host__ __device__ __forceinline__ int perm32(int rho) { const int n = rho >> 4, i = rho & 15; return 8 * (i >> 2) + 4 * n + (i & 3); }

struct Unit { int pm, pn; };
struct Gemm { const bf16_t* A; const bf16_t* Bt; int M, N, K; };

struct StaticOrder {
    int nM, nN, nwg, G, c;
    __host__ __device__ void init(int M, int N, int G_, int c_) { nM = M / BM; nN = N / BM; nwg = nM * nN; G = G_; c = c_; }
    __host__ __device__ bool next(int i, Unit& u) const {
        const long L = (long)i * G + c; if (L >= nwg) return false;
        int wgid = (int)L; { const int q = nwg / NXCD, r = nwg % NXCD, xcd = wgid % NXCD, off = wgid / NXCD; wgid = (xcd < r ? xcd * (q + 1) : r * (q + 1) + (xcd - r) * q) + off; }
        const int nig = WGM * nN, gid = wgid / nig, fm = gid * WGM, gsz = (nM - fm) < WGM ? (nM - fm) : WGM;
        u.pm = fm + ((wgid % nig) % gsz); u.pn = (wgid % nig) / gsz; return true;
    }
    __device__ __forceinline__ void a_ready(const Unit&) const {}
    __device__ __forceinline__ void done(const Unit&) const {}
};

__device__ __forceinline__ unsigned cvt_pk_bf16(float lo, float hi) { unsigned r; asm volatile("v_cvt_pk_bf16_f32 %0, %1, %2" : "=v"(r) : "v"(lo), "v"(hi)); return r; }
typedef unsigned u32x2 __attribute__((ext_vector_type(2)));
constexpr float RMS_EPS = 1e-6f;
constexpr float LOG2E = 1.4426950408889634f;
__device__ __forceinline__ void epi_bar() { asm volatile("s_waitcnt lgkmcnt(0)\n\ts_barrier" ::: "memory"); }
__device__ __forceinline__ float sum4(f32x4 a) { return (a[0] + a[1]) + (a[2] + a[3]); }
__device__ __forceinline__ float sumsq4(f32x4 v) { return (v[0] * v[0] + v[1] * v[1]) + (v[2] * v[2] + v[3] * v[3]); }
__device__ __forceinline__ float rstd_row(const float* ssq, int row) {
    const f32x4* p = (const f32x4*)(ssq + (size_t)row * 16);
    const f32x4 a = p[0], b = p[1], c = p[2], d = p[3];
    return __builtin_amdgcn_rsqf(((sum4(a) + sum4(b)) + (sum4(c) + sum4(d))) * (1.0f / 1024.0f) + RMS_EPS);
}
__device__ __forceinline__ void rstd_to_lds(const float* ssq, int row0, PG8_LAS float* RS) {
    const int t = threadIdx.x; if (t < 256) RS[t] = rstd_row(ssq, row0 + t);
}
__device__ __forceinline__ u32x4 pack8(f32x4 a, f32x4 b) { u32x4 w; w.x = cvt_pk_bf16(a[0], a[1]); w.y = cvt_pk_bf16(a[2], a[3]); w.z = cvt_pk_bf16(b[0], b[1]); w.w = cvt_pk_bf16(b[2], b[3]); return w; }
__device__ __forceinline__ float log2sigmoid(float x) { return LOG2E * (fminf(x, 0.f) - log1pf(expf(-fabsf(x)))); }

struct EpiResid {
    static constexpr bool PERM = true, AFTER_DRAIN = false;
    const float* basef; float* outf; bf16_t* hb; float* ssq; const bf16_t* fw; float* fp;
    __device__ __forceinline__ void tail(const f32x4& o0, const f32x4& o1, size_t off, float& s) const {
        if (outf) { __builtin_nontemporal_store(o0, (f32x4*)(outf + off)); __builtin_nontemporal_store(o1, (f32x4*)(outf + off + 4)); }
        else { *(u32x4*)(hb + off) = pack8(o0, o1); s += sumsq4(o0) + sumsq4(o1); }
    }
    __device__ __forceinline__ void operator()(const f32x4 (&acc)[2][2][4][2], const Unit& u, int wr, int wc, int fr, int fq) const {
        const int col0 = u.pn * BM + wc * 32 + 8 * fq, row0 = u.pm * BM + wr * 64 + fr; const size_t off0 = (size_t)row0 * 1024 + col0;
        if (basef) {
#pragma unroll
            for (int ai = 0; ai < 2; ++ai) {
                f32x4 bf[4][2][2];
#pragma unroll
                for (int m = 0; m < 4; ++m)
#pragma unroll
                    for (int bj = 0; bj < 2; ++bj) { const float* p = basef + off0 + (size_t)(ai * HALF + m * 16) * 1024 + bj * HALF; bf[m][bj][0] = *(const f32x4*)p; bf[m][bj][1] = *(const f32x4*)(p + 4); }
                asm volatile("" ::: "memory");
#pragma unroll
                for (int m = 0; m < 4; ++m) { const size_t off = off0 + (size_t)(ai * HALF + m * 16) * 1024; float s = 0.f;
#pragma unroll
                    for (int bj = 0; bj < 2; ++bj) tail(bf[m][bj][0] + acc[ai][bj][m][0], bf[m][bj][1] + acc[ai][bj][m][1], off + bj * HALF, s);
                    if (!outf) { s += __shfl_xor(s, 16); s += __shfl_xor(s, 32); if (fq == 0) ssq[(size_t)(row0 + ai * HALF + m * 16) * 16 + u.pn * 4 + wc] = s; } }
                asm volatile("" ::: "memory");
            }
        } else {
            u32x4 bw[2][4][2]; bf16x8 wfr[2];
            if (fw) { wfr[0] = *(const bf16x8*)(fw + (size_t)fr * 1024 + col0); wfr[1] = *(const bf16x8*)(fw + (size_t)fr * 1024 + col0 + HALF); }
#pragma unroll
            for (int ai = 0; ai < 2; ++ai)
#pragma unroll
                for (int m = 0; m < 4; ++m)
#pragma unroll
                    for (int bj = 0; bj < 2; ++bj) bw[ai][m][bj] = *(const u32x4*)(hb + off0 + (size_t)(ai * HALF + m * 16) * 1024 + bj * HALF);
            asm volatile("" ::: "memory");
#pragma unroll
            for (int ai = 0; ai < 2; ++ai)
#pragma unroll
                for (int m = 0; m < 4; ++m) { const size_t off = off0 + (size_t)(ai * HALF + m * 16) * 1024; float s = 0.f; f32x4 fd = (f32x4){0.f, 0.f, 0.f, 0.f};
#pragma unroll
                    for (int bj = 0; bj < 2; ++bj) { const u32x4 w = bw[ai][m][bj];
                        const f32x4 b0 = (f32x4){__uint_as_float(w.x << 16), __uint_as_float(w.x & 0xffff0000u), __uint_as_float(w.y << 16), __uint_as_float(w.y & 0xffff0000u)};
                        const f32x4 b1 = (f32x4){__uint_as_float(w.z << 16), __uint_as_float(w.z & 0xffff0000u), __uint_as_float(w.w << 16), __uint_as_float(w.w & 0xffff0000u)};
                        const f32x4 o0 = b0 + acc[ai][bj][m][0], o1 = b1 + acc[ai][bj][m][1];
                        tail(o0, o1, off + bj * HALF, s);
                        if (fw) fd = __builtin_amdgcn_mfma_f32_16x16x32_bf16(wfr[bj], __builtin_bit_cast(bf16x8, pack8(o0, o1)), fd, 0, 0, 0); }
                    if (!outf) { s += __shfl_xor(s, 16); s += __shfl_xor(s, 32); if (fq == 0) ssq[(size_t)(row0 + ai * HALF + m * 16) * 16 + u.pn * 4 + wc] = s; }
                    if (fw && fq < 2) *(f32x4*)(fp + ((size_t)(row0 + ai * HALF + m * 16) * 16 + u.pn * 4 + wc) * 8 + 4 * fq) = fd;
                    asm volatile("" ::: "memory"); }
        }
    }
};

struct EpiInProj {
    static constexpr bool PERM = true, AFTER_DRAIN = false;
    const float* ssq; bf16_t *Q, *K, *V, *P; float* LF; const float *gq, *gk, *bfg; PG8_LAS float* X; float qscale; mutable int last_pm;
    __device__ __forceinline__ void operator()(const f32x4 (&acc)[2][2][4][2], const Unit& u, int wr, int wc, int fr, int fq) const {
        const int pn = u.pn, rl0 = wr * 64 + fr; PG8_LAS float* RS = X + 2048;
        const bool newpm = (u.pm != last_pm); last_pm = u.pm;
        if (newpm) rstd_to_lds(ssq, u.pm * BM, RS);
        if (pn < 4) {
#pragma unroll
            for (int ai = 0; ai < 2; ++ai)
#pragma unroll
                for (int m = 0; m < 4; ++m)
#pragma unroll
                    for (int bj = 0; bj < 2; ++bj) { float s = sumsq4(acc[ai][bj][m][0]) + sumsq4(acc[ai][bj][m][1]);
                        s += __shfl_xor(s, 16); s += __shfl_xor(s, 32);
                        if (fq == 0) X[(ai * HALF + rl0 + m * 16) * 8 + bj * 4 + wc] = s; }
        }
        if (newpm || pn < 4) epi_bar();
        if (pn < 4) {
            const float* g = (pn < 2) ? gq : gk; const float extra = (pn < 2) ? qscale : 1.0f; bf16_t* O = (pn < 2) ? Q : K;
            const int dcol = (wc & 1) * 32 + 8 * fq; const f32x4 g0 = *(const f32x4*)(g + dcol) * extra, g1 = *(const f32x4*)(g + dcol + 4) * extra;
            const int colb = (pn & 1) * 256 + wc * 32 + 8 * fq;
#pragma unroll
            for (int ai = 0; ai < 2; ++ai)
#pragma unroll
                for (int m = 0; m < 4; ++m) { const int rl = ai * HALF + rl0 + m * 16; bf16_t* rowp = O + (size_t)(u.pm * BM + rl) * 512 + colb; const float rsv = RS[rl];
#pragma unroll
                    for (int bj = 0; bj < 2; ++bj) { const float hs = X[rl * 8 + bj * 4 + (wc & 2)] + X[rl * 8 + bj * 4 + (wc & 2) + 1];
                        const float sc = rsv * __builtin_amdgcn_rsqf(hs * rsv * rsv * (1.0f / 64.0f) + RMS_EPS);
                        *(u32x4*)(rowp + bj * HALF) = pack8(acc[ai][bj][m][0] * sc * g0, acc[ai][bj][m][1] * sc * g1); }
                    asm volatile("" ::: "memory"); }
        } else if (pn < 8) {
            bf16_t* O = (pn < 6) ? V : P; const int colb = (pn & 1) * 256 + wc * 32 + 8 * fq;
#pragma unroll
            for (int ai = 0; ai < 2; ++ai)
#pragma unroll
                for (int m = 0; m < 4; ++m) { bf16_t* rowp = O + (size_t)(u.pm * BM + ai * HALF + rl0 + m * 16) * 512 + colb; const float rsv = RS[ai * HALF + rl0 + m * 16];
#pragma unroll
                    for (int bj = 0; bj < 2; ++bj) *(u32x4*)(rowp + bj * HALF) = pack8(acc[ai][bj][m][0] * rsv, acc[ai][bj][m][1] * rsv);
                    asm volatile("" ::: "memory"); }
        } else {
            if (wc == 0 && fq == 0) {
                const f32x4 b0 = *(const f32x4*)(bfg), b1 = *(const f32x4*)(bfg + 4);
#pragma unroll
                for (int ai = 0; ai < 2; ++ai)
#pragma unroll
                    for (int m = 0; m < 4; ++m) { float* lp = LF + (size_t)(u.pm * BM + ai * HALF + rl0 + m * 16) * 8; const float rsv = RS[ai * HALF + rl0 + m * 16];
                        const f32x4 z0 = acc[ai][0][m][0] * rsv + b0, z1 = acc[ai][0][m][1] * rsv + b1;
                        *(f32x4*)(lp) = (f32x4){log2sigmoid(z0[0]), log2sigmoid(z0[1]), log2sigmoid(z0[2]), log2sigmoid(z0[3])};
                        *(f32x4*)(lp + 4) = (f32x4){log2sigmoid(z1[0]), log2sigmoid(z1[1]), log2sigmoid(z1[2]), log2sigmoid(z1[3])}; }
            }
        }
    }
};

template <int MODE> struct EpiHead128 {
    static constexpr bool PERM = true, AFTER_DRAIN = false;
    const float* ssq; bf16_t* O; bf16_t* O2; const float* g; PG8_LAS float* X; float oscale;
    __device__ __forceinline__ void operator()(const f32x4 (&acc)[2][2][4][2], const Unit& u, int wr, int wc, int fr, int fq) const {
        const int pn = u.pn, rl0 = wr * 64 + fr; PG8_LAS float* RS = X + 2048;
        if (MODE == 0) rstd_to_lds(ssq, u.pm * BM, RS);
        if (MODE == 0 || pn < 2) {
#pragma unroll
            for (int ai = 0; ai < 2; ++ai)
#pragma unroll
                for (int m = 0; m < 4; ++m)
#pragma unroll
                    for (int bj = 0; bj < 2; ++bj) { float s = sumsq4(acc[ai][bj][m][0]) + sumsq4(acc[ai][bj][m][1]);
                        s += __shfl_xor(s, 16); s += __shfl_xor(s, 32);
                        if (fq == 0) X[(ai * HALF + rl0 + m * 16) * 8 + bj * 4 + wc] = s; }
            epi_bar();
            const int d0 = wc * 32 + 8 * fq; const f32x4 g0 = *(const f32x4*)(g + d0) * oscale, g1 = *(const f32x4*)(g + d0 + 4) * oscale;
#pragma unroll
            for (int ai = 0; ai < 2; ++ai)
#pragma unroll
                for (int m = 0; m < 4; ++m) { const int rl = ai * HALF + rl0 + m * 16; const float rsv = (MODE == 0) ? RS[rl] : 1.0f;
#pragma unroll
                    for (int bj = 0; bj < 2; ++bj) { const f32x4 xs = *(const PG8_LAS f32x4*)(X + rl * 8 + bj * 4);
                        const float sc = rsv * __builtin_amdgcn_rsqf(sum4(xs) * rsv * rsv * (1.0f / 128.0f) + RMS_EPS);
                        bf16_t* dst = (MODE == 0) ? O + (size_t)(u.pm * BM + rl) * 512 + pn * 256 + bj * HALF + d0
                                                  : O + ((size_t)(u.pm * 4 + 2 * pn + bj) * 256 + rl) * 128 + d0;
                        *(u32x4*)dst = pack8(acc[ai][bj][m][0] * sc * g0, acc[ai][bj][m][1] * sc * g1); }
                    asm volatile("" ::: "memory"); }
        } else {
            const int d0 = wc * 32 + 8 * fq;
#pragma unroll
            for (int ai = 0; ai < 2; ++ai)
#pragma unroll
                for (int m = 0; m < 4; ++m) { const int rl = ai * HALF + rl0 + m * 16;
#pragma unroll
                    for (int bj = 0; bj < 2; ++bj) { bf16_t* dst = O2 + ((size_t)(u.pm * 4 + 2 * (pn - 2) + bj) * 128 + d0) * 256 + rl;
                        const u32x4 w = pack8(acc[ai][bj][m][0], acc[ai][bj][m][1]);
                        dst[0 * 256] = (bf16_t)(w.x & 0xffffu); dst[1 * 256] = (bf16_t)(w.x >> 16); dst[2 * 256] = (bf16_t)(w.y & 0xffffu); dst[3 * 256] = (bf16_t)(w.y >> 16);
                        dst[4 * 256] = (bf16_t)(w.z & 0xffffu); dst[5 * 256] = (bf16_t)(w.z >> 16); dst[6 * 256] = (bf16_t)(w.w & 0xffffu); dst[7 * 256] = (bf16_t)(w.w >> 16); }
                    asm volatile("" ::: "memory"); }
        }
    }
};

struct EpiSwiglu {
    static constexpr bool PERM = true, AFTER_DRAIN = false;
    const float* ssq; bf16_t* ACT; PG8_LAS float* X; mutable int last_pm;
    __device__ __forceinline__ static f32x4 swi(f32x4 gt, f32x4 up) { f32x4 r;
#pragma unroll
        for (int j = 0; j < 4; ++j) { const float e = __builtin_amdgcn_exp2f(-LOG2E * gt[j]); r[j] = gt[j] * __builtin_amdgcn_rcpf(1.0f + e) * up[j]; }
        return r; }
    __device__ __forceinline__ void operator()(const f32x4 (&acc)[2][2][4][2], const Unit& u, int wr, int wc, int fr, int fq) const {
        const int rl0 = wr * 64 + fr, colb = u.pn * 128 + wc * 32 + 8 * fq; PG8_LAS float* RS = X + 2048;
        if (u.pm != last_pm) { last_pm = u.pm; rstd_to_lds(ssq, u.pm * BM, RS); epi_bar(); }
#pragma unroll
        for (int ai = 0; ai < 2; ++ai)
#pragma unroll
            for (int m = 0; m < 4; ++m) { const int row = u.pm * BM + ai * HALF + rl0 + m * 16; const float rs = RS[ai * HALF + rl0 + m * 16];
                const f32x4 a0 = swi(acc[ai][0][m][0] * rs, acc[ai][1][m][0] * rs), a1 = swi(acc[ai][0][m][1] * rs, acc[ai][1][m][1] * rs);
                *(u32x4*)(ACT + (size_t)row * 2816 + colb) = pack8(a0, a1); asm volatile("" ::: "memory"); }
    }
};

struct RangeOrder {
    int nN, c0, n, c;
    __host__ __device__ bool next(int i, Unit& u) const { const int k = c - c0; if (i != 0 || k < 0 || k >= n) return false; u.pm = k / nN; u.pn = k % nN; return true; }
    __device__ __forceinline__ void a_ready(const Unit&) const {}
    __device__ __forceinline__ void done(const Unit&) const {}
};
template <class Epi, class Sched, bool ALIGN_EPI = false, bool SP2 = false>
__device__ __forceinline__ void gemm_phase(PG8_LAS unsigned char* lds, const Gemm g, const Sched& S, const Epi& E) {
    int tid_l = threadIdx.x; asm volatile("" : "+v"(tid_l));
    const int tid = tid_l, wid = __builtin_amdgcn_readfirstlane(tid >> 6), lane = tid & 63, wr = wid >> 2, wc = wid & 3, fr = lane & 15, fq = lane >> 4;
    const int K = g.K, nt = K / BK;
    unsigned voffA[2], voffB[2];
#pragma unroll
    for (int i = 0; i < 2; ++i) { int R, C; stage_rc(tid * 16 + i * 8192, R, C); const int Rb = Epi::PERM ? ((R & ~31) + perm32(R & 31)) : R;
        voffA[i] = (unsigned)(R * K + C) * 2u; voffB[i] = (unsigned)(Rb * K + C) * 2u; }
    const size_t kstep = (size_t)(BK * 2);
    const size_t hstep = (size_t)HALF * K * 2;
    const size_t tstep = 2 * hstep;
    const unsigned ldsw = (unsigned)wid * 1024u;
    const int aoff = lds_byte(wr * 64 + fr, fq * 8), boff = lds_byte(wc * 32 + fr, fq * 8);
#define PG8_SA(b, h) (((b) * 2 + (h)) * HTB)
#define PG8_SB(b, h) ((4 + (b) * 2 + (h)) * HTB)
#define PG8_STAGE(bufoff, gbase, voff) do { _Pragma("unroll") for (int _i = 0; _i < 2; ++_i) \
        __builtin_amdgcn_global_load_lds((const unsigned*)((const char*)(gbase) + (voff)[_i]), (PG8_LAS unsigned*)(lds + (bufoff) + ldsw + _i * 8192), 16, 0, 0); } while (0)
#define PG8_LDA(dst, b, h) do { _Pragma("unroll") for (int m = 0; m < 4; ++m) _Pragma("unroll") for (int k = 0; k < 2; ++k) dst[m][k] = *(const PG8_LAS bf16x8*)(lds + PG8_SA(b, h) + aoff + m * 2048 + k * 1024); } while (0)
#define PG8_LDB(dst, b, h) do { _Pragma("unroll") for (int n = 0; n < 2; ++n) _Pragma("unroll") for (int k = 0; k < 2; ++k) dst[n][k] = *(const PG8_LAS bf16x8*)(lds + PG8_SB(b, h) + boff + n * 2048 + k * 1024); } while (0)
#define PG8_MMA(ai, bj, At, Bt) do { __builtin_amdgcn_s_setprio(1); _Pragma("unroll") for (int m = 0; m < 4; ++m) _Pragma("unroll") for (int n = 0; n < 2; ++n) _Pragma("unroll") for (int k = 0; k < 2; ++k) \
        acc[ai][bj][m][n] = __builtin_amdgcn_mfma_f32_16x16x32_bf16(Bt[n][k], At[m][k], acc[ai][bj][m][n], 0, 0, 0); __builtin_amdgcn_s_setprio(0); } while (0)
#define PG8_WAIT_V(n) asm volatile("s_waitcnt vmcnt(" #n ")" ::: "memory")
#define PG8_WAIT_L(n) asm volatile("s_waitcnt lgkmcnt(" #n ")" ::: "memory")
#define PG8_BAR __builtin_amdgcn_s_barrier()
#define PG8_SCHED __builtin_amdgcn_sched_barrier(0)
    Unit cur, nxt; int ui = 0;
    if (!S.next(0, cur)) return;
    f32x4 acc[2][2][4][2];
#pragma unroll
    for (int a = 0; a < 2; ++a)
#pragma unroll
        for (int b = 0; b < 2; ++b)
#pragma unroll
            for (int m = 0; m < 4; ++m)
#pragma unroll
                for (int n = 0; n < 2; ++n) acc[a][b][m][n] = (f32x4){0.f, 0.f, 0.f, 0.f};
    bf16x8 At[4][2], B0[2][2], B1[2][2];
    const char* cA = (const char*)g.A + (size_t)cur.pm * tstep; const char* cB = (const char*)g.Bt + (size_t)cur.pn * tstep;
    S.a_ready(cur);
    if constexpr (SP2) {
        PG8_STAGE(PG8_SB(0, 0), cB, voffB); PG8_STAGE(PG8_SB(0, 1), cB + hstep, voffB); PG8_STAGE(PG8_SA(0, 0), cA, voffA); PG8_STAGE(PG8_SA(0, 1), cA + hstep, voffA);
        if (wr == 1) PG8_BAR;
        PG8_WAIT_V(2); PG8_BAR;
        PG8_STAGE(PG8_SB(1, 0), cB + kstep, voffB); PG8_STAGE(PG8_SA(1, 0), cA + kstep, voffA); PG8_STAGE(PG8_SB(1, 1), cB + hstep + kstep, voffB);
        PG8_WAIT_V(6); PG8_BAR;
    } else {
        PG8_STAGE(PG8_SB(0, 0), cB, voffB); PG8_STAGE(PG8_SA(0, 0), cA, voffA); PG8_STAGE(PG8_SB(0, 1), cB + hstep, voffB); PG8_STAGE(PG8_SA(0, 1), cA + hstep, voffA);
        if (wr == 1) PG8_BAR;
        PG8_WAIT_V(4); PG8_BAR;
        PG8_STAGE(PG8_SB(1, 0), cB + kstep, voffB); PG8_STAGE(PG8_SA(1, 0), cA + kstep, voffA); PG8_STAGE(PG8_SB(1, 1), cB + hstep + kstep, voffB);
        PG8_WAIT_V(6); PG8_BAR;
    }
    for (;;) {
        const bool has_next = S.next(ui + 1, nxt);
        const char* nA = has_next ? (const char*)g.A + (size_t)nxt.pm * tstep : cA; const char* nB = has_next ? (const char*)g.Bt + (size_t)nxt.pn * tstep : cB;
        for (int t = 0; t < nt; t += 2) {
            const bool last = (t == nt - 2);
            const char* a1 = cA + (size_t)(t + 1) * kstep;
            const char* a2 = last ? nA : cA + (size_t)(t + 2) * kstep; const char* b2 = last ? nB : cB + (size_t)(t + 2) * kstep;
            const char* a3 = a2 + kstep; const char* b3 = b2 + kstep;
            if (last && has_next) S.a_ready(nxt);
            if constexpr (SP2) {
            PG8_LDB(B0, 0, 0); PG8_LDB(B1, 0, 1); PG8_SCHED; PG8_LDA(At, 0, 0); PG8_STAGE(PG8_SA(1, 1), a1 + hstep, voffA);
            PG8_WAIT_V(8); PG8_WAIT_L(0); PG8_BAR; PG8_MMA(0, 0, At, B0); PG8_MMA(0, 1, At, B1); PG8_BAR; PG8_SCHED;
            PG8_LDA(At, 0, 1); PG8_STAGE(PG8_SB(0, 0), b2, voffB); PG8_STAGE(PG8_SB(0, 1), b2 + hstep, voffB); PG8_STAGE(PG8_SA(0, 0), a2, voffA);
            PG8_WAIT_V(8); PG8_WAIT_L(0); PG8_BAR; PG8_MMA(1, 0, At, B0); PG8_MMA(1, 1, At, B1); PG8_BAR; PG8_SCHED;
            PG8_LDB(B0, 1, 0); PG8_LDB(B1, 1, 1); PG8_SCHED; PG8_LDA(At, 1, 0); PG8_STAGE(PG8_SA(0, 1), a2 + hstep, voffA);
            PG8_WAIT_V(8); PG8_WAIT_L(0); PG8_BAR; PG8_MMA(0, 0, At, B0); PG8_MMA(0, 1, At, B1); PG8_BAR; PG8_SCHED;
            PG8_LDA(At, 1, 1); PG8_STAGE(PG8_SB(1, 0), b3, voffB); PG8_STAGE(PG8_SB(1, 1), b3 + hstep, voffB); PG8_STAGE(PG8_SA(1, 0), a3, voffA);
            PG8_WAIT_V(8); PG8_WAIT_L(0); PG8_BAR; PG8_MMA(1, 0, At, B0); PG8_MMA(1, 1, At, B1); PG8_BAR; PG8_SCHED;
            } else {
            PG8_LDB(B0, 0, 0); PG8_SCHED; PG8_LDA(At, 0, 0); PG8_STAGE(PG8_SA(1, 1), a1 + hstep, voffA);
            PG8_WAIT_L(8); PG8_BAR; PG8_WAIT_L(0); PG8_MMA(0, 0, At, B0); PG8_BAR; PG8_SCHED;
            PG8_LDB(B1, 0, 1); PG8_STAGE(PG8_SB(0, 0), b2, voffB);
            PG8_BAR; PG8_WAIT_L(0); PG8_MMA(0, 1, At, B1); PG8_BAR;
            PG8_LDA(At, 0, 1); PG8_STAGE(PG8_SA(0, 0), a2, voffA);
            PG8_BAR; PG8_WAIT_L(0); PG8_MMA(1, 0, At, B0); PG8_BAR; PG8_SCHED;
            PG8_STAGE(PG8_SB(0, 1), b2 + hstep, voffB);
            PG8_WAIT_V(6); PG8_BAR; PG8_MMA(1, 1, At, B1); PG8_BAR;
            PG8_LDB(B0, 1, 0); PG8_SCHED; PG8_LDA(At, 1, 0); PG8_STAGE(PG8_SA(0, 1), a2 + hstep, voffA);
            PG8_WAIT_L(8); PG8_BAR; PG8_WAIT_L(0); PG8_MMA(0, 0, At, B0); PG8_BAR; PG8_SCHED;
            PG8_LDB(B1, 1, 1); PG8_STAGE(PG8_SB(1, 0), b3, voffB);
            PG8_BAR; PG8_WAIT_L(0); PG8_MMA(0, 1, At, B1); PG8_BAR;
            PG8_LDA(At, 1, 1); PG8_STAGE(PG8_SA(1, 0), a3, voffA);
            PG8_BAR; PG8_WAIT_L(0); PG8_MMA(1, 0, At, B0); PG8_BAR; PG8_SCHED;
            PG8_STAGE(PG8_SB(1, 1), b3 + hstep, voffB);
            PG8_WAIT_V(6); PG8_BAR; PG8_MMA(1, 1, At, B1); PG8_BAR;
            }
        }
        if constexpr (ALIGN_EPI) { if (wr == 0) PG8_BAR; }
        if constexpr (!Epi::AFTER_DRAIN) { E(acc, cur, wr, wc, fr, fq); S.done(cur); }
        if (!has_next) break;
#pragma unroll
        for (int a = 0; a < 2; ++a)
#pragma unroll
            for (int b = 0; b < 2; ++b)
#pragma unroll
                for (int m = 0; m < 4; ++m)
#pragma unroll
                    for (int n = 0; n < 2; ++n) acc[a][b][m][n] = (f32x4){0.f, 0.f, 0.f, 0.f};
        cur = nxt; cA = nA; cB = nB; ++ui;
        if constexpr (ALIGN_EPI) { if (wr == 1) PG8_BAR; }
    }
    PG8_WAIT_V(0);
    if constexpr (!ALIGN_EPI) { if (wr == 0) PG8_BAR; }
    PG8_BAR;
    if constexpr (Epi::AFTER_DRAIN) { E.fused(acc, cur, wr, wc, fr, fq, lds, wid, lane); S.done(cur); }
#undef PG8_SA
#undef PG8_SB
#undef PG8_STAGE
#undef PG8_LDA
#undef PG8_LDB
#undef PG8_MMA
#undef PG8_WAIT_V
#undef PG8_WAIT_L
#undef PG8_BAR
#undef PG8_SCHED
}
}
#include <hip/hip_bf16.h>
#include <cmath>
namespace attn_body {
using bf16=__hip_bfloat16;
using bf16x8=__attribute__((ext_vector_type(8)))short;
using s16x4=__attribute__((ext_vector_type(4)))short;
using f32x16=__attribute__((ext_vector_type(16)))float;
using u32x4=__attribute__((ext_vector_type(4)))unsigned;
using f32x4v=__attribute__((ext_vector_type(4)))float;
typedef const __attribute__((address_space(3))) f32x4v* lds_f4p;
constexpr int BATCH=8,NHEAD=8,SEQ=8192,D=64,DM=NHEAD*D,OPITCH=1024;
constexpr int NW=8,QBLK=32,QB=QBLK*NW,KVBLK=64,NQB=SEQ/QB;
constexpr int ATTN_PITCH=DM, ATTN_UNIT_ROWS=QB;
__device__ __forceinline__ int crow(int r,int hi){return (r&3)+8*(r>>2)+4*hi;}
#define SBAR() __builtin_amdgcn_sched_barrier(0)
__device__ __forceinline__ void cmask(f32x16&p0,f32x16&p1,int jb,int qrel,int hi){
  const float NEG=-INFINITY; int kb=64*jb+4*hi;
  #pragma unroll
  for(int r=0;r<16;++r){int kv=kb+(r&3)+8*(r>>2); if(kv>qrel)p0[r]=NEG; if(kv+32>qrel)p1[r]=NEG;}
}

constexpr int NSLOT=3, SLOTB=8192;
constexpr int LDS_K=0, LDS_V=NSLOT*SLOTB, LDS_WS=2*NSLOT*SLOTB, LDS_OST=LDS_WS+NW*64*4, LDS_C2=LDS_OST+NW*4096, LDS_BYTES=LDS_C2+SEQ*4, LDS_TSL=LDS_BYTES+1024;
constexpr float C2=0.125f*1.4426950408889634f;
__device__ __forceinline__ void glds16(const void*gsrc,unsigned lds_dst){unsigned keep;
  asm volatile("s_mov_b32 %0, m0\n\ts_mov_b32 m0, %2\n\ts_nop 0\n\tglobal_load_lds_dwordx4 %1, off\n\ts_mov_b32 m0, %0":"=&s"(keep):"v"(gsrc),"s"(lds_dst):"memory");}
__device__ __forceinline__ float max3f(float a,float b,float c){float r;asm("v_max3_f32 %0, %1, %2, %3":"=v"(r):"v"(a),"v"(b),"v"(c));return r;}
__device__ __forceinline__ float max2f(float a,float b){float r;asm("v_max_f32_e32 %0, %1, %2":"=v"(r):"v"(a),"v"(b));return r;}
__device__ __forceinline__ float fadd_s(float a,float b){float r;asm("v_add_f32_e32 %0, %1, %2":"=v"(r):"v"(a),"v"(b));return r;}
__device__ __forceinline__ float fsub_s(float a,float b){float r;asm("v_sub_f32_e32 %0, %1, %2":"=v"(r):"v"(a),"v"(b));return r;}
typedef float f32x2_t __attribute__((ext_vector_type(2))); typedef __bf16 bf16x2_t __attribute__((ext_vector_type(2)));
__device__ __forceinline__ unsigned cvtpk_s(float lo,float hi){f32x2_t v={lo,hi};bf16x2_t b=__builtin_convertvector(v,bf16x2_t);return __builtin_bit_cast(unsigned,b);}
#define WAIT_BAR(N) asm volatile("s_waitcnt vmcnt(" #N ") lgkmcnt(0)\n\ts_barrier":::"memory")

__device__ __forceinline__ void qkt(f32x16&p0,f32x16&p1,const char*Kslot,const bf16x8*qr,int r32,int hi){
  const char*kb=Kslot+hi*1024+r32*16;
  #pragma unroll
  for(int d0=0;d0<4;++d0){
    const bf16x8 b0=*reinterpret_cast<const bf16x8*>(kb+d0*2048);
    const bf16x8 b1=*reinterpret_cast<const bf16x8*>(kb+d0*2048+512);
    p0=__builtin_amdgcn_mfma_f32_32x32x16_bf16(b0,qr[d0],p0,0,0,0);p1=__builtin_amdgcn_mfma_f32_32x32x16_bf16(b1,qr[d0],p1,0,0,0);}
}
typedef __attribute__((address_space(3))) const char* lds_cptr;
typedef short v4i16_t __attribute__((ext_vector_type(4)));
__device__ __forceinline__ void kload8(bf16x8*kf,lds_cptr kp){
  kf[0]=*(const __attribute__((address_space(3))) bf16x8*)(kp);      kf[1]=*(const __attribute__((address_space(3))) bf16x8*)(kp+512);
  kf[2]=*(const __attribute__((address_space(3))) bf16x8*)(kp+2048); kf[3]=*(const __attribute__((address_space(3))) bf16x8*)(kp+2560);
  kf[4]=*(const __attribute__((address_space(3))) bf16x8*)(kp+4096); kf[5]=*(const __attribute__((address_space(3))) bf16x8*)(kp+4608);
  kf[6]=*(const __attribute__((address_space(3))) bf16x8*)(kp+6144); kf[7]=*(const __attribute__((address_space(3))) bf16x8*)(kp+6656);
}
__device__ __forceinline__ void kload2(bf16x8*kf,lds_cptr kp,int j){ kf[2*j]=*(const __attribute__((address_space(3))) bf16x8*)(kp+j*2048); kf[2*j+1]=*(const __attribute__((address_space(3))) bf16x8*)(kp+j*2048+512); }
__device__ __forceinline__ s16x4 vtr(lds_cptr p){ return __builtin_bit_cast(s16x4,__builtin_amdgcn_ds_read_tr16_b64_v4i16((__attribute__((address_space(3))) v4i16_t*)p)); }
__device__ __forceinline__ float rowmax(const f32x16&p0,const f32x16&p1){
  float a=max3f(p0[0],p0[1],p1[0]),b=max3f(p0[2],p0[3],p1[1]);a=max3f(a,p1[2],p1[3]);
  #pragma unroll
  for(int r=4;r<16;r+=4){a=max3f(a,p0[r],p0[r+1]);b=max3f(b,p0[r+2],p0[r+3]);a=max3f(a,p1[r],p1[r+1]);b=max3f(b,p1[r+2],p1[r+3]);}
  const float m=max2f(a,b);
  auto rr=__builtin_amdgcn_permlane32_swap(__float_as_uint(m),__float_as_uint(m),false,false);
  return max2f(__uint_as_float(rr[0]),__uint_as_float(rr[1]));
}
__device__ __forceinline__ void pv(f32x16*o,int vb,bf16x8 pa0,bf16x8 pa1,bf16x8 pa2,bf16x8 pa3){
  #pragma unroll
  for(int d0=0;d0<2;++d0){s16x4 lo[4],hi[4];
    #pragma unroll
    for(int ks=0;ks<4;++ks){
      asm volatile("ds_read_b64_tr_b16 %0,%1 offset:%c2":"=&v"(lo[ks]):"v"(vb),"i"(d0*4096+ks*1024):"memory");
      asm volatile("ds_read_b64_tr_b16 %0,%1 offset:%c2":"=&v"(hi[ks]):"v"(vb),"i"(d0*4096+ks*1024+512):"memory");}
    asm volatile("s_waitcnt lgkmcnt(0)":::"memory");SBAR();
    #define PK(k) (bf16x8){lo[k][0],lo[k][1],lo[k][2],lo[k][3],hi[k][0],hi[k][1],hi[k][2],hi[k][3]}
    o[d0]=__builtin_amdgcn_mfma_f32_32x32x16_bf16(pa0,PK(0),o[d0],0,0,0);
    o[d0]=__builtin_amdgcn_mfma_f32_32x32x16_bf16(pa1,PK(1),o[d0],0,0,0);
    o[d0]=__builtin_amdgcn_mfma_f32_32x32x16_bf16(pa2,PK(2),o[d0],0,0,0);
    o[d0]=__builtin_amdgcn_mfma_f32_32x32x16_bf16(pa3,PK(3),o[d0],0,0,0);
    #undef PK
  }
}

#ifndef ATTN_STORE16
#define ATTN_STORE16(p,v) (*(u32x4*)(p)=(v))
#endif
template<int THRL,class SchedT> __device__ __forceinline__ void attn_unit(const SchedT&Sq,int b,int h,int qb,const bf16*Q,const bf16*__restrict__ K,const bf16*__restrict__ V,bf16*O,const float*__restrict__ NC2,int ts,char*shm){
  int tid_l=threadIdx.x; asm volatile("":"+v"(tid_l)); const int tid=tid_l,lane=tid&63,r32=lane&31,hi=lane>>5; const int wid=__builtin_amdgcn_readfirstlane(tid>>6);
  const long rowbase=(long)b*SEQ; const int q0=qb*QB;
  const bf16*Qw=Q+(rowbase+q0+wid*QBLK)*DM+h*D;
  const bf16*Kh=K+(rowbase+(long)ts*KVBLK)*DM+h*D,*Vh=V+(rowbase+(long)ts*KVBLK)*DM+h*D;
  const unsigned lds0=(unsigned)(uintptr_t)shm;
  float*wsf=(float*)(shm+LDS_WS)+wid*64;
  const bf16*ksrc=Kh+(long)lane*DM+wid*8;
  const bf16*vsrc=Vh+(long)(16*(wid&3)+(lane>>2))*DM+(wid>>2)*32+(lane&3)*8;
  const unsigned kdst=lds0+LDS_K+wid*1024, vdst=lds0+LDS_V+wid*1024;
  #define DMA_K(t,slot) glds16(ksrc+(long)(t)*KVBLK*DM,(unsigned)__builtin_amdgcn_readfirstlane(kdst+(slot)))
  #define DMA_V(t,slot) glds16(vsrc+(long)(t)*KVBLK*DM,(unsigned)__builtin_amdgcn_readfirstlane(vdst+(slot)))
  const int vb0=(int)(lds0+LDS_V)+((lane>>4)&1)*32+(lane&3)*8+(4*hi+((lane&15)>>2))*64;
  const char*Kbase=shm+LDS_K; bf16x8 kf[8];
  const lds_cptr shm3=(lds_cptr)shm; const lds_cptr c2l=shm3+LDS_C2+16*hi; const lds_cptr kp0=shm3+LDS_K+hi*1024+r32*16; const lds_cptr vp0=shm3+LDS_V+((lane>>4)&1)*32+(lane&3)*8+(4*hi+((lane&15)>>2))*64;
  const int NT=(q0+QB)/KVBLK-ts;
  DMA_K(0,0);DMA_V(0,0);DMA_K(1,SLOTB);
  bf16x8 qr[4];
  #pragma unroll
  for(int d0=0;d0<4;++d0)qr[d0]=*reinterpret_cast<const bf16x8*>(&Qw[(long)r32*DM+d0*16+hi*8]);
  { const float*cg_=NC2+(long)(b*NHEAD+h)*SEQ+ts*KVBLK; float*cl_=(float*)(shm+LDS_C2); const int nq_=q0+QB-ts*KVBLK;
    for(int i_=tid*4;i_<nq_;i_+=NW*64*4)*(f32x4v*)(cl_+i_)=*(const f32x4v*)(cg_+i_); }
  float mhat=0.f,l_reg=0.f;f32x16 o[2];o[0]=f32x16{};o[1]=f32x16{};
  const int qrel=wid*QBLK+r32;
  #define CMASK(P0,P1,t) do{int jb_=(t)-(NT-4); if(jb_>=0)cmask(P0,P1,jb_,qrel,hi);}while(0)
  bool resc=false;
  #define START(P0,P1) do{ const float rm=rowmax(P0,P1); resc=false; \
    { const float dl=rm; mhat=fadd_s(mhat,dl); \
      _Pragma("unroll") for(int r=0;r<16;++r){P0[r]=fsub_s(P0[r],dl);P1[r]=fsub_s(P1[r],dl);} \
      } \
    _Pragma("unroll") for(int r=0;r<16;++r)P0[r]=__builtin_amdgcn_exp2f(P0[r]); }while(0)
  #define RESC() do{ if(resc){ asm volatile("s_waitcnt lgkmcnt(0)":::"memory"); \
      _Pragma("unroll") for(int d_=0;d_<2;++d_) _Pragma("unroll") for(int r=0;r<16;++r)o[d_][r]*=wsf[crow(r,hi)]; } }while(0)
  f32x16 pA0,pA1,pB0,pB1;
  #define KBLD(X0,X1,tt) do{ const lds_f4p cb_=(lds_f4p)(c2l+(tt)*256); \
    _Pragma("unroll") for(int g_=0;g_<4;++g_){ const f32x4v a_=cb_[2*g_], b_=cb_[2*g_+8]; \
      X0[4*g_+0]=a_[0]-mhat; X0[4*g_+1]=a_[1]-mhat; X0[4*g_+2]=a_[2]-mhat; X0[4*g_+3]=a_[3]-mhat; \
      X1[4*g_+0]=b_[0]-mhat; X1[4*g_+1]=b_[1]-mhat; X1[4*g_+2]=b_[2]-mhat; X1[4*g_+3]=b_[3]-mhat; } }while(0)
  int sl_prev=0,sl_cur=0,sl_next=SLOTB;
  #define ROT() do{sl_prev=sl_cur;sl_cur=sl_next;sl_next=(sl_next==(NSLOT-1)*SLOTB)?0:sl_next+SLOTB;}while(0)
  DMA_K(2,2*SLOTB);
  WAIT_BAR(3);
  KBLD(pA0,pA1,0);
  qkt(pA0,pA1,Kbase,qr,r32,hi);asm volatile("s_nop 15\n\ts_nop 7":"+v"(pA0),"+v"(pA1));CMASK(pA0,pA1,0);
  START(pA0,pA1);
  KBLD(pB0,pB1,1);
  _Pragma("unroll") for(int r=0;r<16;++r)pA1[r]=__builtin_amdgcn_exp2f(pA1[r]);
  WAIT_BAR(0);
  DMA_K(3,0);DMA_V(1,SLOTB);
  ROT();
  kload8(kf,kp0+sl_cur);
  WAIT_BAR(2);
  s16x4 vlo[8],vhi[8]; u32x4 pw0,pw1,pw2,pw3;
  #define PKW(P,B) cvtpk_s(P[B],P[B+1])
  #define PAF(k) __builtin_bit_cast(bf16x8,pw##k)
  #define VFR(i) (bf16x8){vlo[i][0],vlo[i][1],vlo[i][2],vlo[i][3],vhi[i][0],vhi[i][1],vhi[i][2],vhi[i][3]}
  #define PIN(x) asm volatile("":"+v"(x))
  #define MX3(a,b,c) __builtin_fmaxf(__builtin_fmaxf((a),(b)),(c))
  #define GAPA(MF,A0,A1,A2,A3,W0,W1,PW) do{ MF; sacc+=A0; sacc+=A1; sacc+=A2; sacc+=A3; PIN(sacc); W0; W1; PIN(PW); SBAR(); }while(0)
  #define EX(v) __builtin_amdgcn_exp2f(v)
  #define GAPB(MF,X,B) do{ MF; X[B]=EX(X[B]); X[B+1]=EX(X[B+1]); X[B+2]=EX(X[B+2]); X[B+3]=EX(X[B+3]); PIN(X); SBAR(); }while(0)
  #define VRD(i) do{ vlo[i]=vtr(vp_+(((i)>>2)*4096+((i)&3)*1024)); vhi[i]=vtr(vp_+(((i)>>2)*4096+((i)&3)*1024+512)); }while(0)
  #define KBQ(X,g_,i_) do{ const f32x4v a_=cb_[i_]; X[4*(g_)+0]=a_[0]; X[4*(g_)+1]=a_[1]; X[4*(g_)+2]=a_[2]; X[4*(g_)+3]=a_[3]; }while(0)
  #define KBQ2(G,XA,ga,ia,XB,gb,ib) do{ if(G){ KBQ(XA,ga,ia); KBQ(XB,gb,ib); SBAR(); } }while(0)
  #define KRD(G,j) do{ if(G){ kload2(kf,kp0+sl_next,j); SBAR(); } }while(0)
  #define STEP(C0,C1,P0,P1,t,GK,GV,GL) do{ SBAR(); \
    const lds_cptr vp_=vp0+sl_prev; \
    VRD(0); SBAR(); float sacc=(P0[0]+P0[1]); \
    GAPA(C0=__builtin_amdgcn_mfma_f32_32x32x16_bf16(kf[0],qr[0],C0,0,0,0), P0[2],P0[3],P0[4],P0[5],     pw0[0]=PKW(P0,0), pw0[1]=PKW(P0,2), pw0); \
    VRD(4); SBAR(); GAPA(C1=__builtin_amdgcn_mfma_f32_32x32x16_bf16(kf[1],qr[0],C1,0,0,0), P0[6],P0[7],P0[8],P0[9],     pw0[2]=PKW(P0,4), pw0[3]=PKW(P0,6), pw0); \
    VRD(1); SBAR(); GAPA(C0=__builtin_amdgcn_mfma_f32_32x32x16_bf16(kf[2],qr[1],C0,0,0,0),   P0[10],P0[11],P0[12],P0[13], pw1[0]=PKW(P0,8), pw1[1]=PKW(P0,10), pw1); \
    VRD(5); SBAR(); GAPA(C1=__builtin_amdgcn_mfma_f32_32x32x16_bf16(kf[3],qr[1],C1,0,0,0),   P0[14],P0[15],P1[0],P1[1],   pw1[2]=PKW(P0,12),pw1[3]=PKW(P0,14), pw1); \
    VRD(2); SBAR(); GAPA(C0=__builtin_amdgcn_mfma_f32_32x32x16_bf16(kf[4],qr[2],C0,0,0,0),   P1[2],P1[3],P1[4],P1[5],     pw2[0]=PKW(P1,0), pw2[1]=PKW(P1,2), pw2); \
    VRD(6); SBAR(); GAPA(C1=__builtin_amdgcn_mfma_f32_32x32x16_bf16(kf[5],qr[2],C1,0,0,0),   P1[6],P1[7],P1[8],P1[9],     pw2[2]=PKW(P1,4), pw2[3]=PKW(P1,6), pw2); \
    VRD(3); SBAR(); GAPA(C0=__builtin_amdgcn_mfma_f32_32x32x16_bf16(kf[6],qr[3],C0,0,0,0),   P1[10],P1[11],P1[12],P1[13], pw3[0]=PKW(P1,8), pw3[1]=PKW(P1,10), pw3); \
    VRD(7); SBAR(); GAPA(C1=__builtin_amdgcn_mfma_f32_32x32x16_bf16(kf[7],qr[3],C1,0,0,0),   P1[14],P1[15],0.f,0.f,       pw3[2]=PKW(P1,12),pw3[3]=PKW(P1,14), pw3); \
    l_reg+=sacc; \
    if(GK){DMA_K((t)+3,sl_cur);} if(GV){DMA_V((t)+1,sl_next);} \
    CMASK(C0,C1,t); \
    { float a=MX3(C0[0],C0[1],C1[0]),b=MX3(C0[2],C0[3],C1[1]); a=MX3(a,C1[2],C1[3]); \
      _Pragma("unroll") for(int r=4;r<16;r+=4){a=MX3(a,C0[r],C0[r+1]);b=MX3(b,C0[r+2],C0[r+3]);a=MX3(a,C1[r],C1[r+1]);b=MX3(b,C1[r+2],C1[r+3]);} \
      float rm=__builtin_fmaxf(a,b); { auto rr=__builtin_amdgcn_permlane32_swap(__float_as_uint(rm),__float_as_uint(rm),false,false); rm=__builtin_fmaxf(__uint_as_float(rr[0]),__uint_as_float(rr[1])); } \
      resc=false; \
      if(__builtin_expect(__any(rm>(float)THRL),0)){ const float dl=__builtin_fmaxf(rm,0.f); mhat+=dl; \
        _Pragma("unroll") for(int r=0;r<16;++r){C0[r]-=dl;C1[r]-=dl;} \
        const float f=__builtin_amdgcn_exp2f(-dl); l_reg*=f; if(hi==0)wsf[r32]=f; resc=true; } } \
    SBAR(); \
    const lds_f4p cb_=(lds_f4p)(c2l+((t)+1)*256);     \
    KBQ2(GL,P0,0,0,P0,1,2); GAPB(o[0]=__builtin_amdgcn_mfma_f32_32x32x16_bf16(PAF(0),VFR(0),o[0],0,0,0), C0,0); \
    KBQ2(GL,P0,2,4,P0,3,6); GAPB(o[1]=__builtin_amdgcn_mfma_f32_32x32x16_bf16(PAF(0),VFR(4),o[1],0,0,0), C0,4); \
    KRD(GL,0); GAPB(o[0]=__builtin_amdgcn_mfma_f32_32x32x16_bf16(PAF(1),VFR(1),o[0],0,0,0), C0,8); \
    KRD(GL,1); GAPB(o[1]=__builtin_amdgcn_mfma_f32_32x32x16_bf16(PAF(1),VFR(5),o[1],0,0,0), C0,12); \
    KRD(GL,2); GAPB(o[0]=__builtin_amdgcn_mfma_f32_32x32x16_bf16(PAF(2),VFR(2),o[0],0,0,0), C1,0); \
    KRD(GL,3); GAPB(o[1]=__builtin_amdgcn_mfma_f32_32x32x16_bf16(PAF(2),VFR(6),o[1],0,0,0), C1,4); \
    KBQ2(GL,P1,0,8,P1,1,10); GAPB(o[0]=__builtin_amdgcn_mfma_f32_32x32x16_bf16(PAF(3),VFR(3),o[0],0,0,0), C1,8); \
    KBQ2(GL,P1,2,12,P1,3,14); GAPB(o[1]=__builtin_amdgcn_mfma_f32_32x32x16_bf16(PAF(3),VFR(7),o[1],0,0,0), C1,12); \
    if(GL){ _Pragma("unroll") for(int r=0;r<16;++r){P0[r]-=mhat;P1[r]-=mhat;} } \
    }while(0)
  int t=1;
  #undef CMASK
  #define CMASK(P0,P1,t) do{}while(0)
  for(;t+5<NT;t+=2){
    STEP(pB0,pB1,pA0,pA1,t,true,true,true);     WAIT_BAR(2); RESC(); ROT();
    STEP(pA0,pA1,pB0,pB1,t+1,true,true,true);   WAIT_BAR(2); RESC(); ROT();
  }
  #undef CMASK
  #define CMASK(P0,P1,t) do{int jb_=(t)-(NT-4); if(jb_>=0)cmask(P0,P1,jb_,qrel,hi);}while(0)
  #define ENDW(tt) do{ if((tt)+3<NT){WAIT_BAR(2);} else if((tt)+2<NT){WAIT_BAR(1);} else {WAIT_BAR(0);} }while(0)
  for(;t+1<NT;t+=2){
    STEP(pB0,pB1,pA0,pA1,t,(t+3<NT),(t+1<NT),(t+1<NT));       ENDW(t);   RESC(); ROT();
    STEP(pA0,pA1,pB0,pB1,t+1,(t+4<NT),(t+2<NT),(t+2<NT));     ENDW(t+1); RESC(); ROT();
  }
  STEP(pB0,pB1,pA0,pA1,NT-1,false,false,false); RESC();
  { float sacc=pB0[0]+pB0[1]; _Pragma("unroll") for(int r=2;r<16;++r)sacc+=pB0[r]; _Pragma("unroll") for(int r=0;r<16;++r)sacc+=pB1[r]; l_reg+=sacc;
    pw0=(u32x4){PKW(pB0,0),PKW(pB0,2),PKW(pB0,4),PKW(pB0,6)};pw1=(u32x4){PKW(pB0,8),PKW(pB0,10),PKW(pB0,12),PKW(pB0,14)};pw2=(u32x4){PKW(pB1,0),PKW(pB1,2),PKW(pB1,4),PKW(pB1,6)};pw3=(u32x4){PKW(pB1,8),PKW(pB1,10),PKW(pB1,12),PKW(pB1,14)};
    SBAR(); pv(o,vb0+sl_cur,PAF(0),PAF(1),PAF(2),PAF(3)); }
  #undef PKW
  #undef PAF
  #undef VFR
  #undef PIN
  #undef MX3
  #undef GAPA
  #undef GAPB
  #undef EX
  #undef VRD
  #undef KRD
  #undef KBQ
  #undef KBQ2
  #undef STEP
  #undef ENDW
  Sq.prefetch();
  {auto rr=__builtin_amdgcn_permlane32_swap(__float_as_uint(l_reg),__float_as_uint(l_reg),false,false);l_reg=__uint_as_float(rr[0])+__uint_as_float(rr[1]);}
  if(hi==0)wsf[32+r32]=l_reg;asm volatile("s_waitcnt lgkmcnt(0)":::"memory");
  float rli[16];
  #pragma unroll
  for(int r=0;r<16;++r)rli[r]=__builtin_amdgcn_rcpf(wsf[32+crow(r,hi)]);
  bf16*Ow=O+(rowbase+q0+wid*QBLK)*OPITCH+h*D;
  { bf16*stg=(bf16*)(shm+LDS_OST)+wid*2048;
    #pragma unroll
    for(int r=0;r<16;++r){const int orow=crow(r,hi);
      #pragma unroll
      for(int d0=0;d0<2;++d0)stg[orow*64+d0*32+r32]=__float2bfloat16(o[d0][r]*rli[r]);}
    asm volatile("s_waitcnt lgkmcnt(0)":::"memory");
    #pragma unroll
    for(int i=0;i<4;++i){const int row=i*8+(lane>>3),ch=lane&7; const u32x4 v=*(const u32x4*)(stg+row*64+ch*8); ATTN_STORE16(Ow+(long)row*OPITCH+ch*8,v);} }
  asm volatile("s_waitcnt lgkmcnt(0)\n\ts_barrier":::"memory");
  #undef DMA_K
  #undef DMA_V
  #undef CMASK
  #undef START
  #undef RESC
  #undef ROT
  #undef KBLD
}
constexpr int ATTN_LDS_BYTES=LDS_BYTES;
struct AttnTensors { const bf16* Q; const bf16* K; const bf16* V; bf16* O; const float* NC2; const int* TS; };
struct AttnUnit { int bh; int qb; };
struct QueueOrder {
  unsigned* cnt; volatile __attribute__((address_space(3))) unsigned* slot; mutable unsigned pend; int qid;
  __device__ __forceinline__ void prefetch()const{ if(threadIdx.x==0)pend=__hip_atomic_fetch_add(cnt,1u,__ATOMIC_RELAXED,__HIP_MEMORY_SCOPE_AGENT); }
  __device__ __forceinline__ bool next(int i,AttnUnit&u)const{
    if(i==0)prefetch();
    if(threadIdx.x==0)*slot=pend;
    __syncthreads(); const unsigned n=*slot; if(n>=(unsigned)(NHEAD*NQB))return false; u.qb=NQB-1-(int)(n>>3); u.bh=qid*NHEAD+(int)(n&7u); return true; }
  __device__ __forceinline__ void a_ready(const AttnUnit&)const{}
  __device__ __forceinline__ void done(const AttnUnit&)const{}
};
struct StaticOrder {
  int vcu;
  __device__ __forceinline__ explicit StaticOrder(int grid,int block):vcu((block%8)*(grid/8)+block/8){}
  __device__ __forceinline__ bool next(int i,AttnUnit&u)const{ if(i>=8)return false; const int s=vcu&3; u.bh=vcu>>2; u.qb=8*(i>>1)+((i&1)?7-s:s); return true; }
  __device__ __forceinline__ void a_ready(const AttnUnit&)const{}
  __device__ __forceinline__ void done(const AttnUnit&)const{}
  __device__ __forceinline__ void prefetch()const{}
};
template<class Sched,int THRL=8> __device__ __forceinline__ void attn_phase(char*lds,const AttnTensors&T,const Sched&S){
  AttnUnit u;
  for(int i=0;S.next(i,u);++i){ S.a_ready(u); attn_unit<THRL,Sched>(S,u.bh/NHEAD,u.bh%NHEAD,u.qb,T.Q,T.K,T.V,T.O,T.NC2,__builtin_amdgcn_readfirstlane(((const __attribute__((address_space(3))) int*)(lds_cptr)lds)[(LDS_TSL>>2)+u.bh*NQB+u.qb]),lds); S.done(u); }
}
#undef SBAR
#undef WAIT_BAR
}
namespace xat {
#define XLAS __attribute__((address_space(3)))
typedef unsigned short bf16_t;
typedef short bf16x8 __attribute__((ext_vector_type(8)));
typedef float f32x16 __attribute__((ext_vector_type(16)));
typedef unsigned u32x4 __attribute__((ext_vector_type(4)));
typedef unsigned u32x2 __attribute__((ext_vector_type(2)));
constexpr int KROW = 272, VROW = 520, LDS_K = 0, LDS_V = 256 * KROW, LDS_END = LDS_V + 128 * VROW;
__device__ __forceinline__ unsigned cvtpk(float lo, float hi) { unsigned r; asm volatile("v_cvt_pk_bf16_f32 %0, %1, %2" : "=v"(r) : "v"(lo), "v"(hi)); return r; }
__device__ __forceinline__ void load_kv(const bf16_t* MKbh, const bf16_t* MVtbh, XLAS unsigned char* lds, int tid) {
    for (int i = tid; i < 4096; i += 512) { const int row = i >> 4, ch = i & 15; const u32x4 v = *(const u32x4*)(MKbh + row * 128 + ch * 8); *(XLAS u32x4*)(lds + LDS_K + row * KROW + ch * 16) = v; }
    for (int i = tid; i < 4096; i += 512) { const int row = i >> 5, ch = i & 31; const u32x4 v = *(const u32x4*)(MVtbh + row * 256 + ch * 8);
        XLAS u32x2* p = (XLAS u32x2*)(lds + LDS_V + row * VROW + ch * 16); p[0] = (u32x2){v.x, v.y}; p[1] = (u32x2){v.z, v.w}; }
}
__device__ __forceinline__ void unit(const bf16_t* MQ, bf16_t* MO, int b, int h, int qblk, XLAS unsigned char* lds) {
    int tid = threadIdx.x; asm volatile("" : "+v"(tid)); const int lane = tid & 63, r32 = lane & 31, hi = lane >> 5, wid = tid >> 6;
    const size_t row = (size_t)b * 8192 + qblk * 256 + wid * 32 + r32;
    const bf16_t* qp = MQ + row * 512 + h * 128 + hi * 8;
    bf16x8 qr[8];
#pragma unroll
    for (int d0 = 0; d0 < 8; ++d0) qr[d0] = *(const bf16x8*)(qp + d0 * 16);
    f32x16 S[8];
#pragma unroll
    for (int kb = 0; kb < 8; ++kb) { S[kb] = f32x16{};
#pragma unroll
        for (int d0 = 0; d0 < 8; ++d0) { const bf16x8 kf = *(const XLAS bf16x8*)(lds + LDS_K + (32 * kb + r32) * KROW + d0 * 32 + hi * 16);
            S[kb] = __builtin_amdgcn_mfma_f32_32x32x16_bf16(kf, qr[d0], S[kb], 0, 0, 0); }
        __builtin_amdgcn_sched_barrier(0); }
    float m = S[0][0];
#pragma unroll
    for (int kb = 0; kb < 8; ++kb)
#pragma unroll
        for (int r = 0; r < 16; ++r) m = fmaxf(m, S[kb][r]);
    m = fmaxf(m, __shfl_xor(m, 32));
    float l = 0.f;
#pragma unroll
    for (int kb = 0; kb < 8; ++kb)
#pragma unroll
        for (int r = 0; r < 16; ++r) { const float p = __builtin_amdgcn_exp2f(S[kb][r] - m); S[kb][r] = p; l += p; }
    l += __shfl_xor(l, 32);
    u32x4 pw[8][2];
#pragma unroll
    for (int kb = 0; kb < 8; ++kb)
#pragma unroll
        for (int sp = 0; sp < 2; ++sp) { pw[kb][sp].x = cvtpk(S[kb][8 * sp + 0], S[kb][8 * sp + 1]); pw[kb][sp].y = cvtpk(S[kb][8 * sp + 2], S[kb][8 * sp + 3]); pw[kb][sp].z = cvtpk(S[kb][8 * sp + 4], S[kb][8 * sp + 5]); pw[kb][sp].w = cvtpk(S[kb][8 * sp + 6], S[kb][8 * sp + 7]); }
    __builtin_amdgcn_sched_barrier(0);
    f32x16 o[4];
#pragma unroll
    for (int db = 0; db < 4; ++db) o[db] = f32x16{};
#pragma unroll
    for (int kb = 0; kb < 8; ++kb)
#pragma unroll
        for (int sp = 0; sp < 2; ++sp) {
            const bf16x8 pk = __builtin_bit_cast(bf16x8, pw[kb][sp]);
#pragma unroll
            for (int db = 0; db < 4; ++db) { const XLAS unsigned char* vb = lds + LDS_V + (32 * db + r32) * VROW + (32 * kb + 16 * sp + 4 * hi) * 2;
                const u32x2 lo = *(const XLAS u32x2*)vb, hh = *(const XLAS u32x2*)(vb + 16);
                const u32x4 vw = (u32x4){lo.x, lo.y, hh.x, hh.y};
                o[db] = __builtin_amdgcn_mfma_f32_32x32x16_bf16(__builtin_bit_cast(bf16x8, vw), pk, o[db], 0, 0, 0); }
            __builtin_amdgcn_sched_barrier(0); }
    const float inv = 1.0f / l;
    bf16_t* op = MO + row * 512 + h * 128 + 4 * hi;
#pragma unroll
    for (int db = 0; db < 4; ++db)
#pragma unroll
        for (int g = 0; g < 4; ++g) { u32x2 w; w.x = cvtpk(o[db][4 * g + 0] * inv, o[db][4 * g + 1] * inv); w.y = cvtpk(o[db][4 * g + 2] * inv, o[db][4 * g + 3] * inv);
            *(u32x2*)(op + 32 * db + 8 * g) = w; }
}
}

namespace cg = cooperative_groups;
#define LAS __attribute__((address_space(3)))
typedef unsigned short bf16;
typedef unsigned v4u __attribute__((ext_vector_type(4)));
typedef unsigned v2u __attribute__((ext_vector_type(2)));
typedef float f32x4 __attribute__((ext_vector_type(4)));
constexpr int NWAVES = 8;
constexpr int DM = 1024, BATCH = 8, SEQ = 8192, MTOK = BATCH * SEQ, DEPTH = 2, NIN = 2056, NINP = 2304, DFF = 2816, MEMLEN = 256;
constexpr float EPS = 1e-6f;
constexpr size_t MiB = 1u << 20;
constexpr size_t WS_W = 1 * MiB, WS_WSTRIDE = 28 * MiB;
constexpr size_t WO_IN = 0, WO_OUT = 5 * MiB, WO_MQ = 7 * MiB, WO_MKV = 8 * MiB, WO_MO = 10 * MiB, WO_GU = 11 * MiB, WO_D = 22 * MiB;
constexpr size_t WS_BAR = 65536, WS_BAR_BYTES = 16384;
constexpr int XBST_OFF = 141312;
constexpr size_t WS_QCNT = 0, WS_TS = 4096;
constexpr size_t WS_LF = 58 * MiB, WS_NC2 = 60 * MiB, WS_SSQ = 62 * MiB, WS_MN = 66 * MiB, WS_MK = 74 * MiB, WS_MVT = 78 * MiB;
constexpr size_t WS_HB = 96 * MiB, WS_Q = 224 * MiB, WS_K = 288 * MiB, WS_V = 352 * MiB, WS_P = 416 * MiB, WS_CAT = 480 * MiB, WS_MQ = 608 * MiB, WS_MO = 672 * MiB, WS_FP = 736 * MiB, WS_END = 768 * MiB;
constexpr size_t WS_ACT = 224 * MiB;
static_assert(WS_ACT + (size_t)MTOK * DFF * 2 <= WS_MQ, "ACT overlay");
constexpr int RING_BYTES = 131072, EPIX_OFF = 132096, LDS_BYTES = 147456;

__device__ __forceinline__ unsigned f2bf(float f) { unsigned u = __builtin_bit_cast(unsigned, f); return (u + 0x7fffu + ((u >> 16) & 1u)) >> 16; }
__device__ __forceinline__ unsigned pk2(float lo, float hi) { return f2bf(lo) | (f2bf(hi) << 16); }
__device__ __forceinline__ float wave_sum(float v) {
#pragma unroll
    for (int o = 1; o < 64; o <<= 1) v += __shfl_xor(v, o);
    return v;
}
__device__ __forceinline__ void tr_item(const float* W, int N, int k0, int n0, const float* g, bf16* WT, int Kdst, int drow0, LAS float* scr, int lane) {
    const int nq = (lane & 15) * 4; const bool ok = (n0 + nq) < N;
    f32x4 v[16];
#pragma unroll
    for (int i = 0; i < 16; ++i) { const int kk = 4 * i + (lane >> 4); v[i] = ok ? __builtin_nontemporal_load((const f32x4*)(W + (size_t)(k0 + kk) * N + n0 + nq)) : (f32x4){0.f, 0.f, 0.f, 0.f}; if (g) v[i] = v[i] * g[k0 + kk]; }
#pragma unroll
    for (int i = 0; i < 16; ++i) { const int kk = 4 * i + (lane >> 4); LAS float* d = scr + kk * 65 + nq; d[0] = v[i].x; d[1] = v[i].y; d[2] = v[i].z; d[3] = v[i].w; }
    asm volatile("s_waitcnt lgkmcnt(0)" ::: "memory");
    const int c = lane & 7;
#pragma unroll
    for (int j = 0; j < 8; ++j) { const int n = (lane >> 3) + 8 * j; const LAS float* s = scr + (8 * c) * 65 + n;
        v4u o; o.x = pk2(s[0 * 65], s[1 * 65]); o.y = pk2(s[2 * 65], s[3 * 65]); o.z = pk2(s[4 * 65], s[5 * 65]); o.w = pk2(s[6 * 65], s[7 * 65]);
        *(v4u*)(WT + (size_t)(drow0 + n) * Kdst + k0 + 8 * c) = o; }
    asm volatile("s_waitcnt lgkmcnt(0)" ::: "memory");
}

#ifndef PHMASK
#define PHMASK 0x3ff
#endif
#define XB_TMO      128
#define XB_XCNT(j)  (256  + 64 * (j))
#define XB_XSUB(j)  (1280 + 64 * (j))
#define XB_XGEN(j)  (2304 + 64 * (j))
#define XB_TOP      3328
#define XB_TOPGEN   3392
#define XCD_BAR_WORDS 3456
#define XB_SPIN_CAP (1u << 18)

__device__ __forceinline__ unsigned xb_ld(unsigned* p)              { return __hip_atomic_load(p, __ATOMIC_RELAXED, __HIP_MEMORY_SCOPE_AGENT); }
__device__ __forceinline__ unsigned xb_add(unsigned* p, unsigned v) { return __hip_atomic_fetch_add(p, v, __ATOMIC_RELAXED, __HIP_MEMORY_SCOPE_AGENT); }
__device__ __forceinline__ unsigned xb_xcc_id() { return (unsigned)__builtin_amdgcn_s_getreg((3 << 11) | 20) & 0xFu; }
#define XB_SPIN(cond, bar) do { unsigned _sp = 0; while (cond) { __builtin_amdgcn_s_sleep(1); \
    if ((++_sp & 255u) == 0u) { if (xb_ld(&(bar)[XB_TMO])) break; if (_sp > XB_SPIN_CAP) { atomicAdd(&(bar)[XB_TMO], 1u); break; } } } } while (0)

struct XcdBarrier {
    unsigned* bar; unsigned x;
    volatile LAS unsigned* st;
};

__device__ __forceinline__ XcdBarrier xcd_barrier_post(unsigned* bar, volatile LAS unsigned* st) {
    XcdBarrier b; b.bar = bar; b.x = xb_xcc_id(); b.st = st;
    if (threadIdx.x == 0) (void)xb_add(&bar[XB_XCNT(b.x)], 1u);
    return b;
}
__device__ __forceinline__ void xcd_barrier_complete(unsigned* bar, unsigned x, unsigned& nloc, unsigned& nx) {
    const unsigned G = gridDim.x * gridDim.y * gridDim.z;
    unsigned sum, cnt, mine, sp = 0u;
    for (;;) {
        sum = 0u; cnt = 0u; mine = 0u;
#pragma unroll
        for (unsigned j = 0; j < 16; ++j) { const unsigned c = xb_ld(&bar[XB_XCNT(j)]); sum += c; cnt += (c > 0u) ? 1u : 0u; mine = (j == x) ? c : mine; }
        if (sum == G) break;
        __builtin_amdgcn_s_sleep(1);
        if ((++sp & 255u) == 0u) { if (xb_ld(&bar[XB_TMO])) break; if (sp > XB_SPIN_CAP) { atomicAdd(&bar[XB_TMO], 1u); break; } }
    }
    nloc = mine > 0u ? mine : 1u; nx = cnt > 0u ? cnt : 1u;
}

__device__ __forceinline__ void xcd_barrier(const XcdBarrier& b) {
    asm volatile("s_waitcnt vmcnt(0)" ::: "memory");
    __syncthreads();
    if (threadIdx.x == 0) {
        unsigned* bar = b.bar;
        __builtin_amdgcn_s_waitcnt(0);
        unsigned nloc = b.st[0], nx = b.st[1];
        if (nloc == 0u) { xcd_barrier_complete(bar, b.x, nloc, nx); b.st[0] = nloc; b.st[1] = nx; }
        const unsigned old = xb_add(&bar[XB_XSUB(b.x)], 1u);
        const unsigned gen = old / nloc;
        if (old + 1u == (gen + 1u) * nloc) {
            __builtin_amdgcn_fence(__ATOMIC_RELEASE, "agent");
            asm volatile("s_waitcnt vmcnt(0)" ::: "memory");
            const unsigned og = xb_add(&bar[XB_TOP], 1u);
            const unsigned tg = og / nx;
            if (og + 1u == (tg + 1u) * nx) xb_add(&bar[XB_TOPGEN], 1u);
            else XB_SPIN(xb_ld(&bar[XB_TOPGEN]) == tg, bar);
            __builtin_amdgcn_fence(__ATOMIC_ACQUIRE, "agent");
            xb_add(&bar[XB_XGEN(b.x)], 1u);
            asm volatile("s_waitcnt vmcnt(0)" ::: "memory");
        } else {
            XB_SPIN(xb_ld(&bar[XB_XGEN(b.x)]) == gen, bar);
            __builtin_amdgcn_fence(__ATOMIC_ACQUIRE, "agent");
            asm volatile("s_waitcnt vmcnt(0)" ::: "memory");
        }
    }
    __syncthreads();
}

#define GAS1 __attribute__((address_space(1)))
__device__ __forceinline__ unsigned long long karg(int k) {
    const __attribute__((address_space(4))) unsigned long long* ka = (const __attribute__((address_space(4))) unsigned long long*)__builtin_amdgcn_kernarg_segment_ptr();
    asm volatile("" : "+s"(ka)); return ka[k];
}
#define MIX_UNPACK(u, f) do { f[0] = __uint_as_float(u.x << 16); f[1] = __uint_as_float(u.x & 0xffff0000u); f[2] = __uint_as_float(u.y << 16); f[3] = __uint_as_float(u.y & 0xffff0000u); \
    f[4] = __uint_as_float(u.z << 16); f[5] = __uint_as_float(u.z & 0xffff0000u); f[6] = __uint_as_float(u.w << 16); f[7] = __uint_as_float(u.w & 0xffff0000u); } while (0)
template <int W> __device__ __forceinline__ void mix_rows16(const bf16* Pb, bf16* CAT, int r0, int colgrp) {
    const int t0 = r0 & (SEQ - 1);
    const bf16* pp = Pb + (size_t)r0 * 512 + colgrp * 8; bf16* op = CAT + (size_t)r0 * DM + 512 + colgrp * 8;
    v4u rw[W - 1 + 16];
#pragma unroll
    for (int k = 0; k < W - 1 + 16; ++k) { const int rel = k - (W - 1); rw[k] = *(const v4u*)(pp + (ptrdiff_t)((t0 + rel >= 0) ? rel : 0) * 512); }
    float sum[8];
#pragma unroll
    for (int j = 0; j < 8; ++j) sum[j] = 0.f;
#pragma unroll
    for (int k = 0; k < W - 1; ++k) { const float m = (t0 + k - (W - 1) >= 0) ? 1.0f : 0.0f; float f[8]; MIX_UNPACK(rw[k], f);
#pragma unroll
        for (int j = 0; j < 8; ++j) sum[j] += m * f[j]; }
#pragma unroll
    for (int i = 0; i < 16; ++i) { float cur[8]; asm volatile("" : "+v"(rw[W - 1 + i]));
        MIX_UNPACK(rw[W - 1 + i], cur);
        const int t = t0 + i; const float rc = 1.0f / (float)((t + 1 < W) ? t + 1 : W); float o[8];
#pragma unroll
        for (int j = 0; j < 8; ++j) { sum[j] += cur[j]; o[j] = sum[j] * rc - cur[j]; }
        *(v4u*)(op + (size_t)i * DM) = (v4u){pk2(o[0], o[1]), pk2(o[2], o[3]), pk2(o[4], o[5]), pk2(o[6], o[7])};
        { const float m = (t + 1 - W >= 0) ? 1.0f : 0.0f; float f[8]; asm volatile("" : "+v"(rw[i])); MIX_UNPACK(rw[i], f);
#pragma unroll
            for (int j = 0; j < 8; ++j) sum[j] -= m * f[j]; } }
}

#ifdef USE_CG_SYNC
#define GSYNC() grid.sync()
#else
#define GSYNC() xcd_barrier(xbar)
#endif
#ifdef TIMING
#ifndef MASKA
#define MASKA 0
#endif
#ifndef MASKB
#define MASKB 0
#endif
#define TSTAMP(id) do { const unsigned long long t_ = __builtin_amdgcn_s_memrealtime(); const unsigned long long d_ = t_ - t_prev; t_prev = t_; if ((MASKA >> (id)) & 1) accA += d_; if ((MASKB >> (id)) & 1) accB += d_; } while (0)
#else
#define TSTAMP(id) do {} while (0)
#endif
struct Args { const float* in[20]; float* out; unsigned char* ws; };

__global__ void __launch_bounds__(NWAVES * 64, 2) fwd_megakernel(Args args) {
    extern __shared__ __attribute__((aligned(16))) unsigned char lds[];
    cg::grid_group grid = cg::this_grid();
    LAS unsigned char* const L = (LAS unsigned char*)lds;
    const int wave = __builtin_amdgcn_readfirstlane((int)threadIdx.x >> 6);
    const int G = gridDim.x, bx = blockIdx.x;
    const int vcu = (G % 8 == 0) ? (bx % 8) * (G / 8) + bx / 8 : bx;
    LAS float* const EX = (LAS float*)(L + EPIX_OFF);
    if (threadIdx.x < 2) ((LAS unsigned*)(L + XBST_OFF))[threadIdx.x] = 0u;
    __syncthreads();
    const XcdBarrier xbar = xcd_barrier_post((unsigned*)((unsigned char*)(GAS1 unsigned char*)karg(21) + WS_BAR), (volatile LAS unsigned*)(L + XBST_OFF));
#define DEFPTRS \
    int tid = threadIdx.x; asm volatile("" : "+v"(tid)); const int lane = tid & 63; (void)lane; \
    unsigned char* const ws = (unsigned char*)(GAS1 unsigned char*)karg(21); float* const out = (float*)(GAS1 float*)karg(20); (void)out; \
    bf16* const HB = (bf16*)(ws + WS_HB); bf16* const Qb = (bf16*)(ws + WS_Q); bf16* const Kb = (bf16*)(ws + WS_K); bf16* const Vb = (bf16*)(ws + WS_V); bf16* const Pb = (bf16*)(ws + WS_P); \
    bf16* const CAT = (bf16*)(ws + WS_CAT); bf16* const MQ = (bf16*)(ws + WS_MQ); bf16* const MO = (bf16*)(ws + WS_MO); bf16* const ACT = (bf16*)(ws + WS_ACT); \
    float* const LF = (float*)(ws + WS_LF); float* const NC2 = (float*)(ws + WS_NC2); float* const SSQ = (float*)(ws + WS_SSQ); \
    bf16* const MN = (bf16*)(ws + WS_MN); bf16* const MK = (bf16*)(ws + WS_MK); bf16* const MVT = (bf16*)(ws + WS_MVT); \
    (void)HB; (void)Qb; (void)Kb; (void)Vb; (void)Pb; (void)CAT; (void)MQ; (void)MO; (void)ACT; (void)LF; (void)NC2; (void)SSQ; (void)MN; (void)MK; (void)MVT;
#define IN(k) ((const float*)(GAS1 const float*)karg(k))

#ifdef TIMING
    unsigned long long t_prev = __builtin_amdgcn_s_memrealtime(), accA = 0, accB = 0;
#endif
    if constexpr ((PHMASK >> 0) & 1) { DEFPTRS
        LAS float* scr = (LAS float*)(L + wave * 16640);
        const int gw = vcu * NWAVES + wave, NGW = G * NWAVES;
        constexpr int I_IN = 16 * 36, I_OUT = 8 * 16, I_MQ = 16 * 8, I_MKV = 16 * 16, I_MO = 8 * 16, I_GU = 16 * 88, I_D = 44 * 16, I_L = I_IN + I_OUT + I_MQ + I_MKV + I_MO + I_GU + I_D;
        for (int it = gw; it < DEPTH * I_L; it += NGW) {
            const int l = it / I_L; int r = it % I_L; unsigned char* wl = ws + WS_W + (size_t)l * WS_WSTRIDE;
            if (r < I_IN) { const int kb = r / 36, nb = r % 36; tr_item(IN(3) + (size_t)l * DM * NIN, NIN, 64 * kb, 64 * nb, IN(2) + l * DM, (bf16*)(wl + WO_IN), DM, 64 * nb, scr, lane); continue; } r -= I_IN;
            if (r < I_OUT) { const int kb = r / 16, nb = r % 16; tr_item(IN(9) + (size_t)l * DM * DM, DM, 64 * kb, 64 * nb, nullptr, (bf16*)(wl + WO_OUT), DM, 64 * nb, scr, lane); continue; } r -= I_OUT;
            if (r < I_MQ) { const int kb = r / 8, nb = r % 8; tr_item(IN(12) + (size_t)l * DM * 512, 512, 64 * kb, 64 * nb, IN(10) + l * DM, (bf16*)(wl + WO_MQ), DM, 64 * nb, scr, lane); continue; } r -= I_MQ;
            if (r < I_MKV) { const int kb = r / 16, nb = r % 16; tr_item(IN(13) + (size_t)l * DM * 1024, 1024, 64 * kb, 64 * nb, nullptr, (bf16*)(wl + WO_MKV), DM, 64 * nb, scr, lane); continue; } r -= I_MKV;
            if (r < I_MO) { const int kb = r / 16, nb = r % 16; tr_item(IN(16) + (size_t)l * 512 * DM, DM, 64 * kb, 64 * nb, nullptr, (bf16*)(wl + WO_MO), 512, 64 * nb, scr, lane); continue; } r -= I_MO;
            if (r < I_GU) { const int kb = r / 88, nb = r % 88; const int n0 = 64 * nb; const int drow = (n0 < DFF) ? (n0 / 128) * 256 + (n0 % 128) : ((n0 - DFF) / 128) * 256 + 128 + ((n0 - DFF) % 128);
                tr_item(IN(18) + (size_t)l * DM * 2 * DFF, 2 * DFF, 64 * kb, n0, IN(17) + l * DM, (bf16*)(wl + WO_GU), DM, drow, scr, lane); continue; } r -= I_GU;
            { const int kb = r / 16, nb = r % 16; tr_item(IN(19) + (size_t)l * DFF * DM, DM, 64 * kb, 64 * nb, nullptr, (bf16*)(wl + WO_D), DFF, 64 * nb, scr, lane); }
        }
        if (bx == 0 && tid < DEPTH * 8) ((unsigned*)(ws + WS_QCNT))[tid * 64] = 0u;
        for (int tw = __builtin_amdgcn_readfirstlane(bx * 8 + wave); tw < DEPTH * 64 * 16; tw += G * 8) {
            const int l = tw / 1024, rem = tw % 1024, kc8 = rem >> 4, n = (rem & 15) * 64 + lane, g = kc8 >> 4, c0 = (kc8 & 15) * 8;
            const float* wp = IN(7) + ((size_t)(l * 4 + g) * 128 + c0) * 128; const float* ps = IN(8) + l * 512 + g * 128; const float* wo = IN(9) + (size_t)l * DM * DM + (size_t)(512 + g * 128) * DM + n;
            float a[8];
#pragma unroll
            for (int j = 0; j < 8; ++j) a[j] = 0.f;
#pragma unroll 8
            for (int d = 0; d < 128; ++d) { const float wv = wo[(size_t)d * DM] * ps[d];
#pragma unroll
                for (int j = 0; j < 8; ++j) a[j] += wp[j * 128 + d] * wv; }
            *(v4u*)((bf16*)(ws + WS_W + (size_t)l * WS_WSTRIDE + WO_OUT) + (size_t)n * DM + 512 + g * 128 + c0) = (v4u){pk2(a[0], a[1]), pk2(a[2], a[3]), pk2(a[4], a[5]), pk2(a[6], a[7])};
        }
        {
            f32x4 wf[4][4][2];
#pragma unroll
            for (int j = 0; j < 4; ++j)
#pragma unroll
                for (int c = 0; c < 4; ++c) { const int k = 256 * j + 4 * lane + c; const float gk = IN(2)[k]; const float* wr = IN(3) + (size_t)k * NIN + 2048;
                    wf[j][c][0] = *(const f32x4*)wr * gk; wf[j][c][1] = *(const f32x4*)(wr + 4) * gk; }
            const float bfo = IN(4)[lane & 7];
        for (int m0 = gw * 4; m0 < MTOK; m0 += NGW * 4) {
            f32x4 v[4][4]; float sq[4];
#pragma unroll
            for (int r = 0; r < 4; ++r) { const f32x4* xr = (const f32x4*)(IN(0) + (size_t)(m0 + r) * DM) + lane;
#pragma unroll
                for (int j = 0; j < 4; ++j) v[r][j] = __builtin_nontemporal_load(xr + 64 * j); }
#pragma unroll
            for (int r = 0; r < 4; ++r) { float s = 0.f;
#pragma unroll
                for (int j = 0; j < 4; ++j) s += (v[r][j].x * v[r][j].x + v[r][j].y * v[r][j].y) + (v[r][j].z * v[r][j].z + v[r][j].w * v[r][j].w);
                sq[r] = wave_sum(s); }
#pragma unroll
            for (int r = 0; r < 4; ++r) { v2u* o8 = (v2u*)(HB + (size_t)(m0 + r) * DM) + lane;
#pragma unroll
                for (int j = 0; j < 4; ++j) o8[64 * j] = (v2u){pk2(v[r][j].x, v[r][j].y), pk2(v[r][j].z, v[r][j].w)};
                if (lane < 16) SSQ[(size_t)(m0 + r) * 16 + lane] = (lane == 0) ? sq[r] : 0.f;
                f32x4 d0 = (f32x4){0.f, 0.f, 0.f, 0.f}, d1 = d0;
#pragma unroll
                for (int j = 0; j < 4; ++j) { d0 += wf[j][0][0] * v[r][j].x + wf[j][1][0] * v[r][j].y + wf[j][2][0] * v[r][j].z + wf[j][3][0] * v[r][j].w;
                                              d1 += wf[j][0][1] * v[r][j].x + wf[j][1][1] * v[r][j].y + wf[j][2][1] * v[r][j].z + wf[j][3][1] * v[r][j].w; }
                float f8[8] = {d0.x, d0.y, d0.z, d0.w, d1.x, d1.y, d1.z, d1.w};
#pragma unroll
                for (int o = 0; o < 8; ++o) f8[o] = wave_sum(f8[o]);
                float mine = f8[0];
#pragma unroll
                for (int o = 1; o < 8; ++o) mine = ((lane & 7) == o) ? f8[o] : mine;
                const float rstd = __builtin_amdgcn_rsqf(sq[r] * (1.0f / DM) + EPS);
                if (lane < 8) LF[(size_t)(m0 + r) * 8 + lane] = pg8::log2sigmoid(mine * rstd + bfo); }
        }
        }
        for (int m = gw; m < DEPTH * BATCH * MEMLEN; m += NGW) {
            const int l = m / (BATCH * MEMLEN), rr = m % (BATCH * MEMLEN);
            const f32x4* xr = (const f32x4*)(IN(1) + (size_t)rr * DM) + lane; const f32x4* gr = (const f32x4*)(IN(11) + l * DM) + lane; f32x4 v[4]; float s = 0.f;
#pragma unroll
            for (int j = 0; j < 4; ++j) { v[j] = xr[64 * j]; s += (v[j].x * v[j].x + v[j].y * v[j].y) + (v[j].z * v[j].z + v[j].w * v[j].w); }
            const float rstd = 1.0f / sqrtf(wave_sum(s) * (1.0f / DM) + EPS);
            v2u* o8 = (v2u*)(MN + (size_t)m * DM) + lane;
#pragma unroll
            for (int j = 0; j < 4; ++j) { const f32x4 gg = gr[64 * j]; o8[64 * j] = (v2u){pk2(v[j].x * rstd * gg.x, v[j].y * rstd * gg.y), pk2(v[j].z * rstd * gg.z, v[j].w * rstd * gg.w)}; }
        }
    }
    grid.sync();
    TSTAMP(0);

    for (int l = 0; l < DEPTH; ++l) {
        if constexpr ((PHMASK >> 1) & 1) { DEFPTRS
            const int nin = 2048;
            if (l > 0) {
                const float* FPb = (const float*)(ws + WS_FP); const float* bfp = IN(4) + l * 8;
                for (int row = bx * 512 + tid; row < MTOK; row += G * 512) {
                    const f32x4* p = (const f32x4*)(FPb + (size_t)row * 128); f32x4 a0 = p[0], a1 = p[1];
#pragma unroll
                    for (int si = 1; si < 16; ++si) { a0 += p[2 * si]; a1 += p[2 * si + 1]; }
                    const float rs = pg8::rstd_row(SSQ, row); const f32x4 b0 = *(const f32x4*)bfp, b1 = *(const f32x4*)(bfp + 4);
                    const f32x4 z0 = a0 * rs + b0, z1 = a1 * rs + b1;
                    *(f32x4*)(LF + (size_t)row * 8) = (f32x4){pg8::log2sigmoid(z0[0]), pg8::log2sigmoid(z0[1]), pg8::log2sigmoid(z0[2]), pg8::log2sigmoid(z0[3])};
                    *(f32x4*)(LF + (size_t)row * 8 + 4) = (f32x4){pg8::log2sigmoid(z1[0]), pg8::log2sigmoid(z1[1]), pg8::log2sigmoid(z1[2]), pg8::log2sigmoid(z1[3])};
                }
            }
            pg8::Gemm g{HB, (const bf16*)(ws + WS_W + (size_t)l * WS_WSTRIDE + WO_IN), MTOK, nin, DM}; pg8::StaticOrder S; S.init(MTOK, nin, G, bx);
            pg8::EpiInProj E{SSQ, Qb, Kb, Vb, Pb, LF, IN(5) + l * 64, IN(6) + l * 64, IN(4) + l * 8, EX, 0.125f * pg8::LOG2E, -1};
            pg8::gemm_phase<pg8::EpiInProj, pg8::StaticOrder, true, true>(L, g, S, E);
#ifdef EXP_DUP_G1
            pg8::gemm_phase<pg8::EpiInProj, pg8::StaticOrder, true, true>(L, g, S, E);
#endif
        }
        GSYNC(); TSTAMP(1);
        if constexpr ((PHMASK >> 2) & 1) { DEFPTRS
            if (bx < 64) {
                const int b = bx >> 3, h = bx & 7; const float* src = LF + ((size_t)b * SEQ + tid * 16) * 8 + h; float v[16]; float s = 0.f;
#pragma unroll
                for (int j = 0; j < 16; ++j) { s += src[j * 8]; v[j] = s; }
                LAS float* sc = (LAS float*)L; sc[tid] = s; __syncthreads();
                for (int off = 1; off < 512; off <<= 1) { const float t = (tid >= off) ? sc[tid - off] : 0.f; __syncthreads(); sc[tid] += t; __syncthreads(); }
                const float excl = sc[tid] - s; float* dst = NC2 + (size_t)bx * SEQ + tid * 16; LAS float* ncl = (LAS float*)(L + 4096) + tid * 16;
#pragma unroll
                for (int j = 0; j < 16; j += 4) { const f32x4 nv = (f32x4){-(excl + v[j]), -(excl + v[j + 1]), -(excl + v[j + 2]), -(excl + v[j + 3])}; *(f32x4*)(dst + j) = nv; *(LAS f32x4*)(ncl + j) = nv; }
                __syncthreads();
                if (tid < 32) {
                    float gq = 0.f, gk = 0.f; const float* gqp = IN(5) + l * 64; const float* gkp = IN(6) + l * 64;
                    for (int d = 0; d < 64; ++d) { gq = fmaxf(gq, fabsf(gqp[d])); gk = fmaxf(gk, fabsf(gkp[d])); }
                    const float thresh = 2.0f * (64.0f * gq * gk * 0.125f * pg8::LOG2E) + 20.0f;
                    const LAS float* nc = (const LAS float*)(L + 4096); const float ref = nc[256 * tid]; int t = 0;
                    while (t < 4 * tid && ref - nc[64 * t + 63] > thresh) ++t;
                    ((int*)(ws + WS_TS))[bx * 32 + tid] = t & ~1;
                }
                __syncthreads();
            } else if (l == 0 && bx < 128) {
                const int l2 = (bx - 64) >> 5;
                pg8::Gemm g{MN + (size_t)l2 * BATCH * MEMLEN * DM, (const bf16*)(ws + WS_W + (size_t)l2 * WS_WSTRIDE + WO_MKV), BATCH * MEMLEN, 1024, DM};
                pg8::RangeOrder S{4, 64 + 32 * l2, 32, bx};
                pg8::EpiHead128<1> E{nullptr, MK + (size_t)l2 * BATCH * 4 * MEMLEN * 128, MVT + (size_t)l2 * BATCH * 4 * MEMLEN * 128, IN(15) + l2 * 128, EX, 1.0f};
                pg8::gemm_phase<pg8::EpiHead128<1>, pg8::RangeOrder, true, true>(L, g, S, E);
            }
            for (int T = bx * 512 + tid; T < (MTOK / 16) * 64; T += G * 512) {
                const int wv = T >> 6, g = __builtin_amdgcn_readfirstlane(wv & 3), r0 = ((wv >> 2) * 4 + (lane >> 4)) * 16, colgrp = g * 16 + (lane & 15);
                if (g == 0) mix_rows16<2>(Pb, CAT, r0, colgrp); else if (g == 1) mix_rows16<4>(Pb, CAT, r0, colgrp); else if (g == 2) mix_rows16<8>(Pb, CAT, r0, colgrp); else mix_rows16<16>(Pb, CAT, r0, colgrp);
            }
        }
        GSYNC(); TSTAMP(2);
        if constexpr ((PHMASK >> 3) & 1) { DEFPTRS
            const attn_body::AttnTensors AT{(const attn_body::bf16*)Qb, (const attn_body::bf16*)Kb, (const attn_body::bf16*)Vb, (attn_body::bf16*)CAT, NC2, (const int*)(ws + WS_TS)};
            { const int* tsg = (const int*)(ws + WS_TS); LAS int* tsl = (LAS int*)(L + attn_body::LDS_TSL); for (int i = tid; i < 2048; i += 512) tsl[i] = tsg[i]; }
            const attn_body::QueueOrder S{(unsigned*)(ws + WS_QCNT) + (l * 8 + (bx & 7)) * 64, (volatile LAS unsigned*)(L + attn_body::ATTN_LDS_BYTES), 0u, bx & 7};
            attn_body::attn_phase<attn_body::QueueOrder, 20>((char*)lds, AT, S);
        }
        GSYNC(); TSTAMP(3);
        if constexpr ((PHMASK >> 4) & 1) { DEFPTRS
            pg8::Gemm g{CAT, (const bf16*)(ws + WS_W + (size_t)l * WS_WSTRIDE + WO_OUT), MTOK, DM, DM}; pg8::StaticOrder S; S.init(MTOK, DM, G, bx);
            pg8::EpiResid E{nullptr, nullptr, HB, SSQ, nullptr, nullptr};
            pg8::gemm_phase<pg8::EpiResid, pg8::StaticOrder, false, true>(L, g, S, E);
        }
        GSYNC(); TSTAMP(4);
        if constexpr ((PHMASK >> 5) & 1) { DEFPTRS
            pg8::Gemm g{HB, (const bf16*)(ws + WS_W + (size_t)l * WS_WSTRIDE + WO_MQ), MTOK, 512, DM}; pg8::StaticOrder S; S.init(MTOK, 512, G, bx);
            pg8::EpiHead128<0> E{SSQ, MQ, nullptr, IN(14) + l * 128, EX, 0.08838834764831845f * pg8::LOG2E};
            pg8::gemm_phase<pg8::EpiHead128<0>, pg8::StaticOrder, true, true>(L, g, S, E);
#ifdef EXP_DUP_G3
            pg8::gemm_phase<pg8::EpiHead128<0>, pg8::StaticOrder, true, true>(L, g, S, E);
#endif
        }
        GSYNC(); TSTAMP(5);
        if constexpr ((PHMASK >> 6) & 1) { DEFPTRS
            const int bh = vcu >> 3, b = bh >> 2, h = bh & 3;
            if (bh < BATCH * 4) {
                xat::load_kv(MK + ((size_t)l * BATCH * 4 + bh) * MEMLEN * 128, MVT + ((size_t)l * BATCH * 4 + bh) * MEMLEN * 128, L, tid);
                __syncthreads();
                for (int i = 0; i < 4; ++i) xat::unit(MQ, MO, b, h, (vcu & 7) * 4 + i, L);
                __syncthreads();
            }
        }
        GSYNC(); TSTAMP(6);
        if constexpr ((PHMASK >> 7) & 1) { DEFPTRS
            pg8::Gemm g{MO, (const bf16*)(ws + WS_W + (size_t)l * WS_WSTRIDE + WO_MO), MTOK, DM, 512}; pg8::StaticOrder S; S.init(MTOK, DM, G, bx);
            pg8::EpiResid E{nullptr, nullptr, HB, SSQ, nullptr, nullptr};
            pg8::gemm_phase<pg8::EpiResid, pg8::StaticOrder, false, true>(L, g, S, E);
        }
        GSYNC(); TSTAMP(7);
        if constexpr ((PHMASK >> 8) & 1) { DEFPTRS
            pg8::Gemm g{HB, (const bf16*)(ws + WS_W + (size_t)l * WS_WSTRIDE + WO_GU), MTOK, 2 * DFF, DM}; pg8::StaticOrder S; S.init(MTOK, 2 * DFF, G, bx);
            pg8::EpiSwiglu E{SSQ, ACT, EX, -1};
            pg8::gemm_phase<pg8::EpiSwiglu, pg8::StaticOrder, true, true>(L, g, S, E);
        }
        GSYNC(); TSTAMP(8);
        if constexpr ((PHMASK >> 9) & 1) { DEFPTRS
            pg8::Gemm g{ACT, (const bf16*)(ws + WS_W + (size_t)l * WS_WSTRIDE + WO_D), MTOK, DM, DFF}; pg8::StaticOrder S; S.init(MTOK, DM, G, bx);
            pg8::EpiResid E{nullptr, (l == DEPTH - 1) ? out : nullptr, HB, SSQ, (l + 1 < DEPTH) ? (const bf16*)(ws + WS_W + (size_t)(l + 1) * WS_WSTRIDE + WO_IN) + (size_t)2048 * DM : nullptr, (float*)(ws + WS_FP)};
            pg8::gemm_phase<pg8::EpiResid, pg8::StaticOrder, false, true>(L, g, S, E);
        }
#ifdef TIMING
        GSYNC(); TSTAMP(9);
#else
        if (l + 1 < DEPTH) GSYNC();
#endif
    }
#ifdef TIMING
    {
        DEFPTRS
#ifdef TIMING_CAL
        const unsigned long long n = 1000000ull;
#else
        const unsigned long long n = (accA / 400ull) + 1000ull * (accB / 400ull);
#endif
        if (bx == 0) for (unsigned long long i = tid; i < n; i += 512) out[i] += 0.125f;
    }
#endif
}

extern "C" void kernel_launch(void* const* d_in, const int* in_sizes, int n_in, void* d_out, int out_size, void* d_ws, size_t ws_size, hipStream_t stream) {
    static int grid = 0;
    if (grid == 0) {
        if (n_in != 20 || out_size != MTOK * DM || ws_size < WS_END) { fprintf(stderr, "kernel_launch: unexpected shapes (n_in %d, out %d, ws %zu)\n", n_in, out_size, ws_size); grid = -1; return; }
        int dev = 0, cus = 0, per_cu = 0;
        if (hipGetDevice(&dev) != hipSuccess || hipDeviceGetAttribute(&cus, hipDeviceAttributeMultiprocessorCount, dev) != hipSuccess) { grid = -1; return; }
        if (hipFuncSetAttribute((const void*)fwd_megakernel, hipFuncAttributeMaxDynamicSharedMemorySize, LDS_BYTES) != hipSuccess) { fprintf(stderr, "kernel_launch: hipFuncSetAttribute failed\n"); grid = -1; return; }
        if (hipOccupancyMaxActiveBlocksPerMultiprocessor(&per_cu, (const void*)fwd_megakernel, NWAVES * 64, LDS_BYTES) != hipSuccess || per_cu < 1) { fprintf(stderr, "kernel_launch: occupancy query says %d\n", per_cu); per_cu = 1; }
        (void)hipGetLastError();
        grid = cus * 1;
        if (grid != 256) fprintf(stderr, "kernel_launch: %d CUs; the unit orders assume 256\n", grid);
    }
    if (grid < 0) return;
    if (hipMemsetAsync((char*)d_ws + WS_BAR, 0, WS_BAR_BYTES, stream) != hipSuccess) { fprintf(stderr, "kernel_launch: hipMemsetAsync failed\n"); return; }
    Args a{};
    for (int i = 0; i < 20; ++i) a.in[i] = (const float*)d_in[i];
    a.out = (float*)d_out; a.ws = (unsigned char*)d_ws;
    void* kargs[] = {&a};
    hipError_t e = hipLaunchCooperativeKernel((const void*)fwd_megakernel, dim3(grid), dim3(NWAVES * 64), kargs, LDS_BYTES, stream);
    if (e != hipSuccess) fprintf(stderr, "kernel_launch: cooperative launch failed: %s (grid %d)\n", hipGetErrorString(e), grid);
}
```
